# Optimizing an MI355X kernel written in HIP

```python
import math
import jax, jax.numpy as jnp
from jax import lax
import numpy as np

D_MODEL = 1024
BATCH = 8
SEQ = 4096
DEPTH = 1

D_MIX = D_MODEL
DN_WIDTH = D_MIX // 2
DN_HEADS = 4
DN_HEAD_DIM = DN_WIDTH // DN_HEADS
CONV_K = 4
DN_CHUNK = 64
SGU_WIDTH = D_MIX - DN_WIDTH
SGU_GROUPS = 4
SGU_GROUP_DIM = SGU_WIDTH // SGU_GROUPS
SGU_CHUNK = 128
IN_COLS = 4 * DN_WIDTH + 2 * DN_HEADS + 2 * SGU_WIDTH
MOE_GROUPS = 8
EXPERTS_PER_GROUP = 8
N_EXPERTS = MOE_GROUPS * EXPERTS_PER_GROUP
TOP_K = 2
D_EXPERT = D_MODEL // 2
MOE_BLOCK = 128
DEEPNORM_ALPHA = (2.0 * DEPTH) ** 0.25
DEEPNORM_BETA = (8.0 * DEPTH) ** -0.25
LN_EPS = 1e-5
RMS_EPS = 1e-6

kernel_name = "hybrid_deltanet_sgu_hmoe_deepnorm"


def _layernorm(x, g, b):
    xf = x.astype(jnp.float32)
    mu = jnp.mean(xf, axis=-1, keepdims=True)
    xc = xf - mu
    var = jnp.mean(xc * xc, axis=-1, keepdims=True)
    return (xc * lax.rsqrt(var + LN_EPS) * g + b).astype(x.dtype)


def _l2norm(x):
    return x * lax.rsqrt(jnp.sum(x * x, axis=-1, keepdims=True) + RMS_EPS)


def _causal_conv_silu(x, w):
    y = lax.conv_general_dilated(
        x, w[:, None, :], window_strides=(1,), padding=[(CONV_K - 1, 0)],
        dimension_numbers=("NWC", "WIO", "NWC"), feature_group_count=x.shape[-1])
    return jax.nn.silu(y)


def _chunked_gated_delta_rule(q, k, v, g, beta):
    B, T, H, dk = q.shape
    dv = v.shape[-1]
    C = DN_CHUNK
    NC = T // C

    def to_chunks(t):
        return t.reshape(B, NC, C, H, t.shape[-1]).transpose(0, 3, 1, 2, 4)

    q, k, v = to_chunks(q), to_chunks(k), to_chunks(v)
    g = g.reshape(B, NC, C, H).transpose(0, 3, 1, 2)
    beta = beta.reshape(B, NC, C, H).transpose(0, 3, 1, 2)
    gc = jnp.cumsum(g, axis=-1)

    pos = jnp.arange(C)
    causal = pos[:, None] >= pos[None, :]
    strict = pos[:, None] > pos[None, :]
    decay = jnp.exp(jnp.where(causal, gc[..., :, None] - gc[..., None, :], -jnp.inf))

    kb = k * beta[..., None]
    kkt = jnp.einsum("bhnid,bhnjd->bhnij", kb, k) * decay
    a_mat = jnp.eye(C, dtype=jnp.float32) + jnp.where(strict, kkt, 0.0)
    rhs = jnp.concatenate([v * beta[..., None], kb * jnp.exp(gc)[..., None]], axis=-1)
    sol = lax.linalg.triangular_solve(a_mat, rhs, left_side=True, lower=True, unit_diagonal=True)
    u_vals, w_dec = sol[..., :dv], sol[..., dv:]

    qk_intra = jnp.einsum("bhnid,bhnjd->bhnij", q, k) * decay
    q_dec = q * jnp.exp(gc)[..., None]
    k_dec = k * jnp.exp(gc[..., -1:] - gc)[..., None]
    g_last = jnp.exp(gc[..., -1])

    xs = tuple(jnp.moveaxis(t, 2, 0) for t in (q_dec, k_dec, u_vals, w_dec, qk_intra, g_last))

    def step(S, inp):
        qd, kd, u, w, a_intra, gl = inp
        v_new = u - jnp.einsum("bhck,bhkv->bhcv", w, S)
        o = jnp.einsum("bhck,bhkv->bhcv", qd, S) + jnp.einsum("bhij,bhjv->bhiv", a_intra, v_new)
        S = S * gl[..., None, None] + jnp.einsum("bhck,bhcv->bhkv", kd, v_new)
        return S, o

    S0 = jnp.zeros((B, H, dk, dv), jnp.float32)
    _, o = lax.scan(step, S0, xs)
    return o.transpose(1, 0, 3, 2, 4).reshape(B, T, H, dv)


def _gated_deltanet(qkv, z, b_raw, a_raw, conv_w, a_log, dt_bias, norm_w):
    B, T, _ = qkv.shape
    qkv = _causal_conv_silu(qkv.astype(jnp.float32), conv_w.astype(jnp.float32))
    q, k, v = jnp.split(qkv, 3, axis=-1)
    q = _l2norm(q.reshape(B, T, DN_HEADS, DN_HEAD_DIM)) * (DN_HEAD_DIM ** -0.5)
    k = _l2norm(k.reshape(B, T, DN_HEADS, DN_HEAD_DIM))
    v = v.reshape(B, T, DN_HEADS, DN_HEAD_DIM)
    beta = jax.nn.sigmoid(b_raw.astype(jnp.float32))
    g = -jnp.exp(a_log.astype(jnp.float32)) * jax.nn.softplus(a_raw.astype(jnp.float32) + dt_bias.astype(jnp.float32))
    o = _chunked_gated_delta_rule(q, k, v, g, beta)
    zf = z.astype(jnp.float32).reshape(B, T, DN_HEADS, DN_HEAD_DIM)
    o = o * lax.rsqrt(jnp.mean(o * o, axis=-1, keepdims=True) + RMS_EPS) * norm_w * jax.nn.silu(zf)
    return o.reshape(B, T, DN_WIDTH)


def _spatial_gating(u, v, ln_g, ln_b, w_spatial, b_spatial):
    B, T, _ = u.shape
    n_chunks = T // SGU_CHUNK
    u = jax.nn.gelu(u)
    v = jax.nn.gelu(v).reshape(B, n_chunks, SGU_CHUNK, SGU_GROUPS, SGU_GROUP_DIM)
    v = _layernorm(v, ln_g.reshape(SGU_GROUPS, SGU_GROUP_DIM), ln_b.reshape(SGU_GROUPS, SGU_GROUP_DIM))
    mask = jnp.tril(jnp.ones((SGU_CHUNK, SGU_CHUNK), dtype=bool))
    ws = jnp.where(mask, w_spatial, 0.0).astype(v.dtype)
    mixed = jnp.einsum("gts,bnsgd->bntgd", ws, v) + b_spatial.T[None, None, :, :, None].astype(v.dtype)
    return u * mixed.reshape(B, T, SGU_WIDTH)


def _mixer(h, w_in, conv_w, a_log, dt_bias, dn_norm_w, sgu_ln_g, sgu_ln_b, w_spatial, b_spatial, w_out):
    proj = h @ w_in
    splits = [3 * DN_WIDTH, 4 * DN_WIDTH, 4 * DN_WIDTH + DN_HEADS,
              4 * DN_WIDTH + 2 * DN_HEADS, 4 * DN_WIDTH + 2 * DN_HEADS + SGU_WIDTH]
    qkv, z, b_raw, a_raw, u, v = jnp.split(proj, splits, axis=-1)
    y_dn = _gated_deltanet(qkv, z, b_raw, a_raw, conv_w, a_log, dt_bias, dn_norm_w).astype(h.dtype)
    y_sgu = _spatial_gating(u, v, sgu_ln_g, sgu_ln_b, w_spatial, b_spatial)
    return jnp.concatenate([y_dn, y_sgu], axis=-1) @ w_out


def _hierarchical_moe(h, w_rg, b_rg, w_re, b_re, w_gate, w_up, w_down):
    B, T, D = h.shape
    xf = h.reshape(B * T, D)
    N = xf.shape[0]
    group_logits = (xf @ w_rg).astype(jnp.float32) + b_rg.astype(jnp.float32)
    g_idx = jnp.argmax(group_logits, axis=-1)
    p_group = jnp.take_along_axis(jax.nn.softmax(group_logits, axis=-1), g_idx[:, None], axis=-1)
    exp_logits = ((xf @ w_re).astype(jnp.float32) + b_re.astype(jnp.float32)).reshape(N, MOE_GROUPS, EXPERTS_PER_GROUP)
    within = jnp.take_along_axis(exp_logits, g_idx[:, None, None], axis=1)[:, 0]
    top_vals, top_idx = lax.top_k(within, TOP_K)
    weights = p_group * jax.nn.softmax(top_vals, axis=-1)
    expert_ids = g_idx[:, None] * EXPERTS_PER_GROUP + top_idx

    A = N * TOP_K
    e_flat = expert_ids.reshape(A).astype(jnp.int32)
    tok_flat = jnp.repeat(jnp.arange(N, dtype=jnp.int32), TOP_K)
    w_flat = weights.reshape(A)
    order = jnp.argsort(e_flat)
    e_sorted, tok_sorted, w_sorted = e_flat[order], tok_flat[order], w_flat[order]
    counts = jnp.zeros((N_EXPERTS,), jnp.int32).at[e_flat].add(1)
    padded = ((counts + MOE_BLOCK - 1) // MOE_BLOCK) * MOE_BLOCK
    starts = jnp.cumsum(counts) - counts
    pends = jnp.cumsum(padded)
    pstarts = pends - padded
    dest = pstarts[e_sorted] + (jnp.arange(A, dtype=jnp.int32) - starts[e_sorted])
    P = (-(-A // MOE_BLOCK)) * MOE_BLOCK + N_EXPERTS * MOE_BLOCK
    NB = P // MOE_BLOCK
    row_tok = jnp.full((P,), N, jnp.int32).at[dest].set(tok_sorted)
    row_w = jnp.zeros((P,), h.dtype).at[dest].set(w_sorted.astype(h.dtype))
    block_start = jnp.arange(NB, dtype=jnp.int32) * MOE_BLOCK
    block_e = jnp.minimum(jnp.searchsorted(pends, block_start, side="right"), N_EXPERTS - 1)

    x_pad = jnp.concatenate([xf, jnp.zeros((1, D), xf.dtype)], axis=0)
    xs = x_pad[row_tok].reshape(NB, MOE_BLOCK, D)

    def expert_block(args):
        xb, e = args
        hid = jax.nn.silu(xb @ w_gate[e]) * (xb @ w_up[e])
        return hid @ w_down[e]

    ys = lax.map(expert_block, (xs, block_e)).reshape(P, D) * row_w[:, None]
    out = jnp.zeros((N + 1, D), h.dtype).at[row_tok].add(ys)[:N]
    return out.reshape(B, T, D)


def setup_inputs(seed: int = 0) -> dict:
    key = jax.random.key(seed)
    ks = jax.random.split(key, 24)
    f32 = jnp.float32
    L = DEPTH

    def nrm(k, shape, scale):
        return jax.random.normal(k, shape, f32) * scale

    x = jax.random.normal(ks[0], (BATCH, SEQ, D_MODEL), f32)
    w_in = nrm(ks[1], (L, D_MODEL, IN_COLS), D_MODEL ** -0.5)
    conv_w = nrm(ks[2], (L, CONV_K, 3 * DN_WIDTH), CONV_K ** -0.5)
    a_log = jnp.log(jax.random.uniform(ks[3], (L, DN_HEADS), f32, 1.0, 16.0))
    dt = jnp.exp(jax.random.uniform(ks[4], (L, DN_HEADS), f32, math.log(1e-3), math.log(1e-1)))
    dt_bias = dt + jnp.log(-jnp.expm1(-dt))
    dn_norm_w = 1.0 + nrm(ks[5], (L, DN_HEAD_DIM), 0.02)
    sgu_ln_g = 1.0 + nrm(ks[6], (L, SGU_WIDTH), 0.02)
    sgu_ln_b = nrm(ks[7], (L, SGU_WIDTH), 0.02)
    tri = jnp.tril(jnp.ones((SGU_CHUNK, SGU_CHUNK), f32))
    w_spatial = nrm(ks[8], (L, SGU_GROUPS, SGU_CHUNK, SGU_CHUNK), SGU_CHUNK ** -0.5) * tri
    b_spatial = 1.0 + nrm(ks[9], (L, SGU_GROUPS, SGU_CHUNK), 0.02)
    w_out = nrm(ks[10], (L, D_MIX, D_MODEL), DEEPNORM_BETA * D_MIX ** -0.5)
    ln1_g = 1.0 + nrm(ks[11], (L, D_MODEL), 0.02)
    ln1_b = nrm(ks[12], (L, D_MODEL), 0.02)
    w_router_group = nrm(ks[13], (L, D_MODEL, MOE_GROUPS), D_MODEL ** -0.5)
    b_router_group = nrm(ks[14], (L, MOE_GROUPS), 0.01)
    w_router_expert = nrm(ks[15], (L, D_MODEL, N_EXPERTS), D_MODEL ** -0.5)
    b_router_expert = nrm(ks[16], (L, N_EXPERTS), 0.01)
    w_gate = nrm(ks[17], (L, N_EXPERTS, D_MODEL, D_EXPERT), D_MODEL ** -0.5)
    w_up = nrm(ks[18], (L, N_EXPERTS, D_MODEL, D_EXPERT), D_MODEL ** -0.5)
    w_down = nrm(ks[19], (L, N_EXPERTS, D_EXPERT, D_MODEL), DEEPNORM_BETA * D_EXPERT ** -0.5)
    ln2_g = 1.0 + nrm(ks[20], (L, D_MODEL), 0.02)
    ln2_b = nrm(ks[21], (L, D_MODEL), 0.02)
    return {"x": x, "w_in": w_in, "conv_w": conv_w, "a_log": a_log, "dt_bias": dt_bias,
            "dn_norm_w": dn_norm_w, "sgu_ln_g": sgu_ln_g, "sgu_ln_b": sgu_ln_b,
            "w_spatial": w_spatial, "b_spatial": b_spatial, "w_out": w_out,
            "ln1_g": ln1_g, "ln1_b": ln1_b,
            "w_router_group": w_router_group, "b_router_group": b_router_group,
            "w_router_expert": w_router_expert, "b_router_expert": b_router_expert,
            "w_gate": w_gate, "w_up": w_up, "w_down": w_down,
            "ln2_g": ln2_g, "ln2_b": ln2_b}


def reference(x, w_in, conv_w, a_log, dt_bias, dn_norm_w, sgu_ln_g, sgu_ln_b, w_spatial, b_spatial,
              w_out, ln1_g, ln1_b, w_router_group, b_router_group, w_router_expert, b_router_expert,
              w_gate, w_up, w_down, ln2_g, ln2_b):
    h = x
    for l in range(DEPTH):
        mix = _mixer(h, w_in[l], conv_w[l], a_log[l], dt_bias[l], dn_norm_w[l], sgu_ln_g[l], sgu_ln_b[l],
                     w_spatial[l], b_spatial[l], w_out[l])
        h = _layernorm(DEEPNORM_ALPHA * h + mix, ln1_g[l], ln1_b[l])
        ffn = _hierarchical_moe(h, w_router_group[l], b_router_group[l], w_router_expert[l], b_router_expert[l],
                                w_gate[l], w_up[l], w_down[l])
        h = _layernorm(DEEPNORM_ALPHA * h + ffn, ln2_g[l], ln2_b[l])
    return h
```

```cpp
#include <hip/hip_runtime.h>
#include <math.h>
#ifndef BATCH
#define BATCH 8
#endif
#ifndef SEQ
#define SEQ 4096
#endif
#ifndef D_MODEL
#define D_MODEL 1024
#endif
#ifdef HOST_EMU
#define KFN static inline
#else
#define KFN __device__ __forceinline__
#endif

namespace nv {
constexpr int B_ = BATCH, T_ = SEQ, D_ = D_MODEL;
constexpr int DNW = D_ / 2, H_ = 4, HD = DNW / H_, CK = 4;
constexpr int SGW = D_ - DNW, G_ = 4, GD = SGW / G_, SC = 128;
constexpr int INC = 4 * DNW + 2 * H_ + 2 * SGW;
constexpr int C_Z = 3 * DNW, C_B = 4 * DNW, C_A = 4 * DNW + H_, C_U = 4 * DNW + 2 * H_, C_V = C_U + SGW;
constexpr int NE = 64, NG = 8, EPG = 8, DE = D_ / 2;
constexpr float ALPHA = 1.189207115002721f;
constexpr float LN_EPS = 1e-5f, RMS_EPS = 1e-6f;

struct P {
    const float *x, *w_in, *conv_w, *a_log, *dt_bias, *dn_norm_w, *sgu_ln_g, *sgu_ln_b, *w_spatial, *b_spatial, *w_out, *ln1_g, *ln1_b,
        *w_rg, *b_rg, *w_re, *b_re, *w_gate, *w_up, *w_down, *ln2_g, *ln2_b;
    float* out;
    float *proj, *qkv, *odn, *vn, *y, *z1, *h1, *wgt, *hid, *yexp;
    int *eid, *cnt, *sorted, *eos;
};

KFN float sigmoidf_(float x) { return 1.f / (1.f + expf(-x)); }
KFN float siluf_(float x) { return x * sigmoidf_(x); }
KFN float softplusf_(float x) { return x > 20.f ? x : log1pf(expf(x)); }
KFN float geluf_(float x) { return 0.5f * x * (1.f + tanhf(0.7978845608028654f * (x + 0.044715f * x * x * x))); }

struct Acc16 { float v[4][4]; };
KFN void gemm4x4(const float* a0, const float* a1, const float* a2, const float* a3, const float* Bm, int ldb, int n0, int K, Acc16& acc) {
    for (int i = 0; i < 4; ++i) for (int j = 0; j < 4; ++j) acc.v[i][j] = 0.f;
    for (int k = 0; k < K; ++k) {
        const float av[4] = {a0[k], a1[k], a2[k], a3[k]};
        const float* br = Bm + (size_t)k * ldb + n0;
        const float bv[4] = {br[0], br[1], br[2], br[3]};
        for (int i = 0; i < 4; ++i) for (int j = 0; j < 4; ++j) acc.v[i][j] += av[i] * bv[j];
    }
}

constexpr long N_S1 = (long)(T_ / 4) * (INC / 4);
KFN void s1_proj(const P& p, int b, long i) {
    const int nt = INC / 4; const int mt = (int)(i / nt), ct = (int)(i % nt); const int m0 = mt * 4, n0 = ct * 4;
    const float* xa = p.x + ((size_t)b * T_ + m0) * D_;
    Acc16 acc; gemm4x4(xa, xa + D_, xa + 2 * D_, xa + 3 * D_, p.w_in, INC, n0, D_, acc);
    for (int r = 0; r < 4; ++r) for (int c = 0; c < 4; ++c) p.proj[(size_t)(m0 + r) * INC + n0 + c] = acc.v[r][c];
}
constexpr long N_S2 = (long)T_ * 3 * DNW;
KFN void s2_conv(const P& p, int b, long i) {
    const int t = (int)(i / (3 * DNW)), c = (int)(i % (3 * DNW));
    float s = 0.f;
    for (int j = 0; j < CK; ++j) { const int tt = t - (CK - 1) + j; if (tt >= 0) s += p.conv_w[j * 3 * DNW + c] * p.proj[(size_t)tt * INC + c]; }
    p.qkv[(size_t)t * 3 * DNW + c] = siluf_(s);
}
constexpr long N_S3 = (long)T_ * 2 * H_;
KFN void s3_l2(const P& p, int b, long i) {
    const int t = (int)(i / (2 * H_)), r = (int)(i % (2 * H_)), which = r / H_, h = r % H_;
    float* v = p.qkv + (size_t)t * 3 * DNW + which * DNW + h * HD;
    float ss = 0.f; for (int d = 0; d < HD; ++d) ss += v[d] * v[d];
    float sc = 1.f / sqrtf(ss + RMS_EPS); if (which == 0) sc *= 1.f / sqrtf((float)HD);
    for (int d = 0; d < HD; ++d) v[d] *= sc;
}
constexpr long N_S4 = (long)H_ * HD;
KFN void s4_delta(const P& p, int b, long i) {
    const int h = (int)(i / HD), j = (int)(i % HD);
    float S[HD];
#pragma unroll
    for (int d = 0; d < HD; ++d) S[d] = 0.f;
    const float ea = expf(p.a_log[h]), dtb = p.dt_bias[h];
    for (int t = 0; t < T_; ++t) {
        const float* pr = p.proj + (size_t)t * INC;
        const float beta = sigmoidf_(pr[C_B + h]);
        const float g = -ea * softplusf_(pr[C_A + h] + dtb);
        const float a = expf(g);
        const float* q = p.qkv + (size_t)t * 3 * DNW + h * HD;
        const float* k = q + DNW;
        const float vj = p.qkv[(size_t)t * 3 * DNW + 2 * DNW + h * HD + j];
        float r = 0.f;
#pragma unroll
        for (int d = 0; d < HD; ++d) { S[d] *= a; r += k[d] * S[d]; }
        const float dlt = beta * (vj - r);
        float o = 0.f;
#pragma unroll
        for (int d = 0; d < HD; ++d) { S[d] += k[d] * dlt; o += q[d] * S[d]; }
        p.odn[(size_t)t * DNW + h * HD + j] = o;
    }
}
constexpr long N_S5 = (long)T_ * H_;
KFN void s5_gnorm(const P& p, int b, long i) {
    const int t = (int)(i / H_), h = (int)(i % H_);
    const float* o = p.odn + (size_t)t * DNW + h * HD;
    float ss = 0.f; for (int d = 0; d < HD; ++d) ss += o[d] * o[d];
    const float rs = 1.f / sqrtf(ss / HD + RMS_EPS);
    for (int d = 0; d < HD; ++d) { const float z = p.proj[(size_t)t * INC + C_Z + h * HD + d]; p.y[(size_t)t * D_ + h * HD + d] = o[d] * rs * p.dn_norm_w[d] * siluf_(z); }
}
constexpr long N_S6 = (long)T_ * G_;
KFN void s6_sguv(const P& p, int b, long i) {
    const int t = (int)(i / G_), g = (int)(i % G_);
    const float* v = p.proj + (size_t)t * INC + C_V + g * GD;
    float mu = 0.f; for (int d = 0; d < GD; ++d) mu += geluf_(v[d]); mu /= GD;
    float var = 0.f; for (int d = 0; d < GD; ++d) { const float c = geluf_(v[d]) - mu; var += c * c; } var /= GD;
    const float rs = 1.f / sqrtf(var + LN_EPS);
    for (int d = 0; d < GD; ++d) p.vn[(size_t)t * SGW + g * GD + d] = (geluf_(v[d]) - mu) * rs * p.sgu_ln_g[g * GD + d] + p.sgu_ln_b[g * GD + d];
}
constexpr long N_S7 = (long)T_ * SGW;
KFN void s7_sgumix(const P& p, int b, long i) {
    const int t = (int)(i / SGW), c = (int)(i % SGW), g = c / GD, tl = t % SC, t0 = t - tl;
    const float* w = p.w_spatial + ((size_t)g * SC + tl) * SC;
    float s = 0.f; for (int sidx = 0; sidx <= tl; ++sidx) s += w[sidx] * p.vn[(size_t)(t0 + sidx) * SGW + c];
    s += p.b_spatial[g * SC + tl];
    p.y[(size_t)t * D_ + DNW + c] = geluf_(p.proj[(size_t)t * INC + C_U + c]) * s;
}
constexpr long N_S8 = (long)(T_ / 4) * (D_ / 4);
KFN void s8_outproj(const P& p, int b, long i) {
    const int nt = D_ / 4; const int m0 = (int)(i / nt) * 4, n0 = (int)(i % nt) * 4;
    const float* ya = p.y + (size_t)m0 * D_;
    Acc16 acc; gemm4x4(ya, ya + D_, ya + 2 * D_, ya + 3 * D_, p.w_out, D_, n0, D_, acc);
    for (int r = 0; r < 4; ++r) for (int c = 0; c < 4; ++c) p.z1[(size_t)(m0 + r) * D_ + n0 + c] = acc.v[r][c] + ALPHA * p.x[((size_t)b * T_ + m0 + r) * D_ + n0 + c];
}
KFN void ln_row(const float* in, const float* g, const float* bb, float* out) {
    float mu = 0.f; for (int d = 0; d < D_; ++d) mu += in[d]; mu /= D_;
    float var = 0.f; for (int d = 0; d < D_; ++d) { const float c = in[d] - mu; var += c * c; } var /= D_;
    const float rs = 1.f / sqrtf(var + LN_EPS);
    for (int d = 0; d < D_; ++d) out[d] = (in[d] - mu) * rs * g[d] + bb[d];
}
constexpr long N_S9 = T_;
KFN void s9_ln1(const P& p, int b, long i) { ln_row(p.z1 + (size_t)i * D_, p.ln1_g, p.ln1_b, p.h1 + (size_t)i * D_); }
constexpr long N_S10 = T_;
KFN void s10_router(const P& p, int b, long i) {
    const float* h = p.h1 + (size_t)i * D_;
    float gl[NG];
#pragma unroll
    for (int g = 0; g < NG; ++g) gl[g] = 0.f;
    for (int k = 0; k < D_; ++k) { const float hv = h[k];
#pragma unroll
        for (int g = 0; g < NG; ++g) gl[g] += hv * p.w_rg[(size_t)k * NG + g]; }
    int gi = 0; float gm = -INFINITY;
#pragma unroll
    for (int g = 0; g < NG; ++g) { gl[g] += p.b_rg[g]; if (gl[g] > gm) { gm = gl[g]; gi = g; } }
    float den = 0.f;
#pragma unroll
    for (int g = 0; g < NG; ++g) den += expf(gl[g] - gm);
    const float pg = 1.f / den;
    float el[EPG];
#pragma unroll
    for (int e = 0; e < EPG; ++e) el[e] = 0.f;
    for (int k = 0; k < D_; ++k) { const float hv = h[k];
#pragma unroll
        for (int e = 0; e < EPG; ++e) el[e] += hv * p.w_re[(size_t)k * NE + gi * EPG + e]; }
    int i0 = 0, i1 = 0; float v0 = -INFINITY, v1 = -INFINITY;
#pragma unroll
    for (int e = 0; e < EPG; ++e) { el[e] += p.b_re[gi * EPG + e]; if (el[e] > v0) { v0 = el[e]; i0 = e; } }
#pragma unroll
    for (int e = 0; e < EPG; ++e) { if (e != i0 && el[e] > v1) { v1 = el[e]; i1 = e; } }
    const float e1 = expf(v1 - v0), s = 1.f / (1.f + e1);
    p.eid[2 * i] = gi * EPG + i0; p.eid[2 * i + 1] = gi * EPG + i1;
    p.wgt[2 * i] = pg * s; p.wgt[2 * i + 1] = pg * e1 * s;
}
constexpr long N_S11 = NE;
KFN void s11_count(const P& p, int b, long i) { int c = 0; for (int a = 0; a < 2 * T_; ++a) c += (p.eid[a] == (int)i); p.cnt[i] = c; }
constexpr long N_S12 = NE;
KFN void s12_sort(const P& p, int b, long i) {
    int off = 0; for (int e = 0; e < (int)i; ++e) off += p.cnt[e];
    for (int a = 0; a < 2 * T_; ++a) if (p.eid[a] == (int)i) { p.sorted[off] = a; p.eos[off] = (int)i; ++off; }
}
constexpr long N_S13 = (long)2 * T_ * (DE / 4);
KFN void s13_hid(const P& p, int b, long i) {
    const int pos = (int)(i / (DE / 4)), j0 = (int)(i % (DE / 4)) * 4;
    const int a = p.sorted[pos], e = p.eos[pos], tok = a >> 1;
    const float* h = p.h1 + (size_t)tok * D_;
    const float* wg = p.w_gate + (size_t)e * D_ * DE; const float* wu = p.w_up + (size_t)e * D_ * DE;
    float g[4] = {0, 0, 0, 0}, u[4] = {0, 0, 0, 0};
    for (int k = 0; k < D_; ++k) { const float hv = h[k];
#pragma unroll
        for (int c = 0; c < 4; ++c) { g[c] += hv * wg[(size_t)k * DE + j0 + c]; u[c] += hv * wu[(size_t)k * DE + j0 + c]; } }
#pragma unroll
    for (int c = 0; c < 4; ++c) p.hid[(size_t)pos * DE + j0 + c] = siluf_(g[c]) * u[c];
}
constexpr long N_S14 = (long)2 * T_ * (D_ / 4);
KFN void s14_down(const P& p, int b, long i) {
    const int pos = (int)(i / (D_ / 4)), n0 = (int)(i % (D_ / 4)) * 4;
    const int a = p.sorted[pos], e = p.eos[pos];
    const float* hd = p.hid + (size_t)pos * DE; const float* wd = p.w_down + (size_t)e * DE * D_;
    float s[4] = {0, 0, 0, 0};
    for (int k = 0; k < DE; ++k) { const float hv = hd[k];
#pragma unroll
        for (int c = 0; c < 4; ++c) s[c] += hv * wd[(size_t)k * D_ + n0 + c]; }
    const float w = p.wgt[a];
#pragma unroll
    for (int c = 0; c < 4; ++c) p.yexp[(size_t)a * D_ + n0 + c] = w * s[c];
}
constexpr long N_S15 = T_;
KFN void s15_final(const P& p, int b, long i) {
    float* o = p.out + ((size_t)b * T_ + i) * D_;
    const float* h = p.h1 + (size_t)i * D_; const float* y0 = p.yexp + (size_t)(2 * i) * D_; const float* y1 = y0 + D_;
    float mu = 0.f; for (int d = 0; d < D_; ++d) mu += ALPHA * h[d] + y0[d] + y1[d]; mu /= D_;
    float var = 0.f; for (int d = 0; d < D_; ++d) { const float c = ALPHA * h[d] + y0[d] + y1[d] - mu; var += c * c; } var /= D_;
    const float rs = 1.f / sqrtf(var + LN_EPS);
    for (int d = 0; d < D_; ++d) o[d] = (ALPHA * h[d] + y0[d] + y1[d] - mu) * rs * p.ln2_g[d] + p.ln2_b[d];
}

struct Carve { size_t proj, qkv, odn, vn, y, z1, h1, wgt, hid, yexp, eid, cnt, sorted, eos, total; };
static inline Carve carve() {
    Carve c; size_t o = 0; auto al = [&](size_t bytes) { size_t r = o; o += (bytes + 255) & ~(size_t)255; return r; };
    c.proj = al((size_t)T_ * INC * 4); c.qkv = al((size_t)T_ * 3 * DNW * 4); c.odn = al((size_t)T_ * DNW * 4); c.vn = al((size_t)T_ * SGW * 4);
    c.y = al((size_t)T_ * D_ * 4); c.z1 = al((size_t)T_ * D_ * 4); c.h1 = al((size_t)T_ * D_ * 4); c.wgt = al((size_t)2 * T_ * 4);
    c.hid = al((size_t)2 * T_ * DE * 4); c.yexp = al((size_t)2 * T_ * D_ * 4); c.eid = al((size_t)2 * T_ * 4); c.cnt = al(NE * 4);
    c.sorted = al((size_t)2 * T_ * 4); c.eos = al((size_t)2 * T_ * 4); c.total = o; return c;
}
static inline void bind(P& p, void* const* in, float* out, unsigned char* ws) {
    const float** f = (const float**)&p.x; for (int i = 0; i < 22; ++i) f[i] = (const float*)in[i];
    p.out = out; const Carve c = carve();
    p.proj = (float*)(ws + c.proj); p.qkv = (float*)(ws + c.qkv); p.odn = (float*)(ws + c.odn); p.vn = (float*)(ws + c.vn); p.y = (float*)(ws + c.y);
    p.z1 = (float*)(ws + c.z1); p.h1 = (float*)(ws + c.h1); p.wgt = (float*)(ws + c.wgt); p.hid = (float*)(ws + c.hid); p.yexp = (float*)(ws + c.yexp);
    p.eid = (int*)(ws + c.eid); p.cnt = (int*)(ws + c.cnt); p.sorted = (int*)(ws + c.sorted); p.eos = (int*)(ws + c.eos);
}
#define NV_STAGES(X) X(1, s1_proj, N_S1) X(2, s2_conv, N_S2) X(3, s3_l2, N_S3) X(4, s4_delta, N_S4) X(5, s5_gnorm, N_S5) X(6, s6_sguv, N_S6) X(7, s7_sgumix, N_S7) \
    X(8, s8_outproj, N_S8) X(9, s9_ln1, N_S9) X(10, s10_router, N_S10) X(11, s11_count, N_S11) X(12, s12_sort, N_S12) X(13, s13_hid, N_S13) X(14, s14_down, N_S14) X(15, s15_final, N_S15)
}

using namespace nv;
#define X(id, fn, n) __global__ void __launch_bounds__(256) k_##fn(P p, int b) { const long i = (long)blockIdx.x * blockDim.x + threadIdx.x; if (i < n) fn(p, b, i); }
NV_STAGES(X)
#undef X

extern "C" void kernel_launch(void* const* d_in, const int* in_sizes, int n_in, void* d_out, int out_size, void* d_ws, size_t ws_size, hipStream_t stream) {
    const Carve c = carve();
    if (ws_size < c.total || n_in != 22) return;
    P p; bind(p, d_in, (float*)d_out, (unsigned char*)d_ws);
    for (int b = 0; b < B_; ++b) {
#define X(id, fn, n) { const int bs = (id == 4) ? 64 : 256; hipLaunchKernelGGL(k_##fn, dim3((unsigned)((n + bs - 1) / bs)), dim3(bs), 0, stream, p, b); }
        NV_STAGES(X)
#undef X
    }
}
```

```cpp
#include <hip/hip_runtime.h>
#include <hip/hip_cooperative_groups.h>
#include <cstdio>
namespace cg = cooperative_groups;
#include <math.h>
#ifndef BATCH
#define BATCH 8
#endif
#ifndef SEQ
#define SEQ 4096
#endif
#ifndef D_MODEL
#define D_MODEL 1024
#endif
#ifdef HOST_EMU
#define KFN static inline
#else
#define KFN __device__ __forceinline__
#endif

namespace nv {
constexpr int B_ = BATCH, T_ = SEQ, D_ = D_MODEL;
constexpr int DNW = D_ / 2, H_ = 4, HD = DNW / H_, CK = 4;
constexpr int SGW = D_ - DNW, G_ = 4, GD = SGW / G_, SC = 128;
constexpr int INC = 4 * DNW + 2 * H_ + 2 * SGW;
constexpr int C_Z = 3 * DNW, C_B = 4 * DNW, C_A = 4 * DNW + H_, C_U = 4 * DNW + 2 * H_, C_V = C_U + SGW;
constexpr int NE = 64, NG = 8, EPG = 8, DE = D_ / 2;
constexpr float ALPHA = 1.189207115002721f;
constexpr float LN_EPS = 1e-5f, RMS_EPS = 1e-6f;

struct P {
    const float *x, *w_in, *conv_w, *a_log, *dt_bias, *dn_norm_w, *sgu_ln_g, *sgu_ln_b, *w_spatial, *b_spatial, *w_out, *ln1_g, *ln1_b,
        *w_rg, *b_rg, *w_re, *b_re, *w_gate, *w_up, *w_down, *ln2_g, *ln2_b;
    float* out;
    float *proj, *qkv, *odn, *vn, *y, *z1, *h1, *wgt, *hid, *yexp;
    int *eid, *cnt, *sorted, *eos;
};

KFN float sigmoidf_(float x) { return 1.f / (1.f + expf(-x)); }
KFN float siluf_(float x) { return x * sigmoidf_(x); }
KFN float softplusf_(float x) { return x > 20.f ? x : log1pf(expf(x)); }
KFN float geluf_(float x) { return 0.5f * x * (1.f + tanhf(0.7978845608028654f * (x + 0.044715f * x * x * x))); }

struct Acc16 { float v[4][4]; };
KFN void gemm4x4(const float* a0, const float* a1, const float* a2, const float* a3, const float* Bm, int ldb, int n0, int K, Acc16& acc) {
    for (int i = 0; i < 4; ++i) for (int j = 0; j < 4; ++j) acc.v[i][j] = 0.f;
    for (int k = 0; k < K; ++k) {
        const float av[4] = {a0[k], a1[k], a2[k], a3[k]};
        const float* br = Bm + (size_t)k * ldb + n0;
        const float bv[4] = {br[0], br[1], br[2], br[3]};
        for (int i = 0; i < 4; ++i) for (int j = 0; j < 4; ++j) acc.v[i][j] += av[i] * bv[j];
    }
}

constexpr long N_S1 = (long)(T_ / 4) * (INC / 4);
KFN void s1_proj(const P& p, int b, long i) {
    const int nt = INC / 4; const int mt = (int)(i / nt), ct = (int)(i % nt); const int m0 = mt * 4, n0 = ct * 4;
    const float* xa = p.x + ((size_t)b * T_ + m0) * D_;
    Acc16 acc; gemm4x4(xa, xa + D_, xa + 2 * D_, xa + 3 * D_, p.w_in, INC, n0, D_, acc);
    for (int r = 0; r < 4; ++r) for (int c = 0; c < 4; ++c) p.proj[(size_t)(m0 + r) * INC + n0 + c] = acc.v[r][c];
}
constexpr long N_S2 = (long)T_ * 3 * DNW;
KFN void s2_conv(const P& p, int b, long i) {
    const int t = (int)(i / (3 * DNW)), c = (int)(i % (3 * DNW));
    float s = 0.f;
    for (int j = 0; j < CK; ++j) { const int tt = t - (CK - 1) + j; if (tt >= 0) s += p.conv_w[j * 3 * DNW + c] * p.proj[(size_t)tt * INC + c]; }
    p.qkv[(size_t)t * 3 * DNW + c] = siluf_(s);
}
constexpr long N_S3 = (long)T_ * 2 * H_;
KFN void s3_l2(const P& p, int b, long i) {
    const int t = (int)(i / (2 * H_)), r = (int)(i % (2 * H_)), which = r / H_, h = r % H_;
    float* v = p.qkv + (size_t)t * 3 * DNW + which * DNW + h * HD;
    float ss = 0.f; for (int d = 0; d < HD; ++d) ss += v[d] * v[d];
    float sc = 1.f / sqrtf(ss + RMS_EPS); if (which == 0) sc *= 1.f / sqrtf((float)HD);
    for (int d = 0; d < HD; ++d) v[d] *= sc;
}
constexpr long N_S4 = (long)H_ * HD;
KFN void s4_delta(const P& p, int b, long i) {
    const int h = (int)(i / HD), j = (int)(i % HD);
    float S[HD];
#pragma unroll
    for (int d = 0; d < HD; ++d) S[d] = 0.f;
    const float ea = expf(p.a_log[h]), dtb = p.dt_bias[h];
    for (int t = 0; t < T_; ++t) {
        const float* pr = p.proj + (size_t)t * INC;
        const float beta = sigmoidf_(pr[C_B + h]);
        const float g = -ea * softplusf_(pr[C_A + h] + dtb);
        const float a = expf(g);
        const float* q = p.qkv + (size_t)t * 3 * DNW + h * HD;
        const float* k = q + DNW;
        const float vj = p.qkv[(size_t)t * 3 * DNW + 2 * DNW + h * HD + j];
        float r = 0.f;
#pragma unroll
        for (int d = 0; d < HD; ++d) { S[d] *= a; r += k[d] * S[d]; }
        const float dlt = beta * (vj - r);
        float o = 0.f;
#pragma unroll
        for (int d = 0; d < HD; ++d) { S[d] += k[d] * dlt; o += q[d] * S[d]; }
        p.odn[(size_t)t * DNW + h * HD + j] = o;
    }
}
constexpr long N_S5 = (long)T_ * H_;
KFN void s5_gnorm(const P& p, int b, long i) {
    const int t = (int)(i / H_), h = (int)(i % H_);
    const float* o = p.odn + (size_t)t * DNW + h * HD;
    float ss = 0.f; for (int d = 0; d < HD; ++d) ss += o[d] * o[d];
    const float rs = 1.f / sqrtf(ss / HD + RMS_EPS);
    for (int d = 0; d < HD; ++d) { const float z = p.proj[(size_t)t * INC + C_Z + h * HD + d]; p.y[(size_t)t * D_ + h * HD + d] = o[d] * rs * p.dn_norm_w[d] * siluf_(z); }
}
constexpr long N_S6 = (long)T_ * G_;
KFN void s6_sguv(const P& p, int b, long i) {
    const int t = (int)(i / G_), g = (int)(i % G_);
    const float* v = p.proj + (size_t)t * INC + C_V + g * GD;
    float mu = 0.f; for (int d = 0; d < GD; ++d) mu += geluf_(v[d]); mu /= GD;
    float var = 0.f; for (int d = 0; d < GD; ++d) { const float c = geluf_(v[d]) - mu; var += c * c; } var /= GD;
    const float rs = 1.f / sqrtf(var + LN_EPS);
    for (int d = 0; d < GD; ++d) p.vn[(size_t)t * SGW + g * GD + d] = (geluf_(v[d]) - mu) * rs * p.sgu_ln_g[g * GD + d] + p.sgu_ln_b[g * GD + d];
}
constexpr long N_S7 = (long)T_ * SGW;
KFN void s7_sgumix(const P& p, int b, long i) {
    const int t = (int)(i / SGW), c = (int)(i % SGW), g = c / GD, tl = t % SC, t0 = t - tl;
    const float* w = p.w_spatial + ((size_t)g * SC + tl) * SC;
    float s = 0.f; for (int sidx = 0; sidx <= tl; ++sidx) s += w[sidx] * p.vn[(size_t)(t0 + sidx) * SGW + c];
    s += p.b_spatial[g * SC + tl];
    p.y[(size_t)t * D_ + DNW + c] = geluf_(p.proj[(size_t)t * INC + C_U + c]) * s;
}
constexpr long N_S8 = (long)(T_ / 4) * (D_ / 4);
KFN void s8_outproj(const P& p, int b, long i) {
    const int nt = D_ / 4; const int m0 = (int)(i / nt) * 4, n0 = (int)(i % nt) * 4;
    const float* ya = p.y + (size_t)m0 * D_;
    Acc16 acc; gemm4x4(ya, ya + D_, ya + 2 * D_, ya + 3 * D_, p.w_out, D_, n0, D_, acc);
    for (int r = 0; r < 4; ++r) for (int c = 0; c < 4; ++c) p.z1[(size_t)(m0 + r) * D_ + n0 + c] = acc.v[r][c] + ALPHA * p.x[((size_t)b * T_ + m0 + r) * D_ + n0 + c];
}
KFN void ln_row(const float* in, const float* g, const float* bb, float* out) {
    float mu = 0.f; for (int d = 0; d < D_; ++d) mu += in[d]; mu /= D_;
    float var = 0.f; for (int d = 0; d < D_; ++d) { const float c = in[d] - mu; var += c * c; } var /= D_;
    const float rs = 1.f / sqrtf(var + LN_EPS);
    for (int d = 0; d < D_; ++d) out[d] = (in[d] - mu) * rs * g[d] + bb[d];
}
constexpr long N_S9 = T_;
KFN void s9_ln1(const P& p, int b, long i) { ln_row(p.z1 + (size_t)i * D_, p.ln1_g, p.ln1_b, p.h1 + (size_t)i * D_); }
constexpr long N_S10 = T_;
KFN void s10_router(const P& p, int b, long i) {
    const float* h = p.h1 + (size_t)i * D_;
    float gl[NG];
#pragma unroll
    for (int g = 0; g < NG; ++g) gl[g] = 0.f;
    for (int k = 0; k < D_; ++k) { const float hv = h[k];
#pragma unroll
        for (int g = 0; g < NG; ++g) gl[g] += hv * p.w_rg[(size_t)k * NG + g]; }
    int gi = 0; float gm = -INFINITY;
#pragma unroll
    for (int g = 0; g < NG; ++g) { gl[g] += p.b_rg[g]; if (gl[g] > gm) { gm = gl[g]; gi = g; } }
    float den = 0.f;
#pragma unroll
    for (int g = 0; g < NG; ++g) den += expf(gl[g] - gm);
    const float pg = 1.f / den;
    float el[EPG];
#pragma unroll
    for (int e = 0; e < EPG; ++e) el[e] = 0.f;
    for (int k = 0; k < D_; ++k) { const float hv = h[k];
#pragma unroll
        for (int e = 0; e < EPG; ++e) el[e] += hv * p.w_re[(size_t)k * NE + gi * EPG + e]; }
    int i0 = 0, i1 = 0; float v0 = -INFINITY, v1 = -INFINITY;
#pragma unroll
    for (int e = 0; e < EPG; ++e) { el[e] += p.b_re[gi * EPG + e]; if (el[e] > v0) { v0 = el[e]; i0 = e; } }
#pragma unroll
    for (int e = 0; e < EPG; ++e) { if (e != i0 && el[e] > v1) { v1 = el[e]; i1 = e; } }
    const float e1 = expf(v1 - v0), s = 1.f / (1.f + e1);
    p.eid[2 * i] = gi * EPG + i0; p.eid[2 * i + 1] = gi * EPG + i1;
    p.wgt[2 * i] = pg * s; p.wgt[2 * i + 1] = pg * e1 * s;
}
constexpr long N_S11 = NE;
KFN void s11_count(const P& p, int b, long i) { int c = 0; for (int a = 0; a < 2 * T_; ++a) c += (p.eid[a] == (int)i); p.cnt[i] = c; }
constexpr long N_S12 = NE;
KFN void s12_sort(const P& p, int b, long i) {
    int off = 0; for (int e = 0; e < (int)i; ++e) off += p.cnt[e];
    for (int a = 0; a < 2 * T_; ++a) if (p.eid[a] == (int)i) { p.sorted[off] = a; p.eos[off] = (int)i; ++off; }
}
constexpr long N_S13 = (long)2 * T_ * (DE / 4);
KFN void s13_hid(const P& p, int b, long i) {
    const int pos = (int)(i / (DE / 4)), j0 = (int)(i % (DE / 4)) * 4;
    const int a = p.sorted[pos], e = p.eos[pos], tok = a >> 1;
    const float* h = p.h1 + (size_t)tok * D_;
    const float* wg = p.w_gate + (size_t)e * D_ * DE; const float* wu = p.w_up + (size_t)e * D_ * DE;
    float g[4] = {0, 0, 0, 0}, u[4] = {0, 0, 0, 0};
    for (int k = 0; k < D_; ++k) { const float hv = h[k];
#pragma unroll
        for (int c = 0; c < 4; ++c) { g[c] += hv * wg[(size_t)k * DE + j0 + c]; u[c] += hv * wu[(size_t)k * DE + j0 + c]; } }
#pragma unroll
    for (int c = 0; c < 4; ++c) p.hid[(size_t)pos * DE + j0 + c] = siluf_(g[c]) * u[c];
}
constexpr long N_S14 = (long)2 * T_ * (D_ / 4);
KFN void s14_down(const P& p, int b, long i) {
    const int pos = (int)(i / (D_ / 4)), n0 = (int)(i % (D_ / 4)) * 4;
    const int a = p.sorted[pos], e = p.eos[pos];
    const float* hd = p.hid + (size_t)pos * DE; const float* wd = p.w_down + (size_t)e * DE * D_;
    float s[4] = {0, 0, 0, 0};
    for (int k = 0; k < DE; ++k) { const float hv = hd[k];
#pragma unroll
        for (int c = 0; c < 4; ++c) s[c] += hv * wd[(size_t)k * D_ + n0 + c]; }
    const float w = p.wgt[a];
#pragma unroll
    for (int c = 0; c < 4; ++c) p.yexp[(size_t)a * D_ + n0 + c] = w * s[c];
}
constexpr long N_S15 = T_;
KFN void s15_final(const P& p, int b, long i) {
    float* o = p.out + ((size_t)b * T_ + i) * D_;
    const float* h = p.h1 + (size_t)i * D_; const float* y0 = p.yexp + (size_t)(2 * i) * D_; const float* y1 = y0 + D_;
    float mu = 0.f; for (int d = 0; d < D_; ++d) mu += ALPHA * h[d] + y0[d] + y1[d]; mu /= D_;
    float var = 0.f; for (int d = 0; d < D_; ++d) { const float c = ALPHA * h[d] + y0[d] + y1[d] - mu; var += c * c; } var /= D_;
    const float rs = 1.f / sqrtf(var + LN_EPS);
    for (int d = 0; d < D_; ++d) o[d] = (ALPHA * h[d] + y0[d] + y1[d] - mu) * rs * p.ln2_g[d] + p.ln2_b[d];
}

struct Carve { size_t proj, qkv, odn, vn, y, z1, h1, wgt, hid, yexp, eid, cnt, sorted, eos, total; };
static inline Carve carve() {
    Carve c; size_t o = 0; auto al = [&](size_t bytes) { size_t r = o; o += (bytes + 255) & ~(size_t)255; return r; };
    c.proj = al((size_t)T_ * INC * 4); c.qkv = al((size_t)T_ * 3 * DNW * 4); c.odn = al((size_t)T_ * DNW * 4); c.vn = al((size_t)T_ * SGW * 4);
    c.y = al((size_t)T_ * D_ * 4); c.z1 = al((size_t)T_ * D_ * 4); c.h1 = al((size_t)T_ * D_ * 4); c.wgt = al((size_t)2 * T_ * 4);
    c.hid = al((size_t)2 * T_ * DE * 4); c.yexp = al((size_t)2 * T_ * D_ * 4); c.eid = al((size_t)2 * T_ * 4); c.cnt = al(NE * 4);
    c.sorted = al((size_t)2 * T_ * 4); c.eos = al((size_t)2 * T_ * 4); c.total = o; return c;
}
static inline void bind(P& p, void* const* in, float* out, unsigned char* ws) {
    const float** f = (const float**)&p.x; for (int i = 0; i < 22; ++i) f[i] = (const float*)in[i];
    p.out = out; const Carve c = carve();
    p.proj = (float*)(ws + c.proj); p.qkv = (float*)(ws + c.qkv); p.odn = (float*)(ws + c.odn); p.vn = (float*)(ws + c.vn); p.y = (float*)(ws + c.y);
    p.z1 = (float*)(ws + c.z1); p.h1 = (float*)(ws + c.h1); p.wgt = (float*)(ws + c.wgt); p.hid = (float*)(ws + c.hid); p.yexp = (float*)(ws + c.yexp);
    p.eid = (int*)(ws + c.eid); p.cnt = (int*)(ws + c.cnt); p.sorted = (int*)(ws + c.sorted); p.eos = (int*)(ws + c.eos);
}
#define NV_STAGES(X) X(1, s1_proj, N_S1) X(2, s2_conv, N_S2) X(3, s3_l2, N_S3) X(4, s4_delta, N_S4) X(5, s5_gnorm, N_S5) X(6, s6_sguv, N_S6) X(7, s7_sgumix, N_S7) \
    X(8, s8_outproj, N_S8) X(9, s9_ln1, N_S9) X(10, s10_router, N_S10) X(11, s11_count, N_S11) X(12, s12_sort, N_S12) X(13, s13_hid, N_S13) X(14, s14_down, N_S14) X(15, s15_final, N_S15)
}

using namespace nv;

constexpr long N_S4B = (long)H_ * HD * 2;
__device__ __forceinline__ void s4b_delta(const P& p, int b, long i) {
    const int half = (int)(i & 1), hj = (int)(i >> 1), h = hj / HD, j = hj % HD; constexpr int HH = HD / 2;
    float S[HH];
#pragma unroll
    for (int d = 0; d < HH; ++d) S[d] = 0.f;
    const float ea = expf(p.a_log[h]), dtb = p.dt_bias[h];
    for (int t = 0; t < T_; ++t) {
        const float* pr = p.proj + (size_t)t * INC;
        const float beta = sigmoidf_(pr[C_B + h]);
        const float g = -ea * softplusf_(pr[C_A + h] + dtb);
        const float a = expf(g);
        const float* q = p.qkv + (size_t)t * 3 * DNW + h * HD + half * HH;
        const float* k = q + DNW;
        const float vj = p.qkv[(size_t)t * 3 * DNW + 2 * DNW + h * HD + j];
        float r = 0.f;
#pragma unroll
        for (int d = 0; d < HH; ++d) { S[d] *= a; r += k[d] * S[d]; }
        r += __shfl_xor(r, 1);
        const float dlt = beta * (vj - r);
        float o = 0.f;
#pragma unroll
        for (int d = 0; d < HH; ++d) { S[d] += k[d] * dlt; o += q[d] * S[d]; }
        o += __shfl_xor(o, 1);
        if (half == 0) p.odn[(size_t)t * DNW + h * HD + j] = o;
    }
}
constexpr int NTHREADS = 512;
constexpr size_t LDS_BYTES = 147456;
__global__ void __launch_bounds__(NTHREADS, 2) fwd_megakernel(P p) {
    extern __shared__ __attribute__((aligned(16))) unsigned char lds[];
    cg::grid_group grid = cg::this_grid();
    const long gtid = (long)blockIdx.x * NTHREADS + threadIdx.x, gsize = (long)gridDim.x * NTHREADS;
    if (threadIdx.x == 0) lds[0] = 0;
    for (int b = 0; b < B_; ++b) {
#define X(id, fn, n) { if (id == 4) { if (gtid < N_S4B) s4b_delta(p, b, gtid); } else { for (long i = gtid; i < n; i += gsize) fn(p, b, i); } grid.sync(); }
        NV_STAGES(X)
#undef X
    }
}

extern "C" void kernel_launch(void* const* d_in, const int* in_sizes, int n_in, void* d_out, int out_size, void* d_ws, size_t ws_size, hipStream_t stream) {
    const Carve c = carve();
    if (ws_size < c.total || n_in != 22) { fprintf(stderr, "kernel_launch: bad ws/n_in\n"); return; }
    static int grid_blocks = 0;
    if (!grid_blocks) {
        int dev = 0, cus = 0, per_cu = 0;
        (void)hipGetDevice(&dev);
        (void)hipDeviceGetAttribute(&cus, hipDeviceAttributeMultiprocessorCount, dev);
        (void)hipFuncSetAttribute((const void*)fwd_megakernel, hipFuncAttributeMaxDynamicSharedMemorySize, (int)LDS_BYTES);
        (void)hipOccupancyMaxActiveBlocksPerMultiprocessor(&per_cu, (const void*)fwd_megakernel, NTHREADS, LDS_BYTES);
        if (per_cu < 1) { fprintf(stderr, "kernel_launch: occupancy query says %d\n", per_cu); per_cu = 1; }
        grid_blocks = cus * per_cu;
    }
    P p{}; bind(p, d_in, (float*)d_out, (unsigned char*)d_ws);
    void* args[] = {&p};
    hipError_t e = hipLaunchCooperativeKernel((const void*)fwd_megakernel, dim3(grid_blocks), dim3(NTHREADS), args, LDS_BYTES, stream);
    if (e != hipSuccess) fprintf(stderr, "cooperative launch failed: %s (grid %d)\n", hipGetErrorString(e), grid_blocks);
}
```

```cpp
#include <hip/hip_runtime.h>
#include <hip/hip_cooperative_groups.h>
#include <cstdio>
#include <cstdint>
namespace cg = cooperative_groups;
#include <math.h>
#ifndef BATCH
#define BATCH 8
#endif
#ifndef SEQ
#define SEQ 4096
#endif
#ifndef D_MODEL
#define D_MODEL 1024
#endif
#ifdef HOST_EMU
#define KFN static inline
#else
#define KFN __device__ __forceinline__
#endif

namespace nv {
constexpr int B_ = BATCH, T_ = SEQ, D_ = D_MODEL;
constexpr int DNW = D_ / 2, H_ = 4, HD = DNW / H_, CK = 4;
constexpr int SGW = D_ - DNW, G_ = 4, GD = SGW / G_, SC = 128;
constexpr int INC = 4 * DNW + 2 * H_ + 2 * SGW;
constexpr int C_Z = 3 * DNW, C_B = 4 * DNW, C_A = 4 * DNW + H_, C_U = 4 * DNW + 2 * H_, C_V = C_U + SGW;
constexpr int NE = 64, NG = 8, EPG = 8, DE = D_ / 2;
constexpr float ALPHA = 1.189207115002721f;
constexpr float LN_EPS = 1e-5f, RMS_EPS = 1e-6f;

struct P {
    const float *x, *w_in, *conv_w, *a_log, *dt_bias, *dn_norm_w, *sgu_ln_g, *sgu_ln_b, *w_spatial, *b_spatial, *w_out, *ln1_g, *ln1_b,
        *w_rg, *b_rg, *w_re, *b_re, *w_gate, *w_up, *w_down, *ln2_g, *ln2_b;
    float* out;
    float *proj, *qkv, *odn, *vn, *y, *z1, *h1, *wgt, *hid, *yexp;
    int *eid, *cnt, *sorted, *eos;
};

KFN float sigmoidf_(float x) { return 1.f / (1.f + expf(-x)); }
KFN float siluf_(float x) { return x * sigmoidf_(x); }
KFN float softplusf_(float x) { return x > 20.f ? x : log1pf(expf(x)); }
KFN float geluf_(float x) { return 0.5f * x * (1.f + tanhf(0.7978845608028654f * (x + 0.044715f * x * x * x))); }

struct Acc16 { float v[4][4]; };
KFN void gemm4x4(const float* a0, const float* a1, const float* a2, const float* a3, const float* Bm, int ldb, int n0, int K, Acc16& acc) {
    for (int i = 0; i < 4; ++i) for (int j = 0; j < 4; ++j) acc.v[i][j] = 0.f;
    for (int k = 0; k < K; ++k) {
        const float av[4] = {a0[k], a1[k], a2[k], a3[k]};
        const float* br = Bm + (size_t)k * ldb + n0;
        const float bv[4] = {br[0], br[1], br[2], br[3]};
        for (int i = 0; i < 4; ++i) for (int j = 0; j < 4; ++j) acc.v[i][j] += av[i] * bv[j];
    }
}

constexpr long N_S1 = (long)(T_ / 4) * (INC / 4);
KFN void s1_proj(const P& p, int b, long i) {
    const int nt = INC / 4; const int mt = (int)(i / nt), ct = (int)(i % nt); const int m0 = mt * 4, n0 = ct * 4;
    const float* xa = p.x + ((size_t)b * T_ + m0) * D_;
    Acc16 acc; gemm4x4(xa, xa + D_, xa + 2 * D_, xa + 3 * D_, p.w_in, INC, n0, D_, acc);
    for (int r = 0; r < 4; ++r) for (int c = 0; c < 4; ++c) p.proj[(size_t)(m0 + r) * INC + n0 + c] = acc.v[r][c];
}
constexpr long N_S2 = (long)T_ * 3 * DNW;
KFN void s2_conv(const P& p, int b, long i) {
    const int t = (int)(i / (3 * DNW)), c = (int)(i % (3 * DNW));
    float s = 0.f;
    for (int j = 0; j < CK; ++j) { const int tt = t - (CK - 1) + j; if (tt >= 0) s += p.conv_w[j * 3 * DNW + c] * p.proj[(size_t)tt * INC + c]; }
    p.qkv[(size_t)t * 3 * DNW + c] = siluf_(s);
}
constexpr long N_S3 = (long)T_ * 2 * H_;
KFN void s3_l2(const P& p, int b, long i) {
    const int t = (int)(i / (2 * H_)), r = (int)(i % (2 * H_)), which = r / H_, h = r % H_;
    float* v = p.qkv + (size_t)t * 3 * DNW + which * DNW + h * HD;
    float ss = 0.f; for (int d = 0; d < HD; ++d) ss += v[d] * v[d];
    float sc = 1.f / sqrtf(ss + RMS_EPS); if (which == 0) sc *= 1.f / sqrtf((float)HD);
    for (int d = 0; d < HD; ++d) v[d] *= sc;
}
constexpr long N_S4 = (long)H_ * HD;
KFN void s4_delta(const P& p, int b, long i) {
    const int h = (int)(i / HD), j = (int)(i % HD);
    float S[HD];
#pragma unroll
    for (int d = 0; d < HD; ++d) S[d] = 0.f;
    const float ea = expf(p.a_log[h]), dtb = p.dt_bias[h];
    for (int t = 0; t < T_; ++t) {
        const float* pr = p.proj + (size_t)t * INC;
        const float beta = sigmoidf_(pr[C_B + h]);
        const float g = -ea * softplusf_(pr[C_A + h] + dtb);
        const float a = expf(g);
        const float* q = p.qkv + (size_t)t * 3 * DNW + h * HD;
        const float* k = q + DNW;
        const float vj = p.qkv[(size_t)t * 3 * DNW + 2 * DNW + h * HD + j];
        float r = 0.f;
#pragma unroll
        for (int d = 0; d < HD; ++d) { S[d] *= a; r += k[d] * S[d]; }
        const float dlt = beta * (vj - r);
        float o = 0.f;
#pragma unroll
        for (int d = 0; d < HD; ++d) { S[d] += k[d] * dlt; o += q[d] * S[d]; }
        p.odn[(size_t)t * DNW + h * HD + j] = o;
    }
}
constexpr long N_S5 = (long)T_ * H_;
KFN void s5_gnorm(const P& p, int b, long i) {
    const int t = (int)(i / H_), h = (int)(i % H_);
    const float* o = p.odn + (size_t)t * DNW + h * HD;
    float ss = 0.f; for (int d = 0; d < HD; ++d) ss += o[d] * o[d];
    const float rs = 1.f / sqrtf(ss / HD + RMS_EPS);
    for (int d = 0; d < HD; ++d) { const float z = p.proj[(size_t)t * INC + C_Z + h * HD + d]; p.y[(size_t)t * D_ + h * HD + d] = o[d] * rs * p.dn_norm_w[d] * siluf_(z); }
}
constexpr long N_S6 = (long)T_ * G_;
KFN void s6_sguv(const P& p, int b, long i) {
    const int t = (int)(i / G_), g = (int)(i % G_);
    const float* v = p.proj + (size_t)t * INC + C_V + g * GD;
    float mu = 0.f; for (int d = 0; d < GD; ++d) mu += geluf_(v[d]); mu /= GD;
    float var = 0.f; for (int d = 0; d < GD; ++d) { const float c = geluf_(v[d]) - mu; var += c * c; } var /= GD;
    const float rs = 1.f / sqrtf(var + LN_EPS);
    for (int d = 0; d < GD; ++d) p.vn[(size_t)t * SGW + g * GD + d] = (geluf_(v[d]) - mu) * rs * p.sgu_ln_g[g * GD + d] + p.sgu_ln_b[g * GD + d];
}
constexpr long N_S7 = (long)T_ * SGW;
KFN void s7_sgumix(const P& p, int b, long i) {
    const int t = (int)(i / SGW), c = (int)(i % SGW), g = c / GD, tl = t % SC, t0 = t - tl;
    const float* w = p.w_spatial + ((size_t)g * SC + tl) * SC;
    float s = 0.f; for (int sidx = 0; sidx <= tl; ++sidx) s += w[sidx] * p.vn[(size_t)(t0 + sidx) * SGW + c];
    s += p.b_spatial[g * SC + tl];
    p.y[(size_t)t * D_ + DNW + c] = geluf_(p.proj[(size_t)t * INC + C_U + c]) * s;
}
constexpr long N_S8 = (long)(T_ / 4) * (D_ / 4);
KFN void s8_outproj(const P& p, int b, long i) {
    const int nt = D_ / 4; const int m0 = (int)(i / nt) * 4, n0 = (int)(i % nt) * 4;
    const float* ya = p.y + (size_t)m0 * D_;
    Acc16 acc; gemm4x4(ya, ya + D_, ya + 2 * D_, ya + 3 * D_, p.w_out, D_, n0, D_, acc);
    for (int r = 0; r < 4; ++r) for (int c = 0; c < 4; ++c) p.z1[(size_t)(m0 + r) * D_ + n0 + c] = acc.v[r][c] + ALPHA * p.x[((size_t)b * T_ + m0 + r) * D_ + n0 + c];
}
KFN void ln_row(const float* in, const float* g, const float* bb, float* out) {
    float mu = 0.f; for (int d = 0; d < D_; ++d) mu += in[d]; mu /= D_;
    float var = 0.f; for (int d = 0; d < D_; ++d) { const float c = in[d] - mu; var += c * c; } var /= D_;
    const float rs = 1.f / sqrtf(var + LN_EPS);
    for (int d = 0; d < D_; ++d) out[d] = (in[d] - mu) * rs * g[d] + bb[d];
}
constexpr long N_S9 = T_;
KFN void s9_ln1(const P& p, int b, long i) { ln_row(p.z1 + (size_t)i * D_, p.ln1_g, p.ln1_b, p.h1 + (size_t)i * D_); }
constexpr long N_S10 = T_;
KFN void s10_router(const P& p, int b, long i) {
    const float* h = p.h1 + (size_t)i * D_;
    float gl[NG];
#pragma unroll
    for (int g = 0; g < NG; ++g) gl[g] = 0.f;
    for (int k = 0; k < D_; ++k) { const float hv = h[k];
#pragma unroll
        for (int g = 0; g < NG; ++g) gl[g] += hv * p.w_rg[(size_t)k * NG + g]; }
    int gi = 0; float gm = -INFINITY;
#pragma unroll
    for (int g = 0; g < NG; ++g) { gl[g] += p.b_rg[g]; if (gl[g] > gm) { gm = gl[g]; gi = g; } }
    float den = 0.f;
#pragma unroll
    for (int g = 0; g < NG; ++g) den += expf(gl[g] - gm);
    const float pg = 1.f / den;
    float el[EPG];
#pragma unroll
    for (int e = 0; e < EPG; ++e) el[e] = 0.f;
    for (int k = 0; k < D_; ++k) { const float hv = h[k];
#pragma unroll
        for (int e = 0; e < EPG; ++e) el[e] += hv * p.w_re[(size_t)k * NE + gi * EPG + e]; }
    int i0 = 0, i1 = 0; float v0 = -INFINITY, v1 = -INFINITY;
#pragma unroll
    for (int e = 0; e < EPG; ++e) { el[e] += p.b_re[gi * EPG + e]; if (el[e] > v0) { v0 = el[e]; i0 = e; } }
#pragma unroll
    for (int e = 0; e < EPG; ++e) { if (e != i0 && el[e] > v1) { v1 = el[e]; i1 = e; } }
    const float e1 = expf(v1 - v0), s = 1.f / (1.f + e1);
    p.eid[2 * i] = gi * EPG + i0; p.eid[2 * i + 1] = gi * EPG + i1;
    p.wgt[2 * i] = pg * s; p.wgt[2 * i + 1] = pg * e1 * s;
}
constexpr long N_S11 = NE;
KFN void s11_count(const P& p, int b, long i) { int c = 0; for (int a = 0; a < 2 * T_; ++a) c += (p.eid[a] == (int)i); p.cnt[i] = c; }
constexpr long N_S12 = NE;
KFN void s12_sort(const P& p, int b, long i) {
    int off = 0; for (int e = 0; e < (int)i; ++e) off += p.cnt[e];
    for (int a = 0; a < 2 * T_; ++a) if (p.eid[a] == (int)i) { p.sorted[off] = a; p.eos[off] = (int)i; ++off; }
}
constexpr long N_S13 = (long)2 * T_ * (DE / 4);
KFN void s13_hid(const P& p, int b, long i) {
    const int pos = (int)(i / (DE / 4)), j0 = (int)(i % (DE / 4)) * 4;
    const int a = p.sorted[pos], e = p.eos[pos], tok = a >> 1;
    const float* h = p.h1 + (size_t)tok * D_;
    const float* wg = p.w_gate + (size_t)e * D_ * DE; const float* wu = p.w_up + (size_t)e * D_ * DE;
    float g[4] = {0, 0, 0, 0}, u[4] = {0, 0, 0, 0};
    for (int k = 0; k < D_; ++k) { const float hv = h[k];
#pragma unroll
        for (int c = 0; c < 4; ++c) { g[c] += hv * wg[(size_t)k * DE + j0 + c]; u[c] += hv * wu[(size_t)k * DE + j0 + c]; } }
#pragma unroll
    for (int c = 0; c < 4; ++c) p.hid[(size_t)pos * DE + j0 + c] = siluf_(g[c]) * u[c];
}
constexpr long N_S14 = (long)2 * T_ * (D_ / 4);
KFN void s14_down(const P& p, int b, long i) {
    const int pos = (int)(i / (D_ / 4)), n0 = (int)(i % (D_ / 4)) * 4;
    const int a = p.sorted[pos], e = p.eos[pos];
    const float* hd = p.hid + (size_t)pos * DE; const float* wd = p.w_down + (size_t)e * DE * D_;
    float s[4] = {0, 0, 0, 0};
    for (int k = 0; k < DE; ++k) { const float hv = hd[k];
#pragma unroll
        for (int c = 0; c < 4; ++c) s[c] += hv * wd[(size_t)k * D_ + n0 + c]; }
    const float w = p.wgt[a];
#pragma unroll
    for (int c = 0; c < 4; ++c) p.yexp[(size_t)a * D_ + n0 + c] = w * s[c];
}
constexpr long N_S15 = T_;
KFN void s15_final(const P& p, int b, long i) {
    float* o = p.out + ((size_t)b * T_ + i) * D_;
    const float* h = p.h1 + (size_t)i * D_; const float* y0 = p.yexp + (size_t)(2 * i) * D_; const float* y1 = y0 + D_;
    float mu = 0.f; for (int d = 0; d < D_; ++d) mu += ALPHA * h[d] + y0[d] + y1[d]; mu /= D_;
    float var = 0.f; for (int d = 0; d < D_; ++d) { const float c = ALPHA * h[d] + y0[d] + y1[d] - mu; var += c * c; } var /= D_;
    const float rs = 1.f / sqrtf(var + LN_EPS);
    for (int d = 0; d < D_; ++d) o[d] = (ALPHA * h[d] + y0[d] + y1[d] - mu) * rs * p.ln2_g[d] + p.ln2_b[d];
}

struct Carve { size_t proj, qkv, odn, vn, y, z1, h1, wgt, hid, yexp, eid, cnt, sorted, eos, total; };
static inline Carve carve() {
    Carve c; size_t o = 0; auto al = [&](size_t bytes) { size_t r = o; o += (bytes + 255) & ~(size_t)255; return r; };
    c.proj = al((size_t)T_ * INC * 4); c.qkv = al((size_t)T_ * 3 * DNW * 4); c.odn = al((size_t)T_ * DNW * 4); c.vn = al((size_t)T_ * SGW * 4);
    c.y = al((size_t)T_ * D_ * 4); c.z1 = al((size_t)T_ * D_ * 4); c.h1 = al((size_t)T_ * D_ * 4); c.wgt = al((size_t)2 * T_ * 4);
    c.hid = al((size_t)2 * T_ * DE * 4); c.yexp = al((size_t)2 * T_ * D_ * 4); c.eid = al((size_t)2 * T_ * 4); c.cnt = al(NE * 4);
    c.sorted = al((size_t)2 * T_ * 4); c.eos = al((size_t)2 * T_ * 4); c.total = o; return c;
}
static inline void bind(P& p, void* const* in, float* out, unsigned char* ws) {
    const float** f = (const float**)&p.x; for (int i = 0; i < 22; ++i) f[i] = (const float*)in[i];
    p.out = out; const Carve c = carve();
    p.proj = (float*)(ws + c.proj); p.qkv = (float*)(ws + c.qkv); p.odn = (float*)(ws + c.odn); p.vn = (float*)(ws + c.vn); p.y = (float*)(ws + c.y);
    p.z1 = (float*)(ws + c.z1); p.h1 = (float*)(ws + c.h1); p.wgt = (float*)(ws + c.wgt); p.hid = (float*)(ws + c.hid); p.yexp = (float*)(ws + c.yexp);
    p.eid = (int*)(ws + c.eid); p.cnt = (int*)(ws + c.cnt); p.sorted = (int*)(ws + c.sorted); p.eos = (int*)(ws + c.eos);
}
#define NV_STAGES(X) X(1, s1_proj, N_S1) X(2, s2_conv, N_S2) X(3, s3_l2, N_S3) X(4, s4_delta, N_S4) X(5, s5_gnorm, N_S5) X(6, s6_sguv, N_S6) X(7, s7_sgumix, N_S7) \
    X(8, s8_outproj, N_S8) X(9, s9_ln1, N_S9) X(10, s10_router, N_S10) X(11, s11_count, N_S11) X(12, s12_sort, N_S12) X(13, s13_hid, N_S13) X(14, s14_down, N_S14) X(15, s15_final, N_S15)
}
namespace pg8 {
#define PG8_LAS __attribute__((address_space(3)))
typedef unsigned short bf16_t;
typedef short bf16x8 __attribute__((ext_vector_type(8)));
typedef float f32x4 __attribute__((ext_vector_type(4)));
typedef unsigned u32x4 __attribute__((ext_vector_type(4)));
typedef unsigned u32x2 __attribute__((ext_vector_type(2)));
constexpr int BM = 256, BK = 64, HALF = 128, HTB = HALF * BK * 2  , STAGE_BYTES = 8 * HTB, NXCD = 8, WGM = 8;

__host__ __device__ __forceinline__ int lds_byte(int r, int c) { const int st = (r >> 4) * 2 + (c >> 5), rr = r & 15, cc = c & 31, ob = rr * 64 + cc * 2; return st * 1024 + (ob ^ (((ob >> 9) & 1) << 5)); }
__host__ __device__ __forceinline__ void stage_rc(int b, int& R, int& C) { const int st = b / 1024, sb = b % 1024, swz = sb ^ (((sb >> 9) & 1) << 5); R = (st >> 1) * 16 + swz / 64; C = (st & 1) * 32 + (swz % 64) / 2; }
__host__ __device__ __forceinline__ int perm32(int rho) { const int n = rho >> 4, i = rho & 15; return 8 * (i >> 2) + 4 * n + (i & 3); }

struct Unit { int pm, pn, e, rows; };

typedef float f32x2_t __attribute__((ext_vector_type(2))); typedef __bf16 bf16x2_t __attribute__((ext_vector_type(2)));
__device__ __forceinline__ unsigned cvt_pk_bf16(float lo, float hi) { const f32x2_t v = {lo, hi}; const bf16x2_t b = __builtin_convertvector(v, bf16x2_t); return __builtin_bit_cast(unsigned, b); }

__device__ __forceinline__ int lane_id_fresh() { int l; asm volatile("v_mbcnt_lo_u32_b32 %0, -1, 0\n\tv_mbcnt_hi_u32_b32 %0, -1, %0" : "=v"(l)); return l; }
__device__ __forceinline__ int xcd_remap(int L, int nwg) { const int q = nwg / NXCD, r = nwg % NXCD, xcd = L % NXCD, off = L / NXCD; return (xcd < r ? xcd * (q + 1) : r * (q + 1) + (xcd - r) * q) + off; }

struct DenseOrder {
    const bf16_t* A; const bf16_t* Bt; int lda, K; int nM, nN, nwg, G, c;
    static constexpr bool GATHER = false;
    __device__ void init(const bf16_t* A_, int lda_, const bf16_t* Bt_, int M, int N, int K_, int G_, int c_) { A = A_; Bt = Bt_; lda = lda_; K = K_; nM = M / BM; nN = N / BM; nwg = nM * nN; G = G_; c = c_; }
    __device__ bool next(int i, Unit& u) const {
        const long L = (long)i * G + c; if (L >= nwg) return false;
        const int wgid = xcd_remap((int)L, nwg);
        const int nig = WGM * nN, gid = wgid / nig, fm = gid * WGM, gsz = (nM - fm) < WGM ? (nM - fm) : WGM;
        u.pm = fm + ((wgid % nig) % gsz); u.pn = (wgid % nig) / gsz; u.e = 0; u.rows = BM; return true;
    }
    __device__ __forceinline__ const char* a_base(const Unit& u) const { return (const char*)A + (size_t)u.pm * BM * lda * 2; }
    __device__ __forceinline__ const char* b_base(const Unit& u) const { return (const char*)Bt + (size_t)u.pn * BM * K * 2; }
    __device__ __forceinline__ void a_off(const Unit&, const int (&R)[2], const int (&C)[2], unsigned (&v)[4]) const {
#pragma unroll
        for (int h = 0; h < 2; ++h)
#pragma unroll
            for (int i = 0; i < 2; ++i) v[h * 2 + i] = (unsigned)((h * HALF + R[i]) * lda + C[i]) * 2u;
    }
};

struct GroupedOrder {
    const bf16_t* A; const bf16_t* Bt; const int* list; const PG8_LAS int* pref;
    int lda, K, N, cap, ashift, nN, G, c, ne;
    static constexpr bool GATHER = true;
    __device__ bool next(int i, Unit& u) const {
        const int nwg = pref[ne]; const long L = (long)i * G + c; if (L >= nwg) return false;
        const int w = xcd_remap((int)L, nwg);
        int e = 0; while (pref[e + 1] <= w) ++e;
        const int j = w - pref[e], ntm = (pref[e + 1] - pref[e]) / nN;
        u.e = e; u.pm = j % ntm; u.pn = j / ntm; u.rows = 0; return true;
    }
    __device__ __forceinline__ const char* a_base(const Unit&) const { return (const char*)A; }
    __device__ __forceinline__ const char* b_base(const Unit& u) const { return (const char*)Bt + ((size_t)u.e * N + (size_t)u.pn * BM) * K * 2; }
    __device__ __forceinline__ void a_off(const Unit& u, const int (&R)[2], const int (&C)[2], unsigned (&v)[4], int cnt) const {
        const int* lp = list + (size_t)u.e * cap;
#pragma unroll
        for (int h = 0; h < 2; ++h)
#pragma unroll
            for (int i = 0; i < 2; ++i) { int r = u.pm * BM + h * HALF + R[i]; if (r >= cnt) r = 0; const int a = lp[r] >> ashift; v[h * 2 + i] = (unsigned)(a * lda + C[i]) * 2u; }
    }
};

template <class Epi, class Sched, bool ALIGN_EPI>
__device__ __forceinline__ void gemm_phase(PG8_LAS unsigned char* lds, const Sched& S, const Epi& E, const int* gcnt, const int wave_s) {
    const int tid_ = wave_s * 64 + lane_id_fresh();
    const int tid = tid_, wid = wave_s, lane = tid & 63, wr = wid >> 2, wc = wid & 3, fr = lane & 15, fq = lane >> 4;
    const int K = S.K, nt = K / BK;
    int Rr[2], Cc[2]; unsigned voffB[2];
#pragma unroll
    for (int i = 0; i < 2; ++i) { int R, C; stage_rc(tid * 16 + i * 8192, R, C); const int Rb = Epi::PERM ? ((R & ~31) + perm32(R & 31)) : R; Rr[i] = R; Cc[i] = C; voffB[i] = (unsigned)(Rb * K + C) * 2u; }
    const size_t kstep = (size_t)(BK * 2);
    const size_t hstep = (size_t)HALF * K * 2;
    const unsigned ldsw = (unsigned)wid * 1024u;
    const int aoff = lds_byte(wr * 64 + fr, fq * 8), boff = lds_byte(wc * 32 + fr, fq * 8);
#define PG8_SA(b, h) (((b) * 2 + (h)) * HTB)
#define PG8_SB(b, h) ((4 + (b) * 2 + (h)) * HTB)
#define PG8_STAGE(bufoff, gbase, v0, v1) do { \
        __builtin_amdgcn_global_load_lds((const unsigned*)((const char*)(gbase) + (v0)), (PG8_LAS unsigned*)(lds + (bufoff) + ldsw), 16, 0, 0); \
        __builtin_amdgcn_global_load_lds((const unsigned*)((const char*)(gbase) + (v1)), (PG8_LAS unsigned*)(lds + (bufoff) + ldsw + 8192), 16, 0, 0); } while (0)
#define PG8_STAGEB(bufoff, gbase) PG8_STAGE(bufoff, gbase, voffB[0], voffB[1])
#define PG8_LDA(dst, b, h) do { _Pragma("unroll") for (int m = 0; m < 4; ++m) _Pragma("unroll") for (int k = 0; k < 2; ++k) dst[m][k] = *(const PG8_LAS bf16x8*)(lds + PG8_SA(b, h) + aoff + m * 2048 + k * 1024); } while (0)
#define PG8_LDB(dst, b, h) do { _Pragma("unroll") for (int n = 0; n < 2; ++n) _Pragma("unroll") for (int k = 0; k < 2; ++k) dst[n][k] = *(const PG8_LAS bf16x8*)(lds + PG8_SB(b, h) + boff + n * 2048 + k * 1024); } while (0)
#define PG8_MMA(ai, bj, At, Bt) do { __builtin_amdgcn_s_setprio(1); _Pragma("unroll") for (int m = 0; m < 4; ++m) _Pragma("unroll") for (int n = 0; n < 2; ++n) _Pragma("unroll") for (int k = 0; k < 2; ++k) \
        acc[ai][bj][m][n] = __builtin_amdgcn_mfma_f32_16x16x32_bf16(Bt[n][k], At[m][k], acc[ai][bj][m][n], 0, 0, 0); __builtin_amdgcn_s_setprio(0); } while (0)
#define PG8_WAIT_V(n) asm volatile("s_waitcnt vmcnt(" #n ")" ::: "memory")
#define PG8_WAIT_L(n) asm volatile("s_waitcnt lgkmcnt(" #n ")" ::: "memory")
#define PG8_BAR __builtin_amdgcn_s_barrier()
#define PG8_SCHED __builtin_amdgcn_sched_barrier(0)
    Unit cur, nxt; int ui = 0;
    if (!S.next(0, cur)) return;
    int ccnt = BM * 1024, ncnt = BM * 1024;
    if constexpr (Sched::GATHER) { ccnt = gcnt[cur.e]; }
    cur.rows = ccnt - cur.pm * BM;
    f32x4 acc[2][2][4][2];
#pragma unroll
    for (int a = 0; a < 2; ++a)
#pragma unroll
        for (int b = 0; b < 2; ++b)
#pragma unroll
            for (int m = 0; m < 4; ++m)
#pragma unroll
                for (int n = 0; n < 2; ++n) acc[a][b][m][n] = (f32x4){0.f, 0.f, 0.f, 0.f};
    bf16x8 At[4][2], B0[2][2], B1[2][2];
    unsigned va[4], vn[4];
    if constexpr (Sched::GATHER) S.a_off(cur, Rr, Cc, va, ccnt); else S.a_off(cur, Rr, Cc, va);
    const char* cA = S.a_base(cur); const char* cB = S.b_base(cur);
    PG8_STAGEB(PG8_SB(0, 0), cB); PG8_STAGEB(PG8_SB(0, 1), cB + hstep); PG8_STAGE(PG8_SA(0, 0), cA, va[0], va[1]); PG8_STAGE(PG8_SA(0, 1), cA, va[2], va[3]);
    if (wr == 1) PG8_BAR;
    PG8_WAIT_V(2); PG8_BAR;
    PG8_STAGEB(PG8_SB(1, 0), cB + kstep); PG8_STAGE(PG8_SA(1, 0), cA + kstep, va[0], va[1]); PG8_STAGEB(PG8_SB(1, 1), cB + hstep + kstep);
    PG8_WAIT_V(6); PG8_BAR;
    for (;;) {
        const bool has_next = S.next(ui + 1, nxt);
        const char* nA = cA; const char* nB = cB;
#pragma unroll
        for (int j = 0; j < 4; ++j) vn[j] = va[j];
        if (has_next) {
            nA = S.a_base(nxt); nB = S.b_base(nxt);
            if constexpr (Sched::GATHER) { ncnt = gcnt[nxt.e]; S.a_off(nxt, Rr, Cc, vn, ncnt); } else S.a_off(nxt, Rr, Cc, vn);
            nxt.rows = ncnt - nxt.pm * BM;
        }
        for (int t = 0; t < nt; t += 2) {
            const bool last = (t == nt - 2);
            const char* a1 = cA + (size_t)(t + 1) * kstep;
            const char* a2 = last ? nA : cA + (size_t)(t + 2) * kstep; const char* b2 = last ? nB : cB + (size_t)(t + 2) * kstep;
            const char* a3 = a2 + kstep; const char* b3 = b2 + kstep;
            unsigned w0 = va[0], w1 = va[1], w2 = va[2], w3 = va[3];
            if (last) { w0 = vn[0]; w1 = vn[1]; w2 = vn[2]; w3 = vn[3]; }
            PG8_LDB(B0, 0, 0); PG8_LDB(B1, 0, 1); PG8_SCHED; PG8_LDA(At, 0, 0); PG8_STAGE(PG8_SA(1, 1), a1, va[2], va[3]);
            PG8_WAIT_V(8); PG8_WAIT_L(0); PG8_BAR; PG8_MMA(0, 0, At, B0); PG8_MMA(0, 1, At, B1); PG8_BAR; PG8_SCHED;
            PG8_LDA(At, 0, 1); PG8_STAGEB(PG8_SB(0, 0), b2); PG8_STAGEB(PG8_SB(0, 1), b2 + hstep); PG8_STAGE(PG8_SA(0, 0), a2, w0, w1);
            PG8_WAIT_V(8); PG8_WAIT_L(0); PG8_BAR; PG8_MMA(1, 0, At, B0); PG8_MMA(1, 1, At, B1); PG8_BAR; PG8_SCHED;
            PG8_LDB(B0, 1, 0); PG8_LDB(B1, 1, 1); PG8_SCHED; PG8_LDA(At, 1, 0); PG8_STAGE(PG8_SA(0, 1), a2, w2, w3);
            PG8_WAIT_V(8); PG8_WAIT_L(0); PG8_BAR; PG8_MMA(0, 0, At, B0); PG8_MMA(0, 1, At, B1); PG8_BAR; PG8_SCHED;
            PG8_LDA(At, 1, 1); PG8_STAGEB(PG8_SB(1, 0), b3); PG8_STAGEB(PG8_SB(1, 1), b3 + hstep); PG8_STAGE(PG8_SA(1, 0), a3, w0, w1);
            PG8_WAIT_V(8); PG8_WAIT_L(0); PG8_BAR; PG8_MMA(1, 0, At, B0); PG8_MMA(1, 1, At, B1); PG8_BAR; PG8_SCHED;
        }
        if constexpr (ALIGN_EPI) { if (wr == 0) PG8_BAR; }
        E(acc, cur, wr, wc, fr, fq);
        if (!has_next) break;
#pragma unroll
        for (int a = 0; a < 2; ++a)
#pragma unroll
            for (int b = 0; b < 2; ++b)
#pragma unroll
                for (int m = 0; m < 4; ++m)
#pragma unroll
                    for (int n = 0; n < 2; ++n) acc[a][b][m][n] = (f32x4){0.f, 0.f, 0.f, 0.f};
        cur = nxt; cA = nA; cB = nB; ++ui;
#pragma unroll
        for (int j = 0; j < 4; ++j) va[j] = vn[j];
        if constexpr (ALIGN_EPI) { if (wr == 1) PG8_BAR; }
    }
    PG8_WAIT_V(0);
    if constexpr (!ALIGN_EPI) { if (wr == 0) PG8_BAR; }
    PG8_BAR;
#undef PG8_SA
#undef PG8_SB
#undef PG8_STAGE
#undef PG8_STAGEB
#undef PG8_LDA
#undef PG8_LDB
#undef PG8_MMA
#undef PG8_WAIT_V
#undef PG8_WAIT_L
#undef PG8_BAR
#undef PG8_SCHED
}

struct EpiBf16 {
    static constexpr bool PERM = true;
    bf16_t* O; int ldc;
    __device__ __forceinline__ void operator()(const f32x4 (&acc)[2][2][4][2], const Unit& u, int wr, int wc, int fr, int fq) const {
        const int row0 = u.pm * BM + wr * 64 + fr, col0 = u.pn * BM + wc * 32 + 8 * fq;
#pragma unroll
        for (int ai = 0; ai < 2; ++ai)
#pragma unroll
            for (int m = 0; m < 4; ++m) { bf16_t* rowp = O + (size_t)(row0 + ai * HALF + m * 16) * ldc + col0;
#pragma unroll
                for (int bj = 0; bj < 2; ++bj) { const f32x4 v0 = acc[ai][bj][m][0], v1 = acc[ai][bj][m][1];
                    u32x4 w; w.x = cvt_pk_bf16(v0[0], v0[1]); w.y = cvt_pk_bf16(v0[2], v0[3]); w.z = cvt_pk_bf16(v1[0], v1[1]); w.w = cvt_pk_bf16(v1[2], v1[3]);
                    *(u32x4*)(rowp + bj * HALF) = w; } }
    }
};
}
#define GAS __attribute__((address_space(1)))
#define LAS __attribute__((address_space(3)))
typedef unsigned short bf16;
typedef unsigned v4u __attribute__((ext_vector_type(4)));
typedef float f32x4 __attribute__((ext_vector_type(4)));
typedef short bf16x8 __attribute__((ext_vector_type(8)));
typedef GAS unsigned gu32;
typedef GAS unsigned long long gu64;
#define RLX_AGENT __ATOMIC_RELAXED, __HIP_MEMORY_SCOPE_AGENT
#define LDS_WAIT() asm volatile("s_waitcnt lgkmcnt(0)" ::: "memory")
#define VM_WAIT() asm volatile("s_waitcnt vmcnt(0)" ::: "memory")
__device__ __forceinline__ unsigned long long rt() { return __builtin_amdgcn_s_memrealtime(); }
__device__ __forceinline__ unsigned f2bf(float f) { unsigned u = __builtin_bit_cast(unsigned, f); return (u + 0x7fffu + ((u >> 16) & 1u)) >> 16; }
__device__ __forceinline__ unsigned pk2(float lo, float hi) { return f2bf(lo) | (f2bf(hi) << 16); }

#define XB_TMO      128
#define XB_XCNT(j)  (256  + 64 * (j))
#define XB_XSUB(j)  (1280 + 64 * (j))
#define XB_XGEN(j)  (2304 + 64 * (j))
#define XB_TOP      3328
#define XB_TOPGEN   3392
#define XCD_BAR_WORDS 3456
#define XB_SPIN_CAP (1u << 18)

__device__ __forceinline__ unsigned xb_ld(unsigned* p)              { return __hip_atomic_load(p, __ATOMIC_RELAXED, __HIP_MEMORY_SCOPE_AGENT); }
__device__ __forceinline__ unsigned xb_add(unsigned* p, unsigned v) { return __hip_atomic_fetch_add(p, v, __ATOMIC_RELAXED, __HIP_MEMORY_SCOPE_AGENT); }
__device__ __forceinline__ unsigned xb_xcc_id() { return (unsigned)__builtin_amdgcn_s_getreg((3 << 11) | 20) & 0xFu; }
#define XB_SPIN(cond, bar) do { unsigned _sp = 0; while (cond) { __builtin_amdgcn_s_sleep(1); \
    if ((++_sp & 255u) == 0u) { if (xb_ld(&(bar)[XB_TMO])) break; if (_sp > XB_SPIN_CAP) { atomicAdd(&(bar)[XB_TMO], 1u); break; } } } } while (0)

struct XcdBarrier {
    unsigned* bar; unsigned x;
    volatile LAS unsigned* st;
};

__device__ __forceinline__ XcdBarrier xcd_barrier_post(unsigned* bar, volatile LAS unsigned* st) {
    XcdBarrier b; b.bar = bar; b.x = xb_xcc_id(); b.st = st;
    if (threadIdx.x == 0) (void)xb_add(&bar[XB_XCNT(b.x)], 1u);
    return b;
}
__device__ __forceinline__ void xcd_barrier_complete(unsigned* bar, unsigned x, unsigned& nloc, unsigned& nx) {
    const unsigned G = gridDim.x * gridDim.y * gridDim.z;
    unsigned sum, cnt, mine, sp = 0u;
    for (;;) {
        sum = 0u; cnt = 0u; mine = 0u;
#pragma unroll
        for (unsigned j = 0; j < 16; ++j) { const unsigned c = xb_ld(&bar[XB_XCNT(j)]); sum += c; cnt += (c > 0u) ? 1u : 0u; mine = (j == x) ? c : mine; }
        if (sum == G) break;
        __builtin_amdgcn_s_sleep(1);
        if ((++sp & 255u) == 0u) { if (xb_ld(&bar[XB_TMO])) break; if (sp > XB_SPIN_CAP) { atomicAdd(&bar[XB_TMO], 1u); break; } }
    }
    nloc = mine > 0u ? mine : 1u; nx = cnt > 0u ? cnt : 1u;
}

__device__ __forceinline__ void xcd_barrier(const XcdBarrier& b) {
    asm volatile("s_waitcnt vmcnt(0)" ::: "memory");
    __syncthreads();
    if (threadIdx.x == 0) {
        unsigned* bar = b.bar;
        __builtin_amdgcn_s_waitcnt(0);
        unsigned nloc = b.st[0], nx = b.st[1];
        if (nloc == 0u) { xcd_barrier_complete(bar, b.x, nloc, nx); b.st[0] = nloc; b.st[1] = nx; }
        const unsigned old = xb_add(&bar[XB_XSUB(b.x)], 1u);
        const unsigned gen = old / nloc;
        if (old + 1u == (gen + 1u) * nloc) {
            __builtin_amdgcn_fence(__ATOMIC_RELEASE, "agent");
            asm volatile("s_waitcnt vmcnt(0)" ::: "memory");
            const unsigned og = xb_add(&bar[XB_TOP], 1u);
            const unsigned tg = og / nx;
            if (og + 1u == (tg + 1u) * nx) xb_add(&bar[XB_TOPGEN], 1u);
            else XB_SPIN(xb_ld(&bar[XB_TOPGEN]) == tg, bar);
            __builtin_amdgcn_fence(__ATOMIC_ACQUIRE, "agent");
            xb_add(&bar[XB_XGEN(b.x)], 1u);
            asm volatile("s_waitcnt vmcnt(0)" ::: "memory");
        } else {
            XB_SPIN(xb_ld(&bar[XB_XGEN(b.x)]) == gen, bar);
            __builtin_amdgcn_fence(__ATOMIC_ACQUIRE, "agent");
            asm volatile("s_waitcnt vmcnt(0)" ::: "memory");
        }
    }
    __syncthreads();
}

constexpr int NTOK = 32768, DM = 1024, NPROJ = 3328;
constexpr int PC_Q = 0, PC_K = 512, PC_V = 1024, PC_Z = 1536, PC_U = 2048, PC_VS = 2560, PC_B = 3072, PC_A = 3076;
constexpr int NEXP = 64, DEXP = 512;
constexpr size_t MiB = 1u << 20;
constexpr size_t WS_CTL = 0, CTL_ZERO_BYTES = 1 * MiB;
constexpr size_t WS_WIN = 1 * MiB, WS_WOUT = 8 * MiB, WS_LIST = 10 * MiB, WS_ROUTE = 18 * MiB;
constexpr size_t WS_WREP = 19 * MiB;
constexpr size_t WS_C = 20 * MiB;
constexpr size_t WS_WGU = WS_C, WS_WD = WS_C + 128 * MiB;
constexpr size_t WS_A = 212 * MiB;
constexpr size_t WS_B = 276 * MiB;
constexpr size_t WS_H1BF = WS_B, WS_YEXP = WS_B + 64 * MiB;
constexpr size_t WS_END = 484 * MiB;
constexpr int CW_BAR = 4096;
constexpr int CW_CNT = 16384;
constexpr int RING_BYTES = 131072, LDSCTL_OFF = RING_BYTES, MISC_OFF = LDSCTL_OFF + 320, PREF_OFF = MISC_OFF + 128, LDS_BYTES = 147456;
constexpr int NTHREADS = 512, NWAVES = 8;
constexpr float ALPHA_F = 1.189207115002721f;

__device__ __forceinline__ float bf2f(unsigned short v) { return __builtin_bit_cast(float, (unsigned)v << 16); }
__device__ __forceinline__ float wave_sum(float v) {
#pragma unroll
    for (int o = 1; o < 64; o <<= 1) v += __shfl_xor(v, o);
    return v;
}

__device__ __forceinline__ void p0_item_load(const float* W, int ldw, int k0, int n0src, int lane, float (&r)[32]) {
#pragma unroll
    for (int i = 0; i < 32; ++i) r[i] = W[(size_t)(k0 + 2 * i + (lane >> 5)) * ldw + n0src + (lane & 31)];
}
__device__ __forceinline__ void p0_item_store(const float (&r)[32], int K, int k0, bf16* WT, int dst_row0, LAS float* scr, int lane) {
#pragma unroll
    for (int i = 0; i < 32; ++i) scr[(2 * i + (lane >> 5)) * 33 + (lane & 31)] = r[i];
    LDS_WAIT(); asm volatile("" ::: "memory");
    const int c = lane & 7;
#pragma unroll
    for (int j = 0; j < 4; ++j) { const int n = (lane >> 3) + 8 * j; const LAS float* s = scr + (8 * c) * 33 + n;
        v4u o; o.x = pk2(s[0 * 33], s[1 * 33]); o.y = pk2(s[2 * 33], s[3 * 33]); o.z = pk2(s[4 * 33], s[5 * 33]); o.w = pk2(s[6 * 33], s[7 * 33]);
        *(GAS v4u*)(WT + (size_t)(dst_row0 + n) * K + k0 + 8 * c) = o; }
    LDS_WAIT(); asm volatile("" ::: "memory");
}
__device__ __forceinline__ void p0_transpose_item(const float* W, int ldw, int K, int k0, int n0src, bf16* WT, int dst_row0, LAS float* scr, int lane) {
    float r[32]; p0_item_load(W, ldw, k0, n0src, lane, r); p0_item_store(r, K, k0, WT, dst_row0, scr, lane);
}
struct P0Exp { const float* W; bf16* WT; int ldw, K, k0, n0, drow; };
__device__ __forceinline__ P0Exp p0_exp_item(int it, const float* wg, const float* wu, const float* wd, bf16* WGU, bf16* WD) {
    P0Exp x;
    if (it < 32768) { const int nb = it & 15, kb = (it >> 4) & 15, half = (it >> 8) & 1, e = it >> 9, n0 = nb * 32;
        x.W = (half ? wu : wg) + (size_t)e * DM * DEXP; x.WT = WGU + (size_t)e * 1024 * DM; x.ldw = DEXP; x.K = DM; x.k0 = kb * 64; x.n0 = n0; x.drow = (n0 >> 7) * 256 + half * 128 + (n0 & 127); }
    else { const int i2 = it - 32768, nb = i2 & 31, kb = (i2 >> 5) & 7, e = i2 >> 8;
        x.W = wd + (size_t)e * DEXP * DM; x.WT = WD + (size_t)e * DM * DEXP; x.ldw = DM; x.K = DEXP; x.k0 = kb * 64; x.n0 = nb * 32; x.drow = nb * 32; }
    return x;
}
__device__ __forceinline__ void p0_experts(const float* wg, const float* wu, const float* wd, bf16* WGU, bf16* WD, LAS float* scr, int gw, int NGW, int lane) {
    constexpr int NIT = 32768 + 16384;
    int it = gw; if (it >= NIT) return;
    float cur[32], nxt[32];
    P0Exp xc = p0_exp_item(it, wg, wu, wd, WGU, WD); p0_item_load(xc.W, xc.ldw, xc.k0, xc.n0, lane, cur);
    for (;;) {
        const int itn = it + NGW; const bool more = itn < NIT; P0Exp xn = xc;
        if (more) { xn = p0_exp_item(itn, wg, wu, wd, WGU, WD); p0_item_load(xn.W, xn.ldw, xn.k0, xn.n0, lane, nxt); }
        p0_item_store(cur, xc.K, xc.k0, xc.WT, xc.drow, scr, lane);
        if (!more) break;
#pragma unroll
        for (int i = 0; i < 32; ++i) cur[i] = nxt[i];
        xc = xn; it = itn;
    }
}

struct MK {
    nv::P p;
    unsigned char* ws;
};

namespace pg8 {
__device__ __forceinline__ float silu_f(float x) { return x * __builtin_amdgcn_rcpf(1.f + __builtin_amdgcn_exp2f(-1.4426950408889634f * x)); }
struct EpiHid {
    static constexpr bool PERM = true;
    bf16_t* HID; const int* list; const int* cnt; int cap;
    __device__ __forceinline__ void operator()(const f32x4 (&acc)[2][2][4][2], const Unit& u, int wr, int wc, int fr, int fq) const {
        const int* lp = list + (size_t)u.e * cap; const int col0 = u.pn * 128 + wc * 32 + 8 * fq;
#pragma unroll
        for (int ai = 0; ai < 2; ++ai)
#pragma unroll
            for (int m = 0; m < 4; ++m) { const int r = ai * HALF + wr * 64 + m * 16 + fr;
                if (r < u.rows) { const int a = lp[u.pm * BM + r];
                    const f32x4 g0 = acc[ai][0][m][0], g1 = acc[ai][0][m][1], u0 = acc[ai][1][m][0], u1 = acc[ai][1][m][1];
                    u32x4 w; w.x = cvt_pk_bf16(silu_f(g0[0]) * u0[0], silu_f(g0[1]) * u0[1]); w.y = cvt_pk_bf16(silu_f(g0[2]) * u0[2], silu_f(g0[3]) * u0[3]);
                    w.z = cvt_pk_bf16(silu_f(g1[0]) * u1[0], silu_f(g1[1]) * u1[1]); w.w = cvt_pk_bf16(silu_f(g1[2]) * u1[2], silu_f(g1[3]) * u1[3]);
                    *(u32x4*)(HID + (size_t)a * 512 + col0) = w; } }
    }
};
struct EpiYexp {
    static constexpr bool PERM = true;
    bf16_t* Y; const int* list; const float* wgt; int cap;
    __device__ __forceinline__ void operator()(const f32x4 (&acc)[2][2][4][2], const Unit& u, int wr, int wc, int fr, int fq) const {
        const int* lp = list + (size_t)u.e * cap; const int col0 = u.pn * BM + wc * 32 + 8 * fq;
#pragma unroll
        for (int ai = 0; ai < 2; ++ai)
#pragma unroll
            for (int m = 0; m < 4; ++m) { const int r = ai * HALF + wr * 64 + m * 16 + fr;
                if (r < u.rows) { const int a = lp[u.pm * BM + r]; const float w8 = wgt[a];
#pragma unroll
                    for (int bj = 0; bj < 2; ++bj) { const f32x4 v0 = acc[ai][bj][m][0] * w8, v1 = acc[ai][bj][m][1] * w8;
                        u32x4 w; w.x = cvt_pk_bf16(v0[0], v0[1]); w.y = cvt_pk_bf16(v0[2], v0[3]); w.z = cvt_pk_bf16(v1[0], v1[1]); w.w = cvt_pk_bf16(v1[2], v1[3]);
                        *(u32x4*)(Y + (size_t)a * 1024 + col0 + bj * HALF) = w; } } }
    }
};

struct EpiZ1 {
    static constexpr bool PERM = false;
    float* O; const float* X; float alpha;
    __device__ __forceinline__ void operator()(const f32x4 (&acc)[2][2][4][2], const Unit& u, int wr, int wc, int fr, int fq) const {
        const int row0 = u.pm * BM + wr * 64 + fr, col0 = u.pn * BM + wc * 32 + 4 * fq;
#pragma unroll
        for (int ai = 0; ai < 2; ++ai)
#pragma unroll
            for (int m = 0; m < 4; ++m) { const size_t off = (size_t)(row0 + ai * HALF + m * 16) * 1024 + col0;
#pragma unroll
                for (int bj = 0; bj < 2; ++bj)
#pragma unroll
                    for (int n = 0; n < 2; ++n) { const f32x4 xv = *(const f32x4*)(X + off + bj * HALF + n * 16); *(f32x4*)(O + off + bj * HALF + n * 16) = acc[ai][bj][m][n] + xv * alpha; } }
    }
};
}


typedef short s16x4 __attribute__((ext_vector_type(4)));
typedef short v4i16_t __attribute__((ext_vector_type(4)));
__device__ __forceinline__ unsigned off_b(unsigned row, unsigned ch) { return 256u * row + 16u * (ch ^ (((row & 3) << 2) | ((row >> 2) & 3))); }
__device__ __forceinline__ s16x4 vtr(LAS unsigned char* p) { return __builtin_bit_cast(s16x4, __builtin_amdgcn_ds_read_tr16_b64_v4i16((LAS v4i16_t*)p)); }
__device__ __forceinline__ float gelu_tanh(float x) { return x * __builtin_amdgcn_rcpf(1.f + __builtin_amdgcn_exp2f(-2.3022081986f * (x + 0.044715f * x * x * x))); }

__device__ __forceinline__ void sgu_phase(LAS unsigned char* lds, bf16* PROJ, const nv::P& p, int G, int vcu, int wave_s) {
    const int lane = pg8::lane_id_fresh(), tid = wave_s * 64 + lane;
    const int g4 = lane >> 4, q = (lane & 15) >> 2, pp = lane & 3, l15 = lane & 15;
    v4u rawn[4];
    { const int u0 = vcu < 1024 ? vcu : 0; const bf16* src = PROJ + ((size_t)(u0 >> 2) * 128 + (tid >> 2)) * NPROJ + PC_VS + (u0 & 3) * 128 + (tid & 3) * 32;
#pragma unroll
      for (int i = 0; i < 4; ++i) rawn[i] = *(const GAS v4u*)(src + 8 * i); }
    for (int u = vcu; u < 1024; u += G) {
        const int g = u & 3, bc = u >> 2; const size_t row0 = (size_t)bc * 128;
        {
            const int s = tid >> 2, qt = tid & 3;
            v4u raw[4];
#pragma unroll
            for (int i = 0; i < 4; ++i) raw[i] = rawn[i];
            { const int un = (u + G < 1024) ? u + G : u; const bf16* srcn = PROJ + ((size_t)(un >> 2) * 128 + s) * NPROJ + PC_VS + (un & 3) * 128 + qt * 32;
#pragma unroll
              for (int i = 0; i < 4; ++i) rawn[i] = *(const GAS v4u*)(srcn + 8 * i); }
            float x[32]; float s1 = 0.f;
#pragma unroll
            for (int i = 0; i < 4; ++i)
#pragma unroll
                for (int c = 0; c < 4; ++c) { const unsigned w = raw[i][c]; const float a = gelu_tanh(__builtin_bit_cast(float, w << 16)), b = gelu_tanh(__builtin_bit_cast(float, w & 0xffff0000u)); x[i * 8 + c * 2] = a; x[i * 8 + c * 2 + 1] = b; s1 += a + b; }
            s1 += __shfl_xor(s1, 1); s1 += __shfl_xor(s1, 2);
            const float mean = s1 * (1.f / 128.f); float s2 = 0.f;
#pragma unroll
            for (int i = 0; i < 32; ++i) { x[i] -= mean; s2 += x[i] * x[i]; }
            s2 += __shfl_xor(s2, 1); s2 += __shfl_xor(s2, 2);
            const float rstd = 1.f / sqrtf(s2 * (1.f / 128.f) + 1e-5f);
            const float* lg = p.sgu_ln_g + g * 128 + qt * 32; const float* lb = p.sgu_ln_b + g * 128 + qt * 32;
#pragma unroll
            for (int i = 0; i < 4; ++i) { const f32x4 g0 = *(const GAS f32x4*)(lg + 8 * i), g1 = *(const GAS f32x4*)(lg + 8 * i + 4), b0 = *(const GAS f32x4*)(lb + 8 * i), b1 = *(const GAS f32x4*)(lb + 8 * i + 4);
                v4u o; o.x = pk2(x[8 * i] * rstd * g0.x + b0.x, x[8 * i + 1] * rstd * g0.y + b0.y); o.y = pk2(x[8 * i + 2] * rstd * g0.z + b0.z, x[8 * i + 3] * rstd * g0.w + b0.w);
                o.z = pk2(x[8 * i + 4] * rstd * g1.x + b1.x, x[8 * i + 5] * rstd * g1.y + b1.y); o.w = pk2(x[8 * i + 6] * rstd * g1.z + b1.z, x[8 * i + 7] * rstd * g1.w + b1.w);
                *(LAS v4u*)(lds + off_b((unsigned)s, (unsigned)(qt * 4 + i))) = o; }
        }
        __syncthreads();
        {
            const int w = wave_s, t = 16 * w + l15, nks = (w >> 1) + 1;
            f32x4 acc[8];
#pragma unroll
            for (int dt = 0; dt < 8; ++dt) acc[dt] = (f32x4){0.f, 0.f, 0.f, 0.f};
            for (int ks = 0; ks < nks; ++ks) {
                const int sb = 32 * ks + 8 * g4;
                const float* wp = p.w_spatial + ((size_t)(g * 128 + t)) * 128 + sb;
                const f32x4 w0 = *(const GAS f32x4*)wp, w1 = *(const GAS f32x4*)(wp + 4);
                float wv[8] = {w0.x, w0.y, w0.z, w0.w, w1.x, w1.y, w1.z, w1.w};
#pragma unroll
                for (int j = 0; j < 8; ++j) if (sb + j > t) wv[j] = 0.f;
                v4u bw; bw.x = pk2(wv[0], wv[1]); bw.y = pk2(wv[2], wv[3]); bw.z = pk2(wv[4], wv[5]); bw.w = pk2(wv[6], wv[7]);
                const bf16x8 bfrag = __builtin_bit_cast(bf16x8, bw);
#pragma unroll
                for (int dt = 0; dt < 8; ++dt) {
                    const s16x4 lo = vtr(lds + off_b((unsigned)(sb + q), (unsigned)(2 * dt + (pp >> 1))) + 8 * (pp & 1));
                    const s16x4 hi = vtr(lds + off_b((unsigned)(sb + 4 + q), (unsigned)(2 * dt + (pp >> 1))) + 8 * (pp & 1));
                    const bf16x8 afrag = (bf16x8){lo[0], lo[1], lo[2], lo[3], hi[0], hi[1], hi[2], hi[3]};
                    acc[dt] = __builtin_amdgcn_mfma_f32_16x16x32_bf16(afrag, bfrag, acc[dt], 0, 0, 0);
                }
            }
            const float bias = p.b_spatial[g * 128 + t];
            bf16* rowp = PROJ + (row0 + t) * NPROJ;
#pragma unroll
            for (int dt = 0; dt < 8; ++dt) {
                const int d = g * 128 + 16 * dt + 4 * g4;
                const unsigned long long uu = *(const GAS unsigned long long*)(rowp + PC_U + d);
                const float u0 = gelu_tanh(bf2f((unsigned short)uu)), u1 = gelu_tanh(bf2f((unsigned short)(uu >> 16))), u2 = gelu_tanh(bf2f((unsigned short)(uu >> 32))), u3 = gelu_tanh(bf2f((unsigned short)(uu >> 48)));
                const unsigned long long o = (unsigned long long)pk2(u0 * (acc[dt][0] + bias), u1 * (acc[dt][1] + bias)) | ((unsigned long long)pk2(u2 * (acc[dt][2] + bias), u3 * (acc[dt][3] + bias)) << 32);
                *(GAS unsigned long long*)(rowp + 512 + d) = o;
            }
        }
        __syncthreads();
    }
}

constexpr int DNA_PIECES = 57, DNU_PIECES = 2, DN_STEP_BYTES = (DNA_PIECES + DNU_PIECES) * 1024;
constexpr size_t DNA_CHUNK_BYTES = (size_t)DNA_PIECES * 1024, DNU_CHUNK_BYTES = 8 * DNU_PIECES * 1024;
__device__ __forceinline__ void glds16(const void* gsrc, LAS unsigned char* dst) { __builtin_amdgcn_global_load_lds((const unsigned*)gsrc, (LAS unsigned*)dst, 16, 0, 0); }
typedef float f32x2_t __attribute__((ext_vector_type(2))); typedef __bf16 bf16x2_t __attribute__((ext_vector_type(2)));
__device__ __forceinline__ unsigned cvtpk(float lo, float hi) { const f32x2_t v = {lo, hi}; const bf16x2_t b = __builtin_convertvector(v, bf16x2_t); return __builtin_bit_cast(unsigned, b); }

constexpr int DN_RING_PIECES = 42, DN_SLOT_BYTES = DN_RING_PIECES * 1024;
__device__ __forceinline__ void dn_scan_phase(LAS unsigned char* lds, const unsigned char* DNA, const unsigned char* DNU, bf16* ODN, int vcu, int wave_s) {
    if (vcu >= 256) return;
    const int lane = pg8::lane_id_fresh();
    const int bh = vcu >> 3, sl = vcu & 7, l15 = lane & 15, g4 = lane >> 4;
    const unsigned char* a_src = DNA + (size_t)bh * 64 * DNA_CHUNK_BYTES + lane * 16;
    const unsigned char* u_src = DNU + ((size_t)bh * 64 * 8 + sl) * (DNU_PIECES * 1024) + lane * 16;
#define DN_STAGE(step) do { if (wave_s >= 1 && wave_s <= 6) { const unsigned char* as_ = a_src + (size_t)(step) * DNA_CHUNK_BYTES; const unsigned char* us_ = u_src + (size_t)(step) * DNU_CHUNK_BYTES; \
        LAS unsigned char* sp_ = lds + ((step) % 3) * DN_SLOT_BYTES; \
        _Pragma("unroll") for (int i_ = 0; i_ < 7; ++i_) { const int p_ = (wave_s - 1) + 6 * i_; \
            const unsigned char* g_ = p_ < 16 ? as_ + p_ * 1024 : p_ < 32 ? as_ + (16 + p_) * 1024 : p_ < 40 ? as_ + (16 + p_) * 1024 : us_ + (p_ - 40) * 1024; \
            glds16(g_, sp_ + p_ * 1024); } } } while (0)
    DN_STAGE(0); DN_STAGE(1);
    if (wave_s != 0) {
        for (int n = 0; n < 64; ++n) {
            if (n < 63) asm volatile("s_waitcnt vmcnt(7)" ::: "memory"); else asm volatile("s_waitcnt vmcnt(0)" ::: "memory");
            __builtin_amdgcn_s_barrier();
            asm volatile("" ::: "memory");
            if (n + 2 < 64) DN_STAGE(n + 2);
        }
        asm volatile("s_waitcnt vmcnt(0)" ::: "memory");
        return;
    }
#undef DN_STAGE
    f32x4 S[8];
#pragma unroll
    for (int k = 0; k < 8; ++k) S[k] = (f32x4){0.f, 0.f, 0.f, 0.f};
    bf16x8 Qc[16], Qn[16]; float glc, gln;
#pragma unroll
    for (int i = 0; i < 16; ++i) Qc[i] = *(const GAS bf16x8*)(a_src + (16 + i) * 1024);
    glc = *(const GAS float*)(a_src + 56 * 1024);
    bf16* orow = ODN + (size_t)vcu * (64 * 64 * 16) + l15;
    for (int n = 0; n < 64; ++n) {
        asm volatile("s_waitcnt lgkmcnt(0)" ::: "memory");
        __builtin_amdgcn_s_barrier();
        asm volatile("" ::: "memory");
        { const unsigned char* nx = a_src + (size_t)(n + 1 < 64 ? n + 1 : n) * DNA_CHUNK_BYTES;
#pragma unroll
          for (int i = 0; i < 16; ++i) Qn[i] = *(const GAS bf16x8*)(nx + (16 + i) * 1024);
          gln = *(const GAS float*)(nx + 56 * 1024); }
        LAS unsigned char* lb = lds + (n % 3) * DN_SLOT_BYTES + lane * 16;
#define FRAG(piece) (*(const LAS bf16x8*)(lb + (piece) * 1024))
        bf16x8 Sb[4];
#pragma unroll
        for (int ks = 0; ks < 4; ++ks) { v4u w; w.x = cvtpk(S[2 * ks][0], S[2 * ks][1]); w.y = cvtpk(S[2 * ks][2], S[2 * ks][3]); w.z = cvtpk(S[2 * ks + 1][0], S[2 * ks + 1][1]); w.w = cvtpk(S[2 * ks + 1][2], S[2 * ks + 1][3]); Sb[ks] = __builtin_bit_cast(bf16x8, w); }
        f32x4 P[4];
        { const v4u u0 = *(const LAS v4u*)(lb + 40 * 1024), u1 = *(const LAS v4u*)(lb + 41 * 1024);
          P[0] = (f32x4){__builtin_bit_cast(float, u0.x << 16), __builtin_bit_cast(float, u0.x & 0xffff0000u), __builtin_bit_cast(float, u0.y << 16), __builtin_bit_cast(float, u0.y & 0xffff0000u)};
          P[1] = (f32x4){__builtin_bit_cast(float, u0.z << 16), __builtin_bit_cast(float, u0.z & 0xffff0000u), __builtin_bit_cast(float, u0.w << 16), __builtin_bit_cast(float, u0.w & 0xffff0000u)};
          P[2] = (f32x4){__builtin_bit_cast(float, u1.x << 16), __builtin_bit_cast(float, u1.x & 0xffff0000u), __builtin_bit_cast(float, u1.y << 16), __builtin_bit_cast(float, u1.y & 0xffff0000u)};
          P[3] = (f32x4){__builtin_bit_cast(float, u1.z << 16), __builtin_bit_cast(float, u1.z & 0xffff0000u), __builtin_bit_cast(float, u1.w << 16), __builtin_bit_cast(float, u1.w & 0xffff0000u)}; }
#pragma unroll
        for (int mt = 0; mt < 4; ++mt)
#pragma unroll
            for (int ks = 0; ks < 4; ++ks) P[mt] = __builtin_amdgcn_mfma_f32_16x16x32_bf16(FRAG(mt * 4 + ks), Sb[ks], P[mt], 0, 0, 0);
        bf16x8 Vb[2];
#pragma unroll
        for (int ks = 0; ks < 2; ++ks) { v4u w; w.x = cvtpk(P[2 * ks][0], P[2 * ks][1]); w.y = cvtpk(P[2 * ks][2], P[2 * ks][3]); w.z = cvtpk(P[2 * ks + 1][0], P[2 * ks + 1][1]); w.w = cvtpk(P[2 * ks + 1][2], P[2 * ks + 1][3]); Vb[ks] = __builtin_bit_cast(bf16x8, w); }
        f32x4 O[4];
#pragma unroll
        for (int mt = 0; mt < 4; ++mt) { O[mt] = (f32x4){0.f, 0.f, 0.f, 0.f};
#pragma unroll
            for (int ks = 0; ks < 4; ++ks) O[mt] = __builtin_amdgcn_mfma_f32_16x16x32_bf16(Qc[mt * 4 + ks], Sb[ks], O[mt], 0, 0, 0);
#pragma unroll
            for (int ks = 0; ks < 2; ++ks) O[mt] = __builtin_amdgcn_mfma_f32_16x16x32_bf16(FRAG(32 + mt * 2 + ks), Vb[ks], O[mt], 0, 0, 0); }
#pragma unroll
        for (int kt = 0; kt < 8; ++kt) { S[kt] = S[kt] * glc;
#pragma unroll
            for (int ks = 0; ks < 2; ++ks) S[kt] = __builtin_amdgcn_mfma_f32_16x16x32_bf16(FRAG(16 + kt * 2 + ks), Vb[ks], S[kt], 0, 0, 0); }
#undef FRAG
        bf16* ob = orow + (size_t)(n * 64 + 4 * g4) * 16;
#pragma unroll
        for (int mt = 0; mt < 4; ++mt)
#pragma unroll
            for (int r = 0; r < 4; ++r) ob[(16 * mt + r) * 16] = (bf16)f2bf(O[mt][r]);
#pragma unroll
        for (int i = 0; i < 16; ++i) Qc[i] = Qn[i];
        glc = gln;
    }
    asm volatile("s_waitcnt vmcnt(0)" ::: "memory");
}

__device__ __forceinline__ void dn_final_phase(const bf16* ODN, bf16* PROJ, const float* norm_w, int gw, int NGW, int lane) {
    const f32x4 nw0 = *(const GAS f32x4*)(norm_w + ((8 * lane) & 127)), nw1 = *(const GAS f32x4*)(norm_w + ((8 * lane) & 127) + 4);
    for (int m = gw; m < NTOK; m += NGW) {
        const int bb = m >> 12, nn = (m >> 6) & 63, ii = m & 63;
        const v4u ov = *(const GAS v4u*)(ODN + ((((size_t)((bb * 4 + (lane >> 4)) * 8 + ((lane >> 1) & 7)) * 64 + nn) * 64 + ii) * 16 + 8 * (lane & 1))), zv = *(const GAS v4u*)(PROJ + (size_t)m * NPROJ + PC_Z + 8 * lane);
        float o[8], z[8];
#pragma unroll
        for (int c = 0; c < 4; ++c) { o[2 * c] = __builtin_bit_cast(float, ov[c] << 16); o[2 * c + 1] = __builtin_bit_cast(float, ov[c] & 0xffff0000u); z[2 * c] = __builtin_bit_cast(float, zv[c] << 16); z[2 * c + 1] = __builtin_bit_cast(float, zv[c] & 0xffff0000u); }
        float ss = 0.f;
#pragma unroll
        for (int c = 0; c < 8; ++c) ss += o[c] * o[c];
        ss += __shfl_xor(ss, 1); ss += __shfl_xor(ss, 2); ss += __shfl_xor(ss, 4); ss += __shfl_xor(ss, 8);
        const float rs = 1.f / sqrtf(ss * (1.f / 128.f) + 1e-6f);
        const float nw[8] = {nw0.x, nw0.y, nw0.z, nw0.w, nw1.x, nw1.y, nw1.z, nw1.w};
        float y[8];
#pragma unroll
        for (int c = 0; c < 8; ++c) y[c] = o[c] * rs * nw[c] * z[c] * __builtin_amdgcn_rcpf(1.f + __builtin_amdgcn_exp2f(-1.4426950408889634f * z[c]));
        v4u w; w.x = pk2(y[0], y[1]); w.y = pk2(y[2], y[3]); w.z = pk2(y[4], y[5]); w.w = pk2(y[6], y[7]);
        *(GAS v4u*)(PROJ + (size_t)m * NPROJ + 8 * lane) = w;
    }
}

__device__ __forceinline__ float wave_sum_dpp(float v) {
    v = v + __builtin_bit_cast(float, __builtin_amdgcn_update_dpp(0, __builtin_bit_cast(int, v), 0xB1, 0xf, 0xf, true));
    v = v + __builtin_bit_cast(float, __builtin_amdgcn_update_dpp(0, __builtin_bit_cast(int, v), 0x4E, 0xf, 0xf, true));
    v = v + __builtin_bit_cast(float, __builtin_amdgcn_update_dpp(0, __builtin_bit_cast(int, v), 0x141, 0xf, 0xf, true));
    v = v + __builtin_bit_cast(float, __builtin_amdgcn_update_dpp(0, __builtin_bit_cast(int, v), 0x140, 0xf, 0xf, true));
    v = v + __builtin_bit_cast(float, __builtin_amdgcn_update_dpp(0, __builtin_bit_cast(int, v), 0x142, 0xa, 0xf, true));
    v = v + __builtin_bit_cast(float, __builtin_amdgcn_update_dpp(0, __builtin_bit_cast(int, v), 0x143, 0xc, 0xf, true));
    return __builtin_bit_cast(float, __builtin_amdgcn_readlane(__builtin_bit_cast(int, v), 63));
}

constexpr int XTAB_OFF = RING_BYTES + 2048, XTAB_BYTES = 1792;
__device__ __forceinline__ unsigned off_t64(unsigned row, unsigned ch) { return 128u * row + 16u * (ch ^ (row & 7u)); }
__device__ __forceinline__ bf16x8 pack8(const float (&v)[8]) { v4u w; w.x = cvtpk(v[0], v[1]); w.y = cvtpk(v[2], v[3]); w.z = cvtpk(v[4], v[5]); w.w = cvtpk(v[6], v[7]); return __builtin_bit_cast(bf16x8, w); }
__device__ __forceinline__ void unpack8(const v4u w, float (&v)[8]) {
#pragma unroll
    for (int c = 0; c < 4; ++c) { v[2 * c] = __builtin_bit_cast(float, w[c] << 16); v[2 * c + 1] = __builtin_bit_cast(float, w[c] & 0xffff0000u); }
}
__device__ __forceinline__ float conv_silu_rows(const bf16* src0, bool seq_start, const float* cw, LAS unsigned char* img, int lane) {
    float w[4][2];
#pragma unroll
    for (int j = 0; j < 4; ++j) { const f32x2_t t = *(const GAS f32x2_t*)(cw + j * 1536 + 2 * lane); w[j][0] = t[0]; w[j][1] = t[1]; }
    const GAS unsigned* gsrc = (const GAS unsigned*)(src0 + 2 * lane);
    unsigned raw[67];
#pragma unroll
    for (int r = 0; r < 3; ++r) raw[r] = seq_start ? 0u : gsrc[(long)(r - 3) * (NPROJ / 2)];
#pragma unroll
    for (int r = 0; r < 64; ++r) raw[3 + r] = gsrc[(size_t)r * (NPROJ / 2)];
    float myss = 0.f;
    const unsigned lbase = (unsigned)((lane & 3) * 4);
#pragma unroll
    for (int pz = 0; pz < 64; ++pz) {
        float y0 = 0.f, y1 = 0.f;
#pragma unroll
        for (int j = 0; j < 4; ++j) { const unsigned u = raw[pz + j]; y0 += w[j][0] * __builtin_bit_cast(float, u << 16); y1 += w[j][1] * __builtin_bit_cast(float, u & 0xffff0000u); }
        y0 = y0 * __builtin_amdgcn_rcpf(1.f + __builtin_amdgcn_exp2f(-1.4426950408889634f * y0));
        y1 = y1 * __builtin_amdgcn_rcpf(1.f + __builtin_amdgcn_exp2f(-1.4426950408889634f * y1));
        const float tot = wave_sum_dpp(y0 * y0 + y1 * y1);
        myss = (lane == pz) ? tot : myss;
        *(LAS unsigned*)(img + off_b((unsigned)pz, (unsigned)(lane >> 2)) + lbase) = cvtpk(y0, y1);
    }
    return myss;
}

template <int STOP>
__device__ __forceinline__ void dn_prep_chunk(LAS unsigned char* IMG  , LAS float* tab, const bf16* PROJ, const nv::P& p, unsigned char* DNA, unsigned char* DNU, int ci) {
    int lane = pg8::lane_id_fresh();
    const int bh = ci >> 6, n = ci & 63, b = bh >> 2, h = bh & 3;
    int l15 = lane & 15, g4 = lane >> 4, q = l15 >> 2, pp = lane & 3;
    LAS float* t_gc = tab; LAS float* t_be = tab + 64; LAS float* t_rk = tab + 128; LAS float* t_rq = tab + 192; LAS float* t_eq = tab + 256; LAS float* t_ekk = tab + 320; LAS float* t_bg = tab + 384;
    const size_t tok = (size_t)b * 4096 + n * 64 + lane;
    const bf16* prow = PROJ + tok * NPROJ;
    const bf16* prow0 = PROJ + ((size_t)b * 4096 + n * 64) * NPROJ;
    unsigned char* dna = DNA + (size_t)ci * DNA_CHUNK_BYTES + lane * 16;
    (void)q; (void)pp;
    float gc, beta, eg, gc63;
    {
        const float araw = bf2f(prow[PC_A + h]), braw = bf2f(prow[PC_B + h]);
        const float xx = araw + p.dt_bias[h];
        const float sp = xx > 20.f ? xx : log1pf(expf(xx));
        gc = -expf(p.a_log[h]) * sp;
        beta = 1.f / (1.f + expf(-braw));
#pragma unroll
        for (int o = 1; o < 64; o <<= 1) { const float t = __shfl_up(gc, o); if (lane >= o) gc += t; }
        gc63 = __shfl(gc, 63);
        eg = expf(gc);
        const unsigned gb = __builtin_bit_cast(unsigned, expf(gc63));
        *(GAS v4u*)(dna + 56 * 1024) = (v4u){gb, gb, gb, gb};
        const float ssq = conv_silu_rows(prow0 + PC_Q + h * 128, n == 0, p.conv_w + h * 128, IMG, lane);
        const float rq = 0.08838834764831845f / sqrtf(ssq + 1e-6f);
        t_gc[lane] = gc; t_be[lane] = beta; t_rq[lane] = rq; t_eq[lane] = eg * rq;
    }
    LDS_WAIT(); asm volatile("" ::: "memory");
    if constexpr (STOP == 1) return;
    bf16x8 qF[4][4];
#pragma unroll
    for (int mt = 0; mt < 4; ++mt)
#pragma unroll
        for (int ks = 0; ks < 4; ++ks) qF[mt][ks] = *(const LAS bf16x8*)(IMG + off_b((unsigned)(16 * mt + l15), (unsigned)(4 * ks + g4)));
#pragma unroll
    for (int mt = 0; mt < 4; ++mt) {
        const float egi = t_eq[16 * mt + l15];
#pragma unroll
        for (int ks = 0; ks < 4; ++ks) {
            const unsigned long long lo = *(const LAS unsigned long long*)(IMG + off_b((unsigned)(16 * mt + l15), (unsigned)(4 * ks + (g4 >> 1))) + (g4 & 1) * 8);
            const unsigned long long hi = *(const LAS unsigned long long*)(IMG + off_b((unsigned)(16 * mt + l15), (unsigned)(4 * ks + 2 + (g4 >> 1))) + (g4 & 1) * 8);
            float t8[8]; unpack8((v4u){(unsigned)lo, (unsigned)(lo >> 32), (unsigned)hi, (unsigned)(hi >> 32)}, t8);
#pragma unroll
            for (int e = 0; e < 8; ++e) t8[e] *= egi;
            *(GAS bf16x8*)(dna + (16 + mt * 4 + ks) * 1024) = pack8(t8);
        }
    }
    LDS_WAIT(); asm volatile("" ::: "memory");
    {
        const float ssk = conv_silu_rows(prow0 + PC_K + h * 128, n == 0, p.conv_w + 512 + h * 128, IMG, lane);
        const float rk = 1.f / sqrtf(ssk + 1e-6f);
        t_rk[lane] = rk; t_ekk[lane] = expf(gc63 - gc) * rk; t_bg[lane] = beta * eg * rk;
    }
    LDS_WAIT(); asm volatile("" ::: "memory");
    if constexpr (STOP == 2) return;
    f32x4 Am[4][4];
    {
        bf16x8 kF[4][4];
#pragma unroll
        for (int mt = 0; mt < 4; ++mt)
#pragma unroll
            for (int ks = 0; ks < 4; ++ks) kF[mt][ks] = *(const LAS bf16x8*)(IMG + off_b((unsigned)(16 * mt + l15), (unsigned)(4 * ks + g4)));
#pragma unroll
        for (int mi = 0; mi < 4; ++mi) {
            const f32x4 gci = *(const LAS f32x4*)(t_gc + 16 * mi + 4 * g4), bei = *(const LAS f32x4*)(t_be + 16 * mi + 4 * g4), rki = *(const LAS f32x4*)(t_rk + 16 * mi + 4 * g4);
#pragma unroll
            for (int nj = 0; nj <= mi; ++nj) {
                f32x4 acc = (f32x4){0.f, 0.f, 0.f, 0.f};
#pragma unroll
                for (int ks = 0; ks < 4; ++ks) acc = __builtin_amdgcn_mfma_f32_16x16x32_bf16(kF[mi][ks], kF[nj][ks], acc, 0, 0, 0);
                const float gcj = t_gc[16 * nj + l15], rkj = t_rk[16 * nj + l15]; const int j = 16 * nj + l15;
#pragma unroll
                for (int r = 0; r < 4; ++r) { const int i = 16 * mi + 4 * g4 + r; acc[r] = (j < i) ? bei[r] * rki[r] * rkj * acc[r] * expf(gci[r] - gcj) : 0.f; }
                Am[mi][nj] = acc;
            }
        }
#pragma unroll
        for (int it = 0; it < 4; ++it) {
            const float gci = t_gc[16 * it + l15], rqi = t_rq[16 * it + l15]; const int i = 16 * it + l15;
            f32x4 kq[4];
#pragma unroll
            for (int jt = 0; jt < 4; ++jt) {
                f32x4 acc = (f32x4){0.f, 0.f, 0.f, 0.f};
                if (jt <= it) {
#pragma unroll
                    for (int ks = 0; ks < 4; ++ks) acc = __builtin_amdgcn_mfma_f32_16x16x32_bf16(kF[jt][ks], qF[it][ks], acc, 0, 0, 0);
                    const f32x4 gcj = *(const LAS f32x4*)(t_gc + 16 * jt + 4 * g4), rkj = *(const LAS f32x4*)(t_rk + 16 * jt + 4 * g4);
#pragma unroll
                    for (int r = 0; r < 4; ++r) { const int j = 16 * jt + 4 * g4 + r; acc[r] = (j <= i) ? acc[r] * rqi * rkj[r] * expf(gci - gcj[r]) : 0.f; }
                }
                kq[jt] = acc;
            }
#pragma unroll
            for (int ks = 0; ks < 2; ++ks) { const float t8[8] = {kq[2 * ks][0], kq[2 * ks][1], kq[2 * ks][2], kq[2 * ks][3], kq[2 * ks + 1][0], kq[2 * ks + 1][1], kq[2 * ks + 1][2], kq[2 * ks + 1][3]};
                *(GAS bf16x8*)(dna + (48 + it * 2 + ks) * 1024) = pack8(t8); }
        }
    }
    if constexpr (STOP == 3) return;
    bf16x8 ktr[8][2];
    {
#pragma unroll
        for (int ks = 0; ks < 2; ++ks) {
            const f32x4 ek0 = *(const LAS f32x4*)(t_ekk + 32 * ks + 4 * g4), ek1 = *(const LAS f32x4*)(t_ekk + 32 * ks + 16 + 4 * g4);
#pragma unroll
            for (int mt = 0; mt < 8; ++mt) {
                const s16x4 lo = vtr(IMG + off_b((unsigned)(32 * ks + 4 * g4 + q), (unsigned)(2 * mt + (pp >> 1))) + 8 * (pp & 1));
                const s16x4 hi = vtr(IMG + off_b((unsigned)(32 * ks + 16 + 4 * g4 + q), (unsigned)(2 * mt + (pp >> 1))) + 8 * (pp & 1));
                const float t8[8] = {bf2f((unsigned short)lo[0]) * ek0.x, bf2f((unsigned short)lo[1]) * ek0.y, bf2f((unsigned short)lo[2]) * ek0.z, bf2f((unsigned short)lo[3]) * ek0.w,
                                     bf2f((unsigned short)hi[0]) * ek1.x, bf2f((unsigned short)hi[1]) * ek1.y, bf2f((unsigned short)hi[2]) * ek1.z, bf2f((unsigned short)hi[3]) * ek1.w};
                *(GAS bf16x8*)(dna + (32 + mt * 2 + ks) * 1024) = pack8(t8);
            }
        }
#pragma unroll
        for (int dt = 0; dt < 8; ++dt)
#pragma unroll
            for (int ks = 0; ks < 2; ++ks) {
                const s16x4 lo = vtr(IMG + off_b((unsigned)(32 * ks + 8 * g4 + q), (unsigned)(2 * dt + (pp >> 1))) + 8 * (pp & 1));
                const s16x4 hi = vtr(IMG + off_b((unsigned)(32 * ks + 8 * g4 + 4 + q), (unsigned)(2 * dt + (pp >> 1))) + 8 * (pp & 1));
                ktr[dt][ks] = (bf16x8){lo[0], lo[1], lo[2], lo[3], hi[0], hi[1], hi[2], hi[3]};
            }
    }
    LDS_WAIT(); asm volatile("" ::: "memory");
    {
        LAS float* AL = (LAS float*)IMG;
#pragma unroll
        for (int mi = 0; mi < 4; ++mi)
#pragma unroll
            for (int nj = 0; nj <= mi; ++nj)
#pragma unroll
                for (int r = 0; r < 4; ++r) AL[(16 * mi + 4 * g4 + r) * 64 + 16 * nj + l15] = Am[mi][nj][r];
    }
    LDS_WAIT(); asm volatile("" ::: "memory");
    float T[64];
    {
        const LAS float* AL = (const LAS float*)IMG;
#pragma clang loop unroll(full)
        for (int i = 0; i < 64; ++i) {
            float v4[4] = {(lane == i) ? 1.f : 0.f, 0.f, 0.f, 0.f};
#pragma clang loop unroll(full)
            for (int j4 = 0; j4 < (i + 3) / 4; ++j4) {
                const f32x4 a = *(const LAS f32x4*)(AL + i * 64 + 4 * j4);
#pragma clang loop unroll(full)
                for (int e = 0; e < 4; ++e) if (4 * j4 + e < i) v4[e] -= a[e] * T[4 * j4 + e];
            }
            T[i] = (v4[0] + v4[1]) + (v4[2] + v4[3]);
        }
    }
    LDS_WAIT(); asm volatile("" ::: "memory");
    if constexpr (STOP == 4) return;
    lane = pg8::lane_id_fresh(); l15 = lane & 15; g4 = lane >> 4; q = l15 >> 2; pp = lane & 3;
    dna = DNA + (size_t)ci * DNA_CHUNK_BYTES + lane * 16;
    {
        const float bc = t_be[lane], bgc = t_bg[lane];
        LAS unsigned char* TB = IMG; LAS unsigned char* TBE = IMG + 8192;
#pragma unroll
        for (int i = 0; i < 64; ++i) { const unsigned o = off_t64((unsigned)i, (unsigned)(lane >> 3)) + (lane & 7) * 2;
            *(LAS unsigned short*)(TB + o) = (unsigned short)f2bf(T[i] * bc); *(LAS unsigned short*)(TBE + o) = (unsigned short)f2bf(T[i] * bgc); }
    }
    LDS_WAIT(); asm volatile("" ::: "memory");
    bf16x8 tb[4][2];
    {
#pragma unroll
        for (int it = 0; it < 4; ++it) {
            bf16x8 tbe[2];
#pragma unroll
            for (int ks = 0; ks < 2; ++ks) tbe[ks] = *(const LAS bf16x8*)(IMG + 8192 + off_t64((unsigned)(16 * it + l15), (unsigned)(4 * ks + g4)));
            f32x4 acc[8];
#pragma unroll
            for (int dt = 0; dt < 8; ++dt) { acc[dt] = (f32x4){0.f, 0.f, 0.f, 0.f};
#pragma unroll
                for (int ks = 0; ks < 2; ++ks) acc[dt] = __builtin_amdgcn_mfma_f32_16x16x32_bf16(ktr[dt][ks], tbe[ks], acc[dt], 0, 0, 0); }
#pragma unroll
            for (int ks = 0; ks < 4; ++ks) { const float t8[8] = {-acc[2 * ks][0], -acc[2 * ks][1], -acc[2 * ks][2], -acc[2 * ks][3], -acc[2 * ks + 1][0], -acc[2 * ks + 1][1], -acc[2 * ks + 1][2], -acc[2 * ks + 1][3]};
                *(GAS bf16x8*)(dna + (it * 4 + ks) * 1024) = pack8(t8); }
        }
#pragma unroll
        for (int mt = 0; mt < 4; ++mt)
#pragma unroll
            for (int ks = 0; ks < 2; ++ks) tb[mt][ks] = *(const LAS bf16x8*)(IMG + off_t64((unsigned)(16 * mt + l15), (unsigned)(4 * ks + g4)));
    }
    LDS_WAIT(); asm volatile("" ::: "memory");
    if constexpr (STOP == 5) return;
    (void)conv_silu_rows(prow0 + PC_V + h * 128, n == 0, p.conv_w + 1024 + h * 128, IMG, lane);
    LDS_WAIT(); asm volatile("" ::: "memory");
    {
        unsigned char* dnu = DNU + (size_t)ci * DNU_CHUNK_BYTES + lane * 16;
#pragma unroll
        for (int dt = 0; dt < 8; ++dt) {
            bf16x8 vt[2];
#pragma unroll
            for (int ks = 0; ks < 2; ++ks) {
                const s16x4 lo = vtr(IMG + off_b((unsigned)(32 * ks + 8 * g4 + q), (unsigned)(2 * dt + (pp >> 1))) + 8 * (pp & 1));
                const s16x4 hi = vtr(IMG + off_b((unsigned)(32 * ks + 8 * g4 + 4 + q), (unsigned)(2 * dt + (pp >> 1))) + 8 * (pp & 1));
                vt[ks] = (bf16x8){lo[0], lo[1], lo[2], lo[3], hi[0], hi[1], hi[2], hi[3]};
            }
            f32x4 u[4];
#pragma unroll
            for (int mt = 0; mt < 4; ++mt) { u[mt] = (f32x4){0.f, 0.f, 0.f, 0.f};
#pragma unroll
                for (int ks = 0; ks < 2; ++ks) u[mt] = __builtin_amdgcn_mfma_f32_16x16x32_bf16(tb[mt][ks], vt[ks], u[mt], 0, 0, 0); }
#pragma unroll
            for (int pc = 0; pc < 2; ++pc) { const float t8[8] = {u[2 * pc][0], u[2 * pc][1], u[2 * pc][2], u[2 * pc][3], u[2 * pc + 1][0], u[2 * pc + 1][1], u[2 * pc + 1][2], u[2 * pc + 1][3]};
                *(GAS bf16x8*)(dnu + (dt * 2 + pc) * 1024) = pack8(t8); }
        }
    }
    LDS_WAIT(); asm volatile("" ::: "memory");
}

template <int STOP>
__device__ __forceinline__ void dn_prep_phase(LAS unsigned char* lds, const bf16* PROJ, const nv::P& p, unsigned char* DNA, unsigned char* DNU, int G, int vcu, int wave_s) {
    LAS unsigned char* img = lds + wave_s * 16384; LAS float* tab = (LAS float*)(lds + XTAB_OFF + wave_s * XTAB_BYTES);
    for (int ci = vcu * 8 + wave_s; ci < 2048; ci += G * 8) dn_prep_chunk<STOP>(img, tab, PROJ, p, DNA, DNU, ci);
}

using namespace nv;


struct RouterArgs { const float* z; const bf16* mix; float* zout; bf16* H1BF; int* EID; float* WGT; int* LIST; int* CNT; const float *ln_g, *ln_b, *w_rg, *b_rg, *w_re, *b_re; };
__device__ __forceinline__ void router_fill(LAS float* dst, const float* W, int ldw, int col0, int tid) {
#pragma unroll
    for (int it = 0; it < 4; ++it) { const int qd = tid + it * NTHREADS, k = qd >> 1, half = qd & 1;
        const f32x4 v = *(const GAS f32x4*)(W + (size_t)k * ldw + col0 + half * 4);
        *(LAS f32x4*)(dst + ((((k >> 8) * 4 + (k & 3)) * 64 + ((k >> 2) & 63)) * 8 + half * 4)) = v; }
}
__device__ __forceinline__ void router_phase(LAS unsigned char* lds, const RouterArgs& A, int gw, int NGW, int wave_s) {
    const int lane = pg8::lane_id_fresh(), tid = wave_s * 64 + lane;
    LAS float* WG = (LAS float*)lds; LAS int* HIST = (LAS int*)(lds + 32768); LAS int* BASE = HIST + 64; LAS int* RR = HIST + 128;
    router_fill(WG, A.w_rg, 8, 0, tid);
    if (tid < 64) HIST[tid] = 0;
    __syncthreads();
    int it_ = 0;
    f32x4 vn[4]; unsigned long long mn_[4];
    { const GAS f32x4* zr = (const GAS f32x4*)(A.z + (size_t)gw * DM) + lane; const GAS unsigned long long* mr = (const GAS unsigned long long*)(A.mix + (size_t)gw * DM) + lane;
#pragma unroll
      for (int j = 0; j < 4; ++j) { vn[j] = zr[64 * j]; mn_[j] = mr[64 * j]; } }
    for (int m = gw; m < NTOK; m += NGW) {
        f32x4 v[4];
#pragma unroll
        for (int j = 0; j < 4; ++j) { const unsigned long long mm = mn_[j];
            v[j].x = ALPHA_F * vn[j].x + bf2f((unsigned short)mm); v[j].y = ALPHA_F * vn[j].y + bf2f((unsigned short)(mm >> 16));
            v[j].z = ALPHA_F * vn[j].z + bf2f((unsigned short)(mm >> 32)); v[j].w = ALPHA_F * vn[j].w + bf2f((unsigned short)(mm >> 48)); }
        { const int mn = (m + NGW < NTOK) ? m + NGW : m; const GAS f32x4* zn = (const GAS f32x4*)(A.z + (size_t)mn * DM) + lane; const GAS unsigned long long* mr = (const GAS unsigned long long*)(A.mix + (size_t)mn * DM) + lane;
#pragma unroll
          for (int j = 0; j < 4; ++j) { vn[j] = zn[64 * j]; mn_[j] = mr[64 * j]; } }
        float s = 0.f;
#pragma unroll
        for (int j = 0; j < 4; ++j) s += (v[j].x + v[j].y) + (v[j].z + v[j].w);
        const float mean = wave_sum_dpp(s) * (1.f / DM); float s2 = 0.f;
#pragma unroll
        for (int j = 0; j < 4; ++j) { v[j] = v[j] - mean; s2 += (v[j].x * v[j].x + v[j].y * v[j].y) + (v[j].z * v[j].z + v[j].w * v[j].w); }
        const float rstd = 1.f / sqrtf(wave_sum_dpp(s2) * (1.f / DM) + 1e-5f);
        GAS unsigned long long* hb = (GAS unsigned long long*)(A.H1BF + (size_t)m * DM) + lane;
#pragma unroll
        for (int j = 0; j < 4; ++j) { const f32x4 g = *((const GAS f32x4*)A.ln_g + lane + 64 * j), bb = *((const GAS f32x4*)A.ln_b + lane + 64 * j); v[j] = v[j] * rstd * g + bb;
            hb[64 * j] = (unsigned long long)pk2(v[j].x, v[j].y) | ((unsigned long long)pk2(v[j].z, v[j].w) << 32); }
        float gl[8];
#pragma unroll
        for (int c = 0; c < 8; ++c) gl[c] = 0.f;
#pragma unroll
        for (int j = 0; j < 4; ++j)
#pragma unroll
            for (int c4 = 0; c4 < 4; ++c4) { const float hv = v[j][c4]; const LAS float* wp = WG + ((j * 4 + c4) * 64 + lane) * 8;
                const f32x4 w0 = *(const LAS f32x4*)wp, w1 = *(const LAS f32x4*)(wp + 4);
                gl[0] += hv * w0.x; gl[1] += hv * w0.y; gl[2] += hv * w0.z; gl[3] += hv * w0.w; gl[4] += hv * w1.x; gl[5] += hv * w1.y; gl[6] += hv * w1.z; gl[7] += hv * w1.w; }
        int gi = 0; float gm = -INFINITY;
#pragma unroll
        for (int c = 0; c < 8; ++c) { gl[c] = wave_sum_dpp(gl[c]) + A.b_rg[c]; if (gl[c] > gm) { gm = gl[c]; gi = c; } }
        float den = 0.f;
#pragma unroll
        for (int c = 0; c < 8; ++c) den += expf(gl[c] - gm);
        const float pg = 1.f / den;
        float el[8];
#pragma unroll
        for (int c = 0; c < 8; ++c) el[c] = 0.f;
        const float* wre = A.w_re + gi * 8192 + lane * 8;
#pragma unroll
        for (int j = 0; j < 4; ++j)
#pragma unroll
            for (int c4 = 0; c4 < 4; ++c4) { const float hv = v[j][c4];
                const f32x4 w0 = *(const GAS f32x4*)(wre + (j * 4 + c4) * 512), w1 = *(const GAS f32x4*)(wre + (j * 4 + c4) * 512 + 4);
                el[0] += hv * w0.x; el[1] += hv * w0.y; el[2] += hv * w0.z; el[3] += hv * w0.w; el[4] += hv * w1.x; el[5] += hv * w1.y; el[6] += hv * w1.z; el[7] += hv * w1.w; }
        int i0 = 0, i1 = 0; float v0 = -INFINITY, v1 = -INFINITY;
#pragma unroll
        for (int c = 0; c < 8; ++c) { el[c] = wave_sum_dpp(el[c]) + A.b_re[gi * 8 + c]; if (el[c] > v0) { v0 = el[c]; i0 = c; } }
#pragma unroll
        for (int c = 0; c < 8; ++c) { if (c != i0 && el[c] > v1) { v1 = el[c]; i1 = c; } }
        const float e1 = expf(v1 - v0), sm = 1.f / (1.f + e1);
        if (lane == 0) {
            const int ea = gi * 8 + i0, eb = gi * 8 + i1;
            A.EID[2 * m] = ea; A.EID[2 * m + 1] = eb; A.WGT[2 * m] = pg * sm; A.WGT[2 * m + 1] = pg * e1 * sm;
            LAS int* rr = RR + (wave_s * 16 + it_) * 4;
            rr[0] = ea; rr[1] = __hip_atomic_fetch_add(&HIST[ea], 1, __ATOMIC_RELAXED, __HIP_MEMORY_SCOPE_WORKGROUP); rr[2] = eb; rr[3] = __hip_atomic_fetch_add(&HIST[eb], 1, __ATOMIC_RELAXED, __HIP_MEMORY_SCOPE_WORKGROUP);
        }
        ++it_;
    }
    __syncthreads();
    if (tid < 64) BASE[tid] = __hip_atomic_fetch_add(&A.CNT[tid], HIST[tid], __ATOMIC_RELAXED, __HIP_MEMORY_SCOPE_AGENT);
    __syncthreads();
    if (lane < it_) {
        const LAS int* rr = RR + (wave_s * 16 + lane) * 4; const int m = gw + lane * NGW;
        A.LIST[(size_t)rr[0] * NTOK + BASE[rr[0]] + rr[1]] = 2 * m;
        A.LIST[(size_t)rr[2] * NTOK + BASE[rr[2]] + rr[3]] = 2 * m + 1;
    }
}

__device__ __forceinline__ void final_phase(float* OUT, const bf16* H1B, const bf16* YEXP, const float* ln_g, const float* ln_b, int gw, int NGW, int lane) {
    for (int m = gw; m < NTOK; m += NGW) {
        GAS f32x4* orow = (GAS f32x4*)(OUT + (size_t)m * DM) + lane;
        const GAS unsigned long long* hq = (const GAS unsigned long long*)(H1B + (size_t)m * DM) + lane;
        const GAS unsigned long long* y0 = (const GAS unsigned long long*)(YEXP + (size_t)(2 * m) * DM) + lane; const GAS unsigned long long* y1 = y0 + DM / 4;
        f32x4 v[4]; float s = 0.f;
#pragma unroll
        for (int j = 0; j < 4; ++j) { const unsigned long long hh = hq[64 * j], a0 = y0[64 * j], a1 = y1[64 * j];
            v[j].x = ALPHA_F * bf2f((unsigned short)hh) + bf2f((unsigned short)a0) + bf2f((unsigned short)a1);
            v[j].y = ALPHA_F * bf2f((unsigned short)(hh >> 16)) + bf2f((unsigned short)(a0 >> 16)) + bf2f((unsigned short)(a1 >> 16));
            v[j].z = ALPHA_F * bf2f((unsigned short)(hh >> 32)) + bf2f((unsigned short)(a0 >> 32)) + bf2f((unsigned short)(a1 >> 32));
            v[j].w = ALPHA_F * bf2f((unsigned short)(hh >> 48)) + bf2f((unsigned short)(a0 >> 48)) + bf2f((unsigned short)(a1 >> 48));
            s += (v[j].x + v[j].y) + (v[j].z + v[j].w); }
        const float mean = wave_sum_dpp(s) * (1.f / DM); float s2 = 0.f;
#pragma unroll
        for (int j = 0; j < 4; ++j) { v[j] = v[j] - mean; s2 += (v[j].x * v[j].x + v[j].y * v[j].y) + (v[j].z * v[j].z + v[j].w * v[j].w); }
        const float rstd = 1.f / sqrtf(wave_sum_dpp(s2) * (1.f / DM) + 1e-5f);
#pragma unroll
        for (int j = 0; j < 4; ++j) { const f32x4 g = *((const GAS f32x4*)ln_g + lane + 64 * j), bb = *((const GAS f32x4*)ln_b + lane + 64 * j); orow[64 * j] = v[j] * rstd * g + bb; }
    }
}

#ifndef REPEAT_MASK
#define REPEAT_MASK 0
#endif
#define REPS(k) ((((REPEAT_MASK) >> (k)) & 1) + 1)
__global__ void __launch_bounds__(NTHREADS, 2) fwd_megakernel(MK a) {
    extern __shared__ __attribute__((aligned(16))) unsigned char lds_raw[];
    cg::grid_group grid = cg::this_grid();
    LAS unsigned char* lds = (LAS unsigned char*)lds_raw;
    volatile LAS unsigned* MISC = (volatile LAS unsigned*)(lds + MISC_OFF);
    LAS int* PREF = (LAS int*)(lds + PREF_OFF);
    const int tid = threadIdx.x; const int wave_s = __builtin_amdgcn_readfirstlane(tid >> 6);
    const int G = gridDim.x; const int bx = blockIdx.x; const int vcu = (G % 8 == 0) ? (bx % 8) * (G / 8) + bx / 8 : bx;
    unsigned char* ws = a.ws; const P& p = a.p;
    gu32* ctl = (gu32*)(ws + WS_CTL);
    bf16* WIN = (bf16*)(ws + WS_WIN); bf16* WOUT = (bf16*)(ws + WS_WOUT); bf16* XBF = (bf16*)(ws + WS_A); bf16* PROJ = (bf16*)(ws + WS_B);
    bf16* WGU = (bf16*)(ws + WS_WGU); bf16* WD = (bf16*)(ws + WS_WD); bf16* HID = (bf16*)(ws + WS_A); bf16* H1BF = (bf16*)(ws + WS_H1BF); bf16* YEXP = (bf16*)(ws + WS_YEXP);
    int* LIST = (int*)(ws + WS_LIST); int* EID = (int*)(ws + WS_ROUTE); float* WGT = (float*)(ws + WS_ROUTE + 512 * 1024);
    int* CNT = (int*)(ws + WS_CTL) + CW_CNT;
    for (int u = tid; u < (LDS_BYTES - LDSCTL_OFF) / 4; u += NTHREADS) ((LAS unsigned*)(lds + LDSCTL_OFF))[u] = 0u;
    __syncthreads();
    XcdBarrier bar = xcd_barrier_post((unsigned*)(ctl + CW_BAR), MISC + 8);
    grid.sync();
#define FRESH() const int lane = pg8::lane_id_fresh(), wave = wave_s; const int tid_ = wave_s * 64 + lane; const int gtid = (int)blockIdx.x * NTHREADS + tid_, gsize = G * NTHREADS, gw = vcu * NWAVES + wave, NGW = G * NWAVES; (void)lane; (void)gtid; (void)gsize; (void)gw; (void)NGW;

    _Pragma("unroll 1") for (int rep_ = 0; rep_ < REPS(0); ++rep_) {
    {
        FRESH();
        LAS float* scr = (LAS float*)(lds + wave * 16384);
        constexpr int NB = 96, KB = DM / 64;
        for (int it = gw; it < NB * KB; it += NGW) { const int nb = it % NB, kb = it / NB; const int nsrc = nb < 64 ? nb * 32 : 2056 + (nb - 64) * 32, ndst = nb * 32;
            p0_transpose_item(p.w_in, nv::INC, DM, kb * 64, nsrc, WIN, ndst, scr, lane); }
        for (int i = gtid; i < 8 * DM; i += gsize) { const int j = (int)(i / DM), k = (int)(i % DM); WIN[(size_t)(PC_B + j) * DM + k] = (bf16)f2bf(p.w_in[(size_t)k * nv::INC + 2048 + j]); }
        for (int i = gtid; i < (long)(NPROJ - 3080) * DM / 8; i += gsize) *(GAS v4u*)(WIN + (size_t)3080 * DM + i * 8) = (v4u){0u, 0u, 0u, 0u};
        for (int i = gtid; i < (long)NTOK * DM / 8; i += gsize) { const f32x4 v0 = *(const GAS f32x4*)(p.x + i * 8), v1 = *(const GAS f32x4*)(p.x + i * 8 + 4);
            v4u o; o.x = pk2(v0.x, v0.y); o.y = pk2(v0.z, v0.w); o.z = pk2(v1.x, v1.y); o.w = pk2(v1.z, v1.w); *(GAS v4u*)(XBF + i * 8) = o; }
        for (int it = gw; it < 16 * 32; it += NGW) { const int nb = it & 31, kb = it >> 5; p0_transpose_item(p.w_out, DM, DM, kb * 64, nb * 32, WOUT, nb * 32, scr, lane); }
        for (int d = gtid; d < 8 * 8192; d += gsize) { const int g = d >> 13, r = d & 8191, c = r & 7, ll = (r >> 3) & 63, jc = r >> 9, k = 4 * (ll + 64 * (jc >> 2)) + (jc & 3);
            ((float*)(ws + WS_WREP))[d] = p.w_re[(size_t)k * 64 + g * 8 + c]; }
        p0_experts(p.w_gate, p.w_up, p.w_down, WGU, WD, scr, gw, NGW, lane);
    }
    xcd_barrier(bar);
    }
    _Pragma("unroll 1") for (int rep_ = 0; rep_ < REPS(1); ++rep_) {
    {
        pg8::DenseOrder S; S.init(XBF, DM, WIN, NTOK, NPROJ, DM, G, bx);
        pg8::EpiBf16 E{PROJ, NPROJ};
        pg8::gemm_phase<pg8::EpiBf16, pg8::DenseOrder, true>(lds, S, E, nullptr, wave_s);
    }
    xcd_barrier(bar);
    }
    unsigned char* DNA = (unsigned char*)p.out; unsigned char* DNU = ws + WS_A + 32 * MiB; bf16* ODN = (bf16*)(ws + WS_A);
    _Pragma("unroll 1") for (int rep_ = 0; rep_ < REPS(2); ++rep_) {
    dn_prep_phase<0>(lds, PROJ, p, DNA, DNU, G, vcu, wave_s);
    xcd_barrier(bar);
    }
    _Pragma("unroll 1") for (int rep_ = 0; rep_ < REPS(3); ++rep_) {
    dn_scan_phase(lds, DNA, DNU, ODN, vcu, wave_s);
    xcd_barrier(bar);
    }
    _Pragma("unroll 1") for (int rep_ = 0; rep_ < REPS(5); ++rep_) {
    sgu_phase(lds, PROJ, p, G, vcu, wave_s);
    { FRESH(); dn_final_phase(ODN, PROJ, p.dn_norm_w, gw, NGW, lane); }
    xcd_barrier(bar);
    }
    _Pragma("unroll 1") for (int rep_ = 0; rep_ < REPS(6); ++rep_) {
    {
        pg8::DenseOrder S; S.init(PROJ, NPROJ, WOUT, NTOK, DM, DM, G, bx);
        pg8::EpiBf16 E{(bf16*)(ws + WS_A), DM};
        pg8::gemm_phase<pg8::EpiBf16, pg8::DenseOrder, true>(lds, S, E, nullptr, wave_s);
    }
    xcd_barrier(bar);
    }
    {
        RouterArgs RA{p.x, (const bf16*)(ws + WS_A), p.out, H1BF, EID, WGT, LIST, CNT, p.ln1_g, p.ln1_b, p.w_rg, p.b_rg, (const float*)(ws + WS_WREP), p.b_re};
        router_phase(lds, RA, vcu * NWAVES + wave_s, G * NWAVES, wave_s);
    }
    xcd_barrier(bar);
    if (threadIdx.x == 0) { int s = 0; for (int e = 0; e < NEXP; ++e) { PREF[e] = s; s += ((CNT[e] + 255) >> 8) * 4; } PREF[NEXP] = s; }
    __syncthreads();
    _Pragma("unroll 1") for (int rep_ = 0; rep_ < REPS(7); ++rep_) {
    {
        pg8::GroupedOrder S{H1BF, WGU, LIST, PREF, DM, DM, 1024, NTOK, 1, 4, G, bx, NEXP};
        pg8::EpiHid E{HID, LIST, CNT, NTOK};
        pg8::gemm_phase<pg8::EpiHid, pg8::GroupedOrder, true>(lds, S, E, CNT, wave_s);
    }
    xcd_barrier(bar);
    }
    _Pragma("unroll 1") for (int rep_ = 0; rep_ < REPS(8); ++rep_) {
    {
        pg8::GroupedOrder S{HID, WD, LIST, PREF, DEXP, DEXP, 1024, NTOK, 0, 4, G, bx, NEXP};
        pg8::EpiYexp E{YEXP, LIST, WGT, NTOK};
        pg8::gemm_phase<pg8::EpiYexp, pg8::GroupedOrder, true>(lds, S, E, CNT, wave_s);
    }
    xcd_barrier(bar);
    }
    { FRESH(); final_phase(p.out, H1BF, YEXP, p.ln2_g, p.ln2_b, gw, NGW, lane); }
#if defined(GHOSTPREP)
    xcd_barrier(bar);
    dn_prep_phase<GHOSTPREP>(lds, (const bf16*)(ws + WS_B), p, ws + WS_C, ws + WS_C + 120 * MiB, G, vcu, wave_s);
#endif
#if defined(GHOST6)
    xcd_barrier(bar);
    { RouterArgs RA{p.out, (const bf16*)(ws + WS_A), (float*)(ws + WS_B), (bf16*)(ws + WS_C), (int*)(ws + WS_A), (float*)(ws + WS_A + 1 * MiB), (int*)(ws + WS_A + 2 * MiB), (int*)(ws + WS_CTL) + CW_CNT + 1024, p.ln1_g, p.ln1_b, p.w_rg, p.b_rg, (const float*)(ws + WS_WREP), p.b_re};
      router_phase(lds, RA, vcu * NWAVES + wave_s, G * NWAVES, wave_s); }
#endif
#if defined(GHOST9)
    xcd_barrier(bar);
    { FRESH(); final_phase((float*)(ws + WS_A), H1BF, (const bf16*)(ws + WS_C), p.ln2_g, p.ln2_b, gw, NGW, lane); }
#endif
}

extern "C" void kernel_launch(void* const* d_in, const int* in_sizes, int n_in, void* d_out, int out_size, void* d_ws, size_t ws_size, hipStream_t stream) {
    if (ws_size < WS_END || n_in != 22) { fprintf(stderr, "kernel_launch: bad ws/n_in\n"); return; }
    static int grid_blocks = 0;
    if (!grid_blocks) {
        int dev = 0, cus = 0, per_cu = 0;
        (void)hipGetDevice(&dev);
        (void)hipDeviceGetAttribute(&cus, hipDeviceAttributeMultiprocessorCount, dev);
        (void)hipFuncSetAttribute((const void*)fwd_megakernel, hipFuncAttributeMaxDynamicSharedMemorySize, (int)LDS_BYTES);
        (void)hipOccupancyMaxActiveBlocksPerMultiprocessor(&per_cu, (const void*)fwd_megakernel, NTHREADS, LDS_BYTES);
        if (per_cu < 1) { fprintf(stderr, "kernel_launch: occupancy query says %d\n", per_cu); per_cu = 1; }
        grid_blocks = cus;
    }
    (void)hipMemsetAsync((char*)d_ws + WS_CTL, 0, CTL_ZERO_BYTES, stream);
    MK a{}; bind(a.p, d_in, (float*)d_out, (unsigned char*)d_ws + WS_A); a.ws = (unsigned char*)d_ws;
    { unsigned char* s = (unsigned char*)d_ws + WS_A; a.p.qkv = (float*)s; s += (size_t)T_ * 3 * DNW * 4; a.p.odn = (float*)s; s += (size_t)T_ * DNW * 4; a.p.vn = (float*)s; s += (size_t)T_ * SGW * 4; a.p.y = (float*)s; s += (size_t)T_ * D_ * 4;
      a.p.proj = nullptr; a.p.z1 = nullptr; a.p.h1 = nullptr; a.p.hid = nullptr; a.p.yexp = nullptr; a.p.wgt = nullptr; a.p.eid = nullptr; a.p.cnt = nullptr; a.p.sorted = nullptr; a.p.eos = nullptr; }
    void* args[] = {&a};
    hipError_t e = hipLaunchCooperativeKernel((const void*)fwd_megakernel, dim3(grid_blocks), dim3(NTHREADS), args, LDS_BYTES, stream);
    if (e != hipSuccess) fprintf(stderr, "cooperative launch failed: %s (grid %d)\n", hipGetErrorString(e), grid_blocks);
}
```

```cpp
#include <hip/hip_runtime.h>
#include <hip/hip_cooperative_groups.h>
#include <cstdio>
#include <cstdint>
namespace cg = cooperative_groups;
#include <math.h>
#ifndef BATCH
#define BATCH 8
#endif
#ifndef SEQ
#define SEQ 4096
#endif
#ifndef D_MODEL
#define D_MODEL 1024
#endif
#ifdef HOST_EMU
#define KFN static inline
#else
#define KFN __device__ __forceinline__
#endif

namespace nv {
constexpr int B_ = BATCH, T_ = SEQ, D_ = D_MODEL;
constexpr int DNW = D_ / 2, H_ = 4, HD = DNW / H_, CK = 4;
constexpr int SGW = D_ - DNW, G_ = 4, GD = SGW / G_, SC = 128;
constexpr int INC = 4 * DNW + 2 * H_ + 2 * SGW;
constexpr int C_Z = 3 * DNW, C_B = 4 * DNW, C_A = 4 * DNW + H_, C_U = 4 * DNW + 2 * H_, C_V = C_U + SGW;
constexpr int NE = 64, NG = 8, EPG = 8, DE = D_ / 2;
constexpr float ALPHA = 1.189207115002721f;
constexpr float LN_EPS = 1e-5f, RMS_EPS = 1e-6f;

struct P {
    const float *x, *w_in, *conv_w, *a_log, *dt_bias, *dn_norm_w, *sgu_ln_g, *sgu_ln_b, *w_spatial, *b_spatial, *w_out, *ln1_g, *ln1_b,
        *w_rg, *b_rg, *w_re, *b_re, *w_gate, *w_up, *w_down, *ln2_g, *ln2_b;
    float* out;
    float *proj, *qkv, *odn, *vn, *y, *z1, *h1, *wgt, *hid, *yexp;
    int *eid, *cnt, *sorted, *eos;
};

KFN float sigmoidf_(float x) { return 1.f / (1.f + expf(-x)); }
KFN float siluf_(float x) { return x * sigmoidf_(x); }
KFN float softplusf_(float x) { return x > 20.f ? x : log1pf(expf(x)); }
KFN float geluf_(float x) { return 0.5f * x * (1.f + tanhf(0.7978845608028654f * (x + 0.044715f * x * x * x))); }

struct Acc16 { float v[4][4]; };
KFN void gemm4x4(const float* a0, const float* a1, const float* a2, const float* a3, const float* Bm, int ldb, int n0, int K, Acc16& acc) {
    for (int i = 0; i < 4; ++i) for (int j = 0; j < 4; ++j) acc.v[i][j] = 0.f;
    for (int k = 0; k < K; ++k) {
        const float av[4] = {a0[k], a1[k], a2[k], a3[k]};
        const float* br = Bm + (size_t)k * ldb + n0;
        const float bv[4] = {br[0], br[1], br[2], br[3]};
        for (int i = 0; i < 4; ++i) for (int j = 0; j < 4; ++j) acc.v[i][j] += av[i] * bv[j];
    }
}

constexpr long N_S1 = (long)(T_ / 4) * (INC / 4);
KFN void s1_proj(const P& p, int b, long i) {
    const int nt = INC / 4; const int mt = (int)(i / nt), ct = (int)(i % nt); const int m0 = mt * 4, n0 = ct * 4;
    const float* xa = p.x + ((size_t)b * T_ + m0) * D_;
    Acc16 acc; gemm4x4(xa, xa + D_, xa + 2 * D_, xa + 3 * D_, p.w_in, INC, n0, D_, acc);
    for (int r = 0; r < 4; ++r) for (int c = 0; c < 4; ++c) p.proj[(size_t)(m0 + r) * INC + n0 + c] = acc.v[r][c];
}
constexpr long N_S2 = (long)T_ * 3 * DNW;
KFN void s2_conv(const P& p, int b, long i) {
    const int t = (int)(i / (3 * DNW)), c = (int)(i % (3 * DNW));
    float s = 0.f;
    for (int j = 0; j < CK; ++j) { const int tt = t - (CK - 1) + j; if (tt >= 0) s += p.conv_w[j * 3 * DNW + c] * p.proj[(size_t)tt * INC + c]; }
    p.qkv[(size_t)t * 3 * DNW + c] = siluf_(s);
}
constexpr long N_S3 = (long)T_ * 2 * H_;
KFN void s3_l2(const P& p, int b, long i) {
    const int t = (int)(i / (2 * H_)), r = (int)(i % (2 * H_)), which = r / H_, h = r % H_;
    float* v = p.qkv + (size_t)t * 3 * DNW + which * DNW + h * HD;
    float ss = 0.f; for (int d = 0; d < HD; ++d) ss += v[d] * v[d];
    float sc = 1.f / sqrtf(ss + RMS_EPS); if (which == 0) sc *= 1.f / sqrtf((float)HD);
    for (int d = 0; d < HD; ++d) v[d] *= sc;
}
constexpr long N_S4 = (long)H_ * HD;
KFN void s4_delta(const P& p, int b, long i) {
    const int h = (int)(i / HD), j = (int)(i % HD);
    float S[HD];
#pragma unroll
    for (int d = 0; d < HD; ++d) S[d] = 0.f;
    const float ea = expf(p.a_log[h]), dtb = p.dt_bias[h];
    for (int t = 0; t < T_; ++t) {
        const float* pr = p.proj + (size_t)t * INC;
        const float beta = sigmoidf_(pr[C_B + h]);
        const float g = -ea * softplusf_(pr[C_A + h] + dtb);
        const float a = expf(g);
        const float* q = p.qkv + (size_t)t * 3 * DNW + h * HD;
        const float* k = q + DNW;
        const float vj = p.qkv[(size_t)t * 3 * DNW + 2 * DNW + h * HD + j];
        float r = 0.f;
#pragma unroll
        for (int d = 0; d < HD; ++d) { S[d] *= a; r += k[d] * S[d]; }
        const float dlt = beta * (vj - r);
        float o = 0.f;
#pragma unroll
        for (int d = 0; d < HD; ++d) { S[d] += k[d] * dlt; o += q[d] * S[d]; }
        p.odn[(size_t)t * DNW + h * HD + j] = o;
    }
}
constexpr long N_S5 = (long)T_ * H_;
KFN void s5_gnorm(const P& p, int b, long i) {
    const int t = (int)(i / H_), h = (int)(i % H_);
    const float* o = p.odn + (size_t)t * DNW + h * HD;
    float ss = 0.f; for (int d = 0; d < HD; ++d) ss += o[d] * o[d];
    const float rs = 1.f / sqrtf(ss / HD + RMS_EPS);
    for (int d = 0; d < HD; ++d) { const float z = p.proj[(size_t)t * INC + C_Z + h * HD + d]; p.y[(size_t)t * D_ + h * HD + d] = o[d] * rs * p.dn_norm_w[d] * siluf_(z); }
}
constexpr long N_S6 = (long)T_ * G_;
KFN void s6_sguv(const P& p, int b, long i) {
    const int t = (int)(i / G_), g = (int)(i % G_);
    const float* v = p.proj + (size_t)t * INC + C_V + g * GD;
    float mu = 0.f; for (int d = 0; d < GD; ++d) mu += geluf_(v[d]); mu /= GD;
    float var = 0.f; for (int d = 0; d < GD; ++d) { const float c = geluf_(v[d]) - mu; var += c * c; } var /= GD;
    const float rs = 1.f / sqrtf(var + LN_EPS);
    for (int d = 0; d < GD; ++d) p.vn[(size_t)t * SGW + g * GD + d] = (geluf_(v[d]) - mu) * rs * p.sgu_ln_g[g * GD + d] + p.sgu_ln_b[g * GD + d];
}
constexpr long N_S7 = (long)T_ * SGW;
KFN void s7_sgumix(const P& p, int b, long i) {
    const int t = (int)(i / SGW), c = (int)(i % SGW), g = c / GD, tl = t % SC, t0 = t - tl;
    const float* w = p.w_spatial + ((size_t)g * SC + tl) * SC;
    float s = 0.f; for (int sidx = 0; sidx <= tl; ++sidx) s += w[sidx] * p.vn[(size_t)(t0 + sidx) * SGW + c];
    s += p.b_spatial[g * SC + tl];
    p.y[(size_t)t * D_ + DNW + c] = geluf_(p.proj[(size_t)t * INC + C_U + c]) * s;
}
constexpr long N_S8 = (long)(T_ / 4) * (D_ / 4);
KFN void s8_outproj(const P& p, int b, long i) {
    const int nt = D_ / 4; const int m0 = (int)(i / nt) * 4, n0 = (int)(i % nt) * 4;
    const float* ya = p.y + (size_t)m0 * D_;
    Acc16 acc; gemm4x4(ya, ya + D_, ya + 2 * D_, ya + 3 * D_, p.w_out, D_, n0, D_, acc);
    for (int r = 0; r < 4; ++r) for (int c = 0; c < 4; ++c) p.z1[(size_t)(m0 + r) * D_ + n0 + c] = acc.v[r][c] + ALPHA * p.x[((size_t)b * T_ + m0 + r) * D_ + n0 + c];
}
KFN void ln_row(const float* in, const float* g, const float* bb, float* out) {
    float mu = 0.f; for (int d = 0; d < D_; ++d) mu += in[d]; mu /= D_;
    float var = 0.f; for (int d = 0; d < D_; ++d) { const float c = in[d] - mu; var += c * c; } var /= D_;
    const float rs = 1.f / sqrtf(var + LN_EPS);
    for (int d = 0; d < D_; ++d) out[d] = (in[d] - mu) * rs * g[d] + bb[d];
}
constexpr long N_S9 = T_;
KFN void s9_ln1(const P& p, int b, long i) { ln_row(p.z1 + (size_t)i * D_, p.ln1_g, p.ln1_b, p.h1 + (size_t)i * D_); }
constexpr long N_S10 = T_;
KFN void s10_router(const P& p, int b, long i) {
    const float* h = p.h1 + (size_t)i * D_;
    float gl[NG];
#pragma unroll
    for (int g = 0; g < NG; ++g) gl[g] = 0.f;
    for (int k = 0; k < D_; ++k) { const float hv = h[k];
#pragma unroll
        for (int g = 0; g < NG; ++g) gl[g] += hv * p.w_rg[(size_t)k * NG + g]; }
    int gi = 0; float gm = -INFINITY;
#pragma unroll
    for (int g = 0; g < NG; ++g) { gl[g] += p.b_rg[g]; if (gl[g] > gm) { gm = gl[g]; gi = g; } }
    float den = 0.f;
#pragma unroll
    for (int g = 0; g < NG; ++g) den += expf(gl[g] - gm);
    const float pg = 1.f / den;
    float el[EPG];
#pragma unroll
    for (int e = 0; e < EPG; ++e) el[e] = 0.f;
    for (int k = 0; k < D_; ++k) { const float hv = h[k];
#pragma unroll
        for (int e = 0; e < EPG; ++e) el[e] += hv * p.w_re[(size_t)k * NE + gi * EPG + e]; }
    int i0 = 0, i1 = 0; float v0 = -INFINITY, v1 = -INFINITY;
#pragma unroll
    for (int e = 0; e < EPG; ++e) { el[e] += p.b_re[gi * EPG + e]; if (el[e] > v0) { v0 = el[e]; i0 = e; } }
#pragma unroll
    for (int e = 0; e < EPG; ++e) { if (e != i0 && el[e] > v1) { v1 = el[e]; i1 = e; } }
    const float e1 = expf(v1 - v0), s = 1.f / (1.f + e1);
    p.eid[2 * i] = gi * EPG + i0; p.eid[2 * i + 1] = gi * EPG + i1;
    p.wgt[2 * i] = pg * s; p.wgt[2 * i + 1] = pg * e1 * s;
}
constexpr long N_S11 = NE;
KFN void s11_count(const P& p, int b, long i) { int c = 0; for (int a = 0; a < 2 * T_; ++a) c += (p.eid[a] == (int)i); p.cnt[i] = c; }
constexpr long N_S12 = NE;
KFN void s12_sort(const P& p, int b, long i) {
    int off = 0; for (int e = 0; e < (int)i; ++e) off += p.cnt[e];
    for (int a = 0; a < 2 * T_; ++a) if (p.eid[a] == (int)i) { p.sorted[off] = a; p.eos[off] = (int)i; ++off; }
}
constexpr long N_S13 = (long)2 * T_ * (DE / 4);
KFN void s13_hid(const P& p, int b, long i) {
    const int pos = (int)(i / (DE / 4)), j0 = (int)(i % (DE / 4)) * 4;
    const int a = p.sorted[pos], e = p.eos[pos], tok = a >> 1;
    const float* h = p.h1 + (size_t)tok * D_;
    const float* wg = p.w_gate + (size_t)e * D_ * DE; const float* wu = p.w_up + (size_t)e * D_ * DE;
    float g[4] = {0, 0, 0, 0}, u[4] = {0, 0, 0, 0};
    for (int k = 0; k < D_; ++k) { const float hv = h[k];
#pragma unroll
        for (int c = 0; c < 4; ++c) { g[c] += hv * wg[(size_t)k * DE + j0 + c]; u[c] += hv * wu[(size_t)k * DE + j0 + c]; } }
#pragma unroll
    for (int c = 0; c < 4; ++c) p.hid[(size_t)pos * DE + j0 + c] = siluf_(g[c]) * u[c];
}
constexpr long N_S14 = (long)2 * T_ * (D_ / 4);
KFN void s14_down(const P& p, int b, long i) {
    const int pos = (int)(i / (D_ / 4)), n0 = (int)(i % (D_ / 4)) * 4;
    const int a = p.sorted[pos], e = p.eos[pos];
    const float* hd = p.hid + (size_t)pos * DE; const float* wd = p.w_down + (size_t)e * DE * D_;
    float s[4] = {0, 0, 0, 0};
    for (int k = 0; k < DE; ++k) { const float hv = hd[k];
#pragma unroll
        for (int c = 0; c < 4; ++c) s[c] += hv * wd[(size_t)k * D_ + n0 + c]; }
    const float w = p.wgt[a];
#pragma unroll
    for (int c = 0; c < 4; ++c) p.yexp[(size_t)a * D_ + n0 + c] = w * s[c];
}
constexpr long N_S15 = T_;
KFN void s15_final(const P& p, int b, long i) {
    float* o = p.out + ((size_t)b * T_ + i) * D_;
    const float* h = p.h1 + (size_t)i * D_; const float* y0 = p.yexp + (size_t)(2 * i) * D_; const float* y1 = y0 + D_;
    float mu = 0.f; for (int d = 0; d < D_; ++d) mu += ALPHA * h[d] + y0[d] + y1[d]; mu /= D_;
    float var = 0.f; for (int d = 0; d < D_; ++d) { const float c = ALPHA * h[d] + y0[d] + y1[d] - mu; var += c * c; } var /= D_;
    const float rs = 1.f / sqrtf(var + LN_EPS);
    for (int d = 0; d < D_; ++d) o[d] = (ALPHA * h[d] + y0[d] + y1[d] - mu) * rs * p.ln2_g[d] + p.ln2_b[d];
}

struct Carve { size_t proj, qkv, odn, vn, y, z1, h1, wgt, hid, yexp, eid, cnt, sorted, eos, total; };
static inline Carve carve() {
    Carve c; size_t o = 0; auto al = [&](size_t bytes) { size_t r = o; o += (bytes + 255) & ~(size_t)255; return r; };
    c.proj = al((size_t)T_ * INC * 4); c.qkv = al((size_t)T_ * 3 * DNW * 4); c.odn = al((size_t)T_ * DNW * 4); c.vn = al((size_t)T_ * SGW * 4);
    c.y = al((size_t)T_ * D_ * 4); c.z1 = al((size_t)T_ * D_ * 4); c.h1 = al((size_t)T_ * D_ * 4); c.wgt = al((size_t)2 * T_ * 4);
    c.hid = al((size_t)2 * T_ * DE * 4); c.yexp = al((size_t)2 * T_ * D_ * 4); c.eid = al((size_t)2 * T_ * 4); c.cnt = al(NE * 4);
    c.sorted = al((size_t)2 * T_ * 4); c.eos = al((size_t)2 * T_ * 4); c.total = o; return c;
}
static inline void bind(P& p, void* const* in, float* out, unsigned char* ws) {
    const float** f = (const float**)&p.x; for (int i = 0; i < 22; ++i) f[i] = (const float*)in[i];
    p.out = out; const Carve c = carve();
    p.proj = (float*)(ws + c.proj); p.qkv = (float*)(ws + c.qkv); p.odn = (float*)(ws + c.odn); p.vn = (float*)(ws + c.vn); p.y = (float*)(ws + c.y);
    p.z1 = (float*)(ws + c.z1); p.h1 = (float*)(ws + c.h1); p.wgt = (float*)(ws + c.wgt); p.hid = (float*)(ws + c.hid); p.yexp = (float*)(ws + c.yexp);
    p.eid = (int*)(ws + c.eid); p.cnt = (int*)(ws + c.cnt); p.sorted = (int*)(ws + c.sorted); p.eos = (int*)(ws + c.eos);
}
#define NV_STAGES(X) X(1, s1_proj, N_S1) X(2, s2_conv, N_S2) X(3, s3_l2, N_S3) X(4, s4_delta, N_S4) X(5, s5_gnorm, N_S5) X(6, s6_sguv, N_S6) X(7, s7_sgumix, N_S7) \
    X(8, s8_outproj, N_S8) X(9, s9_ln1, N_S9) X(10, s10_router, N_S10) X(11, s11_count, N_S11) X(12, s12_sort, N_S12) X(13, s13_hid, N_S13) X(14, s14_down, N_S14) X(15, s15_final, N_S15)
}
namespace pg8 {
#define PG8_LAS __attribute__((address_space(3)))
typedef unsigned short bf16_t;
typedef short bf16x8 __attribute__((ext_vector_type(8)));
typedef float f32x4 __attribute__((ext_vector_type(4)));
typedef unsigned u32x4 __attribute__((ext_vector_type(4)));
typedef unsigned u32x2 __attribute__((ext_vector_type(2)));
constexpr int BM = 256, BK = 64, HALF = 128, HTB = HALF * BK * 2  , STAGE_BYTES = 8 * HTB, NXCD = 8, WGM = 8;

__host__ __device__ __forceinline__ int lds_byte(int r, int c) { const int st = (r >> 4) * 2 + (c >> 5), rr = r & 15, cc = c & 31, ob = rr * 64 + cc * 2; return st * 1024 + (ob ^ (((ob >> 9) & 1) << 5)); }
__host__ __device__ __forceinline__ void stage_rc(int b, int& R, int& C) { const int st = b / 1024, sb = b % 1024, swz = sb ^ (((sb >> 9) & 1) << 5); R = (st >> 1) * 16 + swz / 64; C = (st & 1) * 32 + (swz % 64) / 2; }
__host__ __device__ __forceinline__ int perm32(int rho) { const int n = rho >> 4, i = rho & 15; return 8 * (i >> 2) + 4 * n + (i & 3); }

struct Unit { int pm, pn, e, rows; };

typedef float f32x2_t __attribute__((ext_vector_type(2))); typedef __bf16 bf16x2_t __attribute__((ext_vector_type(2)));
__device__ __forceinline__ unsigned cvt_pk_bf16(float lo, float hi) { const f32x2_t v = {lo, hi}; const bf16x2_t b = __builtin_convertvector(v, bf16x2_t); return __builtin_bit_cast(unsigned, b); }

__device__ __forceinline__ int lane_id_fresh() { int l; asm volatile("v_mbcnt_lo_u32_b32 %0, -1, 0\n\tv_mbcnt_hi_u32_b32 %0, -1, %0" : "=v"(l)); return l; }
__device__ __forceinline__ int xcd_remap(int L, int nwg) { const int q = nwg / NXCD, r = nwg % NXCD, xcd = L % NXCD, off = L / NXCD; return (xcd < r ? xcd * (q + 1) : r * (q + 1) + (xcd - r) * q) + off; }

struct DenseOrder {
    const bf16_t* A; const bf16_t* Bt; int lda, K; int nM, nN, nwg, G, c;
    static constexpr bool GATHER = false;
    __device__ void init(const bf16_t* A_, int lda_, const bf16_t* Bt_, int M, int N, int K_, int G_, int c_) { A = A_; Bt = Bt_; lda = lda_; K = K_; nM = M / BM; nN = N / BM; nwg = nM * nN; G = G_; c = c_; }
    __device__ bool next(int i, Unit& u) const {
        const long L = (long)i * G + c; if (L >= nwg) return false;
        const int wgid = xcd_remap((int)L, nwg);
        const int nig = WGM * nN, gid = wgid / nig, fm = gid * WGM, gsz = (nM - fm) < WGM ? (nM - fm) : WGM;
        u.pm = fm + ((wgid % nig) % gsz); u.pn = (wgid % nig) / gsz; u.e = 0; u.rows = BM; return true;
    }
    __device__ __forceinline__ const char* a_base(const Unit& u) const { return (const char*)A + (size_t)u.pm * BM * lda * 2; }
    __device__ __forceinline__ const char* b_base(const Unit& u) const { return (const char*)Bt + (size_t)u.pn * BM * K * 2; }
    __device__ __forceinline__ void a_off(const Unit&, const int (&R)[2], const int (&C)[2], unsigned (&v)[4]) const {
#pragma unroll
        for (int h = 0; h < 2; ++h)
#pragma unroll
            for (int i = 0; i < 2; ++i) v[h * 2 + i] = (unsigned)((h * HALF + R[i]) * lda + C[i]) * 2u;
    }
};

struct GroupedOrder {
    const bf16_t* A; const bf16_t* Bt; const int* list; const PG8_LAS int* pref;
    int lda, K, N, cap, ashift, nN, G, c, ne;
    static constexpr bool GATHER = true;
    __device__ bool next(int i, Unit& u) const {
        const int nwg = pref[ne]; const long L = (long)i * G + c; if (L >= nwg) return false;
        const int w = xcd_remap((int)L, nwg);
        int e = 0; while (pref[e + 1] <= w) ++e;
        const int j = w - pref[e], ntm = (pref[e + 1] - pref[e]) / nN;
        u.e = e; u.pm = j % ntm; u.pn = j / ntm; u.rows = 0; return true;
    }
    __device__ __forceinline__ const char* a_base(const Unit&) const { return (const char*)A; }
    __device__ __forceinline__ const char* b_base(const Unit& u) const { return (const char*)Bt + ((size_t)u.e * N + (size_t)u.pn * BM) * K * 2; }
    __device__ __forceinline__ void a_off(const Unit& u, const int (&R)[2], const int (&C)[2], unsigned (&v)[4], int cnt) const {
        const int* lp = list + (size_t)u.e * cap;
#pragma unroll
        for (int h = 0; h < 2; ++h)
#pragma unroll
            for (int i = 0; i < 2; ++i) { int r = u.pm * BM + h * HALF + R[i]; if (r >= cnt) r = 0; const int a = (lp[r] & 0xffff) >> ashift; v[h * 2 + i] = (unsigned)(a * lda + C[i]) * 2u; }
    }
};

template <class Epi, class Sched, bool ALIGN_EPI>
__device__ __forceinline__ void gemm_phase(PG8_LAS unsigned char* lds, const Sched& S, const Epi& E, const int* gcnt, const int wave_s) {
    const int tid_ = wave_s * 64 + lane_id_fresh();
    const int tid = tid_, wid = wave_s, lane = tid & 63, wr = wid >> 2, wc = wid & 3, fr = lane & 15, fq = lane >> 4;
    const int K = S.K, nt = K / BK;
    int Rr[2], Cc[2]; unsigned voffB[2];
#pragma unroll
    for (int i = 0; i < 2; ++i) { int R, C; stage_rc(tid * 16 + i * 8192, R, C); const int Rb = Epi::PERM ? ((R & ~31) + perm32(R & 31)) : R; Rr[i] = R; Cc[i] = C; voffB[i] = (unsigned)(Rb * K + C) * 2u; }
    const size_t kstep = (size_t)(BK * 2);
    const size_t hstep = (size_t)HALF * K * 2;
    const unsigned ldsw = (unsigned)wid * 1024u;
    const int aoff = lds_byte(wr * 64 + fr, fq * 8), boff = lds_byte(wc * 32 + fr, fq * 8);
#define PG8_SA(b, h) (((b) * 2 + (h)) * HTB)
#define PG8_SB(b, h) ((4 + (b) * 2 + (h)) * HTB)
#define PG8_STAGE(bufoff, gbase, v0, v1) do { \
        __builtin_amdgcn_global_load_lds((const unsigned*)((const char*)(gbase) + (v0)), (PG8_LAS unsigned*)(lds + (bufoff) + ldsw), 16, 0, 0); \
        __builtin_amdgcn_global_load_lds((const unsigned*)((const char*)(gbase) + (v1)), (PG8_LAS unsigned*)(lds + (bufoff) + ldsw + 8192), 16, 0, 0); } while (0)
#define PG8_STAGEB(bufoff, gbase) PG8_STAGE(bufoff, gbase, voffB[0], voffB[1])
#define PG8_LDA(dst, b, h) do { _Pragma("unroll") for (int m = 0; m < 4; ++m) _Pragma("unroll") for (int k = 0; k < 2; ++k) dst[m][k] = *(const PG8_LAS bf16x8*)(lds + PG8_SA(b, h) + aoff + m * 2048 + k * 1024); } while (0)
#define PG8_LDB(dst, b, h) do { _Pragma("unroll") for (int n = 0; n < 2; ++n) _Pragma("unroll") for (int k = 0; k < 2; ++k) dst[n][k] = *(const PG8_LAS bf16x8*)(lds + PG8_SB(b, h) + boff + n * 2048 + k * 1024); } while (0)
#define PG8_MMA(ai, bj, At, Bt) do { __builtin_amdgcn_s_setprio(1); _Pragma("unroll") for (int m = 0; m < 4; ++m) _Pragma("unroll") for (int n = 0; n < 2; ++n) _Pragma("unroll") for (int k = 0; k < 2; ++k) \
        acc[ai][bj][m][n] = __builtin_amdgcn_mfma_f32_16x16x32_bf16(Bt[n][k], At[m][k], acc[ai][bj][m][n], 0, 0, 0); __builtin_amdgcn_s_setprio(0); } while (0)
#define PG8_WAIT_V(n) asm volatile("s_waitcnt vmcnt(" #n ")" ::: "memory")
#define PG8_WAIT_L(n) asm volatile("s_waitcnt lgkmcnt(" #n ")" ::: "memory")
#define PG8_BAR __builtin_amdgcn_s_barrier()
#define PG8_SCHED __builtin_amdgcn_sched_barrier(0)
    Unit cur, nxt; int ui = 0;
    if (!S.next(0, cur)) return;
    int ccnt = BM * 1024, ncnt = BM * 1024;
    if constexpr (Sched::GATHER) { ccnt = gcnt[cur.e]; }
    cur.rows = ccnt - cur.pm * BM;
    f32x4 acc[2][2][4][2];
#pragma unroll
    for (int a = 0; a < 2; ++a)
#pragma unroll
        for (int b = 0; b < 2; ++b)
#pragma unroll
            for (int m = 0; m < 4; ++m)
#pragma unroll
                for (int n = 0; n < 2; ++n) acc[a][b][m][n] = (f32x4){0.f, 0.f, 0.f, 0.f};
    bf16x8 At[4][2], B0[2][2], B1[2][2];
    unsigned va[4], vn[4];
    if constexpr (Sched::GATHER) S.a_off(cur, Rr, Cc, va, ccnt); else S.a_off(cur, Rr, Cc, va);
    const char* cA = S.a_base(cur); const char* cB = S.b_base(cur);
    PG8_STAGEB(PG8_SB(0, 0), cB); PG8_STAGEB(PG8_SB(0, 1), cB + hstep); PG8_STAGE(PG8_SA(0, 0), cA, va[0], va[1]); PG8_STAGE(PG8_SA(0, 1), cA, va[2], va[3]);
    if (wr == 1) PG8_BAR;
    PG8_WAIT_V(2); PG8_BAR;
    PG8_STAGEB(PG8_SB(1, 0), cB + kstep); PG8_STAGE(PG8_SA(1, 0), cA + kstep, va[0], va[1]); PG8_STAGEB(PG8_SB(1, 1), cB + hstep + kstep);
    PG8_WAIT_V(6); PG8_BAR;
    for (;;) {
        const bool has_next = S.next(ui + 1, nxt);
        const char* nA = cA; const char* nB = cB;
#pragma unroll
        for (int j = 0; j < 4; ++j) vn[j] = va[j];
        if (has_next) {
            nA = S.a_base(nxt); nB = S.b_base(nxt);
            if constexpr (Sched::GATHER) { ncnt = gcnt[nxt.e]; S.a_off(nxt, Rr, Cc, vn, ncnt); } else S.a_off(nxt, Rr, Cc, vn);
            nxt.rows = ncnt - nxt.pm * BM;
        }
        for (int t = 0; t < nt; t += 2) {
            const bool last = (t == nt - 2);
            const char* a1 = cA + (size_t)(t + 1) * kstep;
            const char* a2 = last ? nA : cA + (size_t)(t + 2) * kstep; const char* b2 = last ? nB : cB + (size_t)(t + 2) * kstep;
            const char* a3 = a2 + kstep; const char* b3 = b2 + kstep;
            unsigned w0 = va[0], w1 = va[1], w2 = va[2], w3 = va[3];
            if (last) { w0 = vn[0]; w1 = vn[1]; w2 = vn[2]; w3 = vn[3]; }
            PG8_LDB(B0, 0, 0); PG8_LDB(B1, 0, 1); PG8_SCHED; PG8_LDA(At, 0, 0); PG8_STAGE(PG8_SA(1, 1), a1, va[2], va[3]);
            PG8_WAIT_V(8); PG8_WAIT_L(0); PG8_BAR; PG8_MMA(0, 0, At, B0); PG8_MMA(0, 1, At, B1); PG8_BAR; PG8_SCHED;
            PG8_LDA(At, 0, 1); PG8_STAGEB(PG8_SB(0, 0), b2); PG8_STAGEB(PG8_SB(0, 1), b2 + hstep); PG8_STAGE(PG8_SA(0, 0), a2, w0, w1);
            PG8_WAIT_V(8); PG8_WAIT_L(0); PG8_BAR; PG8_MMA(1, 0, At, B0); PG8_MMA(1, 1, At, B1); PG8_BAR; PG8_SCHED;
            PG8_LDB(B0, 1, 0); PG8_LDB(B1, 1, 1); PG8_SCHED; PG8_LDA(At, 1, 0); PG8_STAGE(PG8_SA(0, 1), a2, w2, w3);
            PG8_WAIT_V(8); PG8_WAIT_L(0); PG8_BAR; PG8_MMA(0, 0, At, B0); PG8_MMA(0, 1, At, B1); PG8_BAR; PG8_SCHED;
            PG8_LDA(At, 1, 1); PG8_STAGEB(PG8_SB(1, 0), b3); PG8_STAGEB(PG8_SB(1, 1), b3 + hstep); PG8_STAGE(PG8_SA(1, 0), a3, w0, w1);
            PG8_WAIT_V(8); PG8_WAIT_L(0); PG8_BAR; PG8_MMA(1, 0, At, B0); PG8_MMA(1, 1, At, B1); PG8_BAR; PG8_SCHED;
        }
        if constexpr (ALIGN_EPI) { if (wr == 0) PG8_BAR; }
        E(acc, cur, wr, wc, fr, fq);
        if (!has_next) break;
#pragma unroll
        for (int a = 0; a < 2; ++a)
#pragma unroll
            for (int b = 0; b < 2; ++b)
#pragma unroll
                for (int m = 0; m < 4; ++m)
#pragma unroll
                    for (int n = 0; n < 2; ++n) acc[a][b][m][n] = (f32x4){0.f, 0.f, 0.f, 0.f};
        cur = nxt; cA = nA; cB = nB; ++ui;
#pragma unroll
        for (int j = 0; j < 4; ++j) va[j] = vn[j];
        if constexpr (ALIGN_EPI) { if (wr == 1) PG8_BAR; }
    }
    PG8_WAIT_V(0);
    if constexpr (!ALIGN_EPI) { if (wr == 0) PG8_BAR; }
    PG8_BAR;
#undef PG8_SA
#undef PG8_SB
#undef PG8_STAGE
#undef PG8_STAGEB
#undef PG8_LDA
#undef PG8_LDB
#undef PG8_MMA
#undef PG8_WAIT_V
#undef PG8_WAIT_L
#undef PG8_BAR
#undef PG8_SCHED
}

struct EpiBf16 {
    static constexpr bool PERM = true;
    bf16_t* O; int ldc;
    __device__ __forceinline__ void operator()(const f32x4 (&acc)[2][2][4][2], const Unit& u, int wr, int wc, int fr, int fq) const {
        const int row0 = u.pm * BM + wr * 64 + fr, col0 = u.pn * BM + wc * 32 + 8 * fq;
#pragma unroll
        for (int ai = 0; ai < 2; ++ai)
#pragma unroll
            for (int m = 0; m < 4; ++m) { bf16_t* rowp = O + (size_t)(row0 + ai * HALF + m * 16) * ldc + col0;
#pragma unroll
                for (int bj = 0; bj < 2; ++bj) { const f32x4 v0 = acc[ai][bj][m][0], v1 = acc[ai][bj][m][1];
                    u32x4 w; w.x = cvt_pk_bf16(v0[0], v0[1]); w.y = cvt_pk_bf16(v0[2], v0[3]); w.z = cvt_pk_bf16(v1[0], v1[1]); w.w = cvt_pk_bf16(v1[2], v1[3]);
                    *(u32x4*)(rowp + bj * HALF) = w; } }
    }
};
}
#define GAS __attribute__((address_space(1)))
#define LAS __attribute__((address_space(3)))
typedef unsigned short bf16;
typedef unsigned v4u __attribute__((ext_vector_type(4)));
typedef float f32x4 __attribute__((ext_vector_type(4)));
typedef short bf16x8 __attribute__((ext_vector_type(8)));
typedef GAS unsigned gu32;
typedef GAS unsigned long long gu64;
#define RLX_AGENT __ATOMIC_RELAXED, __HIP_MEMORY_SCOPE_AGENT
#define LDS_WAIT() asm volatile("s_waitcnt lgkmcnt(0)" ::: "memory")
#define VM_WAIT() asm volatile("s_waitcnt vmcnt(0)" ::: "memory")
__device__ __forceinline__ unsigned long long rt() { return __builtin_amdgcn_s_memrealtime(); }
__device__ __forceinline__ unsigned f2bf(float f) { unsigned u = __builtin_bit_cast(unsigned, f); return (u + 0x7fffu + ((u >> 16) & 1u)) >> 16; }
__device__ __forceinline__ unsigned pk2(float lo, float hi) { return f2bf(lo) | (f2bf(hi) << 16); }

#define XB_TMO      128
#define XB_XCNT(j)  (256  + 64 * (j))
#define XB_XSUB(j)  (1280 + 64 * (j))
#define XB_XGEN(j)  (2304 + 64 * (j))
#define XB_TOP      3328
#define XB_TOPGEN   3392
#define XCD_BAR_WORDS 3456
#define XB_SPIN_CAP (1u << 18)

__device__ __forceinline__ unsigned xb_ld(unsigned* p)              { return __hip_atomic_load(p, __ATOMIC_RELAXED, __HIP_MEMORY_SCOPE_AGENT); }
__device__ __forceinline__ unsigned xb_add(unsigned* p, unsigned v) { return __hip_atomic_fetch_add(p, v, __ATOMIC_RELAXED, __HIP_MEMORY_SCOPE_AGENT); }
__device__ __forceinline__ unsigned xb_xcc_id() { return (unsigned)__builtin_amdgcn_s_getreg((3 << 11) | 20) & 0xFu; }
#define XB_SPIN(cond, bar) do { unsigned _sp = 0; while (cond) { __builtin_amdgcn_s_sleep(1); \
    if ((++_sp & 255u) == 0u) { if (xb_ld(&(bar)[XB_TMO])) break; if (_sp > XB_SPIN_CAP) { atomicAdd(&(bar)[XB_TMO], 1u); break; } } } } while (0)

struct XcdBarrier {
    unsigned* bar; unsigned x;
    volatile LAS unsigned* st;
};

__device__ __forceinline__ XcdBarrier xcd_barrier_post(unsigned* bar, volatile LAS unsigned* st) {
    XcdBarrier b; b.bar = bar; b.x = xb_xcc_id(); b.st = st;
    if (threadIdx.x == 0) (void)xb_add(&bar[XB_XCNT(b.x)], 1u);
    return b;
}
__device__ __forceinline__ void xcd_barrier_complete(unsigned* bar, unsigned x, unsigned& nloc, unsigned& nx) {
    const unsigned G = gridDim.x * gridDim.y * gridDim.z;
    unsigned sum, cnt, mine, sp = 0u;
    for (;;) {
        sum = 0u; cnt = 0u; mine = 0u;
#pragma unroll
        for (unsigned j = 0; j < 16; ++j) { const unsigned c = xb_ld(&bar[XB_XCNT(j)]); sum += c; cnt += (c > 0u) ? 1u : 0u; mine = (j == x) ? c : mine; }
        if (sum == G) break;
        __builtin_amdgcn_s_sleep(1);
        if ((++sp & 255u) == 0u) { if (xb_ld(&bar[XB_TMO])) break; if (sp > XB_SPIN_CAP) { atomicAdd(&bar[XB_TMO], 1u); break; } }
    }
    nloc = mine > 0u ? mine : 1u; nx = cnt > 0u ? cnt : 1u;
}

__device__ __forceinline__ void xcd_barrier(const XcdBarrier& b) {
    asm volatile("s_waitcnt vmcnt(0)" ::: "memory");
    __syncthreads();
    if (threadIdx.x == 0) {
        unsigned* bar = b.bar;
        __builtin_amdgcn_s_waitcnt(0);
        unsigned nloc = b.st[0], nx = b.st[1];
        if (nloc == 0u) { xcd_barrier_complete(bar, b.x, nloc, nx); b.st[0] = nloc; b.st[1] = nx; }
        const unsigned old = xb_add(&bar[XB_XSUB(b.x)], 1u);
        const unsigned gen = old / nloc;
        if (old + 1u == (gen + 1u) * nloc) {
            __builtin_amdgcn_fence(__ATOMIC_RELEASE, "agent");
            asm volatile("s_waitcnt vmcnt(0)" ::: "memory");
            const unsigned og = xb_add(&bar[XB_TOP], 1u);
            const unsigned tg = og / nx;
            if (og + 1u == (tg + 1u) * nx) xb_add(&bar[XB_TOPGEN], 1u);
            else XB_SPIN(xb_ld(&bar[XB_TOPGEN]) == tg, bar);
            __builtin_amdgcn_fence(__ATOMIC_ACQUIRE, "agent");
            xb_add(&bar[XB_XGEN(b.x)], 1u);
            asm volatile("s_waitcnt vmcnt(0)" ::: "memory");
        } else {
            XB_SPIN(xb_ld(&bar[XB_XGEN(b.x)]) == gen, bar);
            __builtin_amdgcn_fence(__ATOMIC_ACQUIRE, "agent");
            asm volatile("s_waitcnt vmcnt(0)" ::: "memory");
        }
    }
    __syncthreads();
}

constexpr int NTOK = 32768, DM = 1024, NPROJ = 3328;
constexpr int PC_Q = 0, PC_K = 512, PC_V = 1024, PC_Z = 1536, PC_U = 2048, PC_VS = 2560, PC_B = 3072, PC_A = 3076;
constexpr int NEXP = 64, DEXP = 512;
constexpr size_t MiB = 1u << 20;
constexpr size_t WS_CTL = 0, CTL_ZERO_BYTES = 1 * MiB;
constexpr size_t WS_WIN = 1 * MiB, WS_WOUT = 8 * MiB, WS_LIST = 10 * MiB, WS_ROUTE = 18 * MiB;
constexpr size_t WS_WREP = 19 * MiB;
constexpr size_t WS_C = 20 * MiB;
constexpr size_t WS_WGU = WS_C, WS_WD = WS_C + 128 * MiB;
constexpr size_t WS_A = 212 * MiB;
constexpr size_t WS_B = 276 * MiB;
constexpr size_t WS_H1BF = WS_B, WS_YEXP = WS_B + 64 * MiB;
constexpr size_t WS_END = 484 * MiB;
constexpr int CW_BAR = 4096;
constexpr int CW_CNT = 16384;
constexpr int RING_BYTES = 131072, LDSCTL_OFF = RING_BYTES, MISC_OFF = LDSCTL_OFF + 320, PREF_OFF = MISC_OFF + 128, LDS_BYTES = 147456;
constexpr int NTHREADS = 512, NWAVES = 8;
constexpr float ALPHA_F = 1.189207115002721f;

__device__ __forceinline__ float bf2f(unsigned short v) { return __builtin_bit_cast(float, (unsigned)v << 16); }
__device__ __forceinline__ float wave_sum(float v) {
#pragma unroll
    for (int o = 1; o < 64; o <<= 1) v += __shfl_xor(v, o);
    return v;
}

__device__ __forceinline__ void p0_item_load(const float* W, int ldw, int k0, int n0src, int lane, float (&r)[32]) {
#pragma unroll
    for (int i = 0; i < 32; ++i) r[i] = W[(size_t)(k0 + 2 * i + (lane >> 5)) * ldw + n0src + (lane & 31)];
}
__device__ __forceinline__ void p0_item_store(const float (&r)[32], int K, int k0, bf16* WT, int dst_row0, LAS float* scr, int lane) {
#pragma unroll
    for (int i = 0; i < 32; ++i) scr[(2 * i + (lane >> 5)) * 33 + (lane & 31)] = r[i];
    LDS_WAIT(); asm volatile("" ::: "memory");
    const int c = lane & 7;
#pragma unroll
    for (int j = 0; j < 4; ++j) { const int n = (lane >> 3) + 8 * j; const LAS float* s = scr + (8 * c) * 33 + n;
        v4u o; o.x = pk2(s[0 * 33], s[1 * 33]); o.y = pk2(s[2 * 33], s[3 * 33]); o.z = pk2(s[4 * 33], s[5 * 33]); o.w = pk2(s[6 * 33], s[7 * 33]);
        *(GAS v4u*)(WT + (size_t)(dst_row0 + n) * K + k0 + 8 * c) = o; }
    LDS_WAIT(); asm volatile("" ::: "memory");
}
__device__ __forceinline__ void p0_transpose_item(const float* W, int ldw, int K, int k0, int n0src, bf16* WT, int dst_row0, LAS float* scr, int lane) {
    float r[32]; p0_item_load(W, ldw, k0, n0src, lane, r); p0_item_store(r, K, k0, WT, dst_row0, scr, lane);
}
struct P0Exp { const float* W; bf16* WT; int ldw, K, k0, n0, drow; };
__device__ __forceinline__ P0Exp p0_exp_item(int it, const float* wg, const float* wu, const float* wd, bf16* WGU, bf16* WD) {
    P0Exp x;
    if (it < 32768) { const int nb = it & 15, kb = (it >> 4) & 15, half = (it >> 8) & 1, e = it >> 9, n0 = nb * 32;
        x.W = (half ? wu : wg) + (size_t)e * DM * DEXP; x.WT = WGU + (size_t)e * 1024 * DM; x.ldw = DEXP; x.K = DM; x.k0 = kb * 64; x.n0 = n0; x.drow = (n0 >> 7) * 256 + half * 128 + (n0 & 127); }
    else { const int i2 = it - 32768, nb = i2 & 31, kb = (i2 >> 5) & 7, e = i2 >> 8;
        x.W = wd + (size_t)e * DEXP * DM; x.WT = WD + (size_t)e * DM * DEXP; x.ldw = DM; x.K = DEXP; x.k0 = kb * 64; x.n0 = nb * 32; x.drow = nb * 32; }
    return x;
}
__device__ __forceinline__ void p0_experts(const float* wg, const float* wu, const float* wd, bf16* WGU, bf16* WD, LAS float* scr, int gw, int NGW, int lane) {
    constexpr int NIT = 32768 + 16384;
    int it = gw; if (it >= NIT) return;
    float cur[32], nxt[32];
    P0Exp xc = p0_exp_item(it, wg, wu, wd, WGU, WD); p0_item_load(xc.W, xc.ldw, xc.k0, xc.n0, lane, cur);
    for (;;) {
        const int itn = it + NGW; const bool more = itn < NIT; P0Exp xn = xc;
        if (more) { xn = p0_exp_item(itn, wg, wu, wd, WGU, WD); p0_item_load(xn.W, xn.ldw, xn.k0, xn.n0, lane, nxt); }
        p0_item_store(cur, xc.K, xc.k0, xc.WT, xc.drow, scr, lane);
        if (!more) break;
#pragma unroll
        for (int i = 0; i < 32; ++i) cur[i] = nxt[i];
        xc = xn; it = itn;
    }
}

struct MK {
    nv::P p;
    unsigned char* ws;
};

namespace pg8 {
__device__ __forceinline__ float silu_f(float x) { return x * __builtin_amdgcn_rcpf(1.f + __builtin_amdgcn_exp2f(-1.4426950408889634f * x)); }
struct EpiHid {
    static constexpr bool PERM = true;
    bf16_t* HID; const int* list; const int* cnt; int cap;
    __device__ __forceinline__ void operator()(const f32x4 (&acc)[2][2][4][2], const Unit& u, int wr, int wc, int fr, int fq) const {
        const int* lp = list + (size_t)u.e * cap; const int col0 = u.pn * 128 + wc * 32 + 8 * fq;
#pragma unroll
        for (int ai = 0; ai < 2; ++ai)
#pragma unroll
            for (int m = 0; m < 4; ++m) { const int r = ai * HALF + wr * 64 + m * 16 + fr;
                if (r < u.rows) { const int a = lp[u.pm * BM + r] & 0xffff;
                    const f32x4 g0 = acc[ai][0][m][0], g1 = acc[ai][0][m][1], u0 = acc[ai][1][m][0], u1 = acc[ai][1][m][1];
                    u32x4 w; w.x = cvt_pk_bf16(silu_f(g0[0]) * u0[0], silu_f(g0[1]) * u0[1]); w.y = cvt_pk_bf16(silu_f(g0[2]) * u0[2], silu_f(g0[3]) * u0[3]);
                    w.z = cvt_pk_bf16(silu_f(g1[0]) * u1[0], silu_f(g1[1]) * u1[1]); w.w = cvt_pk_bf16(silu_f(g1[2]) * u1[2], silu_f(g1[3]) * u1[3]);
                    *(u32x4*)(HID + (size_t)a * 512 + col0) = w; } }
    }
};
struct EpiYexp {
    static constexpr bool PERM = true;
    bf16_t* Y; const int* list; const float* wgt; int cap;
    __device__ __forceinline__ void operator()(const f32x4 (&acc)[2][2][4][2], const Unit& u, int wr, int wc, int fr, int fq) const {
        const int* lp = list + (size_t)u.e * cap; const int col0 = u.pn * BM + wc * 32 + 8 * fq;
#pragma unroll
        for (int ai = 0; ai < 2; ++ai)
#pragma unroll
            for (int m = 0; m < 4; ++m) { const int r = ai * HALF + wr * 64 + m * 16 + fr;
                if (r < u.rows) { const unsigned ent = (unsigned)lp[u.pm * BM + r]; const int a = (int)(ent & 0xffffu); const float w8 = __builtin_bit_cast(float, ent & 0xffff0000u);
#pragma unroll
                    for (int bj = 0; bj < 2; ++bj) { const f32x4 v0 = acc[ai][bj][m][0] * w8, v1 = acc[ai][bj][m][1] * w8;
                        u32x4 w; w.x = cvt_pk_bf16(v0[0], v0[1]); w.y = cvt_pk_bf16(v0[2], v0[3]); w.z = cvt_pk_bf16(v1[0], v1[1]); w.w = cvt_pk_bf16(v1[2], v1[3]);
                        *(u32x4*)(Y + (size_t)a * 1024 + col0 + bj * HALF) = w; } } }
    }
};

struct EpiZ1 {
    static constexpr bool PERM = false;
    float* O; const float* X; float alpha;
    __device__ __forceinline__ void operator()(const f32x4 (&acc)[2][2][4][2], const Unit& u, int wr, int wc, int fr, int fq) const {
        const int row0 = u.pm * BM + wr * 64 + fr, col0 = u.pn * BM + wc * 32 + 4 * fq;
#pragma unroll
        for (int ai = 0; ai < 2; ++ai)
#pragma unroll
            for (int m = 0; m < 4; ++m) { const size_t off = (size_t)(row0 + ai * HALF + m * 16) * 1024 + col0;
#pragma unroll
                for (int bj = 0; bj < 2; ++bj)
#pragma unroll
                    for (int n = 0; n < 2; ++n) { const f32x4 xv = *(const f32x4*)(X + off + bj * HALF + n * 16); *(f32x4*)(O + off + bj * HALF + n * 16) = acc[ai][bj][m][n] + xv * alpha; } }
    }
};
}


typedef short s16x4 __attribute__((ext_vector_type(4)));
typedef short v4i16_t __attribute__((ext_vector_type(4)));
__device__ __forceinline__ unsigned off_b(unsigned row, unsigned ch) { return 256u * row + 16u * (ch ^ (((row & 3) << 2) | ((row >> 2) & 3))); }
__device__ __forceinline__ s16x4 vtr(LAS unsigned char* p) { return __builtin_bit_cast(s16x4, __builtin_amdgcn_ds_read_tr16_b64_v4i16((LAS v4i16_t*)p)); }
__device__ __forceinline__ float gelu_tanh(float x) { return x * __builtin_amdgcn_rcpf(1.f + __builtin_amdgcn_exp2f(-2.3022081986f * (x + 0.044715f * x * x * x))); }

__device__ __forceinline__ void sgu_phase(LAS unsigned char* lds, bf16* PROJ, const nv::P& p, int G, int vcu, int wave_s) {
    const int lane = pg8::lane_id_fresh(), tid = wave_s * 64 + lane;
    const int g4 = lane >> 4, q = (lane & 15) >> 2, pp = lane & 3, l15 = lane & 15;
    v4u rawn[4];
    { const int u0 = vcu < 1024 ? vcu : 0; const bf16* src = PROJ + ((size_t)(u0 >> 2) * 128 + (tid >> 2)) * NPROJ + PC_VS + (u0 & 3) * 128 + (tid & 3) * 32;
#pragma unroll
      for (int i = 0; i < 4; ++i) rawn[i] = *(const GAS v4u*)(src + 8 * i); }
    for (int u = vcu; u < 1024; u += G) {
        const int g = u & 3, bc = u >> 2; const size_t row0 = (size_t)bc * 128;
        {
            const int s = tid >> 2, qt = tid & 3;
            v4u raw[4];
#pragma unroll
            for (int i = 0; i < 4; ++i) raw[i] = rawn[i];
            { const int un = (u + G < 1024) ? u + G : u; const bf16* srcn = PROJ + ((size_t)(un >> 2) * 128 + s) * NPROJ + PC_VS + (un & 3) * 128 + qt * 32;
#pragma unroll
              for (int i = 0; i < 4; ++i) rawn[i] = *(const GAS v4u*)(srcn + 8 * i); }
            float x[32]; float s1 = 0.f;
#pragma unroll
            for (int i = 0; i < 4; ++i)
#pragma unroll
                for (int c = 0; c < 4; ++c) { const unsigned w = raw[i][c]; const float a = gelu_tanh(__builtin_bit_cast(float, w << 16)), b = gelu_tanh(__builtin_bit_cast(float, w & 0xffff0000u)); x[i * 8 + c * 2] = a; x[i * 8 + c * 2 + 1] = b; s1 += a + b; }
            s1 += __shfl_xor(s1, 1); s1 += __shfl_xor(s1, 2);
            const float mean = s1 * (1.f / 128.f); float s2 = 0.f;
#pragma unroll
            for (int i = 0; i < 32; ++i) { x[i] -= mean; s2 += x[i] * x[i]; }
            s2 += __shfl_xor(s2, 1); s2 += __shfl_xor(s2, 2);
            const float rstd = 1.f / sqrtf(s2 * (1.f / 128.f) + 1e-5f);
            const float* lg = p.sgu_ln_g + g * 128 + qt * 32; const float* lb = p.sgu_ln_b + g * 128 + qt * 32;
#pragma unroll
            for (int i = 0; i < 4; ++i) { const f32x4 g0 = *(const GAS f32x4*)(lg + 8 * i), g1 = *(const GAS f32x4*)(lg + 8 * i + 4), b0 = *(const GAS f32x4*)(lb + 8 * i), b1 = *(const GAS f32x4*)(lb + 8 * i + 4);
                v4u o; o.x = pk2(x[8 * i] * rstd * g0.x + b0.x, x[8 * i + 1] * rstd * g0.y + b0.y); o.y = pk2(x[8 * i + 2] * rstd * g0.z + b0.z, x[8 * i + 3] * rstd * g0.w + b0.w);
                o.z = pk2(x[8 * i + 4] * rstd * g1.x + b1.x, x[8 * i + 5] * rstd * g1.y + b1.y); o.w = pk2(x[8 * i + 6] * rstd * g1.z + b1.z, x[8 * i + 7] * rstd * g1.w + b1.w);
                *(LAS v4u*)(lds + off_b((unsigned)s, (unsigned)(qt * 4 + i))) = o; }
        }
        __syncthreads();
        {
            const int w = wave_s, t = 16 * w + l15, nks = (w >> 1) + 1;
            f32x4 acc[8];
#pragma unroll
            for (int dt = 0; dt < 8; ++dt) acc[dt] = (f32x4){0.f, 0.f, 0.f, 0.f};
            for (int ks = 0; ks < nks; ++ks) {
                const int sb = 32 * ks + 8 * g4;
                const float* wp = p.w_spatial + ((size_t)(g * 128 + t)) * 128 + sb;
                const f32x4 w0 = *(const GAS f32x4*)wp, w1 = *(const GAS f32x4*)(wp + 4);
                float wv[8] = {w0.x, w0.y, w0.z, w0.w, w1.x, w1.y, w1.z, w1.w};
#pragma unroll
                for (int j = 0; j < 8; ++j) if (sb + j > t) wv[j] = 0.f;
                v4u bw; bw.x = pk2(wv[0], wv[1]); bw.y = pk2(wv[2], wv[3]); bw.z = pk2(wv[4], wv[5]); bw.w = pk2(wv[6], wv[7]);
                const bf16x8 bfrag = __builtin_bit_cast(bf16x8, bw);
#pragma unroll
                for (int dt = 0; dt < 8; ++dt) {
                    const s16x4 lo = vtr(lds + off_b((unsigned)(sb + q), (unsigned)(2 * dt + (pp >> 1))) + 8 * (pp & 1));
                    const s16x4 hi = vtr(lds + off_b((unsigned)(sb + 4 + q), (unsigned)(2 * dt + (pp >> 1))) + 8 * (pp & 1));
                    const bf16x8 afrag = (bf16x8){lo[0], lo[1], lo[2], lo[3], hi[0], hi[1], hi[2], hi[3]};
                    acc[dt] = __builtin_amdgcn_mfma_f32_16x16x32_bf16(afrag, bfrag, acc[dt], 0, 0, 0);
                }
            }
            const float bias = p.b_spatial[g * 128 + t];
            bf16* rowp = PROJ + (row0 + t) * NPROJ;
#pragma unroll
            for (int dt = 0; dt < 8; ++dt) {
                const int d = g * 128 + 16 * dt + 4 * g4;
                const unsigned long long uu = *(const GAS unsigned long long*)(rowp + PC_U + d);
                const float u0 = gelu_tanh(bf2f((unsigned short)uu)), u1 = gelu_tanh(bf2f((unsigned short)(uu >> 16))), u2 = gelu_tanh(bf2f((unsigned short)(uu >> 32))), u3 = gelu_tanh(bf2f((unsigned short)(uu >> 48)));
                const unsigned long long o = (unsigned long long)pk2(u0 * (acc[dt][0] + bias), u1 * (acc[dt][1] + bias)) | ((unsigned long long)pk2(u2 * (acc[dt][2] + bias), u3 * (acc[dt][3] + bias)) << 32);
                *(GAS unsigned long long*)(rowp + 512 + d) = o;
            }
        }
        __syncthreads();
    }
}

constexpr int DNA_PIECES = 57, DNU_PIECES = 2, DN_STEP_BYTES = (DNA_PIECES + DNU_PIECES) * 1024;
constexpr size_t DNA_CHUNK_BYTES = (size_t)DNA_PIECES * 1024, DNU_CHUNK_BYTES = 8 * DNU_PIECES * 1024;
__device__ __forceinline__ void glds16(const void* gsrc, LAS unsigned char* dst) { __builtin_amdgcn_global_load_lds((const unsigned*)gsrc, (LAS unsigned*)dst, 16, 0, 0); }
typedef float f32x2_t __attribute__((ext_vector_type(2))); typedef __bf16 bf16x2_t __attribute__((ext_vector_type(2)));
__device__ __forceinline__ unsigned cvtpk(float lo, float hi) { const f32x2_t v = {lo, hi}; const bf16x2_t b = __builtin_convertvector(v, bf16x2_t); return __builtin_bit_cast(unsigned, b); }

constexpr int DN_RING_PIECES = 42, DN_SLOT_BYTES = DN_RING_PIECES * 1024;
__device__ __forceinline__ void dn_scan_phase(LAS unsigned char* lds, const unsigned char* DNA, const unsigned char* DNU, bf16* ODN, int vcu, int wave_s) {
    if (vcu >= 256) return;
    const int lane = pg8::lane_id_fresh();
    const int bh = vcu >> 3, sl = vcu & 7, l15 = lane & 15, g4 = lane >> 4;
    const unsigned char* a_src = DNA + (size_t)bh * 64 * DNA_CHUNK_BYTES + lane * 16;
    const unsigned char* u_src = DNU + ((size_t)bh * 64 * 8 + sl) * (DNU_PIECES * 1024) + lane * 16;
#define DN_STAGE(step) do { if (wave_s >= 1 && wave_s <= 6) { const unsigned char* as_ = a_src + (size_t)(step) * DNA_CHUNK_BYTES; const unsigned char* us_ = u_src + (size_t)(step) * DNU_CHUNK_BYTES; \
        LAS unsigned char* sp_ = lds + ((step) % 3) * DN_SLOT_BYTES; \
        _Pragma("unroll") for (int i_ = 0; i_ < 7; ++i_) { const int p_ = (wave_s - 1) + 6 * i_; \
            const unsigned char* g_ = p_ < 16 ? as_ + p_ * 1024 : p_ < 32 ? as_ + (16 + p_) * 1024 : p_ < 40 ? as_ + (16 + p_) * 1024 : us_ + (p_ - 40) * 1024; \
            glds16(g_, sp_ + p_ * 1024); } } } while (0)
    DN_STAGE(0); DN_STAGE(1);
    if (wave_s != 0) {
        for (int n = 0; n < 64; ++n) {
            if (n < 63) asm volatile("s_waitcnt vmcnt(7)" ::: "memory"); else asm volatile("s_waitcnt vmcnt(0)" ::: "memory");
            __builtin_amdgcn_s_barrier();
            asm volatile("" ::: "memory");
            if (n + 2 < 64) DN_STAGE(n + 2);
        }
        asm volatile("s_waitcnt vmcnt(0)" ::: "memory");
        return;
    }
#undef DN_STAGE
    f32x4 S[8];
#pragma unroll
    for (int k = 0; k < 8; ++k) S[k] = (f32x4){0.f, 0.f, 0.f, 0.f};
    bf16x8 Qc[16], Qn[16]; float glc, gln;
#pragma unroll
    for (int i = 0; i < 16; ++i) Qc[i] = *(const GAS bf16x8*)(a_src + (16 + i) * 1024);
    glc = *(const GAS float*)(a_src + 56 * 1024);
    bf16* orow = ODN + (size_t)vcu * (64 * 64 * 16) + l15;
    for (int n = 0; n < 64; ++n) {
        asm volatile("s_waitcnt lgkmcnt(0)" ::: "memory");
        __builtin_amdgcn_s_barrier();
        asm volatile("" ::: "memory");
        { const unsigned char* nx = a_src + (size_t)(n + 1 < 64 ? n + 1 : n) * DNA_CHUNK_BYTES;
#pragma unroll
          for (int i = 0; i < 16; ++i) Qn[i] = *(const GAS bf16x8*)(nx + (16 + i) * 1024);
          gln = *(const GAS float*)(nx + 56 * 1024); }
        LAS unsigned char* lb = lds + (n % 3) * DN_SLOT_BYTES + lane * 16;
#define FRAG(piece) (*(const LAS bf16x8*)(lb + (piece) * 1024))
        bf16x8 Sb[4];
#pragma unroll
        for (int ks = 0; ks < 4; ++ks) { v4u w; w.x = cvtpk(S[2 * ks][0], S[2 * ks][1]); w.y = cvtpk(S[2 * ks][2], S[2 * ks][3]); w.z = cvtpk(S[2 * ks + 1][0], S[2 * ks + 1][1]); w.w = cvtpk(S[2 * ks + 1][2], S[2 * ks + 1][3]); Sb[ks] = __builtin_bit_cast(bf16x8, w); }
        f32x4 P[4];
        { const v4u u0 = *(const LAS v4u*)(lb + 40 * 1024), u1 = *(const LAS v4u*)(lb + 41 * 1024);
          P[0] = (f32x4){__builtin_bit_cast(float, u0.x << 16), __builtin_bit_cast(float, u0.x & 0xffff0000u), __builtin_bit_cast(float, u0.y << 16), __builtin_bit_cast(float, u0.y & 0xffff0000u)};
          P[1] = (f32x4){__builtin_bit_cast(float, u0.z << 16), __builtin_bit_cast(float, u0.z & 0xffff0000u), __builtin_bit_cast(float, u0.w << 16), __builtin_bit_cast(float, u0.w & 0xffff0000u)};
          P[2] = (f32x4){__builtin_bit_cast(float, u1.x << 16), __builtin_bit_cast(float, u1.x & 0xffff0000u), __builtin_bit_cast(float, u1.y << 16), __builtin_bit_cast(float, u1.y & 0xffff0000u)};
          P[3] = (f32x4){__builtin_bit_cast(float, u1.z << 16), __builtin_bit_cast(float, u1.z & 0xffff0000u), __builtin_bit_cast(float, u1.w << 16), __builtin_bit_cast(float, u1.w & 0xffff0000u)}; }
#pragma unroll
        for (int mt = 0; mt < 4; ++mt)
#pragma unroll
            for (int ks = 0; ks < 4; ++ks) P[mt] = __builtin_amdgcn_mfma_f32_16x16x32_bf16(FRAG(mt * 4 + ks), Sb[ks], P[mt], 0, 0, 0);
        bf16x8 Vb[2];
#pragma unroll
        for (int ks = 0; ks < 2; ++ks) { v4u w; w.x = cvtpk(P[2 * ks][0], P[2 * ks][1]); w.y = cvtpk(P[2 * ks][2], P[2 * ks][3]); w.z = cvtpk(P[2 * ks + 1][0], P[2 * ks + 1][1]); w.w = cvtpk(P[2 * ks + 1][2], P[2 * ks + 1][3]); Vb[ks] = __builtin_bit_cast(bf16x8, w); }
        f32x4 O[4];
#pragma unroll
        for (int mt = 0; mt < 4; ++mt) { O[mt] = (f32x4){0.f, 0.f, 0.f, 0.f};
#pragma unroll
            for (int ks = 0; ks < 4; ++ks) O[mt] = __builtin_amdgcn_mfma_f32_16x16x32_bf16(Qc[mt * 4 + ks], Sb[ks], O[mt], 0, 0, 0);
#pragma unroll
            for (int ks = 0; ks < 2; ++ks) O[mt] = __builtin_amdgcn_mfma_f32_16x16x32_bf16(FRAG(32 + mt * 2 + ks), Vb[ks], O[mt], 0, 0, 0); }
#pragma unroll
        for (int kt = 0; kt < 8; ++kt) { S[kt] = S[kt] * glc;
#pragma unroll
            for (int ks = 0; ks < 2; ++ks) S[kt] = __builtin_amdgcn_mfma_f32_16x16x32_bf16(FRAG(16 + kt * 2 + ks), Vb[ks], S[kt], 0, 0, 0); }
#undef FRAG
        bf16* ob = orow + (size_t)(n * 64 + 4 * g4) * 16;
#pragma unroll
        for (int mt = 0; mt < 4; ++mt)
#pragma unroll
            for (int r = 0; r < 4; ++r) ob[(16 * mt + r) * 16] = (bf16)f2bf(O[mt][r]);
#pragma unroll
        for (int i = 0; i < 16; ++i) Qc[i] = Qn[i];
        glc = gln;
    }
    asm volatile("s_waitcnt vmcnt(0)" ::: "memory");
}

__device__ __forceinline__ void dn_final_phase(const bf16* ODN, bf16* PROJ, const float* norm_w, int gw, int NGW, int lane) {
    const f32x4 nw0 = *(const GAS f32x4*)(norm_w + ((8 * lane) & 127)), nw1 = *(const GAS f32x4*)(norm_w + ((8 * lane) & 127) + 4);
    for (int m = gw; m < NTOK; m += NGW) {
        const int bb = m >> 12, nn = (m >> 6) & 63, ii = m & 63;
        const v4u ov = *(const GAS v4u*)(ODN + ((((size_t)((bb * 4 + (lane >> 4)) * 8 + ((lane >> 1) & 7)) * 64 + nn) * 64 + ii) * 16 + 8 * (lane & 1))), zv = *(const GAS v4u*)(PROJ + (size_t)m * NPROJ + PC_Z + 8 * lane);
        float o[8], z[8];
#pragma unroll
        for (int c = 0; c < 4; ++c) { o[2 * c] = __builtin_bit_cast(float, ov[c] << 16); o[2 * c + 1] = __builtin_bit_cast(float, ov[c] & 0xffff0000u); z[2 * c] = __builtin_bit_cast(float, zv[c] << 16); z[2 * c + 1] = __builtin_bit_cast(float, zv[c] & 0xffff0000u); }
        float ss = 0.f;
#pragma unroll
        for (int c = 0; c < 8; ++c) ss += o[c] * o[c];
        ss += __shfl_xor(ss, 1); ss += __shfl_xor(ss, 2); ss += __shfl_xor(ss, 4); ss += __shfl_xor(ss, 8);
        const float rs = 1.f / sqrtf(ss * (1.f / 128.f) + 1e-6f);
        const float nw[8] = {nw0.x, nw0.y, nw0.z, nw0.w, nw1.x, nw1.y, nw1.z, nw1.w};
        float y[8];
#pragma unroll
        for (int c = 0; c < 8; ++c) y[c] = o[c] * rs * nw[c] * z[c] * __builtin_amdgcn_rcpf(1.f + __builtin_amdgcn_exp2f(-1.4426950408889634f * z[c]));
        v4u w; w.x = pk2(y[0], y[1]); w.y = pk2(y[2], y[3]); w.z = pk2(y[4], y[5]); w.w = pk2(y[6], y[7]);
        *(GAS v4u*)(PROJ + (size_t)m * NPROJ + 8 * lane) = w;
    }
}

__device__ __forceinline__ float wave_sum_dpp(float v) {
    v = v + __builtin_bit_cast(float, __builtin_amdgcn_update_dpp(0, __builtin_bit_cast(int, v), 0xB1, 0xf, 0xf, true));
    v = v + __builtin_bit_cast(float, __builtin_amdgcn_update_dpp(0, __builtin_bit_cast(int, v), 0x4E, 0xf, 0xf, true));
    v = v + __builtin_bit_cast(float, __builtin_amdgcn_update_dpp(0, __builtin_bit_cast(int, v), 0x141, 0xf, 0xf, true));
    v = v + __builtin_bit_cast(float, __builtin_amdgcn_update_dpp(0, __builtin_bit_cast(int, v), 0x140, 0xf, 0xf, true));
    v = v + __builtin_bit_cast(float, __builtin_amdgcn_update_dpp(0, __builtin_bit_cast(int, v), 0x142, 0xa, 0xf, true));
    v = v + __builtin_bit_cast(float, __builtin_amdgcn_update_dpp(0, __builtin_bit_cast(int, v), 0x143, 0xc, 0xf, true));
    return __builtin_bit_cast(float, __builtin_amdgcn_readlane(__builtin_bit_cast(int, v), 63));
}

constexpr int XTAB_OFF = RING_BYTES + 2048, XTAB_BYTES = 1792;
__device__ __forceinline__ unsigned off_t64(unsigned row, unsigned ch) { return 128u * row + 16u * (ch ^ (row & 7u)); }
__device__ __forceinline__ bf16x8 pack8(const float (&v)[8]) { v4u w; w.x = cvtpk(v[0], v[1]); w.y = cvtpk(v[2], v[3]); w.z = cvtpk(v[4], v[5]); w.w = cvtpk(v[6], v[7]); return __builtin_bit_cast(bf16x8, w); }
__device__ __forceinline__ void unpack8(const v4u w, float (&v)[8]) {
#pragma unroll
    for (int c = 0; c < 4; ++c) { v[2 * c] = __builtin_bit_cast(float, w[c] << 16); v[2 * c + 1] = __builtin_bit_cast(float, w[c] & 0xffff0000u); }
}
__device__ __forceinline__ float conv_silu_rows(const bf16* src0, bool seq_start, const float* cw, LAS unsigned char* img, int lane) {
    float w[4][2];
#pragma unroll
    for (int j = 0; j < 4; ++j) { const f32x2_t t = *(const GAS f32x2_t*)(cw + j * 1536 + 2 * lane); w[j][0] = t[0]; w[j][1] = t[1]; }
    const GAS unsigned* gsrc = (const GAS unsigned*)(src0 + 2 * lane);
    unsigned raw[67];
#pragma unroll
    for (int r = 0; r < 3; ++r) raw[r] = seq_start ? 0u : gsrc[(long)(r - 3) * (NPROJ / 2)];
#pragma unroll
    for (int r = 0; r < 64; ++r) raw[3 + r] = gsrc[(size_t)r * (NPROJ / 2)];
    float myss = 0.f;
    const unsigned lbase = (unsigned)((lane & 3) * 4);
#pragma unroll
    for (int pz = 0; pz < 64; ++pz) {
        float y0 = 0.f, y1 = 0.f;
#pragma unroll
        for (int j = 0; j < 4; ++j) { const unsigned u = raw[pz + j]; y0 += w[j][0] * __builtin_bit_cast(float, u << 16); y1 += w[j][1] * __builtin_bit_cast(float, u & 0xffff0000u); }
        y0 = y0 * __builtin_amdgcn_rcpf(1.f + __builtin_amdgcn_exp2f(-1.4426950408889634f * y0));
        y1 = y1 * __builtin_amdgcn_rcpf(1.f + __builtin_amdgcn_exp2f(-1.4426950408889634f * y1));
        const float tot = wave_sum_dpp(y0 * y0 + y1 * y1);
        myss = (lane == pz) ? tot : myss;
        *(LAS unsigned*)(img + off_b((unsigned)pz, (unsigned)(lane >> 2)) + lbase) = cvtpk(y0, y1);
    }
    return myss;
}

template <int STOP>
__device__ __forceinline__ void dn_prep_chunk(LAS unsigned char* IMG  , LAS float* tab, const bf16* PROJ, const nv::P& p, unsigned char* DNA, unsigned char* DNU, int ci) {
    int lane = pg8::lane_id_fresh();
    const int bh = ci >> 6, n = ci & 63, b = bh >> 2, h = bh & 3;
    int l15 = lane & 15, g4 = lane >> 4, q = l15 >> 2, pp = lane & 3;
    LAS float* t_gc = tab; LAS float* t_be = tab + 64; LAS float* t_rk = tab + 128; LAS float* t_rq = tab + 192; LAS float* t_eq = tab + 256; LAS float* t_ekk = tab + 320; LAS float* t_bg = tab + 384;
    const size_t tok = (size_t)b * 4096 + n * 64 + lane;
    const bf16* prow = PROJ + tok * NPROJ;
    const bf16* prow0 = PROJ + ((size_t)b * 4096 + n * 64) * NPROJ;
    unsigned char* dna = DNA + (size_t)ci * DNA_CHUNK_BYTES + lane * 16;
    (void)q; (void)pp;
    float gc, beta, eg, gc63;
    {
        const float araw = bf2f(prow[PC_A + h]), braw = bf2f(prow[PC_B + h]);
        const float xx = araw + p.dt_bias[h];
        const float sp = xx > 20.f ? xx : log1pf(expf(xx));
        gc = -expf(p.a_log[h]) * sp;
        beta = 1.f / (1.f + expf(-braw));
#pragma unroll
        for (int o = 1; o < 64; o <<= 1) { const float t = __shfl_up(gc, o); if (lane >= o) gc += t; }
        gc63 = __shfl(gc, 63);
        eg = expf(gc);
        const unsigned gb = __builtin_bit_cast(unsigned, expf(gc63));
        *(GAS v4u*)(dna + 56 * 1024) = (v4u){gb, gb, gb, gb};
        const float ssq = conv_silu_rows(prow0 + PC_Q + h * 128, n == 0, p.conv_w + h * 128, IMG, lane);
        const float rq = 0.08838834764831845f / sqrtf(ssq + 1e-6f);
        t_gc[lane] = gc; t_be[lane] = beta; t_rq[lane] = rq; t_eq[lane] = eg * rq;
    }
    LDS_WAIT(); asm volatile("" ::: "memory");
    if constexpr (STOP == 1) return;
    bf16x8 qF[4][4];
#pragma unroll
    for (int mt = 0; mt < 4; ++mt)
#pragma unroll
        for (int ks = 0; ks < 4; ++ks) qF[mt][ks] = *(const LAS bf16x8*)(IMG + off_b((unsigned)(16 * mt + l15), (unsigned)(4 * ks + g4)));
#pragma unroll
    for (int mt = 0; mt < 4; ++mt) {
        const float egi = t_eq[16 * mt + l15];
#pragma unroll
        for (int ks = 0; ks < 4; ++ks) {
            const unsigned long long lo = *(const LAS unsigned long long*)(IMG + off_b((unsigned)(16 * mt + l15), (unsigned)(4 * ks + (g4 >> 1))) + (g4 & 1) * 8);
            const unsigned long long hi = *(const LAS unsigned long long*)(IMG + off_b((unsigned)(16 * mt + l15), (unsigned)(4 * ks + 2 + (g4 >> 1))) + (g4 & 1) * 8);
            float t8[8]; unpack8((v4u){(unsigned)lo, (unsigned)(lo >> 32), (unsigned)hi, (unsigned)(hi >> 32)}, t8);
#pragma unroll
            for (int e = 0; e < 8; ++e) t8[e] *= egi;
            *(GAS bf16x8*)(dna + (16 + mt * 4 + ks) * 1024) = pack8(t8);
        }
    }
    LDS_WAIT(); asm volatile("" ::: "memory");
    {
        const float ssk = conv_silu_rows(prow0 + PC_K + h * 128, n == 0, p.conv_w + 512 + h * 128, IMG, lane);
        const float rk = 1.f / sqrtf(ssk + 1e-6f);
        t_rk[lane] = rk; t_ekk[lane] = expf(gc63 - gc) * rk; t_bg[lane] = beta * eg * rk;
    }
    LDS_WAIT(); asm volatile("" ::: "memory");
    if constexpr (STOP == 2) return;
    f32x4 Am[4][4];
    {
        bf16x8 kF[4][4];
#pragma unroll
        for (int mt = 0; mt < 4; ++mt)
#pragma unroll
            for (int ks = 0; ks < 4; ++ks) kF[mt][ks] = *(const LAS bf16x8*)(IMG + off_b((unsigned)(16 * mt + l15), (unsigned)(4 * ks + g4)));
#pragma unroll
        for (int mi = 0; mi < 4; ++mi) {
            const f32x4 gci = *(const LAS f32x4*)(t_gc + 16 * mi + 4 * g4), bei = *(const LAS f32x4*)(t_be + 16 * mi + 4 * g4), rki = *(const LAS f32x4*)(t_rk + 16 * mi + 4 * g4);
#pragma unroll
            for (int nj = 0; nj <= mi; ++nj) {
                f32x4 acc = (f32x4){0.f, 0.f, 0.f, 0.f};
#pragma unroll
                for (int ks = 0; ks < 4; ++ks) acc = __builtin_amdgcn_mfma_f32_16x16x32_bf16(kF[mi][ks], kF[nj][ks], acc, 0, 0, 0);
                const float gcj = t_gc[16 * nj + l15], rkj = t_rk[16 * nj + l15]; const int j = 16 * nj + l15;
#pragma unroll
                for (int r = 0; r < 4; ++r) { const int i = 16 * mi + 4 * g4 + r; acc[r] = (j < i) ? bei[r] * rki[r] * rkj * acc[r] * expf(gci[r] - gcj) : 0.f; }
                Am[mi][nj] = acc;
            }
        }
#pragma unroll
        for (int it = 0; it < 4; ++it) {
            const float gci = t_gc[16 * it + l15], rqi = t_rq[16 * it + l15]; const int i = 16 * it + l15;
            f32x4 kq[4];
#pragma unroll
            for (int jt = 0; jt < 4; ++jt) {
                f32x4 acc = (f32x4){0.f, 0.f, 0.f, 0.f};
                if (jt <= it) {
#pragma unroll
                    for (int ks = 0; ks < 4; ++ks) acc = __builtin_amdgcn_mfma_f32_16x16x32_bf16(kF[jt][ks], qF[it][ks], acc, 0, 0, 0);
                    const f32x4 gcj = *(const LAS f32x4*)(t_gc + 16 * jt + 4 * g4), rkj = *(const LAS f32x4*)(t_rk + 16 * jt + 4 * g4);
#pragma unroll
                    for (int r = 0; r < 4; ++r) { const int j = 16 * jt + 4 * g4 + r; acc[r] = (j <= i) ? acc[r] * rqi * rkj[r] * expf(gci - gcj[r]) : 0.f; }
                }
                kq[jt] = acc;
            }
#pragma unroll
            for (int ks = 0; ks < 2; ++ks) { const float t8[8] = {kq[2 * ks][0], kq[2 * ks][1], kq[2 * ks][2], kq[2 * ks][3], kq[2 * ks + 1][0], kq[2 * ks + 1][1], kq[2 * ks + 1][2], kq[2 * ks + 1][3]};
                *(GAS bf16x8*)(dna + (48 + it * 2 + ks) * 1024) = pack8(t8); }
        }
    }
    if constexpr (STOP == 3) return;
    bf16x8 ktr[8][2];
    {
#pragma unroll
        for (int ks = 0; ks < 2; ++ks) {
            const f32x4 ek0 = *(const LAS f32x4*)(t_ekk + 32 * ks + 4 * g4), ek1 = *(const LAS f32x4*)(t_ekk + 32 * ks + 16 + 4 * g4);
#pragma unroll
            for (int mt = 0; mt < 8; ++mt) {
                const s16x4 lo = vtr(IMG + off_b((unsigned)(32 * ks + 4 * g4 + q), (unsigned)(2 * mt + (pp >> 1))) + 8 * (pp & 1));
                const s16x4 hi = vtr(IMG + off_b((unsigned)(32 * ks + 16 + 4 * g4 + q), (unsigned)(2 * mt + (pp >> 1))) + 8 * (pp & 1));
                const float t8[8] = {bf2f((unsigned short)lo[0]) * ek0.x, bf2f((unsigned short)lo[1]) * ek0.y, bf2f((unsigned short)lo[2]) * ek0.z, bf2f((unsigned short)lo[3]) * ek0.w,
                                     bf2f((unsigned short)hi[0]) * ek1.x, bf2f((unsigned short)hi[1]) * ek1.y, bf2f((unsigned short)hi[2]) * ek1.z, bf2f((unsigned short)hi[3]) * ek1.w};
                *(GAS bf16x8*)(dna + (32 + mt * 2 + ks) * 1024) = pack8(t8);
            }
        }
#pragma unroll
        for (int dt = 0; dt < 8; ++dt)
#pragma unroll
            for (int ks = 0; ks < 2; ++ks) {
                const s16x4 lo = vtr(IMG + off_b((unsigned)(32 * ks + 8 * g4 + q), (unsigned)(2 * dt + (pp >> 1))) + 8 * (pp & 1));
                const s16x4 hi = vtr(IMG + off_b((unsigned)(32 * ks + 8 * g4 + 4 + q), (unsigned)(2 * dt + (pp >> 1))) + 8 * (pp & 1));
                ktr[dt][ks] = (bf16x8){lo[0], lo[1], lo[2], lo[3], hi[0], hi[1], hi[2], hi[3]};
            }
    }
    LDS_WAIT(); asm volatile("" ::: "memory");
    {
        LAS float* AL = (LAS float*)IMG;
#pragma unroll
        for (int mi = 0; mi < 4; ++mi)
#pragma unroll
            for (int nj = 0; nj <= mi; ++nj)
#pragma unroll
                for (int r = 0; r < 4; ++r) AL[(16 * mi + 4 * g4 + r) * 64 + 16 * nj + l15] = Am[mi][nj][r];
    }
    LDS_WAIT(); asm volatile("" ::: "memory");
    float T[64];
    {
        const LAS float* AL = (const LAS float*)IMG;
#pragma clang loop unroll(full)
        for (int i = 0; i < 64; ++i) {
            float v4[4] = {(lane == i) ? 1.f : 0.f, 0.f, 0.f, 0.f};
#pragma clang loop unroll(full)
            for (int j4 = 0; j4 < (i + 3) / 4; ++j4) {
                const f32x4 a = *(const LAS f32x4*)(AL + i * 64 + 4 * j4);
#pragma clang loop unroll(full)
                for (int e = 0; e < 4; ++e) if (4 * j4 + e < i) v4[e] -= a[e] * T[4 * j4 + e];
            }
            T[i] = (v4[0] + v4[1]) + (v4[2] + v4[3]);
        }
    }
    LDS_WAIT(); asm volatile("" ::: "memory");
    if constexpr (STOP == 4) return;
    lane = pg8::lane_id_fresh(); l15 = lane & 15; g4 = lane >> 4; q = l15 >> 2; pp = lane & 3;
    dna = DNA + (size_t)ci * DNA_CHUNK_BYTES + lane * 16;
    {
        const float bc = t_be[lane], bgc = t_bg[lane];
        LAS unsigned char* TB = IMG; LAS unsigned char* TBE = IMG + 8192;
#pragma unroll
        for (int i = 0; i < 64; ++i) { const unsigned o = off_t64((unsigned)i, (unsigned)(lane >> 3)) + (lane & 7) * 2;
            *(LAS unsigned short*)(TB + o) = (unsigned short)f2bf(T[i] * bc); *(LAS unsigned short*)(TBE + o) = (unsigned short)f2bf(T[i] * bgc); }
    }
    LDS_WAIT(); asm volatile("" ::: "memory");
    bf16x8 tb[4][2];
    {
#pragma unroll
        for (int it = 0; it < 4; ++it) {
            bf16x8 tbe[2];
#pragma unroll
            for (int ks = 0; ks < 2; ++ks) tbe[ks] = *(const LAS bf16x8*)(IMG + 8192 + off_t64((unsigned)(16 * it + l15), (unsigned)(4 * ks + g4)));
            f32x4 acc[8];
#pragma unroll
            for (int dt = 0; dt < 8; ++dt) { acc[dt] = (f32x4){0.f, 0.f, 0.f, 0.f};
#pragma unroll
                for (int ks = 0; ks < 2; ++ks) acc[dt] = __builtin_amdgcn_mfma_f32_16x16x32_bf16(ktr[dt][ks], tbe[ks], acc[dt], 0, 0, 0); }
#pragma unroll
            for (int ks = 0; ks < 4; ++ks) { const float t8[8] = {-acc[2 * ks][0], -acc[2 * ks][1], -acc[2 * ks][2], -acc[2 * ks][3], -acc[2 * ks + 1][0], -acc[2 * ks + 1][1], -acc[2 * ks + 1][2], -acc[2 * ks + 1][3]};
                *(GAS bf16x8*)(dna + (it * 4 + ks) * 1024) = pack8(t8); }
        }
#pragma unroll
        for (int mt = 0; mt < 4; ++mt)
#pragma unroll
            for (int ks = 0; ks < 2; ++ks) tb[mt][ks] = *(const LAS bf16x8*)(IMG + off_t64((unsigned)(16 * mt + l15), (unsigned)(4 * ks + g4)));
    }
    LDS_WAIT(); asm volatile("" ::: "memory");
    if constexpr (STOP == 5) return;
    (void)conv_silu_rows(prow0 + PC_V + h * 128, n == 0, p.conv_w + 1024 + h * 128, IMG, lane);
    LDS_WAIT(); asm volatile("" ::: "memory");
    {
        unsigned char* dnu = DNU + (size_t)ci * DNU_CHUNK_BYTES + lane * 16;
#pragma unroll
        for (int dt = 0; dt < 8; ++dt) {
            bf16x8 vt[2];
#pragma unroll
            for (int ks = 0; ks < 2; ++ks) {
                const s16x4 lo = vtr(IMG + off_b((unsigned)(32 * ks + 8 * g4 + q), (unsigned)(2 * dt + (pp >> 1))) + 8 * (pp & 1));
                const s16x4 hi = vtr(IMG + off_b((unsigned)(32 * ks + 8 * g4 + 4 + q), (unsigned)(2 * dt + (pp >> 1))) + 8 * (pp & 1));
                vt[ks] = (bf16x8){lo[0], lo[1], lo[2], lo[3], hi[0], hi[1], hi[2], hi[3]};
            }
            f32x4 u[4];
#pragma unroll
            for (int mt = 0; mt < 4; ++mt) { u[mt] = (f32x4){0.f, 0.f, 0.f, 0.f};
#pragma unroll
                for (int ks = 0; ks < 2; ++ks) u[mt] = __builtin_amdgcn_mfma_f32_16x16x32_bf16(tb[mt][ks], vt[ks], u[mt], 0, 0, 0); }
#pragma unroll
            for (int pc = 0; pc < 2; ++pc) { const float t8[8] = {u[2 * pc][0], u[2 * pc][1], u[2 * pc][2], u[2 * pc][3], u[2 * pc + 1][0], u[2 * pc + 1][1], u[2 * pc + 1][2], u[2 * pc + 1][3]};
                *(GAS bf16x8*)(dnu + (dt * 2 + pc) * 1024) = pack8(t8); }
        }
    }
    LDS_WAIT(); asm volatile("" ::: "memory");
}

template <int STOP>
__device__ __forceinline__ void dn_prep_phase(LAS unsigned char* lds, const bf16* PROJ, const nv::P& p, unsigned char* DNA, unsigned char* DNU, int G, int vcu, int wave_s) {
    LAS unsigned char* img = lds + wave_s * 16384; LAS float* tab = (LAS float*)(lds + XTAB_OFF + wave_s * XTAB_BYTES);
    for (int ci = vcu * 8 + wave_s; ci < 2048; ci += G * 8) dn_prep_chunk<STOP>(img, tab, PROJ, p, DNA, DNU, ci);
}

using namespace nv;


struct RouterArgs { const float* z; const bf16* mix; float* zout; bf16* H1BF; int* EID; float* WGT; int* LIST; int* CNT; const float *ln_g, *ln_b, *w_rg, *b_rg, *w_re, *b_re; };
__device__ __forceinline__ void router_fill(LAS float* dst, const float* W, int ldw, int col0, int tid) {
#pragma unroll
    for (int it = 0; it < 4; ++it) { const int qd = tid + it * NTHREADS, k = qd >> 1, half = qd & 1;
        const f32x4 v = *(const GAS f32x4*)(W + (size_t)k * ldw + col0 + half * 4);
        *(LAS f32x4*)(dst + ((((k >> 8) * 4 + (k & 3)) * 64 + ((k >> 2) & 63)) * 8 + half * 4)) = v; }
}
__device__ __forceinline__ void router_phase(LAS unsigned char* lds, const RouterArgs& A, int gw, int NGW, int wave_s) {
    const int lane = pg8::lane_id_fresh(), tid = wave_s * 64 + lane;
    LAS float* WG = (LAS float*)lds; LAS int* HIST = (LAS int*)(lds + 32768); LAS int* BASE = HIST + 64; LAS int* RR = HIST + 128;
    router_fill(WG, A.w_rg, 8, 0, tid);
    if (tid < 64) HIST[tid] = 0;
    __syncthreads();
    int it_ = 0;
    f32x4 vn[4]; unsigned long long mn_[4];
    { const GAS f32x4* zr = (const GAS f32x4*)(A.z + (size_t)gw * DM) + lane; const GAS unsigned long long* mr = (const GAS unsigned long long*)(A.mix + (size_t)gw * DM) + lane;
#pragma unroll
      for (int j = 0; j < 4; ++j) { vn[j] = zr[64 * j]; mn_[j] = mr[64 * j]; } }
    for (int m = gw; m < NTOK; m += NGW) {
        f32x4 v[4];
#pragma unroll
        for (int j = 0; j < 4; ++j) { const unsigned long long mm = mn_[j];
            v[j].x = ALPHA_F * vn[j].x + bf2f((unsigned short)mm); v[j].y = ALPHA_F * vn[j].y + bf2f((unsigned short)(mm >> 16));
            v[j].z = ALPHA_F * vn[j].z + bf2f((unsigned short)(mm >> 32)); v[j].w = ALPHA_F * vn[j].w + bf2f((unsigned short)(mm >> 48)); }
        { const int mn = (m + NGW < NTOK) ? m + NGW : m; const GAS f32x4* zn = (const GAS f32x4*)(A.z + (size_t)mn * DM) + lane; const GAS unsigned long long* mr = (const GAS unsigned long long*)(A.mix + (size_t)mn * DM) + lane;
#pragma unroll
          for (int j = 0; j < 4; ++j) { vn[j] = zn[64 * j]; mn_[j] = mr[64 * j]; } }
        float s = 0.f;
#pragma unroll
        for (int j = 0; j < 4; ++j) s += (v[j].x + v[j].y) + (v[j].z + v[j].w);
        const float mean = wave_sum_dpp(s) * (1.f / DM); float s2 = 0.f;
#pragma unroll
        for (int j = 0; j < 4; ++j) { v[j] = v[j] - mean; s2 += (v[j].x * v[j].x + v[j].y * v[j].y) + (v[j].z * v[j].z + v[j].w * v[j].w); }
        const float rstd = 1.f / sqrtf(wave_sum_dpp(s2) * (1.f / DM) + 1e-5f);
        GAS unsigned long long* hb = (GAS unsigned long long*)(A.H1BF + (size_t)m * DM) + lane;
#pragma unroll
        for (int j = 0; j < 4; ++j) { const f32x4 g = *((const GAS f32x4*)A.ln_g + lane + 64 * j), bb = *((const GAS f32x4*)A.ln_b + lane + 64 * j); v[j] = v[j] * rstd * g + bb;
            hb[64 * j] = (unsigned long long)pk2(v[j].x, v[j].y) | ((unsigned long long)pk2(v[j].z, v[j].w) << 32); }
        float gl[8];
#pragma unroll
        for (int c = 0; c < 8; ++c) gl[c] = 0.f;
#pragma unroll
        for (int j = 0; j < 4; ++j)
#pragma unroll
            for (int c4 = 0; c4 < 4; ++c4) { const float hv = v[j][c4]; const LAS float* wp = WG + ((j * 4 + c4) * 64 + lane) * 8;
                const f32x4 w0 = *(const LAS f32x4*)wp, w1 = *(const LAS f32x4*)(wp + 4);
                gl[0] += hv * w0.x; gl[1] += hv * w0.y; gl[2] += hv * w0.z; gl[3] += hv * w0.w; gl[4] += hv * w1.x; gl[5] += hv * w1.y; gl[6] += hv * w1.z; gl[7] += hv * w1.w; }
        int gi = 0; float gm = -INFINITY;
#pragma unroll
        for (int c = 0; c < 8; ++c) { gl[c] = wave_sum_dpp(gl[c]) + A.b_rg[c]; if (gl[c] > gm) { gm = gl[c]; gi = c; } }
        float den = 0.f;
#pragma unroll
        for (int c = 0; c < 8; ++c) den += expf(gl[c] - gm);
        const float pg = 1.f / den;
        float el[8];
#pragma unroll
        for (int c = 0; c < 8; ++c) el[c] = 0.f;
        const float* wre = A.w_re + gi * 8192 + lane * 8;
#pragma unroll
        for (int j = 0; j < 4; ++j)
#pragma unroll
            for (int c4 = 0; c4 < 4; ++c4) { const float hv = v[j][c4];
                const f32x4 w0 = *(const GAS f32x4*)(wre + (j * 4 + c4) * 512), w1 = *(const GAS f32x4*)(wre + (j * 4 + c4) * 512 + 4);
                el[0] += hv * w0.x; el[1] += hv * w0.y; el[2] += hv * w0.z; el[3] += hv * w0.w; el[4] += hv * w1.x; el[5] += hv * w1.y; el[6] += hv * w1.z; el[7] += hv * w1.w; }
        int i0 = 0, i1 = 0; float v0 = -INFINITY, v1 = -INFINITY;
#pragma unroll
        for (int c = 0; c < 8; ++c) { el[c] = wave_sum_dpp(el[c]) + A.b_re[gi * 8 + c]; if (el[c] > v0) { v0 = el[c]; i0 = c; } }
#pragma unroll
        for (int c = 0; c < 8; ++c) { if (c != i0 && el[c] > v1) { v1 = el[c]; i1 = c; } }
        const float e1 = expf(v1 - v0), sm = 1.f / (1.f + e1);
        if (lane == 0) {
            const int ea = gi * 8 + i0, eb = gi * 8 + i1;
            LAS int* rr = RR + (wave_s * 16 + it_) * 6;
            rr[4] = (int)(f2bf(pg * sm) << 16); rr[5] = (int)(f2bf(pg * e1 * sm) << 16);
            rr[0] = ea; rr[1] = __hip_atomic_fetch_add(&HIST[ea], 1, __ATOMIC_RELAXED, __HIP_MEMORY_SCOPE_WORKGROUP); rr[2] = eb; rr[3] = __hip_atomic_fetch_add(&HIST[eb], 1, __ATOMIC_RELAXED, __HIP_MEMORY_SCOPE_WORKGROUP);
        }
        ++it_;
    }
    __syncthreads();
    if (tid < 64) BASE[tid] = __hip_atomic_fetch_add(&A.CNT[tid], HIST[tid], __ATOMIC_RELAXED, __HIP_MEMORY_SCOPE_AGENT);
    __syncthreads();
    if (lane < it_) {
        const LAS int* rr = RR + (wave_s * 16 + lane) * 6; const int m = gw + lane * NGW;
        A.LIST[(size_t)rr[0] * NTOK + BASE[rr[0]] + rr[1]] = (2 * m) | rr[4];
        A.LIST[(size_t)rr[2] * NTOK + BASE[rr[2]] + rr[3]] = (2 * m + 1) | rr[5];
    }
}

__device__ __forceinline__ void final_phase(float* OUT, const bf16* H1B, const bf16* YEXP, const float* ln_g, const float* ln_b, int gw, int NGW, int lane) {
    for (int m = gw; m < NTOK; m += NGW) {
        GAS f32x4* orow = (GAS f32x4*)(OUT + (size_t)m * DM) + lane;
        const GAS unsigned long long* hq = (const GAS unsigned long long*)(H1B + (size_t)m * DM) + lane;
        const GAS unsigned long long* y0 = (const GAS unsigned long long*)(YEXP + (size_t)(2 * m) * DM) + lane; const GAS unsigned long long* y1 = y0 + DM / 4;
        f32x4 v[4]; float s = 0.f;
#pragma unroll
        for (int j = 0; j < 4; ++j) { const unsigned long long hh = hq[64 * j], a0 = y0[64 * j], a1 = y1[64 * j];
            v[j].x = ALPHA_F * bf2f((unsigned short)hh) + bf2f((unsigned short)a0) + bf2f((unsigned short)a1);
            v[j].y = ALPHA_F * bf2f((unsigned short)(hh >> 16)) + bf2f((unsigned short)(a0 >> 16)) + bf2f((unsigned short)(a1 >> 16));
            v[j].z = ALPHA_F * bf2f((unsigned short)(hh >> 32)) + bf2f((unsigned short)(a0 >> 32)) + bf2f((unsigned short)(a1 >> 32));
            v[j].w = ALPHA_F * bf2f((unsigned short)(hh >> 48)) + bf2f((unsigned short)(a0 >> 48)) + bf2f((unsigned short)(a1 >> 48));
            s += (v[j].x + v[j].y) + (v[j].z + v[j].w); }
        const float mean = wave_sum_dpp(s) * (1.f / DM); float s2 = 0.f;
#pragma unroll
        for (int j = 0; j < 4; ++j) { v[j] = v[j] - mean; s2 += (v[j].x * v[j].x + v[j].y * v[j].y) + (v[j].z * v[j].z + v[j].w * v[j].w); }
        const float rstd = 1.f / sqrtf(wave_sum_dpp(s2) * (1.f / DM) + 1e-5f);
#pragma unroll
        for (int j = 0; j < 4; ++j) { const f32x4 g = *((const GAS f32x4*)ln_g + lane + 64 * j), bb = *((const GAS f32x4*)ln_b + lane + 64 * j); orow[64 * j] = v[j] * rstd * g + bb; }
    }
}

#ifndef REPEAT_MASK
#define REPEAT_MASK 0
#endif
#define REPS(k) ((((REPEAT_MASK) >> (k)) & 1) + 1)
__global__ void __launch_bounds__(NTHREADS, 2) fwd_megakernel(MK a) {
    extern __shared__ __attribute__((aligned(16))) unsigned char lds_raw[];
    cg::grid_group grid = cg::this_grid();
    LAS unsigned char* lds = (LAS unsigned char*)lds_raw;
    volatile LAS unsigned* MISC = (volatile LAS unsigned*)(lds + MISC_OFF);
    LAS int* PREF = (LAS int*)(lds + PREF_OFF);
    const int tid = threadIdx.x; const int wave_s = __builtin_amdgcn_readfirstlane(tid >> 6);
    const int G = gridDim.x; const int bx = blockIdx.x; const int vcu = (G % 8 == 0) ? (bx % 8) * (G / 8) + bx / 8 : bx;
    unsigned char* ws = a.ws; const P& p = a.p;
    gu32* ctl = (gu32*)(ws + WS_CTL);
    bf16* WIN = (bf16*)(ws + WS_WIN); bf16* WOUT = (bf16*)(ws + WS_WOUT); bf16* XBF = (bf16*)(ws + WS_A); bf16* PROJ = (bf16*)(ws + WS_B);
    bf16* WGU = (bf16*)(ws + WS_WGU); bf16* WD = (bf16*)(ws + WS_WD); bf16* HID = (bf16*)(ws + WS_A); bf16* H1BF = (bf16*)(ws + WS_H1BF); bf16* YEXP = (bf16*)(ws + WS_YEXP);
    int* LIST = (int*)(ws + WS_LIST); int* EID = (int*)(ws + WS_ROUTE); float* WGT = (float*)(ws + WS_ROUTE + 512 * 1024);
    int* CNT = (int*)(ws + WS_CTL) + CW_CNT;
    for (int u = tid; u < (LDS_BYTES - LDSCTL_OFF) / 4; u += NTHREADS) ((LAS unsigned*)(lds + LDSCTL_OFF))[u] = 0u;
    __syncthreads();
    XcdBarrier bar = xcd_barrier_post((unsigned*)(ctl + CW_BAR), MISC + 8);
    grid.sync();
#define FRESH() const int lane = pg8::lane_id_fresh(), wave = wave_s; const int tid_ = wave_s * 64 + lane; const int gtid = (int)blockIdx.x * NTHREADS + tid_, gsize = G * NTHREADS, gw = vcu * NWAVES + wave, NGW = G * NWAVES; (void)lane; (void)gtid; (void)gsize; (void)gw; (void)NGW;

    _Pragma("unroll 1") for (int rep_ = 0; rep_ < REPS(0); ++rep_) {
    {
        FRESH();
        LAS float* scr = (LAS float*)(lds + wave * 16384);
        constexpr int NB = 96, KB = DM / 64;
        for (int it = gw; it < NB * KB; it += NGW) { const int nb = it % NB, kb = it / NB; const int nsrc = nb < 64 ? nb * 32 : 2056 + (nb - 64) * 32, ndst = nb * 32;
            p0_transpose_item(p.w_in, nv::INC, DM, kb * 64, nsrc, WIN, ndst, scr, lane); }
        for (int i = gtid; i < 8 * DM; i += gsize) { const int j = (int)(i / DM), k = (int)(i % DM); WIN[(size_t)(PC_B + j) * DM + k] = (bf16)f2bf(p.w_in[(size_t)k * nv::INC + 2048 + j]); }
        for (int i = gtid; i < (long)(NPROJ - 3080) * DM / 8; i += gsize) *(GAS v4u*)(WIN + (size_t)3080 * DM + i * 8) = (v4u){0u, 0u, 0u, 0u};
        for (int i = gtid; i < (long)NTOK * DM / 8; i += gsize) { const f32x4 v0 = *(const GAS f32x4*)(p.x + i * 8), v1 = *(const GAS f32x4*)(p.x + i * 8 + 4);
            v4u o; o.x = pk2(v0.x, v0.y); o.y = pk2(v0.z, v0.w); o.z = pk2(v1.x, v1.y); o.w = pk2(v1.z, v1.w); *(GAS v4u*)(XBF + i * 8) = o; }
        for (int it = gw; it < 16 * 32; it += NGW) { const int nb = it & 31, kb = it >> 5; p0_transpose_item(p.w_out, DM, DM, kb * 64, nb * 32, WOUT, nb * 32, scr, lane); }
        for (int d = gtid; d < 8 * 8192; d += gsize) { const int g = d >> 13, r = d & 8191, c = r & 7, ll = (r >> 3) & 63, jc = r >> 9, k = 4 * (ll + 64 * (jc >> 2)) + (jc & 3);
            ((float*)(ws + WS_WREP))[d] = p.w_re[(size_t)k * 64 + g * 8 + c]; }
        p0_experts(p.w_gate, p.w_up, p.w_down, WGU, WD, scr, gw, NGW, lane);
    }
    xcd_barrier(bar);
    }
    _Pragma("unroll 1") for (int rep_ = 0; rep_ < REPS(1); ++rep_) {
    {
        pg8::DenseOrder S; S.init(XBF, DM, WIN, NTOK, NPROJ, DM, G, bx);
        pg8::EpiBf16 E{PROJ, NPROJ};
        pg8::gemm_phase<pg8::EpiBf16, pg8::DenseOrder, true>(lds, S, E, nullptr, wave_s);
    }
    xcd_barrier(bar);
    }
    unsigned char* DNA = (unsigned char*)p.out; unsigned char* DNU = ws + WS_A + 32 * MiB; bf16* ODN = (bf16*)(ws + WS_A);
    _Pragma("unroll 1") for (int rep_ = 0; rep_ < REPS(2); ++rep_) {
    dn_prep_phase<0>(lds, PROJ, p, DNA, DNU, G, vcu, wave_s);
    xcd_barrier(bar);
    }
    _Pragma("unroll 1") for (int rep_ = 0; rep_ < REPS(3); ++rep_) {
    dn_scan_phase(lds, DNA, DNU, ODN, vcu, wave_s);
    xcd_barrier(bar);
    }
    _Pragma("unroll 1") for (int rep_ = 0; rep_ < REPS(5); ++rep_) {
    sgu_phase(lds, PROJ, p, G, vcu, wave_s);
    { FRESH(); dn_final_phase(ODN, PROJ, p.dn_norm_w, gw, NGW, lane); }
    xcd_barrier(bar);
    }
    _Pragma("unroll 1") for (int rep_ = 0; rep_ < REPS(6); ++rep_) {
    {
        pg8::DenseOrder S; S.init(PROJ, NPROJ, WOUT, NTOK, DM, DM, G, bx);
        pg8::EpiBf16 E{(bf16*)(ws + WS_A), DM};
        pg8::gemm_phase<pg8::EpiBf16, pg8::DenseOrder, true>(lds, S, E, nullptr, wave_s);
    }
    xcd_barrier(bar);
    }
    {
        RouterArgs RA{p.x, (const bf16*)(ws + WS_A), p.out, H1BF, EID, WGT, LIST, CNT, p.ln1_g, p.ln1_b, p.w_rg, p.b_rg, (const float*)(ws + WS_WREP), p.b_re};
        router_phase(lds, RA, vcu * NWAVES + wave_s, G * NWAVES, wave_s);
    }
    xcd_barrier(bar);
    if (threadIdx.x == 0) { int s = 0; for (int e = 0; e < NEXP; ++e) { PREF[e] = s; s += ((CNT[e] + 255) >> 8) * 4; } PREF[NEXP] = s; }
    __syncthreads();
    _Pragma("unroll 1") for (int rep_ = 0; rep_ < REPS(7); ++rep_) {
    {
        pg8::GroupedOrder S{H1BF, WGU, LIST, PREF, DM, DM, 1024, NTOK, 1, 4, G, bx, NEXP};
        pg8::EpiHid E{HID, LIST, CNT, NTOK};
        pg8::gemm_phase<pg8::EpiHid, pg8::GroupedOrder, true>(lds, S, E, CNT, wave_s);
    }
    xcd_barrier(bar);
    }
    _Pragma("unroll 1") for (int rep_ = 0; rep_ < REPS(8); ++rep_) {
    {
        pg8::GroupedOrder S{HID, WD, LIST, PREF, DEXP, DEXP, 1024, NTOK, 0, 4, G, bx, NEXP};
        pg8::EpiYexp E{YEXP, LIST, WGT, NTOK};
        pg8::gemm_phase<pg8::EpiYexp, pg8::GroupedOrder, true>(lds, S, E, CNT, wave_s);
    }
    xcd_barrier(bar);
    }
    { FRESH(); final_phase(p.out, H1BF, YEXP, p.ln2_g, p.ln2_b, gw, NGW, lane); }
#if defined(GHOSTPREP)
    xcd_barrier(bar);
    dn_prep_phase<GHOSTPREP>(lds, (const bf16*)(ws + WS_B), p, ws + WS_C, ws + WS_C + 120 * MiB, G, vcu, wave_s);
#endif
#if defined(GHOST6)
    xcd_barrier(bar);
    { RouterArgs RA{p.out, (const bf16*)(ws + WS_A), (float*)(ws + WS_B), (bf16*)(ws + WS_C), (int*)(ws + WS_A), (float*)(ws + WS_A + 1 * MiB), (int*)(ws + WS_A + 2 * MiB), (int*)(ws + WS_CTL) + CW_CNT + 1024, p.ln1_g, p.ln1_b, p.w_rg, p.b_rg, (const float*)(ws + WS_WREP), p.b_re};
      router_phase(lds, RA, vcu * NWAVES + wave_s, G * NWAVES, wave_s); }
#endif
#if defined(GHOST9)
    xcd_barrier(bar);
    { FRESH(); final_phase((float*)(ws + WS_A), H1BF, (const bf16*)(ws + WS_C), p.ln2_g, p.ln2_b, gw, NGW, lane); }
#endif
}

extern "C" void kernel_launch(void* const* d_in, const int* in_sizes, int n_in, void* d_out, int out_size, void* d_ws, size_t ws_size, hipStream_t stream) {
    if (ws_size < WS_END || n_in != 22) { fprintf(stderr, "kernel_launch: bad ws/n_in\n"); return; }
    static int grid_blocks = 0;
    if (!grid_blocks) {
        int dev = 0, cus = 0, per_cu = 0;
        (void)hipGetDevice(&dev);
        (void)hipDeviceGetAttribute(&cus, hipDeviceAttributeMultiprocessorCount, dev);
        (void)hipFuncSetAttribute((const void*)fwd_megakernel, hipFuncAttributeMaxDynamicSharedMemorySize, (int)LDS_BYTES);
        (void)hipOccupancyMaxActiveBlocksPerMultiprocessor(&per_cu, (const void*)fwd_megakernel, NTHREADS, LDS_BYTES);
        if (per_cu < 1) { fprintf(stderr, "kernel_launch: occupancy query says %d\n", per_cu); per_cu = 1; }
        grid_blocks = cus;
    }
    (void)hipMemsetAsync((char*)d_ws + WS_CTL, 0, CTL_ZERO_BYTES, stream);
    MK a{}; bind(a.p, d_in, (float*)d_out, (unsigned char*)d_ws + WS_A); a.ws = (unsigned char*)d_ws;
    { unsigned char* s = (unsigned char*)d_ws + WS_A; a.p.qkv = (float*)s; s += (size_t)T_ * 3 * DNW * 4; a.p.odn = (float*)s; s += (size_t)T_ * DNW * 4; a.p.vn = (float*)s; s += (size_t)T_ * SGW * 4; a.p.y = (float*)s; s += (size_t)T_ * D_ * 4;
      a.p.proj = nullptr; a.p.z1 = nullptr; a.p.h1 = nullptr; a.p.hid = nullptr; a.p.yexp = nullptr; a.p.wgt = nullptr; a.p.eid = nullptr; a.p.cnt = nullptr; a.p.sorted = nullptr; a.p.eos = nullptr; }
    void* args[] = {&a};
    hipError_t e = hipLaunchCooperativeKernel((const void*)fwd_megakernel, dim3(grid_blocks), dim3(NTHREADS), args, LDS_BYTES, stream);
    if (e != hipSuccess) fprintf(stderr, "cooperative launch failed: %s (grid %d)\n", hipGetErrorString(e), grid_blocks);
}
```

```cpp
#include <hip/hip_runtime.h>
#include <hip/hip_cooperative_groups.h>
#include <cstdio>
#include <cstdint>
namespace cg = cooperative_groups;

namespace nv {
constexpr int INC = 3080;
struct P {
    const float *x, *w_in, *conv_w, *a_log, *dt_bias, *dn_norm_w, *sgu_ln_g, *sgu_ln_b, *w_spatial, *b_spatial, *w_out, *ln1_g, *ln1_b,
        *w_rg, *b_rg, *w_re, *b_re, *w_gate, *w_up, *w_down, *ln2_g, *ln2_b;
    float* out;
};
static inline void bind(P& p, void* const* in, float* out) {
    const float** f = (const float**)&p.x; for (int i = 0; i < 22; ++i) f[i] = (const float*)in[i];
    p.out = out;
}
}
namespace pg8 {
#define PG8_LAS __attribute__((address_space(3)))
typedef unsigned short bf16_t;
typedef short bf16x8 __attribute__((ext_vector_type(8)));
typedef float f32x4 __attribute__((ext_vector_type(4)));
typedef unsigned u32x4 __attribute__((ext_vector_type(4)));
typedef unsigned u32x2 __attribute__((ext_vector_type(2)));
constexpr int BM = 256, BK = 64, HALF = 128, HTB = HALF * BK * 2  , STAGE_BYTES = 8 * HTB, NXCD = 8, WGM = 8;

__host__ __device__ __forceinline__ int lds_byte(int r, int c) { const int st = (r >> 4) * 2 + (c >> 5), rr = r & 15, cc = c & 31, ob = rr * 64 + cc * 2; return st * 1024 + (ob ^ (((ob >> 9) & 1) << 5)); }
__host__ __device__ __forceinline__ void stage_rc(int b, int& R, int& C) { const int st = b / 1024, sb = b % 1024, swz = sb ^ (((sb >> 9) & 1) << 5); R = (st >> 1) * 16 + swz / 64; C = (st & 1) * 32 + (swz % 64) / 2; }
__host__ __device__ __forceinline__ int perm32(int rho) { const int n = rho >> 4, i = rho & 15; return 8 * (i >> 2) + 4 * n + (i & 3); }

struct Unit { int pm, pn, e, rows; };

typedef float f32x2_t __attribute__((ext_vector_type(2))); typedef __bf16 bf16x2_t __attribute__((ext_vector_type(2)));
__device__ __forceinline__ unsigned cvt_pk_bf16(float lo, float hi) { const f32x2_t v = {lo, hi}; const bf16x2_t b = __builtin_convertvector(v, bf16x2_t); return __builtin_bit_cast(unsigned, b); }

__device__ __forceinline__ int lane_id_fresh() { int l; asm volatile("v_mbcnt_lo_u32_b32 %0, -1, 0\n\tv_mbcnt_hi_u32_b32 %0, -1, %0" : "=v"(l)); return l; }
__device__ __forceinline__ int xcd_remap(int L, int nwg) { const int q = nwg / NXCD, r = nwg % NXCD, xcd = L % NXCD, off = L / NXCD; return (xcd < r ? xcd * (q + 1) : r * (q + 1) + (xcd - r) * q) + off; }

struct DenseOrder {
    const bf16_t* A; const bf16_t* Bt; int lda, K; int nM, nN, nwg, G, c;
    static constexpr bool GATHER = false;
    __device__ void init(const bf16_t* A_, int lda_, const bf16_t* Bt_, int M, int N, int K_, int G_, int c_) { A = A_; Bt = Bt_; lda = lda_; K = K_; nM = M / BM; nN = N / BM; nwg = nM * nN; G = G_; c = c_; }
    __device__ bool next(int i, Unit& u) const {
        const long L = (long)i * G + c; if (L >= nwg) return false;
        const int wgid = xcd_remap((int)L, nwg);
        const int nig = WGM * nN, gid = wgid / nig, fm = gid * WGM, gsz = (nM - fm) < WGM ? (nM - fm) : WGM;
        u.pm = fm + ((wgid % nig) % gsz); u.pn = (wgid % nig) / gsz; u.e = 0; u.rows = BM; return true;
    }
    __device__ __forceinline__ const char* a_base(const Unit& u) const { return (const char*)A + (size_t)u.pm * BM * lda * 2; }
    __device__ __forceinline__ const char* b_base(const Unit& u) const { return (const char*)Bt + (size_t)u.pn * BM * K * 2; }
    __device__ __forceinline__ void a_off(const Unit&, const int (&R)[2], const int (&C)[2], unsigned (&v)[4]) const {
#pragma unroll
        for (int h = 0; h < 2; ++h)
#pragma unroll
            for (int i = 0; i < 2; ++i) v[h * 2 + i] = (unsigned)((h * HALF + R[i]) * lda + C[i]) * 2u;
    }
};

struct GroupedOrder {
    const bf16_t* A; const bf16_t* Bt; const int* list; const PG8_LAS int* pref;
    int lda, K, N, cap, ashift, nN, G, c, ne;
    static constexpr bool GATHER = true;
    __device__ bool next(int i, Unit& u) const {
        const int nwg = pref[ne]; const long L = (long)i * G + c; if (L >= nwg) return false;
        const int w = xcd_remap((int)L, nwg);
        int e = 0; while (pref[e + 1] <= w) ++e;
        const int j = w - pref[e], ntm = (pref[e + 1] - pref[e]) / nN;
        u.e = e; u.pm = j % ntm; u.pn = j / ntm; u.rows = 0; return true;
    }
    __device__ __forceinline__ const char* a_base(const Unit&) const { return (const char*)A; }
    __device__ __forceinline__ const char* b_base(const Unit& u) const { return (const char*)Bt + ((size_t)u.e * N + (size_t)u.pn * BM) * K * 2; }
    __device__ __forceinline__ void a_off(const Unit& u, const int (&R)[2], const int (&C)[2], unsigned (&v)[4], int cnt) const {
        const int* lp = list + (size_t)u.e * cap;
#pragma unroll
        for (int h = 0; h < 2; ++h)
#pragma unroll
            for (int i = 0; i < 2; ++i) { int r = u.pm * BM + h * HALF + R[i]; if (r >= cnt) r = 0; const int a = (lp[r] & 0xffff) >> ashift; v[h * 2 + i] = (unsigned)(a * lda + C[i]) * 2u; }
    }
};

template <class Epi, class Sched, bool ALIGN_EPI>
__device__ __forceinline__ void gemm_phase(PG8_LAS unsigned char* lds, const Sched& S, const Epi& E, const int* gcnt, const int wave_s) {
    const int tid_ = wave_s * 64 + lane_id_fresh();
    const int tid = tid_, wid = wave_s, lane = tid & 63, wr = wid >> 2, wc = wid & 3, fr = lane & 15, fq = lane >> 4;
    const int K = S.K, nt = K / BK;
    int Rr[2], Cc[2]; unsigned voffB[2];
#pragma unroll
    for (int i = 0; i < 2; ++i) { int R, C; stage_rc(tid * 16 + i * 8192, R, C); const int Rb = Epi::PERM ? ((R & ~31) + perm32(R & 31)) : R; Rr[i] = R; Cc[i] = C; voffB[i] = (unsigned)(Rb * K + C) * 2u; }
    const size_t kstep = (size_t)(BK * 2);
    const size_t hstep = (size_t)HALF * K * 2;
    const unsigned ldsw = (unsigned)wid * 1024u;
    const int aoff = lds_byte(wr * 64 + fr, fq * 8), boff = lds_byte(wc * 32 + fr, fq * 8);
#define PG8_SA(b, h) (((b) * 2 + (h)) * HTB)
#define PG8_SB(b, h) ((4 + (b) * 2 + (h)) * HTB)
#define PG8_STAGE(bufoff, gbase, v0, v1) do { \
        __builtin_amdgcn_global_load_lds((const unsigned*)((const char*)(gbase) + (v0)), (PG8_LAS unsigned*)(lds + (bufoff) + ldsw), 16, 0, 0); \
        __builtin_amdgcn_global_load_lds((const unsigned*)((const char*)(gbase) + (v1)), (PG8_LAS unsigned*)(lds + (bufoff) + ldsw + 8192), 16, 0, 0); } while (0)
#define PG8_STAGEB(bufoff, gbase) PG8_STAGE(bufoff, gbase, voffB[0], voffB[1])
#define PG8_LDA(dst, b, h) do { _Pragma("unroll") for (int m = 0; m < 4; ++m) _Pragma("unroll") for (int k = 0; k < 2; ++k) dst[m][k] = *(const PG8_LAS bf16x8*)(lds + PG8_SA(b, h) + aoff + m * 2048 + k * 1024); } while (0)
#define PG8_LDB(dst, b, h) do { _Pragma("unroll") for (int n = 0; n < 2; ++n) _Pragma("unroll") for (int k = 0; k < 2; ++k) dst[n][k] = *(const PG8_LAS bf16x8*)(lds + PG8_SB(b, h) + boff + n * 2048 + k * 1024); } while (0)
#define PG8_MMA(ai, bj, At, Bt) do { __builtin_amdgcn_s_setprio(1); _Pragma("unroll") for (int m = 0; m < 4; ++m) _Pragma("unroll") for (int n = 0; n < 2; ++n) _Pragma("unroll") for (int k = 0; k < 2; ++k) \
        acc[ai][bj][m][n] = __builtin_amdgcn_mfma_f32_16x16x32_bf16(Bt[n][k], At[m][k], acc[ai][bj][m][n], 0, 0, 0); __builtin_amdgcn_s_setprio(0); } while (0)
#define PG8_WAIT_V(n) asm volatile("s_waitcnt vmcnt(" #n ")" ::: "memory")
#define PG8_WAIT_L(n) asm volatile("s_waitcnt lgkmcnt(" #n ")" ::: "memory")
#define PG8_BAR __builtin_amdgcn_s_barrier()
#define PG8_SCHED __builtin_amdgcn_sched_barrier(0)
    Unit cur, nxt; int ui = 0;
    if (!S.next(0, cur)) return;
    int ccnt = BM * 1024, ncnt = BM * 1024;
    if constexpr (Sched::GATHER) { ccnt = gcnt[cur.e]; }
    cur.rows = ccnt - cur.pm * BM;
    f32x4 acc[2][2][4][2];
#pragma unroll
    for (int a = 0; a < 2; ++a)
#pragma unroll
        for (int b = 0; b < 2; ++b)
#pragma unroll
            for (int m = 0; m < 4; ++m)
#pragma unroll
                for (int n = 0; n < 2; ++n) acc[a][b][m][n] = (f32x4){0.f, 0.f, 0.f, 0.f};
    bf16x8 At[4][2], B0[2][2], B1[2][2];
    unsigned va[4], vn[4];
    if constexpr (Sched::GATHER) S.a_off(cur, Rr, Cc, va, ccnt); else S.a_off(cur, Rr, Cc, va);
    const char* cA = S.a_base(cur); const char* cB = S.b_base(cur);
    PG8_STAGEB(PG8_SB(0, 0), cB); PG8_STAGEB(PG8_SB(0, 1), cB + hstep); PG8_STAGE(PG8_SA(0, 0), cA, va[0], va[1]); PG8_STAGE(PG8_SA(0, 1), cA, va[2], va[3]);
    if (wr == 1) PG8_BAR;
    PG8_WAIT_V(2); PG8_BAR;
    PG8_STAGEB(PG8_SB(1, 0), cB + kstep); PG8_STAGE(PG8_SA(1, 0), cA + kstep, va[0], va[1]); PG8_STAGEB(PG8_SB(1, 1), cB + hstep + kstep);
    PG8_WAIT_V(6); PG8_BAR;
    for (;;) {
        const bool has_next = S.next(ui + 1, nxt);
        const char* nA = cA; const char* nB = cB;
#pragma unroll
        for (int j = 0; j < 4; ++j) vn[j] = va[j];
        if (has_next) {
            nA = S.a_base(nxt); nB = S.b_base(nxt);
            if constexpr (Sched::GATHER) { ncnt = gcnt[nxt.e]; S.a_off(nxt, Rr, Cc, vn, ncnt); } else S.a_off(nxt, Rr, Cc, vn);
            nxt.rows = ncnt - nxt.pm * BM;
        }
        for (int t = 0; t < nt; t += 2) {
            const bool last = (t == nt - 2);
            const char* a1 = cA + (size_t)(t + 1) * kstep;
            const char* a2 = last ? nA : cA + (size_t)(t + 2) * kstep; const char* b2 = last ? nB : cB + (size_t)(t + 2) * kstep;
            const char* a3 = a2 + kstep; const char* b3 = b2 + kstep;
            unsigned w0 = va[0], w1 = va[1], w2 = va[2], w3 = va[3];
            if (last) { w0 = vn[0]; w1 = vn[1]; w2 = vn[2]; w3 = vn[3]; }
            PG8_LDB(B0, 0, 0); PG8_LDB(B1, 0, 1); PG8_SCHED; PG8_LDA(At, 0, 0); PG8_STAGE(PG8_SA(1, 1), a1, va[2], va[3]);
            PG8_WAIT_V(8); PG8_WAIT_L(0); PG8_BAR; PG8_MMA(0, 0, At, B0); PG8_MMA(0, 1, At, B1); PG8_BAR; PG8_SCHED;
            PG8_LDA(At, 0, 1); PG8_STAGEB(PG8_SB(0, 0), b2); PG8_STAGEB(PG8_SB(0, 1), b2 + hstep); PG8_STAGE(PG8_SA(0, 0), a2, w0, w1);
            PG8_WAIT_V(8); PG8_WAIT_L(0); PG8_BAR; PG8_MMA(1, 0, At, B0); PG8_MMA(1, 1, At, B1); PG8_BAR; PG8_SCHED;
            PG8_LDB(B0, 1, 0); PG8_LDB(B1, 1, 1); PG8_SCHED; PG8_LDA(At, 1, 0); PG8_STAGE(PG8_SA(0, 1), a2, w2, w3);
            PG8_WAIT_V(8); PG8_WAIT_L(0); PG8_BAR; PG8_MMA(0, 0, At, B0); PG8_MMA(0, 1, At, B1); PG8_BAR; PG8_SCHED;
            PG8_LDA(At, 1, 1); PG8_STAGEB(PG8_SB(1, 0), b3); PG8_STAGEB(PG8_SB(1, 1), b3 + hstep); PG8_STAGE(PG8_SA(1, 0), a3, w0, w1);
            PG8_WAIT_V(8); PG8_WAIT_L(0); PG8_BAR; PG8_MMA(1, 0, At, B0); PG8_MMA(1, 1, At, B1); PG8_BAR; PG8_SCHED;
        }
        if constexpr (ALIGN_EPI) { if (wr == 0) PG8_BAR; }
        E(acc, cur, wr, wc, fr, fq);
        if (!has_next) break;
#pragma unroll
        for (int a = 0; a < 2; ++a)
#pragma unroll
            for (int b = 0; b < 2; ++b)
#pragma unroll
                for (int m = 0; m < 4; ++m)
#pragma unroll
                    for (int n = 0; n < 2; ++n) acc[a][b][m][n] = (f32x4){0.f, 0.f, 0.f, 0.f};
        cur = nxt; cA = nA; cB = nB; ++ui;
#pragma unroll
        for (int j = 0; j < 4; ++j) va[j] = vn[j];
        if constexpr (ALIGN_EPI) { if (wr == 1) PG8_BAR; }
    }
    PG8_WAIT_V(0);
    if constexpr (!ALIGN_EPI) { if (wr == 0) PG8_BAR; }
    PG8_BAR;
#undef PG8_SA
#undef PG8_SB
#undef PG8_STAGE
#undef PG8_STAGEB
#undef PG8_LDA
#undef PG8_LDB
#undef PG8_MMA
#undef PG8_WAIT_V
#undef PG8_WAIT_L
#undef PG8_BAR
#undef PG8_SCHED
}

struct EpiBf16 {
    static constexpr bool PERM = true;
    bf16_t* O; int ldc;
    __device__ __forceinline__ void operator()(const f32x4 (&acc)[2][2][4][2], const Unit& u, int wr, int wc, int fr, int fq) const {
        const int row0 = u.pm * BM + wr * 64 + fr, col0 = u.pn * BM + wc * 32 + 8 * fq;
#pragma unroll
        for (int ai = 0; ai < 2; ++ai)
#pragma unroll
            for (int m = 0; m < 4; ++m) { bf16_t* rowp = O + (size_t)(row0 + ai * HALF + m * 16) * ldc + col0;
#pragma unroll
                for (int bj = 0; bj < 2; ++bj) { const f32x4 v0 = acc[ai][bj][m][0], v1 = acc[ai][bj][m][1];
                    u32x4 w; w.x = cvt_pk_bf16(v0[0], v0[1]); w.y = cvt_pk_bf16(v0[2], v0[3]); w.z = cvt_pk_bf16(v1[0], v1[1]); w.w = cvt_pk_bf16(v1[2], v1[3]);
                    *(u32x4*)(rowp + bj * HALF) = w; } }
    }
};
}
#define GAS __attribute__((address_space(1)))
#define LAS __attribute__((address_space(3)))
typedef unsigned short bf16;
typedef unsigned v4u __attribute__((ext_vector_type(4)));
typedef float f32x4 __attribute__((ext_vector_type(4)));
typedef short bf16x8 __attribute__((ext_vector_type(8)));
typedef GAS unsigned gu32;
typedef GAS unsigned long long gu64;
#define RLX_AGENT __ATOMIC_RELAXED, __HIP_MEMORY_SCOPE_AGENT
#define LDS_WAIT() asm volatile("s_waitcnt lgkmcnt(0)" ::: "memory")
#define VM_WAIT() asm volatile("s_waitcnt vmcnt(0)" ::: "memory")
__device__ __forceinline__ unsigned long long rt() { return __builtin_amdgcn_s_memrealtime(); }
__device__ __forceinline__ unsigned f2bf(float f) { unsigned u = __builtin_bit_cast(unsigned, f); return (u + 0x7fffu + ((u >> 16) & 1u)) >> 16; }
__device__ __forceinline__ unsigned pk2(float lo, float hi) { return f2bf(lo) | (f2bf(hi) << 16); }

#define XB_TMO      128
#define XB_XCNT(j)  (256  + 64 * (j))
#define XB_XSUB(j)  (1280 + 64 * (j))
#define XB_XGEN(j)  (2304 + 64 * (j))
#define XB_TOP      3328
#define XB_TOPGEN   3392
#define XCD_BAR_WORDS 3456
#define XB_SPIN_CAP (1u << 18)

__device__ __forceinline__ unsigned xb_ld(unsigned* p)              { return __hip_atomic_load(p, __ATOMIC_RELAXED, __HIP_MEMORY_SCOPE_AGENT); }
__device__ __forceinline__ unsigned xb_add(unsigned* p, unsigned v) { return __hip_atomic_fetch_add(p, v, __ATOMIC_RELAXED, __HIP_MEMORY_SCOPE_AGENT); }
__device__ __forceinline__ unsigned xb_xcc_id() { return (unsigned)__builtin_amdgcn_s_getreg((3 << 11) | 20) & 0xFu; }
#define XB_SPIN(cond, bar) do { unsigned _sp = 0; while (cond) { __builtin_amdgcn_s_sleep(1); \
    if ((++_sp & 255u) == 0u) { if (xb_ld(&(bar)[XB_TMO])) break; if (_sp > XB_SPIN_CAP) { atomicAdd(&(bar)[XB_TMO], 1u); break; } } } } while (0)

struct XcdBarrier {
    unsigned* bar; unsigned x;
    volatile LAS unsigned* st;
};

__device__ __forceinline__ XcdBarrier xcd_barrier_post(unsigned* bar, volatile LAS unsigned* st) {
    XcdBarrier b; b.bar = bar; b.x = xb_xcc_id(); b.st = st;
    if (threadIdx.x == 0) (void)xb_add(&bar[XB_XCNT(b.x)], 1u);
    return b;
}
__device__ __forceinline__ void xcd_barrier_complete(unsigned* bar, unsigned x, unsigned& nloc, unsigned& nx) {
    const unsigned G = gridDim.x * gridDim.y * gridDim.z;
    unsigned sum, cnt, mine, sp = 0u;
    for (;;) {
        sum = 0u; cnt = 0u; mine = 0u;
#pragma unroll
        for (unsigned j = 0; j < 16; ++j) { const unsigned c = xb_ld(&bar[XB_XCNT(j)]); sum += c; cnt += (c > 0u) ? 1u : 0u; mine = (j == x) ? c : mine; }
        if (sum == G) break;
        __builtin_amdgcn_s_sleep(1);
        if ((++sp & 255u) == 0u) { if (xb_ld(&bar[XB_TMO])) break; if (sp > XB_SPIN_CAP) { atomicAdd(&bar[XB_TMO], 1u); break; } }
    }
    nloc = mine > 0u ? mine : 1u; nx = cnt > 0u ? cnt : 1u;
}

__device__ __forceinline__ void xcd_barrier(const XcdBarrier& b) {
    asm volatile("s_waitcnt vmcnt(0)" ::: "memory");
    __syncthreads();
    if (threadIdx.x == 0) {
        unsigned* bar = b.bar;
        __builtin_amdgcn_s_waitcnt(0);
        unsigned nloc = b.st[0], nx = b.st[1];
        if (nloc == 0u) { xcd_barrier_complete(bar, b.x, nloc, nx); b.st[0] = nloc; b.st[1] = nx; }
        const unsigned old = xb_add(&bar[XB_XSUB(b.x)], 1u);
        const unsigned gen = old / nloc;
        if (old + 1u == (gen + 1u) * nloc) {
            __builtin_amdgcn_fence(__ATOMIC_RELEASE, "agent");
            asm volatile("s_waitcnt vmcnt(0)" ::: "memory");
            const unsigned og = xb_add(&bar[XB_TOP], 1u);
            const unsigned tg = og / nx;
            if (og + 1u == (tg + 1u) * nx) xb_add(&bar[XB_TOPGEN], 1u);
            else XB_SPIN(xb_ld(&bar[XB_TOPGEN]) == tg, bar);
            __builtin_amdgcn_fence(__ATOMIC_ACQUIRE, "agent");
            xb_add(&bar[XB_XGEN(b.x)], 1u);
            asm volatile("s_waitcnt vmcnt(0)" ::: "memory");
        } else {
            XB_SPIN(xb_ld(&bar[XB_XGEN(b.x)]) == gen, bar);
            __builtin_amdgcn_fence(__ATOMIC_ACQUIRE, "agent");
            asm volatile("s_waitcnt vmcnt(0)" ::: "memory");
        }
    }
    __syncthreads();
}

constexpr int NTOK = 32768, DM = 1024, NPROJ = 3328;
constexpr int PC_Q = 0, PC_K = 512, PC_V = 1024, PC_Z = 1536, PC_U = 2048, PC_VS = 2560, PC_B = 3072, PC_A = 3076;
constexpr int NEXP = 64, DEXP = 512;
constexpr size_t MiB = 1u << 20;
constexpr size_t WS_CTL = 0, CTL_ZERO_BYTES = 1 * MiB;
constexpr size_t WS_WIN = 1 * MiB, WS_WOUT = 8 * MiB, WS_LIST = 10 * MiB, WS_ROUTE = 18 * MiB;
constexpr size_t WS_WREP = 19 * MiB;
constexpr size_t WS_C = 20 * MiB;
constexpr size_t WS_WGU = WS_C, WS_WD = WS_C + 128 * MiB;
constexpr size_t WS_A = 212 * MiB;
constexpr size_t WS_B = 276 * MiB;
constexpr size_t WS_H1BF = WS_B, WS_YEXP = WS_B + 64 * MiB;
constexpr size_t WS_END = 484 * MiB;
constexpr int CW_BAR = 4096;
constexpr int CW_CNT = 16384;
constexpr int RING_BYTES = 131072, LDSCTL_OFF = RING_BYTES, MISC_OFF = LDSCTL_OFF + 320, PREF_OFF = MISC_OFF + 128, LDS_BYTES = 147456;
constexpr int NTHREADS = 512, NWAVES = 8;
constexpr float ALPHA_F = 1.189207115002721f;

__device__ __forceinline__ float bf2f(unsigned short v) { return __builtin_bit_cast(float, (unsigned)v << 16); }
__device__ __forceinline__ float wave_sum(float v) {
#pragma unroll
    for (int o = 1; o < 64; o <<= 1) v += __shfl_xor(v, o);
    return v;
}

__device__ __forceinline__ void p0_item_load(const float* W, int ldw, int k0, int n0src, int lane, float (&r)[32]) {
#pragma unroll
    for (int i = 0; i < 32; ++i) r[i] = W[(size_t)(k0 + 2 * i + (lane >> 5)) * ldw + n0src + (lane & 31)];
}
__device__ __forceinline__ void p0_item_store(const float (&r)[32], int K, int k0, bf16* WT, int dst_row0, LAS float* scr, int lane) {
#pragma unroll
    for (int i = 0; i < 32; ++i) scr[(2 * i + (lane >> 5)) * 33 + (lane & 31)] = r[i];
    LDS_WAIT(); asm volatile("" ::: "memory");
    const int c = lane & 7;
#pragma unroll
    for (int j = 0; j < 4; ++j) { const int n = (lane >> 3) + 8 * j; const LAS float* s = scr + (8 * c) * 33 + n;
        v4u o; o.x = pk2(s[0 * 33], s[1 * 33]); o.y = pk2(s[2 * 33], s[3 * 33]); o.z = pk2(s[4 * 33], s[5 * 33]); o.w = pk2(s[6 * 33], s[7 * 33]);
        *(GAS v4u*)(WT + (size_t)(dst_row0 + n) * K + k0 + 8 * c) = o; }
    LDS_WAIT(); asm volatile("" ::: "memory");
}
__device__ __forceinline__ void p0_transpose_item(const float* W, int ldw, int K, int k0, int n0src, bf16* WT, int dst_row0, LAS float* scr, int lane) {
    float r[32]; p0_item_load(W, ldw, k0, n0src, lane, r); p0_item_store(r, K, k0, WT, dst_row0, scr, lane);
}
struct P0Exp { const float* W; bf16* WT; int ldw, K, k0, n0, drow; };
__device__ __forceinline__ P0Exp p0_exp_item(int it, const float* wg, const float* wu, const float* wd, bf16* WGU, bf16* WD) {
    P0Exp x;
    if (it < 32768) { const int nb = it & 15, kb = (it >> 4) & 15, half = (it >> 8) & 1, e = it >> 9, n0 = nb * 32;
        x.W = (half ? wu : wg) + (size_t)e * DM * DEXP; x.WT = WGU + (size_t)e * 1024 * DM; x.ldw = DEXP; x.K = DM; x.k0 = kb * 64; x.n0 = n0; x.drow = (n0 >> 7) * 256 + half * 128 + (n0 & 127); }
    else { const int i2 = it - 32768, nb = i2 & 31, kb = (i2 >> 5) & 7, e = i2 >> 8;
        x.W = wd + (size_t)e * DEXP * DM; x.WT = WD + (size_t)e * DM * DEXP; x.ldw = DM; x.K = DEXP; x.k0 = kb * 64; x.n0 = nb * 32; x.drow = nb * 32; }
    return x;
}
__device__ __forceinline__ void p0_experts(const float* wg, const float* wu, const float* wd, bf16* WGU, bf16* WD, LAS float* scr, int gw, int NGW, int lane) {
    constexpr int NIT = 32768 + 16384;
    int it = gw; if (it >= NIT) return;
    float cur[32], nxt[32];
    P0Exp xc = p0_exp_item(it, wg, wu, wd, WGU, WD); p0_item_load(xc.W, xc.ldw, xc.k0, xc.n0, lane, cur);
    for (;;) {
        const int itn = it + NGW; const bool more = itn < NIT; P0Exp xn = xc;
        if (more) { xn = p0_exp_item(itn, wg, wu, wd, WGU, WD); p0_item_load(xn.W, xn.ldw, xn.k0, xn.n0, lane, nxt); }
        p0_item_store(cur, xc.K, xc.k0, xc.WT, xc.drow, scr, lane);
        if (!more) break;
#pragma unroll
        for (int i = 0; i < 32; ++i) cur[i] = nxt[i];
        xc = xn; it = itn;
    }
}

struct MK {
    nv::P p;
    unsigned char* ws;
};

namespace pg8 {
__device__ __forceinline__ float silu_f(float x) { return x * __builtin_amdgcn_rcpf(1.f + __builtin_amdgcn_exp2f(-1.4426950408889634f * x)); }
struct EpiHid {
    static constexpr bool PERM = true;
    bf16_t* HID; const int* list; const int* cnt; int cap;
    __device__ __forceinline__ void operator()(const f32x4 (&acc)[2][2][4][2], const Unit& u, int wr, int wc, int fr, int fq) const {
        const int* lp = list + (size_t)u.e * cap; const int col0 = u.pn * 128 + wc * 32 + 8 * fq;
#pragma unroll
        for (int ai = 0; ai < 2; ++ai)
#pragma unroll
            for (int m = 0; m < 4; ++m) { const int r = ai * HALF + wr * 64 + m * 16 + fr;
                if (r < u.rows) { const int a = lp[u.pm * BM + r] & 0xffff;
                    const f32x4 g0 = acc[ai][0][m][0], g1 = acc[ai][0][m][1], u0 = acc[ai][1][m][0], u1 = acc[ai][1][m][1];
                    u32x4 w; w.x = cvt_pk_bf16(silu_f(g0[0]) * u0[0], silu_f(g0[1]) * u0[1]); w.y = cvt_pk_bf16(silu_f(g0[2]) * u0[2], silu_f(g0[3]) * u0[3]);
                    w.z = cvt_pk_bf16(silu_f(g1[0]) * u1[0], silu_f(g1[1]) * u1[1]); w.w = cvt_pk_bf16(silu_f(g1[2]) * u1[2], silu_f(g1[3]) * u1[3]);
                    *(u32x4*)(HID + (size_t)a * 512 + col0) = w; } }
    }
};
struct EpiYexp {
    static constexpr bool PERM = true;
    bf16_t* Y; const int* list; const float* wgt; int cap;
    __device__ __forceinline__ void operator()(const f32x4 (&acc)[2][2][4][2], const Unit& u, int wr, int wc, int fr, int fq) const {
        const int* lp = list + (size_t)u.e * cap; const int col0 = u.pn * BM + wc * 32 + 8 * fq;
#pragma unroll
        for (int ai = 0; ai < 2; ++ai)
#pragma unroll
            for (int m = 0; m < 4; ++m) { const int r = ai * HALF + wr * 64 + m * 16 + fr;
                if (r < u.rows) { const unsigned ent = (unsigned)lp[u.pm * BM + r]; const int a = (int)(ent & 0xffffu); const float w8 = __builtin_bit_cast(float, ent & 0xffff0000u);
#pragma unroll
                    for (int bj = 0; bj < 2; ++bj) { const f32x4 v0 = acc[ai][bj][m][0] * w8, v1 = acc[ai][bj][m][1] * w8;
                        u32x4 w; w.x = cvt_pk_bf16(v0[0], v0[1]); w.y = cvt_pk_bf16(v0[2], v0[3]); w.z = cvt_pk_bf16(v1[0], v1[1]); w.w = cvt_pk_bf16(v1[2], v1[3]);
                        *(u32x4*)(Y + (size_t)a * 1024 + col0 + bj * HALF) = w; } } }
    }
};

struct EpiZ1 {
    static constexpr bool PERM = false;
    float* O; const float* X; float alpha;
    __device__ __forceinline__ void operator()(const f32x4 (&acc)[2][2][4][2], const Unit& u, int wr, int wc, int fr, int fq) const {
        const int row0 = u.pm * BM + wr * 64 + fr, col0 = u.pn * BM + wc * 32 + 4 * fq;
#pragma unroll
        for (int ai = 0; ai < 2; ++ai)
#pragma unroll
            for (int m = 0; m < 4; ++m) { const size_t off = (size_t)(row0 + ai * HALF + m * 16) * 1024 + col0;
#pragma unroll
                for (int bj = 0; bj < 2; ++bj)
#pragma unroll
                    for (int n = 0; n < 2; ++n) { const f32x4 xv = *(const f32x4*)(X + off + bj * HALF + n * 16); *(f32x4*)(O + off + bj * HALF + n * 16) = acc[ai][bj][m][n] + xv * alpha; } }
    }
};
}


typedef short s16x4 __attribute__((ext_vector_type(4)));
typedef short v4i16_t __attribute__((ext_vector_type(4)));
__device__ __forceinline__ unsigned off_b(unsigned row, unsigned ch) { return 256u * row + 16u * (ch ^ (((row & 3) << 2) | ((row >> 2) & 3))); }
__device__ __forceinline__ s16x4 vtr(LAS unsigned char* p) { return __builtin_bit_cast(s16x4, __builtin_amdgcn_ds_read_tr16_b64_v4i16((LAS v4i16_t*)p)); }
__device__ __forceinline__ float gelu_tanh(float x) { return x * __builtin_amdgcn_rcpf(1.f + __builtin_amdgcn_exp2f(-2.3022081986f * (x + 0.044715f * x * x * x))); }

__device__ __forceinline__ void sgu_phase(LAS unsigned char* lds, bf16* PROJ, const nv::P& p, int G, int vcu, int wave_s) {
    const int lane = pg8::lane_id_fresh(), tid = wave_s * 64 + lane;
    const int g4 = lane >> 4, q = (lane & 15) >> 2, pp = lane & 3, l15 = lane & 15;
    v4u rawn[4];
    { const int u0 = vcu < 1024 ? vcu : 0; const bf16* src = PROJ + ((size_t)(u0 >> 2) * 128 + (tid >> 2)) * NPROJ + PC_VS + (u0 & 3) * 128 + (tid & 3) * 32;
#pragma unroll
      for (int i = 0; i < 4; ++i) rawn[i] = *(const GAS v4u*)(src + 8 * i); }
    for (int u = vcu; u < 1024; u += G) {
        const int g = u & 3, bc = u >> 2; const size_t row0 = (size_t)bc * 128;
        {
            const int s = tid >> 2, qt = tid & 3;
            v4u raw[4];
#pragma unroll
            for (int i = 0; i < 4; ++i) raw[i] = rawn[i];
            { const int un = (u + G < 1024) ? u + G : u; const bf16* srcn = PROJ + ((size_t)(un >> 2) * 128 + s) * NPROJ + PC_VS + (un & 3) * 128 + qt * 32;
#pragma unroll
              for (int i = 0; i < 4; ++i) rawn[i] = *(const GAS v4u*)(srcn + 8 * i); }
            float x[32]; float s1 = 0.f;
#pragma unroll
            for (int i = 0; i < 4; ++i)
#pragma unroll
                for (int c = 0; c < 4; ++c) { const unsigned w = raw[i][c]; const float a = gelu_tanh(__builtin_bit_cast(float, w << 16)), b = gelu_tanh(__builtin_bit_cast(float, w & 0xffff0000u)); x[i * 8 + c * 2] = a; x[i * 8 + c * 2 + 1] = b; s1 += a + b; }
            s1 += __shfl_xor(s1, 1); s1 += __shfl_xor(s1, 2);
            const float mean = s1 * (1.f / 128.f); float s2 = 0.f;
#pragma unroll
            for (int i = 0; i < 32; ++i) { x[i] -= mean; s2 += x[i] * x[i]; }
            s2 += __shfl_xor(s2, 1); s2 += __shfl_xor(s2, 2);
            const float rstd = 1.f / sqrtf(s2 * (1.f / 128.f) + 1e-5f);
            const float* lg = p.sgu_ln_g + g * 128 + qt * 32; const float* lb = p.sgu_ln_b + g * 128 + qt * 32;
#pragma unroll
            for (int i = 0; i < 4; ++i) { const f32x4 g0 = *(const GAS f32x4*)(lg + 8 * i), g1 = *(const GAS f32x4*)(lg + 8 * i + 4), b0 = *(const GAS f32x4*)(lb + 8 * i), b1 = *(const GAS f32x4*)(lb + 8 * i + 4);
                v4u o; o.x = pk2(x[8 * i] * rstd * g0.x + b0.x, x[8 * i + 1] * rstd * g0.y + b0.y); o.y = pk2(x[8 * i + 2] * rstd * g0.z + b0.z, x[8 * i + 3] * rstd * g0.w + b0.w);
                o.z = pk2(x[8 * i + 4] * rstd * g1.x + b1.x, x[8 * i + 5] * rstd * g1.y + b1.y); o.w = pk2(x[8 * i + 6] * rstd * g1.z + b1.z, x[8 * i + 7] * rstd * g1.w + b1.w);
                *(LAS v4u*)(lds + off_b((unsigned)s, (unsigned)(qt * 4 + i))) = o; }
        }
        __syncthreads();
        {
            const int w = wave_s, t = 16 * w + l15, nks = (w >> 1) + 1;
            bf16* rowp = PROJ + (row0 + t) * NPROJ;
            unsigned long long uu8[8];
#pragma unroll
            for (int dt = 0; dt < 8; ++dt) uu8[dt] = *(const GAS unsigned long long*)(rowp + PC_U + g * 128 + 16 * dt + 4 * g4);
            const float bias = p.b_spatial[g * 128 + t];
            f32x4 acc[8];
#pragma unroll
            for (int dt = 0; dt < 8; ++dt) acc[dt] = (f32x4){0.f, 0.f, 0.f, 0.f};
            for (int ks = 0; ks < nks; ++ks) {
                const int sb = 32 * ks + 8 * g4;
                const float* wp = p.w_spatial + ((size_t)(g * 128 + t)) * 128 + sb;
                const f32x4 w0 = *(const GAS f32x4*)wp, w1 = *(const GAS f32x4*)(wp + 4);
                float wv[8] = {w0.x, w0.y, w0.z, w0.w, w1.x, w1.y, w1.z, w1.w};
#pragma unroll
                for (int j = 0; j < 8; ++j) if (sb + j > t) wv[j] = 0.f;
                v4u bw; bw.x = pk2(wv[0], wv[1]); bw.y = pk2(wv[2], wv[3]); bw.z = pk2(wv[4], wv[5]); bw.w = pk2(wv[6], wv[7]);
                const bf16x8 bfrag = __builtin_bit_cast(bf16x8, bw);
#pragma unroll
                for (int dt = 0; dt < 8; ++dt) {
                    const s16x4 lo = vtr(lds + off_b((unsigned)(sb + q), (unsigned)(2 * dt + (pp >> 1))) + 8 * (pp & 1));
                    const s16x4 hi = vtr(lds + off_b((unsigned)(sb + 4 + q), (unsigned)(2 * dt + (pp >> 1))) + 8 * (pp & 1));
                    const bf16x8 afrag = (bf16x8){lo[0], lo[1], lo[2], lo[3], hi[0], hi[1], hi[2], hi[3]};
                    acc[dt] = __builtin_amdgcn_mfma_f32_16x16x32_bf16(afrag, bfrag, acc[dt], 0, 0, 0);
                }
            }
#pragma unroll
            for (int dt = 0; dt < 8; ++dt) {
                const int d = g * 128 + 16 * dt + 4 * g4;
                const unsigned long long uu = uu8[dt];
                const float u0 = gelu_tanh(bf2f((unsigned short)uu)), u1 = gelu_tanh(bf2f((unsigned short)(uu >> 16))), u2 = gelu_tanh(bf2f((unsigned short)(uu >> 32))), u3 = gelu_tanh(bf2f((unsigned short)(uu >> 48)));
                const unsigned long long o = (unsigned long long)pk2(u0 * (acc[dt][0] + bias), u1 * (acc[dt][1] + bias)) | ((unsigned long long)pk2(u2 * (acc[dt][2] + bias), u3 * (acc[dt][3] + bias)) << 32);
                *(GAS unsigned long long*)(rowp + 512 + d) = o;
            }
        }
        __syncthreads();
    }
}

constexpr int DNA_PIECES = 57, DNU_PIECES = 2, DN_STEP_BYTES = (DNA_PIECES + DNU_PIECES) * 1024;
constexpr size_t DNA_CHUNK_BYTES = (size_t)DNA_PIECES * 1024, DNU_CHUNK_BYTES = 8 * DNU_PIECES * 1024;
__device__ __forceinline__ void glds16(const void* gsrc, LAS unsigned char* dst) { __builtin_amdgcn_global_load_lds((const unsigned*)gsrc, (LAS unsigned*)dst, 16, 0, 0); }
typedef float f32x2_t __attribute__((ext_vector_type(2))); typedef __bf16 bf16x2_t __attribute__((ext_vector_type(2)));
__device__ __forceinline__ unsigned cvtpk(float lo, float hi) { const f32x2_t v = {lo, hi}; const bf16x2_t b = __builtin_convertvector(v, bf16x2_t); return __builtin_bit_cast(unsigned, b); }

constexpr int DN_RING_PIECES = 42, DN_SLOT_BYTES = DN_RING_PIECES * 1024;
__device__ __forceinline__ void dn_scan_phase(LAS unsigned char* lds, const unsigned char* DNA, const unsigned char* DNU, bf16* ODN, int vcu, int wave_s) {
    if (vcu >= 256) return;
    const int lane = pg8::lane_id_fresh();
    const int bh = vcu >> 3, sl = vcu & 7, l15 = lane & 15, g4 = lane >> 4;
    const unsigned char* a_src = DNA + (size_t)bh * 64 * DNA_CHUNK_BYTES + lane * 16;
    const unsigned char* u_src = DNU + ((size_t)bh * 64 * 8 + sl) * (DNU_PIECES * 1024) + lane * 16;
#define DN_STAGE(step) do { if (wave_s >= 1 && wave_s <= 6) { const unsigned char* as_ = a_src + (size_t)(step) * DNA_CHUNK_BYTES; const unsigned char* us_ = u_src + (size_t)(step) * DNU_CHUNK_BYTES; \
        LAS unsigned char* sp_ = lds + ((step) % 3) * DN_SLOT_BYTES; \
        _Pragma("unroll") for (int i_ = 0; i_ < 7; ++i_) { const int p_ = (wave_s - 1) + 6 * i_; \
            const unsigned char* g_ = p_ < 16 ? as_ + p_ * 1024 : p_ < 32 ? as_ + (16 + p_) * 1024 : p_ < 40 ? as_ + (16 + p_) * 1024 : us_ + (p_ - 40) * 1024; \
            glds16(g_, sp_ + p_ * 1024); } } } while (0)
    DN_STAGE(0); DN_STAGE(1);
    if (wave_s != 0) {
        for (int n = 0; n < 64; ++n) {
            if (n < 63) asm volatile("s_waitcnt vmcnt(7)" ::: "memory"); else asm volatile("s_waitcnt vmcnt(0)" ::: "memory");
            __builtin_amdgcn_s_barrier();
            asm volatile("" ::: "memory");
            if (n + 2 < 64) DN_STAGE(n + 2);
        }
        asm volatile("s_waitcnt vmcnt(0)" ::: "memory");
        return;
    }
#undef DN_STAGE
    f32x4 S[8];
#pragma unroll
    for (int k = 0; k < 8; ++k) S[k] = (f32x4){0.f, 0.f, 0.f, 0.f};
    bf16x8 Qc[16], Qn[16]; float glc, gln;
#pragma unroll
    for (int i = 0; i < 16; ++i) Qc[i] = *(const GAS bf16x8*)(a_src + (16 + i) * 1024);
    glc = *(const GAS float*)(a_src + 56 * 1024);
    bf16* orow = ODN + (size_t)vcu * (64 * 64 * 16) + l15;
    for (int n = 0; n < 64; ++n) {
        asm volatile("s_waitcnt lgkmcnt(0)" ::: "memory");
        __builtin_amdgcn_s_barrier();
        asm volatile("" ::: "memory");
        { const unsigned char* nx = a_src + (size_t)(n + 1 < 64 ? n + 1 : n) * DNA_CHUNK_BYTES;
#pragma unroll
          for (int i = 0; i < 16; ++i) Qn[i] = *(const GAS bf16x8*)(nx + (16 + i) * 1024);
          gln = *(const GAS float*)(nx + 56 * 1024); }
        LAS unsigned char* lb = lds + (n % 3) * DN_SLOT_BYTES + lane * 16;
#define FRAG(piece) (*(const LAS bf16x8*)(lb + (piece) * 1024))
        bf16x8 Sb[4];
#pragma unroll
        for (int ks = 0; ks < 4; ++ks) { v4u w; w.x = cvtpk(S[2 * ks][0], S[2 * ks][1]); w.y = cvtpk(S[2 * ks][2], S[2 * ks][3]); w.z = cvtpk(S[2 * ks + 1][0], S[2 * ks + 1][1]); w.w = cvtpk(S[2 * ks + 1][2], S[2 * ks + 1][3]); Sb[ks] = __builtin_bit_cast(bf16x8, w); }
        f32x4 P[4];
        { const v4u u0 = *(const LAS v4u*)(lb + 40 * 1024), u1 = *(const LAS v4u*)(lb + 41 * 1024);
          P[0] = (f32x4){__builtin_bit_cast(float, u0.x << 16), __builtin_bit_cast(float, u0.x & 0xffff0000u), __builtin_bit_cast(float, u0.y << 16), __builtin_bit_cast(float, u0.y & 0xffff0000u)};
          P[1] = (f32x4){__builtin_bit_cast(float, u0.z << 16), __builtin_bit_cast(float, u0.z & 0xffff0000u), __builtin_bit_cast(float, u0.w << 16), __builtin_bit_cast(float, u0.w & 0xffff0000u)};
          P[2] = (f32x4){__builtin_bit_cast(float, u1.x << 16), __builtin_bit_cast(float, u1.x & 0xffff0000u), __builtin_bit_cast(float, u1.y << 16), __builtin_bit_cast(float, u1.y & 0xffff0000u)};
          P[3] = (f32x4){__builtin_bit_cast(float, u1.z << 16), __builtin_bit_cast(float, u1.z & 0xffff0000u), __builtin_bit_cast(float, u1.w << 16), __builtin_bit_cast(float, u1.w & 0xffff0000u)}; }
#pragma unroll
        for (int mt = 0; mt < 4; ++mt)
#pragma unroll
            for (int ks = 0; ks < 4; ++ks) P[mt] = __builtin_amdgcn_mfma_f32_16x16x32_bf16(FRAG(mt * 4 + ks), Sb[ks], P[mt], 0, 0, 0);
        bf16x8 Vb[2];
#pragma unroll
        for (int ks = 0; ks < 2; ++ks) { v4u w; w.x = cvtpk(P[2 * ks][0], P[2 * ks][1]); w.y = cvtpk(P[2 * ks][2], P[2 * ks][3]); w.z = cvtpk(P[2 * ks + 1][0], P[2 * ks + 1][1]); w.w = cvtpk(P[2 * ks + 1][2], P[2 * ks + 1][3]); Vb[ks] = __builtin_bit_cast(bf16x8, w); }
        f32x4 O[4];
#pragma unroll
        for (int mt = 0; mt < 4; ++mt) { O[mt] = (f32x4){0.f, 0.f, 0.f, 0.f};
#pragma unroll
            for (int ks = 0; ks < 4; ++ks) O[mt] = __builtin_amdgcn_mfma_f32_16x16x32_bf16(Qc[mt * 4 + ks], Sb[ks], O[mt], 0, 0, 0);
#pragma unroll
            for (int ks = 0; ks < 2; ++ks) O[mt] = __builtin_amdgcn_mfma_f32_16x16x32_bf16(FRAG(32 + mt * 2 + ks), Vb[ks], O[mt], 0, 0, 0); }
#pragma unroll
        for (int kt = 0; kt < 8; ++kt) { S[kt] = S[kt] * glc;
#pragma unroll
            for (int ks = 0; ks < 2; ++ks) S[kt] = __builtin_amdgcn_mfma_f32_16x16x32_bf16(FRAG(16 + kt * 2 + ks), Vb[ks], S[kt], 0, 0, 0); }
#undef FRAG
        bf16* ob = orow + (size_t)(n * 64 + 4 * g4) * 16;
#pragma unroll
        for (int mt = 0; mt < 4; ++mt)
#pragma unroll
            for (int r = 0; r < 4; ++r) ob[(16 * mt + r) * 16] = (bf16)f2bf(O[mt][r]);
#pragma unroll
        for (int i = 0; i < 16; ++i) Qc[i] = Qn[i];
        glc = gln;
    }
    asm volatile("s_waitcnt vmcnt(0)" ::: "memory");
}

__device__ __forceinline__ void dn_final_phase(const bf16* ODN, bf16* PROJ, const float* norm_w, int gw, int NGW, int lane) {
    const f32x4 nw0 = *(const GAS f32x4*)(norm_w + ((8 * lane) & 127)), nw1 = *(const GAS f32x4*)(norm_w + ((8 * lane) & 127) + 4);
#define DNF_LOAD(mm, OV, ZV) do { const int bb_ = (mm) >> 12, nn_ = ((mm) >> 6) & 63, ii_ = (mm) & 63; \
        OV = *(const GAS v4u*)(ODN + ((((size_t)((bb_ * 4 + (lane >> 4)) * 8 + ((lane >> 1) & 7)) * 64 + nn_) * 64 + ii_) * 16 + 8 * (lane & 1))); ZV = *(const GAS v4u*)(PROJ + (size_t)(mm) * NPROJ + PC_Z + 8 * lane); } while (0)
    v4u ovn, zvn; DNF_LOAD(gw < NTOK ? gw : 0, ovn, zvn);
    for (int m = gw; m < NTOK; m += NGW) {
        const v4u ov = ovn, zv = zvn;
        { const int mn = (m + NGW < NTOK) ? m + NGW : m; DNF_LOAD(mn, ovn, zvn); }
        float o[8], z[8];
#pragma unroll
        for (int c = 0; c < 4; ++c) { o[2 * c] = __builtin_bit_cast(float, ov[c] << 16); o[2 * c + 1] = __builtin_bit_cast(float, ov[c] & 0xffff0000u); z[2 * c] = __builtin_bit_cast(float, zv[c] << 16); z[2 * c + 1] = __builtin_bit_cast(float, zv[c] & 0xffff0000u); }
        float ss = 0.f;
#pragma unroll
        for (int c = 0; c < 8; ++c) ss += o[c] * o[c];
        ss += __shfl_xor(ss, 1); ss += __shfl_xor(ss, 2); ss += __shfl_xor(ss, 4); ss += __shfl_xor(ss, 8);
        const float rs = 1.f / sqrtf(ss * (1.f / 128.f) + 1e-6f);
        const float nw[8] = {nw0.x, nw0.y, nw0.z, nw0.w, nw1.x, nw1.y, nw1.z, nw1.w};
        float y[8];
#pragma unroll
        for (int c = 0; c < 8; ++c) y[c] = o[c] * rs * nw[c] * z[c] * __builtin_amdgcn_rcpf(1.f + __builtin_amdgcn_exp2f(-1.4426950408889634f * z[c]));
        v4u w; w.x = pk2(y[0], y[1]); w.y = pk2(y[2], y[3]); w.z = pk2(y[4], y[5]); w.w = pk2(y[6], y[7]);
        *(GAS v4u*)(PROJ + (size_t)m * NPROJ + 8 * lane) = w;
    }
}

__device__ __forceinline__ float wave_sum_dpp(float v) {
    v = v + __builtin_bit_cast(float, __builtin_amdgcn_update_dpp(0, __builtin_bit_cast(int, v), 0xB1, 0xf, 0xf, true));
    v = v + __builtin_bit_cast(float, __builtin_amdgcn_update_dpp(0, __builtin_bit_cast(int, v), 0x4E, 0xf, 0xf, true));
    v = v + __builtin_bit_cast(float, __builtin_amdgcn_update_dpp(0, __builtin_bit_cast(int, v), 0x141, 0xf, 0xf, true));
    v = v + __builtin_bit_cast(float, __builtin_amdgcn_update_dpp(0, __builtin_bit_cast(int, v), 0x140, 0xf, 0xf, true));
    v = v + __builtin_bit_cast(float, __builtin_amdgcn_update_dpp(0, __builtin_bit_cast(int, v), 0x142, 0xa, 0xf, true));
    v = v + __builtin_bit_cast(float, __builtin_amdgcn_update_dpp(0, __builtin_bit_cast(int, v), 0x143, 0xc, 0xf, true));
    return __builtin_bit_cast(float, __builtin_amdgcn_readlane(__builtin_bit_cast(int, v), 63));
}

constexpr int XTAB_OFF = RING_BYTES + 2048, XTAB_BYTES = 1792;
__device__ __forceinline__ unsigned off_t64(unsigned row, unsigned ch) { return 128u * row + 16u * (ch ^ (row & 7u)); }
__device__ __forceinline__ bf16x8 pack8(const float (&v)[8]) { v4u w; w.x = cvtpk(v[0], v[1]); w.y = cvtpk(v[2], v[3]); w.z = cvtpk(v[4], v[5]); w.w = cvtpk(v[6], v[7]); return __builtin_bit_cast(bf16x8, w); }
__device__ __forceinline__ void unpack8(const v4u w, float (&v)[8]) {
#pragma unroll
    for (int c = 0; c < 4; ++c) { v[2 * c] = __builtin_bit_cast(float, w[c] << 16); v[2 * c + 1] = __builtin_bit_cast(float, w[c] & 0xffff0000u); }
}
__device__ __forceinline__ float conv_silu_rows(const bf16* src0, bool seq_start, const float* cw, LAS unsigned char* img, int lane) {
    float w[4][2];
#pragma unroll
    for (int j = 0; j < 4; ++j) { const f32x2_t t = *(const GAS f32x2_t*)(cw + j * 1536 + 2 * lane); w[j][0] = t[0]; w[j][1] = t[1]; }
    const GAS unsigned* gsrc = (const GAS unsigned*)(src0 + 2 * lane);
    unsigned raw[67];
#pragma unroll
    for (int r = 0; r < 3; ++r) raw[r] = seq_start ? 0u : gsrc[(long)(r - 3) * (NPROJ / 2)];
#pragma unroll
    for (int r = 0; r < 64; ++r) raw[3 + r] = gsrc[(size_t)r * (NPROJ / 2)];
    float myss = 0.f;
    const unsigned lbase = (unsigned)((lane & 3) * 4);
#pragma unroll
    for (int pz = 0; pz < 64; ++pz) {
        float y0 = 0.f, y1 = 0.f;
#pragma unroll
        for (int j = 0; j < 4; ++j) { const unsigned u = raw[pz + j]; y0 += w[j][0] * __builtin_bit_cast(float, u << 16); y1 += w[j][1] * __builtin_bit_cast(float, u & 0xffff0000u); }
        y0 = y0 * __builtin_amdgcn_rcpf(1.f + __builtin_amdgcn_exp2f(-1.4426950408889634f * y0));
        y1 = y1 * __builtin_amdgcn_rcpf(1.f + __builtin_amdgcn_exp2f(-1.4426950408889634f * y1));
        const float tot = wave_sum_dpp(y0 * y0 + y1 * y1);
        myss = (lane == pz) ? tot : myss;
        *(LAS unsigned*)(img + off_b((unsigned)pz, (unsigned)(lane >> 2)) + lbase) = cvtpk(y0, y1);
    }
    return myss;
}

template <int STOP>
__device__ __forceinline__ void dn_prep_chunk(LAS unsigned char* IMG  , LAS float* tab, const bf16* PROJ, const nv::P& p, unsigned char* DNA, unsigned char* DNU, int ci) {
    int lane = pg8::lane_id_fresh();
    const int bh = ci >> 6, n = ci & 63, b = bh >> 2, h = bh & 3;
    int l15 = lane & 15, g4 = lane >> 4, q = l15 >> 2, pp = lane & 3;
    LAS float* t_gc = tab; LAS float* t_be = tab + 64; LAS float* t_rk = tab + 128; LAS float* t_rq = tab + 192; LAS float* t_eq = tab + 256; LAS float* t_ekk = tab + 320; LAS float* t_bg = tab + 384;
    const size_t tok = (size_t)b * 4096 + n * 64 + lane;
    const bf16* prow = PROJ + tok * NPROJ;
    const bf16* prow0 = PROJ + ((size_t)b * 4096 + n * 64) * NPROJ;
    unsigned char* dna = DNA + (size_t)ci * DNA_CHUNK_BYTES + lane * 16;
    (void)q; (void)pp;
    float gc, beta, eg, gc63;
    {
        const float araw = bf2f(prow[PC_A + h]), braw = bf2f(prow[PC_B + h]);
        const float xx = araw + p.dt_bias[h];
        const float sp = xx > 20.f ? xx : log1pf(expf(xx));
        gc = -expf(p.a_log[h]) * sp;
        beta = 1.f / (1.f + expf(-braw));
#pragma unroll
        for (int o = 1; o < 64; o <<= 1) { const float t = __shfl_up(gc, o); if (lane >= o) gc += t; }
        gc63 = __shfl(gc, 63);
        eg = expf(gc);
        const unsigned gb = __builtin_bit_cast(unsigned, expf(gc63));
        *(GAS v4u*)(dna + 56 * 1024) = (v4u){gb, gb, gb, gb};
        const float ssq = conv_silu_rows(prow0 + PC_Q + h * 128, n == 0, p.conv_w + h * 128, IMG, lane);
        const float rq = 0.08838834764831845f / sqrtf(ssq + 1e-6f);
        t_gc[lane] = gc; t_be[lane] = beta; t_rq[lane] = rq; t_eq[lane] = eg * rq;
    }
    LDS_WAIT(); asm volatile("" ::: "memory");
    if constexpr (STOP == 1) return;
    bf16x8 qF[4][4];
#pragma unroll
    for (int mt = 0; mt < 4; ++mt)
#pragma unroll
        for (int ks = 0; ks < 4; ++ks) qF[mt][ks] = *(const LAS bf16x8*)(IMG + off_b((unsigned)(16 * mt + l15), (unsigned)(4 * ks + g4)));
#pragma unroll
    for (int mt = 0; mt < 4; ++mt) {
        const float egi = t_eq[16 * mt + l15];
#pragma unroll
        for (int ks = 0; ks < 4; ++ks) {
            const unsigned long long lo = *(const LAS unsigned long long*)(IMG + off_b((unsigned)(16 * mt + l15), (unsigned)(4 * ks + (g4 >> 1))) + (g4 & 1) * 8);
            const unsigned long long hi = *(const LAS unsigned long long*)(IMG + off_b((unsigned)(16 * mt + l15), (unsigned)(4 * ks + 2 + (g4 >> 1))) + (g4 & 1) * 8);
            float t8[8]; unpack8((v4u){(unsigned)lo, (unsigned)(lo >> 32), (unsigned)hi, (unsigned)(hi >> 32)}, t8);
#pragma unroll
            for (int e = 0; e < 8; ++e) t8[e] *= egi;
            *(GAS bf16x8*)(dna + (16 + mt * 4 + ks) * 1024) = pack8(t8);
        }
    }
    LDS_WAIT(); asm volatile("" ::: "memory");
    {
        const float ssk = conv_silu_rows(prow0 + PC_K + h * 128, n == 0, p.conv_w + 512 + h * 128, IMG, lane);
        const float rk = 1.f / sqrtf(ssk + 1e-6f);
        t_rk[lane] = rk; t_ekk[lane] = expf(gc63 - gc) * rk; t_bg[lane] = beta * eg * rk;
    }
    LDS_WAIT(); asm volatile("" ::: "memory");
    if constexpr (STOP == 2) return;
    f32x4 Am[4][4];
    {
        bf16x8 kF[4][4];
#pragma unroll
        for (int mt = 0; mt < 4; ++mt)
#pragma unroll
            for (int ks = 0; ks < 4; ++ks) kF[mt][ks] = *(const LAS bf16x8*)(IMG + off_b((unsigned)(16 * mt + l15), (unsigned)(4 * ks + g4)));
#pragma unroll
        for (int mi = 0; mi < 4; ++mi) {
            const f32x4 gci = *(const LAS f32x4*)(t_gc + 16 * mi + 4 * g4), bei = *(const LAS f32x4*)(t_be + 16 * mi + 4 * g4), rki = *(const LAS f32x4*)(t_rk + 16 * mi + 4 * g4);
#pragma unroll
            for (int nj = 0; nj <= mi; ++nj) {
                f32x4 acc = (f32x4){0.f, 0.f, 0.f, 0.f};
#pragma unroll
                for (int ks = 0; ks < 4; ++ks) acc = __builtin_amdgcn_mfma_f32_16x16x32_bf16(kF[mi][ks], kF[nj][ks], acc, 0, 0, 0);
                const float gcj = t_gc[16 * nj + l15], rkj = t_rk[16 * nj + l15]; const int j = 16 * nj + l15;
#pragma unroll
                for (int r = 0; r < 4; ++r) { const int i = 16 * mi + 4 * g4 + r; acc[r] = (j < i) ? bei[r] * rki[r] * rkj * acc[r] * expf(gci[r] - gcj) : 0.f; }
                Am[mi][nj] = acc;
            }
        }
#pragma unroll
        for (int it = 0; it < 4; ++it) {
            const float gci = t_gc[16 * it + l15], rqi = t_rq[16 * it + l15]; const int i = 16 * it + l15;
            f32x4 kq[4];
#pragma unroll
            for (int jt = 0; jt < 4; ++jt) {
                f32x4 acc = (f32x4){0.f, 0.f, 0.f, 0.f};
                if (jt <= it) {
#pragma unroll
                    for (int ks = 0; ks < 4; ++ks) acc = __builtin_amdgcn_mfma_f32_16x16x32_bf16(kF[jt][ks], qF[it][ks], acc, 0, 0, 0);
                    const f32x4 gcj = *(const LAS f32x4*)(t_gc + 16 * jt + 4 * g4), rkj = *(const LAS f32x4*)(t_rk + 16 * jt + 4 * g4);
#pragma unroll
                    for (int r = 0; r < 4; ++r) { const int j = 16 * jt + 4 * g4 + r; acc[r] = (j <= i) ? acc[r] * rqi * rkj[r] * expf(gci - gcj[r]) : 0.f; }
                }
                kq[jt] = acc;
            }
#pragma unroll
            for (int ks = 0; ks < 2; ++ks) { const float t8[8] = {kq[2 * ks][0], kq[2 * ks][1], kq[2 * ks][2], kq[2 * ks][3], kq[2 * ks + 1][0], kq[2 * ks + 1][1], kq[2 * ks + 1][2], kq[2 * ks + 1][3]};
                *(GAS bf16x8*)(dna + (48 + it * 2 + ks) * 1024) = pack8(t8); }
        }
    }
    if constexpr (STOP == 3) return;
    bf16x8 ktr[8][2];
    {
#pragma unroll
        for (int ks = 0; ks < 2; ++ks) {
            const f32x4 ek0 = *(const LAS f32x4*)(t_ekk + 32 * ks + 4 * g4), ek1 = *(const LAS f32x4*)(t_ekk + 32 * ks + 16 + 4 * g4);
#pragma unroll
            for (int mt = 0; mt < 8; ++mt) {
                const s16x4 lo = vtr(IMG + off_b((unsigned)(32 * ks + 4 * g4 + q), (unsigned)(2 * mt + (pp >> 1))) + 8 * (pp & 1));
                const s16x4 hi = vtr(IMG + off_b((unsigned)(32 * ks + 16 + 4 * g4 + q), (unsigned)(2 * mt + (pp >> 1))) + 8 * (pp & 1));
                const float t8[8] = {bf2f((unsigned short)lo[0]) * ek0.x, bf2f((unsigned short)lo[1]) * ek0.y, bf2f((unsigned short)lo[2]) * ek0.z, bf2f((unsigned short)lo[3]) * ek0.w,
                                     bf2f((unsigned short)hi[0]) * ek1.x, bf2f((unsigned short)hi[1]) * ek1.y, bf2f((unsigned short)hi[2]) * ek1.z, bf2f((unsigned short)hi[3]) * ek1.w};
                *(GAS bf16x8*)(dna + (32 + mt * 2 + ks) * 1024) = pack8(t8);
            }
        }
#pragma unroll
        for (int dt = 0; dt < 8; ++dt)
#pragma unroll
            for (int ks = 0; ks < 2; ++ks) {
                const s16x4 lo = vtr(IMG + off_b((unsigned)(32 * ks + 8 * g4 + q), (unsigned)(2 * dt + (pp >> 1))) + 8 * (pp & 1));
                const s16x4 hi = vtr(IMG + off_b((unsigned)(32 * ks + 8 * g4 + 4 + q), (unsigned)(2 * dt + (pp >> 1))) + 8 * (pp & 1));
                ktr[dt][ks] = (bf16x8){lo[0], lo[1], lo[2], lo[3], hi[0], hi[1], hi[2], hi[3]};
            }
    }
    LDS_WAIT(); asm volatile("" ::: "memory");
    {
        LAS float* AL = (LAS float*)IMG;
#pragma unroll
        for (int mi = 0; mi < 4; ++mi)
#pragma unroll
            for (int nj = 0; nj <= mi; ++nj)
#pragma unroll
                for (int r = 0; r < 4; ++r) AL[(16 * mi + 4 * g4 + r) * 64 + 16 * nj + l15] = Am[mi][nj][r];
    }
    LDS_WAIT(); asm volatile("" ::: "memory");
    float T[64];
    {
        const LAS float* AL = (const LAS float*)IMG;
#pragma clang loop unroll(full)
        for (int i = 0; i < 64; ++i) {
            float v4[4] = {(lane == i) ? 1.f : 0.f, 0.f, 0.f, 0.f};
#pragma clang loop unroll(full)
            for (int j4 = 0; j4 < (i + 3) / 4; ++j4) {
                const f32x4 a = *(const LAS f32x4*)(AL + i * 64 + 4 * j4);
#pragma clang loop unroll(full)
                for (int e = 0; e < 4; ++e) if (4 * j4 + e < i) v4[e] -= a[e] * T[4 * j4 + e];
            }
            T[i] = (v4[0] + v4[1]) + (v4[2] + v4[3]);
        }
    }
    LDS_WAIT(); asm volatile("" ::: "memory");
    if constexpr (STOP == 4) return;
    lane = pg8::lane_id_fresh(); l15 = lane & 15; g4 = lane >> 4; q = l15 >> 2; pp = lane & 3;
    dna = DNA + (size_t)ci * DNA_CHUNK_BYTES + lane * 16;
    {
        const float bc = t_be[lane], bgc = t_bg[lane];
        LAS unsigned char* TB = IMG; LAS unsigned char* TBE = IMG + 8192;
#pragma unroll
        for (int i = 0; i < 64; ++i) { const unsigned o = off_t64((unsigned)i, (unsigned)(lane >> 3)) + (lane & 7) * 2;
            *(LAS unsigned short*)(TB + o) = (unsigned short)f2bf(T[i] * bc); *(LAS unsigned short*)(TBE + o) = (unsigned short)f2bf(T[i] * bgc); }
    }
    LDS_WAIT(); asm volatile("" ::: "memory");
    bf16x8 tb[4][2];
    {
#pragma unroll
        for (int it = 0; it < 4; ++it) {
            bf16x8 tbe[2];
#pragma unroll
            for (int ks = 0; ks < 2; ++ks) tbe[ks] = *(const LAS bf16x8*)(IMG + 8192 + off_t64((unsigned)(16 * it + l15), (unsigned)(4 * ks + g4)));
            f32x4 acc[8];
#pragma unroll
            for (int dt = 0; dt < 8; ++dt) { acc[dt] = (f32x4){0.f, 0.f, 0.f, 0.f};
#pragma unroll
                for (int ks = 0; ks < 2; ++ks) acc[dt] = __builtin_amdgcn_mfma_f32_16x16x32_bf16(ktr[dt][ks], tbe[ks], acc[dt], 0, 0, 0); }
#pragma unroll
            for (int ks = 0; ks < 4; ++ks) { const float t8[8] = {-acc[2 * ks][0], -acc[2 * ks][1], -acc[2 * ks][2], -acc[2 * ks][3], -acc[2 * ks + 1][0], -acc[2 * ks + 1][1], -acc[2 * ks + 1][2], -acc[2 * ks + 1][3]};
                *(GAS bf16x8*)(dna + (it * 4 + ks) * 1024) = pack8(t8); }
        }
#pragma unroll
        for (int mt = 0; mt < 4; ++mt)
#pragma unroll
            for (int ks = 0; ks < 2; ++ks) tb[mt][ks] = *(const LAS bf16x8*)(IMG + off_t64((unsigned)(16 * mt + l15), (unsigned)(4 * ks + g4)));
    }
    LDS_WAIT(); asm volatile("" ::: "memory");
    if constexpr (STOP == 5) return;
    (void)conv_silu_rows(prow0 + PC_V + h * 128, n == 0, p.conv_w + 1024 + h * 128, IMG, lane);
    LDS_WAIT(); asm volatile("" ::: "memory");
    {
        unsigned char* dnu = DNU + (size_t)ci * DNU_CHUNK_BYTES + lane * 16;
#pragma unroll
        for (int dt = 0; dt < 8; ++dt) {
            bf16x8 vt[2];
#pragma unroll
            for (int ks = 0; ks < 2; ++ks) {
                const s16x4 lo = vtr(IMG + off_b((unsigned)(32 * ks + 8 * g4 + q), (unsigned)(2 * dt + (pp >> 1))) + 8 * (pp & 1));
                const s16x4 hi = vtr(IMG + off_b((unsigned)(32 * ks + 8 * g4 + 4 + q), (unsigned)(2 * dt + (pp >> 1))) + 8 * (pp & 1));
                vt[ks] = (bf16x8){lo[0], lo[1], lo[2], lo[3], hi[0], hi[1], hi[2], hi[3]};
            }
            f32x4 u[4];
#pragma unroll
            for (int mt = 0; mt < 4; ++mt) { u[mt] = (f32x4){0.f, 0.f, 0.f, 0.f};
#pragma unroll
                for (int ks = 0; ks < 2; ++ks) u[mt] = __builtin_amdgcn_mfma_f32_16x16x32_bf16(tb[mt][ks], vt[ks], u[mt], 0, 0, 0); }
#pragma unroll
            for (int pc = 0; pc < 2; ++pc) { const float t8[8] = {u[2 * pc][0], u[2 * pc][1], u[2 * pc][2], u[2 * pc][3], u[2 * pc + 1][0], u[2 * pc + 1][1], u[2 * pc + 1][2], u[2 * pc + 1][3]};
                *(GAS bf16x8*)(dnu + (dt * 2 + pc) * 1024) = pack8(t8); }
        }
    }
    LDS_WAIT(); asm volatile("" ::: "memory");
}

template <int STOP>
__device__ __forceinline__ void dn_prep_phase(LAS unsigned char* lds, const bf16* PROJ, const nv::P& p, unsigned char* DNA, unsigned char* DNU, int G, int vcu, int wave_s) {
    LAS unsigned char* img = lds + wave_s * 16384; LAS float* tab = (LAS float*)(lds + XTAB_OFF + wave_s * XTAB_BYTES);
    for (int ci = vcu * 8 + wave_s; ci < 2048; ci += G * 8) dn_prep_chunk<STOP>(img, tab, PROJ, p, DNA, DNU, ci);
}


struct RouterArgs { const float* z; const bf16* mix; float* zout; bf16* H1BF; int* EID; float* WGT; int* LIST; int* CNT; const float *ln_g, *ln_b, *w_rg, *b_rg, *w_re, *b_re; };
__device__ __forceinline__ void router_fill(LAS float* dst, const float* W, int ldw, int col0, int tid) {
#pragma unroll
    for (int it = 0; it < 4; ++it) { const int qd = tid + it * NTHREADS, k = qd >> 1, half = qd & 1;
        const f32x4 v = *(const GAS f32x4*)(W + (size_t)k * ldw + col0 + half * 4);
        *(LAS f32x4*)(dst + ((((k >> 8) * 4 + (k & 3)) * 64 + ((k >> 2) & 63)) * 8 + half * 4)) = v; }
}
__device__ __forceinline__ void router_phase(LAS unsigned char* lds, const RouterArgs& A, int gw, int NGW, int wave_s) {
    const int lane = pg8::lane_id_fresh(), tid = wave_s * 64 + lane;
    LAS float* WG = (LAS float*)lds; LAS int* HIST = (LAS int*)(lds + 32768); LAS int* BASE = HIST + 64; LAS int* RR = HIST + 128;
    router_fill(WG, A.w_rg, 8, 0, tid);
    if (tid < 64) HIST[tid] = 0;
    __syncthreads();
    int it_ = 0;
    f32x4 vn[4]; unsigned long long mn_[4];
    { const GAS f32x4* zr = (const GAS f32x4*)(A.z + (size_t)gw * DM) + lane; const GAS unsigned long long* mr = (const GAS unsigned long long*)(A.mix + (size_t)gw * DM) + lane;
#pragma unroll
      for (int j = 0; j < 4; ++j) { vn[j] = zr[64 * j]; mn_[j] = mr[64 * j]; } }
    for (int m = gw; m < NTOK; m += NGW) {
        f32x4 v[4];
#pragma unroll
        for (int j = 0; j < 4; ++j) { const unsigned long long mm = mn_[j];
            v[j].x = ALPHA_F * vn[j].x + bf2f((unsigned short)mm); v[j].y = ALPHA_F * vn[j].y + bf2f((unsigned short)(mm >> 16));
            v[j].z = ALPHA_F * vn[j].z + bf2f((unsigned short)(mm >> 32)); v[j].w = ALPHA_F * vn[j].w + bf2f((unsigned short)(mm >> 48)); }
        { const int mn = (m + NGW < NTOK) ? m + NGW : m; const GAS f32x4* zn = (const GAS f32x4*)(A.z + (size_t)mn * DM) + lane; const GAS unsigned long long* mr = (const GAS unsigned long long*)(A.mix + (size_t)mn * DM) + lane;
#pragma unroll
          for (int j = 0; j < 4; ++j) { vn[j] = zn[64 * j]; mn_[j] = mr[64 * j]; } }
        float s = 0.f;
#pragma unroll
        for (int j = 0; j < 4; ++j) s += (v[j].x + v[j].y) + (v[j].z + v[j].w);
        const float mean = wave_sum_dpp(s) * (1.f / DM); float s2 = 0.f;
#pragma unroll
        for (int j = 0; j < 4; ++j) { v[j] = v[j] - mean; s2 += (v[j].x * v[j].x + v[j].y * v[j].y) + (v[j].z * v[j].z + v[j].w * v[j].w); }
        const float rstd = 1.f / sqrtf(wave_sum_dpp(s2) * (1.f / DM) + 1e-5f);
        GAS unsigned long long* hb = (GAS unsigned long long*)(A.H1BF + (size_t)m * DM) + lane;
#pragma unroll
        for (int j = 0; j < 4; ++j) { const f32x4 g = *((const GAS f32x4*)A.ln_g + lane + 64 * j), bb = *((const GAS f32x4*)A.ln_b + lane + 64 * j); v[j] = v[j] * rstd * g + bb;
            hb[64 * j] = (unsigned long long)pk2(v[j].x, v[j].y) | ((unsigned long long)pk2(v[j].z, v[j].w) << 32); }
        float gl[8];
#pragma unroll
        for (int c = 0; c < 8; ++c) gl[c] = 0.f;
#pragma unroll
        for (int j = 0; j < 4; ++j)
#pragma unroll
            for (int c4 = 0; c4 < 4; ++c4) { const float hv = v[j][c4]; const LAS float* wp = WG + ((j * 4 + c4) * 64 + lane) * 8;
                const f32x4 w0 = *(const LAS f32x4*)wp, w1 = *(const LAS f32x4*)(wp + 4);
                gl[0] += hv * w0.x; gl[1] += hv * w0.y; gl[2] += hv * w0.z; gl[3] += hv * w0.w; gl[4] += hv * w1.x; gl[5] += hv * w1.y; gl[6] += hv * w1.z; gl[7] += hv * w1.w; }
        int gi = 0; float gm = -INFINITY;
#pragma unroll
        for (int c = 0; c < 8; ++c) { gl[c] = wave_sum_dpp(gl[c]) + A.b_rg[c]; if (gl[c] > gm) { gm = gl[c]; gi = c; } }
        float den = 0.f;
#pragma unroll
        for (int c = 0; c < 8; ++c) den += expf(gl[c] - gm);
        const float pg = 1.f / den;
        float el[8];
#pragma unroll
        for (int c = 0; c < 8; ++c) el[c] = 0.f;
        const float* wre = A.w_re + gi * 8192 + lane * 8;
#pragma unroll
        for (int j = 0; j < 4; ++j)
#pragma unroll
            for (int c4 = 0; c4 < 4; ++c4) { const float hv = v[j][c4];
                const f32x4 w0 = *(const GAS f32x4*)(wre + (j * 4 + c4) * 512), w1 = *(const GAS f32x4*)(wre + (j * 4 + c4) * 512 + 4);
                el[0] += hv * w0.x; el[1] += hv * w0.y; el[2] += hv * w0.z; el[3] += hv * w0.w; el[4] += hv * w1.x; el[5] += hv * w1.y; el[6] += hv * w1.z; el[7] += hv * w1.w; }
        int i0 = 0, i1 = 0; float v0 = -INFINITY, v1 = -INFINITY;
#pragma unroll
        for (int c = 0; c < 8; ++c) { el[c] = wave_sum_dpp(el[c]) + A.b_re[gi * 8 + c]; if (el[c] > v0) { v0 = el[c]; i0 = c; } }
#pragma unroll
        for (int c = 0; c < 8; ++c) { if (c != i0 && el[c] > v1) { v1 = el[c]; i1 = c; } }
        const float e1 = expf(v1 - v0), sm = 1.f / (1.f + e1);
        if (lane == 0) {
            const int ea = gi * 8 + i0, eb = gi * 8 + i1;
            LAS int* rr = RR + (wave_s * 16 + it_) * 6;
            rr[4] = (int)(f2bf(pg * sm) << 16); rr[5] = (int)(f2bf(pg * e1 * sm) << 16);
            rr[0] = ea; rr[1] = __hip_atomic_fetch_add(&HIST[ea], 1, __ATOMIC_RELAXED, __HIP_MEMORY_SCOPE_WORKGROUP); rr[2] = eb; rr[3] = __hip_atomic_fetch_add(&HIST[eb], 1, __ATOMIC_RELAXED, __HIP_MEMORY_SCOPE_WORKGROUP);
        }
        ++it_;
    }
    __syncthreads();
    if (tid < 64) BASE[tid] = __hip_atomic_fetch_add(&A.CNT[tid], HIST[tid], __ATOMIC_RELAXED, __HIP_MEMORY_SCOPE_AGENT);
    __syncthreads();
    if (lane < it_) {
        const LAS int* rr = RR + (wave_s * 16 + lane) * 6; const int m = gw + lane * NGW;
        A.LIST[(size_t)rr[0] * NTOK + BASE[rr[0]] + rr[1]] = (2 * m) | rr[4];
        A.LIST[(size_t)rr[2] * NTOK + BASE[rr[2]] + rr[3]] = (2 * m + 1) | rr[5];
    }
}

__device__ __forceinline__ void final_phase(float* OUT, const bf16* H1B, const bf16* YEXP, const float* ln_g, const float* ln_b, int gw, int NGW, int lane) {
    unsigned long long hn[4], an[4], bn[4];
#define FIN_LOAD(mm) do { const GAS unsigned long long* hq_ = (const GAS unsigned long long*)(H1B + (size_t)(mm) * DM) + lane; const GAS unsigned long long* y0_ = (const GAS unsigned long long*)(YEXP + (size_t)(2 * (mm)) * DM) + lane; \
        _Pragma("unroll") for (int j_ = 0; j_ < 4; ++j_) { hn[j_] = hq_[64 * j_]; an[j_] = y0_[64 * j_]; bn[j_] = y0_[DM / 4 + 64 * j_]; } } while (0)
    FIN_LOAD(gw < NTOK ? gw : 0);
    for (int m = gw; m < NTOK; m += NGW) {
        GAS f32x4* orow = (GAS f32x4*)(OUT + (size_t)m * DM) + lane;
        unsigned long long hc[4], ac[4], bc[4];
#pragma unroll
        for (int j = 0; j < 4; ++j) { hc[j] = hn[j]; ac[j] = an[j]; bc[j] = bn[j]; }
        { const int mn = (m + NGW < NTOK) ? m + NGW : m; FIN_LOAD(mn); }
        f32x4 v[4]; float s = 0.f;
#pragma unroll
        for (int j = 0; j < 4; ++j) { const unsigned long long hh = hc[j], a0 = ac[j], a1 = bc[j];
            v[j].x = ALPHA_F * bf2f((unsigned short)hh) + bf2f((unsigned short)a0) + bf2f((unsigned short)a1);
            v[j].y = ALPHA_F * bf2f((unsigned short)(hh >> 16)) + bf2f((unsigned short)(a0 >> 16)) + bf2f((unsigned short)(a1 >> 16));
            v[j].z = ALPHA_F * bf2f((unsigned short)(hh >> 32)) + bf2f((unsigned short)(a0 >> 32)) + bf2f((unsigned short)(a1 >> 32));
            v[j].w = ALPHA_F * bf2f((unsigned short)(hh >> 48)) + bf2f((unsigned short)(a0 >> 48)) + bf2f((unsigned short)(a1 >> 48));
            s += (v[j].x + v[j].y) + (v[j].z + v[j].w); }
        const float mean = wave_sum_dpp(s) * (1.f / DM); float s2 = 0.f;
#pragma unroll
        for (int j = 0; j < 4; ++j) { v[j] = v[j] - mean; s2 += (v[j].x * v[j].x + v[j].y * v[j].y) + (v[j].z * v[j].z + v[j].w * v[j].w); }
        const float rstd = 1.f / sqrtf(wave_sum_dpp(s2) * (1.f / DM) + 1e-5f);
#pragma unroll
        for (int j = 0; j < 4; ++j) { const f32x4 g = *((const GAS f32x4*)ln_g + lane + 64 * j), bb = *((const GAS f32x4*)ln_b + lane + 64 * j); orow[64 * j] = v[j] * rstd * g + bb; }
    }
}

#ifndef REPEAT_MASK
#define REPEAT_MASK 0
#endif
#define REPS(k) ((((REPEAT_MASK) >> (k)) & 1) + 1)
__global__ void __launch_bounds__(NTHREADS, 2) fwd_megakernel(MK a) {
    extern __shared__ __attribute__((aligned(16))) unsigned char lds_raw[];
    cg::grid_group grid = cg::this_grid();
    LAS unsigned char* lds = (LAS unsigned char*)lds_raw;
    volatile LAS unsigned* MISC = (volatile LAS unsigned*)(lds + MISC_OFF);
    LAS int* PREF = (LAS int*)(lds + PREF_OFF);
    const int tid = threadIdx.x; const int wave_s = __builtin_amdgcn_readfirstlane(tid >> 6);
    const int G = gridDim.x; const int bx = blockIdx.x; const int vcu = (G % 8 == 0) ? (bx % 8) * (G / 8) + bx / 8 : bx;
    unsigned char* ws = a.ws; const nv::P& p = a.p;
    gu32* ctl = (gu32*)(ws + WS_CTL);
    bf16* WIN = (bf16*)(ws + WS_WIN); bf16* WOUT = (bf16*)(ws + WS_WOUT); bf16* XBF = (bf16*)(ws + WS_A); bf16* PROJ = (bf16*)(ws + WS_B);
    bf16* WGU = (bf16*)(ws + WS_WGU); bf16* WD = (bf16*)(ws + WS_WD); bf16* HID = (bf16*)(ws + WS_A); bf16* H1BF = (bf16*)(ws + WS_H1BF); bf16* YEXP = (bf16*)(ws + WS_YEXP);
    int* LIST = (int*)(ws + WS_LIST); int* EID = (int*)(ws + WS_ROUTE); float* WGT = (float*)(ws + WS_ROUTE + 512 * 1024);
    int* CNT = (int*)(ws + WS_CTL) + CW_CNT;
    for (int u = tid; u < (LDS_BYTES - LDSCTL_OFF) / 4; u += NTHREADS) ((LAS unsigned*)(lds + LDSCTL_OFF))[u] = 0u;
    __syncthreads();
    XcdBarrier bar = xcd_barrier_post((unsigned*)(ctl + CW_BAR), MISC + 8);
    grid.sync();
#define FRESH() const int lane = pg8::lane_id_fresh(), wave = wave_s; const int tid_ = wave_s * 64 + lane; const int gtid = (int)blockIdx.x * NTHREADS + tid_, gsize = G * NTHREADS, gw = vcu * NWAVES + wave, NGW = G * NWAVES; (void)lane; (void)gtid; (void)gsize; (void)gw; (void)NGW;

    _Pragma("unroll 1") for (int rep_ = 0; rep_ < REPS(0); ++rep_) {
    {
        FRESH();
        LAS float* scr = (LAS float*)(lds + wave * 16384);
        constexpr int NB = 96, KB = DM / 64;
        for (int it = gw; it < NB * KB; it += NGW) { const int nb = it % NB, kb = it / NB; const int nsrc = nb < 64 ? nb * 32 : 2056 + (nb - 64) * 32, ndst = nb * 32;
            p0_transpose_item(p.w_in, nv::INC, DM, kb * 64, nsrc, WIN, ndst, scr, lane); }
        for (int i = gtid; i < 8 * DM; i += gsize) { const int j = (int)(i / DM), k = (int)(i % DM); WIN[(size_t)(PC_B + j) * DM + k] = (bf16)f2bf(p.w_in[(size_t)k * nv::INC + 2048 + j]); }
        for (int i = gtid; i < (long)(NPROJ - 3080) * DM / 8; i += gsize) *(GAS v4u*)(WIN + (size_t)3080 * DM + i * 8) = (v4u){0u, 0u, 0u, 0u};
        for (int i = gtid; i < (long)NTOK * DM / 8; i += gsize) { const f32x4 v0 = *(const GAS f32x4*)(p.x + i * 8), v1 = *(const GAS f32x4*)(p.x + i * 8 + 4);
            v4u o; o.x = pk2(v0.x, v0.y); o.y = pk2(v0.z, v0.w); o.z = pk2(v1.x, v1.y); o.w = pk2(v1.z, v1.w); *(GAS v4u*)(XBF + i * 8) = o; }
        for (int it = gw; it < 16 * 32; it += NGW) { const int nb = it & 31, kb = it >> 5; p0_transpose_item(p.w_out, DM, DM, kb * 64, nb * 32, WOUT, nb * 32, scr, lane); }
        for (int d = gtid; d < 8 * 8192; d += gsize) { const int g = d >> 13, r = d & 8191, c = r & 7, ll = (r >> 3) & 63, jc = r >> 9, k = 4 * (ll + 64 * (jc >> 2)) + (jc & 3);
            ((float*)(ws + WS_WREP))[d] = p.w_re[(size_t)k * 64 + g * 8 + c]; }
        p0_experts(p.w_gate, p.w_up, p.w_down, WGU, WD, scr, gw, NGW, lane);
    }
    xcd_barrier(bar);
    }
    _Pragma("unroll 1") for (int rep_ = 0; rep_ < REPS(1); ++rep_) {
    {
        pg8::DenseOrder S; S.init(XBF, DM, WIN, NTOK, NPROJ, DM, G, bx);
        pg8::EpiBf16 E{PROJ, NPROJ};
        pg8::gemm_phase<pg8::EpiBf16, pg8::DenseOrder, true>(lds, S, E, nullptr, wave_s);
    }
    xcd_barrier(bar);
    }
    unsigned char* DNA = (unsigned char*)p.out; unsigned char* DNU = ws + WS_A + 32 * MiB; bf16* ODN = (bf16*)(ws + WS_A);
    _Pragma("unroll 1") for (int rep_ = 0; rep_ < REPS(2); ++rep_) {
    dn_prep_phase<0>(lds, PROJ, p, DNA, DNU, G, vcu, wave_s);
    xcd_barrier(bar);
    }
    _Pragma("unroll 1") for (int rep_ = 0; rep_ < REPS(3); ++rep_) {
    dn_scan_phase(lds, DNA, DNU, ODN, vcu, wave_s);
    xcd_barrier(bar);
    }
    _Pragma("unroll 1") for (int rep_ = 0; rep_ < REPS(5); ++rep_) {
    sgu_phase(lds, PROJ, p, G, vcu, wave_s);
    { FRESH(); dn_final_phase(ODN, PROJ, p.dn_norm_w, gw, NGW, lane); }
    xcd_barrier(bar);
    }
    _Pragma("unroll 1") for (int rep_ = 0; rep_ < REPS(6); ++rep_) {
    {
        pg8::DenseOrder S; S.init(PROJ, NPROJ, WOUT, NTOK, DM, DM, G, bx);
        pg8::EpiBf16 E{(bf16*)(ws + WS_A), DM};
        pg8::gemm_phase<pg8::EpiBf16, pg8::DenseOrder, true>(lds, S, E, nullptr, wave_s);
    }
    xcd_barrier(bar);
    }
    {
        RouterArgs RA{p.x, (const bf16*)(ws + WS_A), p.out, H1BF, EID, WGT, LIST, CNT, p.ln1_g, p.ln1_b, p.w_rg, p.b_rg, (const float*)(ws + WS_WREP), p.b_re};
        router_phase(lds, RA, vcu * NWAVES + wave_s, G * NWAVES, wave_s);
    }
    xcd_barrier(bar);
    if (threadIdx.x == 0) { int s = 0; for (int e = 0; e < NEXP; ++e) { PREF[e] = s; s += ((CNT[e] + 255) >> 8) * 4; } PREF[NEXP] = s; }
    __syncthreads();
    _Pragma("unroll 1") for (int rep_ = 0; rep_ < REPS(7); ++rep_) {
    {
        pg8::GroupedOrder S{H1BF, WGU, LIST, PREF, DM, DM, 1024, NTOK, 1, 4, G, bx, NEXP};
        pg8::EpiHid E{HID, LIST, CNT, NTOK};
        pg8::gemm_phase<pg8::EpiHid, pg8::GroupedOrder, true>(lds, S, E, CNT, wave_s);
    }
    xcd_barrier(bar);
    }
    _Pragma("unroll 1") for (int rep_ = 0; rep_ < REPS(8); ++rep_) {
    {
        pg8::GroupedOrder S{HID, WD, LIST, PREF, DEXP, DEXP, 1024, NTOK, 0, 4, G, bx, NEXP};
        pg8::EpiYexp E{YEXP, LIST, WGT, NTOK};
        pg8::gemm_phase<pg8::EpiYexp, pg8::GroupedOrder, true>(lds, S, E, CNT, wave_s);
    }
    xcd_barrier(bar);
    }
    { FRESH(); final_phase(p.out, H1BF, YEXP, p.ln2_g, p.ln2_b, gw, NGW, lane); }
#if defined(GHOSTPREP)
    xcd_barrier(bar);
    dn_prep_phase<GHOSTPREP>(lds, (const bf16*)(ws + WS_B), p, ws + WS_C, ws + WS_C + 120 * MiB, G, vcu, wave_s);
#endif
#if defined(GHOST6)
    xcd_barrier(bar);
    { RouterArgs RA{p.out, (const bf16*)(ws + WS_A), (float*)(ws + WS_B), (bf16*)(ws + WS_C), (int*)(ws + WS_A), (float*)(ws + WS_A + 1 * MiB), (int*)(ws + WS_A + 2 * MiB), (int*)(ws + WS_CTL) + CW_CNT + 1024, p.ln1_g, p.ln1_b, p.w_rg, p.b_rg, (const float*)(ws + WS_WREP), p.b_re};
      router_phase(lds, RA, vcu * NWAVES + wave_s, G * NWAVES, wave_s); }
#endif
#if defined(GHOST9)
    xcd_barrier(bar);
    { FRESH(); final_phase((float*)(ws + WS_A), H1BF, (const bf16*)(ws + WS_C), p.ln2_g, p.ln2_b, gw, NGW, lane); }
#endif
}

extern "C" void kernel_launch(void* const* d_in, const int* in_sizes, int n_in, void* d_out, int out_size, void* d_ws, size_t ws_size, hipStream_t stream) {
    if (ws_size < WS_END || n_in != 22) { fprintf(stderr, "kernel_launch: bad ws/n_in\n"); return; }
    static int grid_blocks = 0;
    if (!grid_blocks) {
        int dev = 0, cus = 0, per_cu = 0;
        (void)hipGetDevice(&dev);
        (void)hipDeviceGetAttribute(&cus, hipDeviceAttributeMultiprocessorCount, dev);
        (void)hipFuncSetAttribute((const void*)fwd_megakernel, hipFuncAttributeMaxDynamicSharedMemorySize, (int)LDS_BYTES);
        (void)hipOccupancyMaxActiveBlocksPerMultiprocessor(&per_cu, (const void*)fwd_megakernel, NTHREADS, LDS_BYTES);
        if (per_cu < 1) { fprintf(stderr, "kernel_launch: occupancy query says %d\n", per_cu); per_cu = 1; }
        grid_blocks = cus;
    }
    (void)hipMemsetAsync((char*)d_ws + WS_CTL, 0, CTL_ZERO_BYTES, stream);
    MK a{}; bind(a.p, d_in, (float*)d_out); a.ws = (unsigned char*)d_ws;
    void* args[] = {&a};
    hipError_t e = hipLaunchCooperativeKernel((const void*)fwd_megakernel, dim3(grid_blocks), dim3(NTHREADS), args, LDS_BYTES, stream);
    if (e != hipSuccess) fprintf(stderr, "cooperative launch failed: %s (grid %d)\n", hipGetErrorString(e), grid_blocks);
}
```

```cpp
#include <hip/hip_runtime.h>
#include <hip/hip_cooperative_groups.h>
#include <cstdio>
#include <cstdint>
namespace cg = cooperative_groups;

namespace nv {
constexpr int INC = 3080;
struct P {
    const float *x, *w_in, *conv_w, *a_log, *dt_bias, *dn_norm_w, *sgu_ln_g, *sgu_ln_b, *w_spatial, *b_spatial, *w_out, *ln1_g, *ln1_b,
        *w_rg, *b_rg, *w_re, *b_re, *w_gate, *w_up, *w_down, *ln2_g, *ln2_b;
    float* out;
};
static inline void bind(P& p, void* const* in, float* out) {
    const float** f = (const float**)&p.x; for (int i = 0; i < 22; ++i) f[i] = (const float*)in[i];
    p.out = out;
}
}
namespace pg8 {
#define PG8_LAS __attribute__((address_space(3)))
typedef unsigned short bf16_t;
typedef short bf16x8 __attribute__((ext_vector_type(8)));
typedef float f32x4 __attribute__((ext_vector_type(4)));
typedef unsigned u32x4 __attribute__((ext_vector_type(4)));
typedef unsigned u32x2 __attribute__((ext_vector_type(2)));
constexpr int BM = 256, BK = 64, HALF = 128, HTB = HALF * BK * 2  , STAGE_BYTES = 8 * HTB, NXCD = 8, WGM = 8;

__host__ __device__ __forceinline__ int lds_byte(int r, int c) { const int st = (r >> 4) * 2 + (c >> 5), rr = r & 15, cc = c & 31, ob = rr * 64 + cc * 2; return st * 1024 + (ob ^ (((ob >> 9) & 1) << 5)); }
__host__ __device__ __forceinline__ void stage_rc(int b, int& R, int& C) { const int st = b / 1024, sb = b % 1024, swz = sb ^ (((sb >> 9) & 1) << 5); R = (st >> 1) * 16 + swz / 64; C = (st & 1) * 32 + (swz % 64) / 2; }
__host__ __device__ __forceinline__ int perm32(int rho) { const int n = rho >> 4, i = rho & 15; return 8 * (i >> 2) + 4 * n + (i & 3); }

struct Unit { int pm, pn, e, rows; };

typedef float f32x2_t __attribute__((ext_vector_type(2))); typedef __bf16 bf16x2_t __attribute__((ext_vector_type(2)));
__device__ __forceinline__ unsigned cvt_pk_bf16(float lo, float hi) { const f32x2_t v = {lo, hi}; const bf16x2_t b = __builtin_convertvector(v, bf16x2_t); return __builtin_bit_cast(unsigned, b); }

__device__ __forceinline__ int lane_id_fresh() { int l; asm volatile("v_mbcnt_lo_u32_b32 %0, -1, 0\n\tv_mbcnt_hi_u32_b32 %0, -1, %0" : "=v"(l)); return l; }
__device__ __forceinline__ int xcd_remap(int L, int nwg) { const int q = nwg / NXCD, r = nwg % NXCD, xcd = L % NXCD, off = L / NXCD; return (xcd < r ? xcd * (q + 1) : r * (q + 1) + (xcd - r) * q) + off; }

struct DenseOrder {
    const bf16_t* A; const bf16_t* Bt; int lda, K; int nM, nN, nwg, G, c;
    static constexpr bool GATHER = false;
    __device__ void init(const bf16_t* A_, int lda_, const bf16_t* Bt_, int M, int N, int K_, int G_, int c_) { A = A_; Bt = Bt_; lda = lda_; K = K_; nM = M / BM; nN = N / BM; nwg = nM * nN; G = G_; c = c_; }
    __device__ bool next(int i, Unit& u) const {
        const long L = (long)i * G + c; if (L >= nwg) return false;
        const int wgid = xcd_remap((int)L, nwg);
        const int nig = WGM * nN, gid = wgid / nig, fm = gid * WGM, gsz = (nM - fm) < WGM ? (nM - fm) : WGM;
        u.pm = fm + ((wgid % nig) % gsz); u.pn = (wgid % nig) / gsz; u.e = 0; u.rows = BM; return true;
    }
    __device__ __forceinline__ const char* a_base(const Unit& u) const { return (const char*)A + (size_t)u.pm * BM * lda * 2; }
    __device__ __forceinline__ const char* b_base(const Unit& u) const { return (const char*)Bt + (size_t)u.pn * BM * K * 2; }
    __device__ __forceinline__ void a_off(const Unit&, const int (&R)[2], const int (&C)[2], unsigned (&v)[4]) const {
#pragma unroll
        for (int h = 0; h < 2; ++h)
#pragma unroll
            for (int i = 0; i < 2; ++i) v[h * 2 + i] = (unsigned)((h * HALF + R[i]) * lda + C[i]) * 2u;
    }
};

struct GroupedOrder {
    const bf16_t* A; const bf16_t* Bt; const int* list; const PG8_LAS int* pref;
    int lda, K, N, cap, ashift, nN, G, c, ne;
    static constexpr bool GATHER = true;
    __device__ bool next(int i, Unit& u) const {
        const int nwg = pref[ne]; const long L = (long)i * G + c; if (L >= nwg) return false;
        const int w = xcd_remap((int)L, nwg);
        int e = 0; while (pref[e + 1] <= w) ++e;
        const int j = w - pref[e], ntm = (pref[e + 1] - pref[e]) / nN;
        u.e = e; u.pm = j % ntm; u.pn = j / ntm; u.rows = 0; return true;
    }
    __device__ __forceinline__ const char* a_base(const Unit&) const { return (const char*)A; }
    __device__ __forceinline__ const char* b_base(const Unit& u) const { return (const char*)Bt + ((size_t)u.e * N + (size_t)u.pn * BM) * K * 2; }
    __device__ __forceinline__ void a_off(const Unit& u, const int (&R)[2], const int (&C)[2], unsigned (&v)[4], int cnt) const {
        const int* lp = list + (size_t)u.e * cap;
#pragma unroll
        for (int h = 0; h < 2; ++h)
#pragma unroll
            for (int i = 0; i < 2; ++i) { int r = u.pm * BM + h * HALF + R[i]; if (r >= cnt) r = 0; const int a = (lp[r] & 0xffff) >> ashift; v[h * 2 + i] = (unsigned)(a * lda + C[i]) * 2u; }
    }
};

template <class Epi, class Sched, bool ALIGN_EPI>
__device__ __forceinline__ void gemm_phase(PG8_LAS unsigned char* lds, const Sched& S, const Epi& E, const int* gcnt, const int wave_s) {
    const int tid_ = wave_s * 64 + lane_id_fresh();
    const int tid = tid_, wid = wave_s, lane = tid & 63, wr = wid >> 2, wc = wid & 3, fr = lane & 15, fq = lane >> 4;
    const int K = S.K, nt = K / BK;
    int Rr[2], Cc[2]; unsigned voffB[2];
#pragma unroll
    for (int i = 0; i < 2; ++i) { int R, C; stage_rc(tid * 16 + i * 8192, R, C); const int Rb = Epi::PERM ? ((R & ~31) + perm32(R & 31)) : R; Rr[i] = R; Cc[i] = C; voffB[i] = (unsigned)(Rb * K + C) * 2u; }
    const size_t kstep = (size_t)(BK * 2);
    const size_t hstep = (size_t)HALF * K * 2;
    const unsigned ldsw = (unsigned)wid * 1024u;
    const int aoff = lds_byte(wr * 64 + fr, fq * 8), boff = lds_byte(wc * 32 + fr, fq * 8);
#define PG8_SA(b, h) (((b) * 2 + (h)) * HTB)
#define PG8_SB(b, h) ((4 + (b) * 2 + (h)) * HTB)
#define PG8_STAGE(bufoff, gbase, v0, v1) do { \
        __builtin_amdgcn_global_load_lds((const unsigned*)((const char*)(gbase) + (v0)), (PG8_LAS unsigned*)(lds + (bufoff) + ldsw), 16, 0, 0); \
        __builtin_amdgcn_global_load_lds((const unsigned*)((const char*)(gbase) + (v1)), (PG8_LAS unsigned*)(lds + (bufoff) + ldsw + 8192), 16, 0, 0); } while (0)
#define PG8_STAGEB(bufoff, gbase) PG8_STAGE(bufoff, gbase, voffB[0], voffB[1])
#define PG8_LDA(dst, b, h) do { _Pragma("unroll") for (int m = 0; m < 4; ++m) _Pragma("unroll") for (int k = 0; k < 2; ++k) dst[m][k] = *(const PG8_LAS bf16x8*)(lds + PG8_SA(b, h) + aoff + m * 2048 + k * 1024); } while (0)
#define PG8_LDB(dst, b, h) do { _Pragma("unroll") for (int n = 0; n < 2; ++n) _Pragma("unroll") for (int k = 0; k < 2; ++k) dst[n][k] = *(const PG8_LAS bf16x8*)(lds + PG8_SB(b, h) + boff + n * 2048 + k * 1024); } while (0)
#define PG8_MMA(ai, bj, At, Bt) do { __builtin_amdgcn_s_setprio(1); _Pragma("unroll") for (int m = 0; m < 4; ++m) _Pragma("unroll") for (int n = 0; n < 2; ++n) _Pragma("unroll") for (int k = 0; k < 2; ++k) \
        acc[ai][bj][m][n] = __builtin_amdgcn_mfma_f32_16x16x32_bf16(Bt[n][k], At[m][k], acc[ai][bj][m][n], 0, 0, 0); __builtin_amdgcn_s_setprio(0); } while (0)
#define PG8_WAIT_V(n) asm volatile("s_waitcnt vmcnt(" #n ")" ::: "memory")
#define PG8_WAIT_L(n) asm volatile("s_waitcnt lgkmcnt(" #n ")" ::: "memory")
#define PG8_BAR __builtin_amdgcn_s_barrier()
#define PG8_SCHED __builtin_amdgcn_sched_barrier(0)
    Unit cur, nxt; int ui = 0;
    if (!S.next(0, cur)) return;
    int ccnt = BM * 1024, ncnt = BM * 1024;
    if constexpr (Sched::GATHER) { ccnt = gcnt[cur.e]; }
    cur.rows = ccnt - cur.pm * BM;
    f32x4 acc[2][2][4][2];
#pragma unroll
    for (int a = 0; a < 2; ++a)
#pragma unroll
        for (int b = 0; b < 2; ++b)
#pragma unroll
            for (int m = 0; m < 4; ++m)
#pragma unroll
                for (int n = 0; n < 2; ++n) acc[a][b][m][n] = (f32x4){0.f, 0.f, 0.f, 0.f};
    bf16x8 At[4][2], B0[2][2], B1[2][2];
    unsigned va[4], vn[4];
    if constexpr (Sched::GATHER) S.a_off(cur, Rr, Cc, va, ccnt); else S.a_off(cur, Rr, Cc, va);
    const char* cA = S.a_base(cur); const char* cB = S.b_base(cur);
    PG8_STAGEB(PG8_SB(0, 0), cB); PG8_STAGEB(PG8_SB(0, 1), cB + hstep); PG8_STAGE(PG8_SA(0, 0), cA, va[0], va[1]); PG8_STAGE(PG8_SA(0, 1), cA, va[2], va[3]);
    if (wr == 1) PG8_BAR;
    PG8_WAIT_V(2); PG8_BAR;
    PG8_STAGEB(PG8_SB(1, 0), cB + kstep); PG8_STAGE(PG8_SA(1, 0), cA + kstep, va[0], va[1]); PG8_STAGEB(PG8_SB(1, 1), cB + hstep + kstep);
    PG8_WAIT_V(6); PG8_BAR;
    for (;;) {
        const bool has_next = S.next(ui + 1, nxt);
        const char* nA = cA; const char* nB = cB;
#pragma unroll
        for (int j = 0; j < 4; ++j) vn[j] = va[j];
        if (has_next) {
            nA = S.a_base(nxt); nB = S.b_base(nxt);
            if constexpr (Sched::GATHER) { ncnt = gcnt[nxt.e]; S.a_off(nxt, Rr, Cc, vn, ncnt); } else S.a_off(nxt, Rr, Cc, vn);
            nxt.rows = ncnt - nxt.pm * BM;
        }
        for (int t = 0; t < nt; t += 2) {
            const bool last = (t == nt - 2);
            const char* a1 = cA + (size_t)(t + 1) * kstep;
            const char* a2 = last ? nA : cA + (size_t)(t + 2) * kstep; const char* b2 = last ? nB : cB + (size_t)(t + 2) * kstep;
            const char* a3 = a2 + kstep; const char* b3 = b2 + kstep;
            unsigned w0 = va[0], w1 = va[1], w2 = va[2], w3 = va[3];
            if (last) { w0 = vn[0]; w1 = vn[1]; w2 = vn[2]; w3 = vn[3]; }
            PG8_LDB(B0, 0, 0); PG8_LDB(B1, 0, 1); PG8_SCHED; PG8_LDA(At, 0, 0); PG8_STAGE(PG8_SA(1, 1), a1, va[2], va[3]);
            PG8_WAIT_V(8); PG8_WAIT_L(0); PG8_BAR; PG8_MMA(0, 0, At, B0); PG8_MMA(0, 1, At, B1); PG8_BAR; PG8_SCHED;
            PG8_LDA(At, 0, 1); PG8_STAGEB(PG8_SB(0, 0), b2); PG8_STAGEB(PG8_SB(0, 1), b2 + hstep); PG8_STAGE(PG8_SA(0, 0), a2, w0, w1);
            PG8_WAIT_V(8); PG8_WAIT_L(0); PG8_BAR; PG8_MMA(1, 0, At, B0); PG8_MMA(1, 1, At, B1); PG8_BAR; PG8_SCHED;
            PG8_LDB(B0, 1, 0); PG8_LDB(B1, 1, 1); PG8_SCHED; PG8_LDA(At, 1, 0); PG8_STAGE(PG8_SA(0, 1), a2, w2, w3);
            PG8_WAIT_V(8); PG8_WAIT_L(0); PG8_BAR; PG8_MMA(0, 0, At, B0); PG8_MMA(0, 1, At, B1); PG8_BAR; PG8_SCHED;
            PG8_LDA(At, 1, 1); PG8_STAGEB(PG8_SB(1, 0), b3); PG8_STAGEB(PG8_SB(1, 1), b3 + hstep); PG8_STAGE(PG8_SA(1, 0), a3, w0, w1);
            PG8_WAIT_V(8); PG8_WAIT_L(0); PG8_BAR; PG8_MMA(1, 0, At, B0); PG8_MMA(1, 1, At, B1); PG8_BAR; PG8_SCHED;
        }
        if constexpr (ALIGN_EPI) { if (wr == 0) PG8_BAR; }
        E(acc, cur, wr, wc, fr, fq);
        if (!has_next) break;
#pragma unroll
        for (int a = 0; a < 2; ++a)
#pragma unroll
            for (int b = 0; b < 2; ++b)
#pragma unroll
                for (int m = 0; m < 4; ++m)
#pragma unroll
                    for (int n = 0; n < 2; ++n) acc[a][b][m][n] = (f32x4){0.f, 0.f, 0.f, 0.f};
        cur = nxt; cA = nA; cB = nB; ++ui;
#pragma unroll
        for (int j = 0; j < 4; ++j) va[j] = vn[j];
        if constexpr (ALIGN_EPI) { if (wr == 1) PG8_BAR; }
    }
    PG8_WAIT_V(0);
    if constexpr (!ALIGN_EPI) { if (wr == 0) PG8_BAR; }
    PG8_BAR;
#undef PG8_SA
#undef PG8_SB
#undef PG8_STAGE
#undef PG8_STAGEB
#undef PG8_LDA
#undef PG8_LDB
#undef PG8_MMA
#undef PG8_WAIT_V
#undef PG8_WAIT_L
#undef PG8_BAR
#undef PG8_SCHED
}

struct EpiBf16 {
    static constexpr bool PERM = true;
    bf16_t* O; int ldc;
    __device__ __forceinline__ void operator()(const f32x4 (&acc)[2][2][4][2], const Unit& u, int wr, int wc, int fr, int fq) const {
        const int row0 = u.pm * BM + wr * 64 + fr, col0 = u.pn * BM + wc * 32 + 8 * fq;
#pragma unroll
        for (int ai = 0; ai < 2; ++ai)
#pragma unroll
            for (int m = 0; m < 4; ++m) { bf16_t* rowp = O + (size_t)(row0 + ai * HALF + m * 16) * ldc + col0;
#pragma unroll
                for (int bj = 0; bj < 2; ++bj) { const f32x4 v0 = acc[ai][bj][m][0], v1 = acc[ai][bj][m][1];
                    u32x4 w; w.x = cvt_pk_bf16(v0[0], v0[1]); w.y = cvt_pk_bf16(v0[2], v0[3]); w.z = cvt_pk_bf16(v1[0], v1[1]); w.w = cvt_pk_bf16(v1[2], v1[3]);
                    *(u32x4*)(rowp + bj * HALF) = w; } }
    }
};
}
#define GAS __attribute__((address_space(1)))
#define LAS __attribute__((address_space(3)))
typedef unsigned short bf16;
typedef unsigned v4u __attribute__((ext_vector_type(4)));
typedef float f32x4 __attribute__((ext_vector_type(4)));
typedef short bf16x8 __attribute__((ext_vector_type(8)));
typedef GAS unsigned gu32;
typedef GAS unsigned long long gu64;
#define RLX_AGENT __ATOMIC_RELAXED, __HIP_MEMORY_SCOPE_AGENT
#define LDS_WAIT() asm volatile("s_waitcnt lgkmcnt(0)" ::: "memory")
#define VM_WAIT() asm volatile("s_waitcnt vmcnt(0)" ::: "memory")
__device__ __forceinline__ unsigned long long rt() { return __builtin_amdgcn_s_memrealtime(); }
__device__ __forceinline__ unsigned f2bf(float f) { unsigned u = __builtin_bit_cast(unsigned, f); return (u + 0x7fffu + ((u >> 16) & 1u)) >> 16; }
__device__ __forceinline__ unsigned pk2(float lo, float hi) { return f2bf(lo) | (f2bf(hi) << 16); }

#define XB_TMO      128
#define XB_XCNT(j)  (256  + 64 * (j))
#define XB_XSUB(j)  (1280 + 64 * (j))
#define XB_XGEN(j)  (2304 + 64 * (j))
#define XB_TOP      3328
#define XB_TOPGEN   3392
#define XCD_BAR_WORDS 3456
#define XB_SPIN_CAP (1u << 18)

__device__ __forceinline__ unsigned xb_ld(unsigned* p)              { return __hip_atomic_load(p, __ATOMIC_RELAXED, __HIP_MEMORY_SCOPE_AGENT); }
__device__ __forceinline__ unsigned xb_add(unsigned* p, unsigned v) { return __hip_atomic_fetch_add(p, v, __ATOMIC_RELAXED, __HIP_MEMORY_SCOPE_AGENT); }
__device__ __forceinline__ unsigned xb_xcc_id() { return (unsigned)__builtin_amdgcn_s_getreg((3 << 11) | 20) & 0xFu; }
#define XB_SPIN(cond, bar) do { unsigned _sp = 0; while (cond) { __builtin_amdgcn_s_sleep(1); \
    if ((++_sp & 255u) == 0u) { if (xb_ld(&(bar)[XB_TMO])) break; if (_sp > XB_SPIN_CAP) { atomicAdd(&(bar)[XB_TMO], 1u); break; } } } } while (0)

struct XcdBarrier {
    unsigned* bar; unsigned x;
    volatile LAS unsigned* st;
};

__device__ __forceinline__ XcdBarrier xcd_barrier_post(unsigned* bar, volatile LAS unsigned* st) {
    XcdBarrier b; b.bar = bar; b.x = xb_xcc_id(); b.st = st;
    if (threadIdx.x == 0) (void)xb_add(&bar[XB_XCNT(b.x)], 1u);
    return b;
}
__device__ __forceinline__ void xcd_barrier_complete(unsigned* bar, unsigned x, unsigned& nloc, unsigned& nx) {
    const unsigned G = gridDim.x * gridDim.y * gridDim.z;
    unsigned sum, cnt, mine, sp = 0u;
    for (;;) {
        sum = 0u; cnt = 0u; mine = 0u;
#pragma unroll
        for (unsigned j = 0; j < 16; ++j) { const unsigned c = xb_ld(&bar[XB_XCNT(j)]); sum += c; cnt += (c > 0u) ? 1u : 0u; mine = (j == x) ? c : mine; }
        if (sum == G) break;
        __builtin_amdgcn_s_sleep(1);
        if ((++sp & 255u) == 0u) { if (xb_ld(&bar[XB_TMO])) break; if (sp > XB_SPIN_CAP) { atomicAdd(&bar[XB_TMO], 1u); break; } }
    }
    nloc = mine > 0u ? mine : 1u; nx = cnt > 0u ? cnt : 1u;
}

__device__ __forceinline__ void xcd_barrier(const XcdBarrier& b) {
    asm volatile("s_waitcnt vmcnt(0)" ::: "memory");
    __syncthreads();
    if (threadIdx.x == 0) {
        unsigned* bar = b.bar;
        __builtin_amdgcn_s_waitcnt(0);
        unsigned nloc = b.st[0], nx = b.st[1];
        if (nloc == 0u) { xcd_barrier_complete(bar, b.x, nloc, nx); b.st[0] = nloc; b.st[1] = nx; }
        const unsigned old = xb_add(&bar[XB_XSUB(b.x)], 1u);
        const unsigned gen = old / nloc;
        if (old + 1u == (gen + 1u) * nloc) {
            __builtin_amdgcn_fence(__ATOMIC_RELEASE, "agent");
            asm volatile("s_waitcnt vmcnt(0)" ::: "memory");
            const unsigned og = xb_add(&bar[XB_TOP], 1u);
            const unsigned tg = og / nx;
            if (og + 1u == (tg + 1u) * nx) xb_add(&bar[XB_TOPGEN], 1u);
            else XB_SPIN(xb_ld(&bar[XB_TOPGEN]) == tg, bar);
            __builtin_amdgcn_fence(__ATOMIC_ACQUIRE, "agent");
            xb_add(&bar[XB_XGEN(b.x)], 1u);
            asm volatile("s_waitcnt vmcnt(0)" ::: "memory");
        } else {
            XB_SPIN(xb_ld(&bar[XB_XGEN(b.x)]) == gen, bar);
            __builtin_amdgcn_fence(__ATOMIC_ACQUIRE, "agent");
            asm volatile("s_waitcnt vmcnt(0)" ::: "memory");
        }
    }
    __syncthreads();
}

constexpr int NTOK = 32768, DM = 1024, NPROJ = 3328;
constexpr int PC_Q = 0, PC_K = 512, PC_V = 1024, PC_Z = 1536, PC_U = 2048, PC_VS = 2560, PC_B = 3072, PC_A = 3076;
constexpr int NEXP = 64, DEXP = 512;
constexpr size_t MiB = 1u << 20;
constexpr size_t WS_CTL = 0, CTL_ZERO_BYTES = 1 * MiB;
constexpr size_t WS_WIN = 1 * MiB, WS_WOUT = 8 * MiB, WS_LIST = 10 * MiB, WS_ROUTE = 18 * MiB;
constexpr size_t WS_WREP = 19 * MiB;
constexpr size_t WS_C = 20 * MiB;
constexpr size_t WS_WGU = WS_C, WS_WD = WS_C + 128 * MiB;
constexpr size_t WS_A = 212 * MiB;
constexpr size_t WS_B = 276 * MiB;
constexpr size_t WS_H1BF = WS_B, WS_YEXP = WS_B + 64 * MiB;
constexpr size_t WS_END = 484 * MiB;
constexpr int CW_BAR = 4096;
constexpr int CW_CNT = 16384;
constexpr int RING_BYTES = 131072, LDSCTL_OFF = RING_BYTES, MISC_OFF = LDSCTL_OFF + 320, PREF_OFF = MISC_OFF + 128, LDS_BYTES = 147456;
constexpr int NTHREADS = 512, NWAVES = 8;
#ifndef GEMM_WGS_N
#define GEMM_WGS_N 192
#endif
constexpr int GEMM_WGS = GEMM_WGS_N;
constexpr float ALPHA_F = 1.189207115002721f;

__device__ __forceinline__ float bf2f(unsigned short v) { return __builtin_bit_cast(float, (unsigned)v << 16); }
__device__ __forceinline__ float wave_sum(float v) {
#pragma unroll
    for (int o = 1; o < 64; o <<= 1) v += __shfl_xor(v, o);
    return v;
}

__device__ __forceinline__ void p0_item_load(const float* W, int ldw, int k0, int n0src, int lane, float (&r)[32]) {
#pragma unroll
    for (int i = 0; i < 32; ++i) r[i] = W[(size_t)(k0 + 2 * i + (lane >> 5)) * ldw + n0src + (lane & 31)];
}
__device__ __forceinline__ void p0_item_store(const float (&r)[32], int K, int k0, bf16* WT, int dst_row0, LAS float* scr, int lane) {
#pragma unroll
    for (int i = 0; i < 32; ++i) scr[(2 * i + (lane >> 5)) * 33 + (lane & 31)] = r[i];
    LDS_WAIT(); asm volatile("" ::: "memory");
    const int c = lane & 7;
#pragma unroll
    for (int j = 0; j < 4; ++j) { const int n = (lane >> 3) + 8 * j; const LAS float* s = scr + (8 * c) * 33 + n;
        v4u o; o.x = pk2(s[0 * 33], s[1 * 33]); o.y = pk2(s[2 * 33], s[3 * 33]); o.z = pk2(s[4 * 33], s[5 * 33]); o.w = pk2(s[6 * 33], s[7 * 33]);
        *(GAS v4u*)(WT + (size_t)(dst_row0 + n) * K + k0 + 8 * c) = o; }
    LDS_WAIT(); asm volatile("" ::: "memory");
}
__device__ __forceinline__ void p0_transpose_item(const float* W, int ldw, int K, int k0, int n0src, bf16* WT, int dst_row0, LAS float* scr, int lane) {
    float r[32]; p0_item_load(W, ldw, k0, n0src, lane, r); p0_item_store(r, K, k0, WT, dst_row0, scr, lane);
}
struct P0Exp { const float* W; bf16* WT; int ldw, K, k0, n0, drow; };
__device__ __forceinline__ P0Exp p0_exp_item(int it, const float* wg, const float* wu, const float* wd, bf16* WGU, bf16* WD) {
    P0Exp x;
    if (it < 32768) { const int nb = it & 15, kb = (it >> 4) & 15, half = (it >> 8) & 1, e = it >> 9, n0 = nb * 32;
        x.W = (half ? wu : wg) + (size_t)e * DM * DEXP; x.WT = WGU + (size_t)e * 1024 * DM; x.ldw = DEXP; x.K = DM; x.k0 = kb * 64; x.n0 = n0; x.drow = (n0 >> 7) * 256 + half * 128 + (n0 & 127); }
    else { const int i2 = it - 32768, nb = i2 & 31, kb = (i2 >> 5) & 7, e = i2 >> 8;
        x.W = wd + (size_t)e * DEXP * DM; x.WT = WD + (size_t)e * DM * DEXP; x.ldw = DM; x.K = DEXP; x.k0 = kb * 64; x.n0 = nb * 32; x.drow = nb * 32; }
    return x;
}
__device__ __forceinline__ void p0_experts(const float* wg, const float* wu, const float* wd, bf16* WGU, bf16* WD, LAS float* scr, int gw, int NGW, int lane) {
    constexpr int NIT = 32768 + 16384;
    int it = gw; if (it >= NIT) return;
    float cur[32], nxt[32];
    P0Exp xc = p0_exp_item(it, wg, wu, wd, WGU, WD); p0_item_load(xc.W, xc.ldw, xc.k0, xc.n0, lane, cur);
    for (;;) {
        const int itn = it + NGW; const bool more = itn < NIT; P0Exp xn = xc;
        if (more) { xn = p0_exp_item(itn, wg, wu, wd, WGU, WD); p0_item_load(xn.W, xn.ldw, xn.k0, xn.n0, lane, nxt); }
        p0_item_store(cur, xc.K, xc.k0, xc.WT, xc.drow, scr, lane);
        if (!more) break;
#pragma unroll
        for (int i = 0; i < 32; ++i) cur[i] = nxt[i];
        xc = xn; it = itn;
    }
}

struct MK {
    nv::P p;
    unsigned char* ws;
};

namespace pg8 {
__device__ __forceinline__ float silu_f(float x) { return x * __builtin_amdgcn_rcpf(1.f + __builtin_amdgcn_exp2f(-1.4426950408889634f * x)); }
struct EpiHid {
    static constexpr bool PERM = true;
    bf16_t* HID; const int* list; const int* cnt; int cap;
    __device__ __forceinline__ void operator()(const f32x4 (&acc)[2][2][4][2], const Unit& u, int wr, int wc, int fr, int fq) const {
        const int* lp = list + (size_t)u.e * cap; const int col0 = u.pn * 128 + wc * 32 + 8 * fq;
#pragma unroll
        for (int ai = 0; ai < 2; ++ai)
#pragma unroll
            for (int m = 0; m < 4; ++m) { const int r = ai * HALF + wr * 64 + m * 16 + fr;
                if (r < u.rows) { const int a = lp[u.pm * BM + r] & 0xffff;
                    const f32x4 g0 = acc[ai][0][m][0], g1 = acc[ai][0][m][1], u0 = acc[ai][1][m][0], u1 = acc[ai][1][m][1];
                    u32x4 w; w.x = cvt_pk_bf16(silu_f(g0[0]) * u0[0], silu_f(g0[1]) * u0[1]); w.y = cvt_pk_bf16(silu_f(g0[2]) * u0[2], silu_f(g0[3]) * u0[3]);
                    w.z = cvt_pk_bf16(silu_f(g1[0]) * u1[0], silu_f(g1[1]) * u1[1]); w.w = cvt_pk_bf16(silu_f(g1[2]) * u1[2], silu_f(g1[3]) * u1[3]);
                    *(u32x4*)(HID + (size_t)a * 512 + col0) = w; } }
    }
};
struct EpiYexp {
    static constexpr bool PERM = true;
    bf16_t* Y; const int* list; const float* wgt; int cap;
    __device__ __forceinline__ void operator()(const f32x4 (&acc)[2][2][4][2], const Unit& u, int wr, int wc, int fr, int fq) const {
        const int* lp = list + (size_t)u.e * cap; const int col0 = u.pn * BM + wc * 32 + 8 * fq;
#pragma unroll
        for (int ai = 0; ai < 2; ++ai)
#pragma unroll
            for (int m = 0; m < 4; ++m) { const int r = ai * HALF + wr * 64 + m * 16 + fr;
                if (r < u.rows) { const unsigned ent = (unsigned)lp[u.pm * BM + r]; const int a = (int)(ent & 0xffffu); const float w8 = __builtin_bit_cast(float, ent & 0xffff0000u);
#pragma unroll
                    for (int bj = 0; bj < 2; ++bj) { const f32x4 v0 = acc[ai][bj][m][0] * w8, v1 = acc[ai][bj][m][1] * w8;
                        u32x4 w; w.x = cvt_pk_bf16(v0[0], v0[1]); w.y = cvt_pk_bf16(v0[2], v0[3]); w.z = cvt_pk_bf16(v1[0], v1[1]); w.w = cvt_pk_bf16(v1[2], v1[3]);
                        *(u32x4*)(Y + (size_t)a * 1024 + col0 + bj * HALF) = w; } } }
    }
};

struct EpiZ1 {
    static constexpr bool PERM = false;
    float* O; const float* X; float alpha;
    __device__ __forceinline__ void operator()(const f32x4 (&acc)[2][2][4][2], const Unit& u, int wr, int wc, int fr, int fq) const {
        const int row0 = u.pm * BM + wr * 64 + fr, col0 = u.pn * BM + wc * 32 + 4 * fq;
#pragma unroll
        for (int ai = 0; ai < 2; ++ai)
#pragma unroll
            for (int m = 0; m < 4; ++m) { const size_t off = (size_t)(row0 + ai * HALF + m * 16) * 1024 + col0;
#pragma unroll
                for (int bj = 0; bj < 2; ++bj)
#pragma unroll
                    for (int n = 0; n < 2; ++n) { const f32x4 xv = *(const f32x4*)(X + off + bj * HALF + n * 16); *(f32x4*)(O + off + bj * HALF + n * 16) = acc[ai][bj][m][n] + xv * alpha; } }
    }
};
}


typedef short s16x4 __attribute__((ext_vector_type(4)));
typedef short v4i16_t __attribute__((ext_vector_type(4)));
__device__ __forceinline__ unsigned off_b(unsigned row, unsigned ch) { return 256u * row + 16u * (ch ^ (((row & 3) << 2) | ((row >> 2) & 3))); }
__device__ __forceinline__ s16x4 vtr(LAS unsigned char* p) { return __builtin_bit_cast(s16x4, __builtin_amdgcn_ds_read_tr16_b64_v4i16((LAS v4i16_t*)p)); }
__device__ __forceinline__ float gelu_tanh(float x) { return x * __builtin_amdgcn_rcpf(1.f + __builtin_amdgcn_exp2f(-2.3022081986f * (x + 0.044715f * x * x * x))); }

__device__ __forceinline__ void sgu_phase(LAS unsigned char* lds, bf16* PROJ, const nv::P& p, int G, int vcu, int wave_s) {
    const int lane = pg8::lane_id_fresh(), tid = wave_s * 64 + lane;
    const int g4 = lane >> 4, q = (lane & 15) >> 2, pp = lane & 3, l15 = lane & 15;
    v4u rawn[4];
    { const int u0 = vcu < 1024 ? vcu : 0; const bf16* src = PROJ + ((size_t)(u0 >> 2) * 128 + (tid >> 2)) * NPROJ + PC_VS + (u0 & 3) * 128 + (tid & 3) * 32;
#pragma unroll
      for (int i = 0; i < 4; ++i) rawn[i] = *(const GAS v4u*)(src + 8 * i); }
    for (int u = vcu; u < 1024; u += G) {
        const int g = u & 3, bc = u >> 2; const size_t row0 = (size_t)bc * 128;
        {
            const int s = tid >> 2, qt = tid & 3;
            v4u raw[4];
#pragma unroll
            for (int i = 0; i < 4; ++i) raw[i] = rawn[i];
            { const int un = (u + G < 1024) ? u + G : u; const bf16* srcn = PROJ + ((size_t)(un >> 2) * 128 + s) * NPROJ + PC_VS + (un & 3) * 128 + qt * 32;
#pragma unroll
              for (int i = 0; i < 4; ++i) rawn[i] = *(const GAS v4u*)(srcn + 8 * i); }
            float x[32]; float s1 = 0.f;
#pragma unroll
            for (int i = 0; i < 4; ++i)
#pragma unroll
                for (int c = 0; c < 4; ++c) { const unsigned w = raw[i][c]; const float a = gelu_tanh(__builtin_bit_cast(float, w << 16)), b = gelu_tanh(__builtin_bit_cast(float, w & 0xffff0000u)); x[i * 8 + c * 2] = a; x[i * 8 + c * 2 + 1] = b; s1 += a + b; }
            s1 += __shfl_xor(s1, 1); s1 += __shfl_xor(s1, 2);
            const float mean = s1 * (1.f / 128.f); float s2 = 0.f;
#pragma unroll
            for (int i = 0; i < 32; ++i) { x[i] -= mean; s2 += x[i] * x[i]; }
            s2 += __shfl_xor(s2, 1); s2 += __shfl_xor(s2, 2);
            const float rstd = 1.f / sqrtf(s2 * (1.f / 128.f) + 1e-5f);
            const float* lg = p.sgu_ln_g + g * 128 + qt * 32; const float* lb = p.sgu_ln_b + g * 128 + qt * 32;
#pragma unroll
            for (int i = 0; i < 4; ++i) { const f32x4 g0 = *(const GAS f32x4*)(lg + 8 * i), g1 = *(const GAS f32x4*)(lg + 8 * i + 4), b0 = *(const GAS f32x4*)(lb + 8 * i), b1 = *(const GAS f32x4*)(lb + 8 * i + 4);
                v4u o; o.x = pk2(x[8 * i] * rstd * g0.x + b0.x, x[8 * i + 1] * rstd * g0.y + b0.y); o.y = pk2(x[8 * i + 2] * rstd * g0.z + b0.z, x[8 * i + 3] * rstd * g0.w + b0.w);
                o.z = pk2(x[8 * i + 4] * rstd * g1.x + b1.x, x[8 * i + 5] * rstd * g1.y + b1.y); o.w = pk2(x[8 * i + 6] * rstd * g1.z + b1.z, x[8 * i + 7] * rstd * g1.w + b1.w);
                *(LAS v4u*)(lds + off_b((unsigned)s, (unsigned)(qt * 4 + i))) = o; }
        }
        __syncthreads();
        {
            const int w = wave_s, t = 16 * w + l15, nks = (w >> 1) + 1;
            bf16* rowp = PROJ + (row0 + t) * NPROJ;
            unsigned long long uu8[8];
#pragma unroll
            for (int dt = 0; dt < 8; ++dt) uu8[dt] = *(const GAS unsigned long long*)(rowp + PC_U + g * 128 + 16 * dt + 4 * g4);
            const float bias = p.b_spatial[g * 128 + t];
            f32x4 acc[8];
#pragma unroll
            for (int dt = 0; dt < 8; ++dt) acc[dt] = (f32x4){0.f, 0.f, 0.f, 0.f};
            for (int ks = 0; ks < nks; ++ks) {
                const int sb = 32 * ks + 8 * g4;
                const float* wp = p.w_spatial + ((size_t)(g * 128 + t)) * 128 + sb;
                const f32x4 w0 = *(const GAS f32x4*)wp, w1 = *(const GAS f32x4*)(wp + 4);
                float wv[8] = {w0.x, w0.y, w0.z, w0.w, w1.x, w1.y, w1.z, w1.w};
#pragma unroll
                for (int j = 0; j < 8; ++j) if (sb + j > t) wv[j] = 0.f;
                v4u bw; bw.x = pk2(wv[0], wv[1]); bw.y = pk2(wv[2], wv[3]); bw.z = pk2(wv[4], wv[5]); bw.w = pk2(wv[6], wv[7]);
                const bf16x8 bfrag = __builtin_bit_cast(bf16x8, bw);
#pragma unroll
                for (int dt = 0; dt < 8; ++dt) {
                    const s16x4 lo = vtr(lds + off_b((unsigned)(sb + q), (unsigned)(2 * dt + (pp >> 1))) + 8 * (pp & 1));
                    const s16x4 hi = vtr(lds + off_b((unsigned)(sb + 4 + q), (unsigned)(2 * dt + (pp >> 1))) + 8 * (pp & 1));
                    const bf16x8 afrag = (bf16x8){lo[0], lo[1], lo[2], lo[3], hi[0], hi[1], hi[2], hi[3]};
                    acc[dt] = __builtin_amdgcn_mfma_f32_16x16x32_bf16(afrag, bfrag, acc[dt], 0, 0, 0);
                }
            }
#pragma unroll
            for (int dt = 0; dt < 8; ++dt) {
                const int d = g * 128 + 16 * dt + 4 * g4;
                const unsigned long long uu = uu8[dt];
                const float u0 = gelu_tanh(bf2f((unsigned short)uu)), u1 = gelu_tanh(bf2f((unsigned short)(uu >> 16))), u2 = gelu_tanh(bf2f((unsigned short)(uu >> 32))), u3 = gelu_tanh(bf2f((unsigned short)(uu >> 48)));
                const unsigned long long o = (unsigned long long)pk2(u0 * (acc[dt][0] + bias), u1 * (acc[dt][1] + bias)) | ((unsigned long long)pk2(u2 * (acc[dt][2] + bias), u3 * (acc[dt][3] + bias)) << 32);
                *(GAS unsigned long long*)(rowp + 512 + d) = o;
            }
        }
        __syncthreads();
    }
}

constexpr int DNA_PIECES = 57, DNU_PIECES = 2, DN_STEP_BYTES = (DNA_PIECES + DNU_PIECES) * 1024;
constexpr size_t DNA_CHUNK_BYTES = (size_t)DNA_PIECES * 1024, DNU_CHUNK_BYTES = 8 * DNU_PIECES * 1024;
__device__ __forceinline__ void glds16(const void* gsrc, LAS unsigned char* dst) { __builtin_amdgcn_global_load_lds((const unsigned*)gsrc, (LAS unsigned*)dst, 16, 0, 0); }
typedef float f32x2_t __attribute__((ext_vector_type(2))); typedef __bf16 bf16x2_t __attribute__((ext_vector_type(2)));
__device__ __forceinline__ unsigned cvtpk(float lo, float hi) { const f32x2_t v = {lo, hi}; const bf16x2_t b = __builtin_convertvector(v, bf16x2_t); return __builtin_bit_cast(unsigned, b); }

constexpr int DN_RING_PIECES = 42, DN_SLOT_BYTES = DN_RING_PIECES * 1024;
__device__ __forceinline__ void dn_scan_phase(LAS unsigned char* lds, const unsigned char* DNA, const unsigned char* DNU, bf16* ODN, int vcu, int wave_s) {
    if (vcu >= 256) return;
    const int lane = pg8::lane_id_fresh();
    const int bh = vcu >> 3, sl = vcu & 7, l15 = lane & 15, g4 = lane >> 4;
    const unsigned char* a_src = DNA + (size_t)bh * 64 * DNA_CHUNK_BYTES + lane * 16;
    const unsigned char* u_src = DNU + ((size_t)bh * 64 * 8 + sl) * (DNU_PIECES * 1024) + lane * 16;
#define DN_STAGE(step) do { if (wave_s >= 1 && wave_s <= 6) { const unsigned char* as_ = a_src + (size_t)(step) * DNA_CHUNK_BYTES; const unsigned char* us_ = u_src + (size_t)(step) * DNU_CHUNK_BYTES; \
        LAS unsigned char* sp_ = lds + ((step) % 3) * DN_SLOT_BYTES; \
        _Pragma("unroll") for (int i_ = 0; i_ < 7; ++i_) { const int p_ = (wave_s - 1) + 6 * i_; \
            const unsigned char* g_ = p_ < 16 ? as_ + p_ * 1024 : p_ < 32 ? as_ + (16 + p_) * 1024 : p_ < 40 ? as_ + (16 + p_) * 1024 : us_ + (p_ - 40) * 1024; \
            glds16(g_, sp_ + p_ * 1024); } } } while (0)
    DN_STAGE(0); DN_STAGE(1);
    if (wave_s != 0) {
        for (int n = 0; n < 64; ++n) {
            if (n < 63) asm volatile("s_waitcnt vmcnt(7)" ::: "memory"); else asm volatile("s_waitcnt vmcnt(0)" ::: "memory");
            __builtin_amdgcn_s_barrier();
            asm volatile("" ::: "memory");
            if (n + 2 < 64) DN_STAGE(n + 2);
        }
        asm volatile("s_waitcnt vmcnt(0)" ::: "memory");
        return;
    }
#undef DN_STAGE
    f32x4 S[8];
#pragma unroll
    for (int k = 0; k < 8; ++k) S[k] = (f32x4){0.f, 0.f, 0.f, 0.f};
    bf16x8 Qc[16], Qn[16]; float glc, gln;
#pragma unroll
    for (int i = 0; i < 16; ++i) Qc[i] = *(const GAS bf16x8*)(a_src + (16 + i) * 1024);
    glc = *(const GAS float*)(a_src + 56 * 1024);
    bf16* orow = ODN + (size_t)vcu * (64 * 64 * 16) + l15;
    for (int n = 0; n < 64; ++n) {
        asm volatile("s_waitcnt lgkmcnt(0)" ::: "memory");
        __builtin_amdgcn_s_barrier();
        asm volatile("" ::: "memory");
        { const unsigned char* nx = a_src + (size_t)(n + 1 < 64 ? n + 1 : n) * DNA_CHUNK_BYTES;
#pragma unroll
          for (int i = 0; i < 16; ++i) Qn[i] = *(const GAS bf16x8*)(nx + (16 + i) * 1024);
          gln = *(const GAS float*)(nx + 56 * 1024); }
        LAS unsigned char* lb = lds + (n % 3) * DN_SLOT_BYTES + lane * 16;
#define FRAG(piece) (*(const LAS bf16x8*)(lb + (piece) * 1024))
        bf16x8 Sb[4];
#pragma unroll
        for (int ks = 0; ks < 4; ++ks) { v4u w; w.x = cvtpk(S[2 * ks][0], S[2 * ks][1]); w.y = cvtpk(S[2 * ks][2], S[2 * ks][3]); w.z = cvtpk(S[2 * ks + 1][0], S[2 * ks + 1][1]); w.w = cvtpk(S[2 * ks + 1][2], S[2 * ks + 1][3]); Sb[ks] = __builtin_bit_cast(bf16x8, w); }
        f32x4 P[4];
        { const v4u u0 = *(const LAS v4u*)(lb + 40 * 1024), u1 = *(const LAS v4u*)(lb + 41 * 1024);
          P[0] = (f32x4){__builtin_bit_cast(float, u0.x << 16), __builtin_bit_cast(float, u0.x & 0xffff0000u), __builtin_bit_cast(float, u0.y << 16), __builtin_bit_cast(float, u0.y & 0xffff0000u)};
          P[1] = (f32x4){__builtin_bit_cast(float, u0.z << 16), __builtin_bit_cast(float, u0.z & 0xffff0000u), __builtin_bit_cast(float, u0.w << 16), __builtin_bit_cast(float, u0.w & 0xffff0000u)};
          P[2] = (f32x4){__builtin_bit_cast(float, u1.x << 16), __builtin_bit_cast(float, u1.x & 0xffff0000u), __builtin_bit_cast(float, u1.y << 16), __builtin_bit_cast(float, u1.y & 0xffff0000u)};
          P[3] = (f32x4){__builtin_bit_cast(float, u1.z << 16), __builtin_bit_cast(float, u1.z & 0xffff0000u), __builtin_bit_cast(float, u1.w << 16), __builtin_bit_cast(float, u1.w & 0xffff0000u)}; }
#pragma unroll
        for (int mt = 0; mt < 4; ++mt)
#pragma unroll
            for (int ks = 0; ks < 4; ++ks) P[mt] = __builtin_amdgcn_mfma_f32_16x16x32_bf16(FRAG(mt * 4 + ks), Sb[ks], P[mt], 0, 0, 0);
        bf16x8 Vb[2];
#pragma unroll
        for (int ks = 0; ks < 2; ++ks) { v4u w; w.x = cvtpk(P[2 * ks][0], P[2 * ks][1]); w.y = cvtpk(P[2 * ks][2], P[2 * ks][3]); w.z = cvtpk(P[2 * ks + 1][0], P[2 * ks + 1][1]); w.w = cvtpk(P[2 * ks + 1][2], P[2 * ks + 1][3]); Vb[ks] = __builtin_bit_cast(bf16x8, w); }
        f32x4 O[4];
#pragma unroll
        for (int mt = 0; mt < 4; ++mt) { O[mt] = (f32x4){0.f, 0.f, 0.f, 0.f};
#pragma unroll
            for (int ks = 0; ks < 4; ++ks) O[mt] = __builtin_amdgcn_mfma_f32_16x16x32_bf16(Qc[mt * 4 + ks], Sb[ks], O[mt], 0, 0, 0);
#pragma unroll
            for (int ks = 0; ks < 2; ++ks) O[mt] = __builtin_amdgcn_mfma_f32_16x16x32_bf16(FRAG(32 + mt * 2 + ks), Vb[ks], O[mt], 0, 0, 0); }
#pragma unroll
        for (int kt = 0; kt < 8; ++kt) { S[kt] = S[kt] * glc;
#pragma unroll
            for (int ks = 0; ks < 2; ++ks) S[kt] = __builtin_amdgcn_mfma_f32_16x16x32_bf16(FRAG(16 + kt * 2 + ks), Vb[ks], S[kt], 0, 0, 0); }
#undef FRAG
        bf16* ob = orow + (size_t)(n * 64 + 4 * g4) * 16;
#pragma unroll
        for (int mt = 0; mt < 4; ++mt)
#pragma unroll
            for (int r = 0; r < 4; ++r) ob[(16 * mt + r) * 16] = (bf16)f2bf(O[mt][r]);
#pragma unroll
        for (int i = 0; i < 16; ++i) Qc[i] = Qn[i];
        glc = gln;
    }
    asm volatile("s_waitcnt vmcnt(0)" ::: "memory");
}

__device__ __forceinline__ void dn_final_phase(const bf16* ODN, bf16* PROJ, const float* norm_w, int gw, int NGW, int lane) {
    const f32x4 nw0 = *(const GAS f32x4*)(norm_w + ((8 * lane) & 127)), nw1 = *(const GAS f32x4*)(norm_w + ((8 * lane) & 127) + 4);
#define DNF_LOAD(mm, OV, ZV) do { const int bb_ = (mm) >> 12, nn_ = ((mm) >> 6) & 63, ii_ = (mm) & 63; \
        OV = *(const GAS v4u*)(ODN + ((((size_t)((bb_ * 4 + (lane >> 4)) * 8 + ((lane >> 1) & 7)) * 64 + nn_) * 64 + ii_) * 16 + 8 * (lane & 1))); ZV = *(const GAS v4u*)(PROJ + (size_t)(mm) * NPROJ + PC_Z + 8 * lane); } while (0)
    v4u ovn, zvn; DNF_LOAD(gw < NTOK ? gw : 0, ovn, zvn);
    for (int m = gw; m < NTOK; m += NGW) {
        const v4u ov = ovn, zv = zvn;
        { const int mn = (m + NGW < NTOK) ? m + NGW : m; DNF_LOAD(mn, ovn, zvn); }
        float o[8], z[8];
#pragma unroll
        for (int c = 0; c < 4; ++c) { o[2 * c] = __builtin_bit_cast(float, ov[c] << 16); o[2 * c + 1] = __builtin_bit_cast(float, ov[c] & 0xffff0000u); z[2 * c] = __builtin_bit_cast(float, zv[c] << 16); z[2 * c + 1] = __builtin_bit_cast(float, zv[c] & 0xffff0000u); }
        float ss = 0.f;
#pragma unroll
        for (int c = 0; c < 8; ++c) ss += o[c] * o[c];
        ss += __shfl_xor(ss, 1); ss += __shfl_xor(ss, 2); ss += __shfl_xor(ss, 4); ss += __shfl_xor(ss, 8);
        const float rs = 1.f / sqrtf(ss * (1.f / 128.f) + 1e-6f);
        const float nw[8] = {nw0.x, nw0.y, nw0.z, nw0.w, nw1.x, nw1.y, nw1.z, nw1.w};
        float y[8];
#pragma unroll
        for (int c = 0; c < 8; ++c) y[c] = o[c] * rs * nw[c] * z[c] * __builtin_amdgcn_rcpf(1.f + __builtin_amdgcn_exp2f(-1.4426950408889634f * z[c]));
        v4u w; w.x = pk2(y[0], y[1]); w.y = pk2(y[2], y[3]); w.z = pk2(y[4], y[5]); w.w = pk2(y[6], y[7]);
        *(GAS v4u*)(PROJ + (size_t)m * NPROJ + 8 * lane) = w;
    }
}

__device__ __forceinline__ float wave_sum_dpp(float v) {
    v = v + __builtin_bit_cast(float, __builtin_amdgcn_update_dpp(0, __builtin_bit_cast(int, v), 0xB1, 0xf, 0xf, true));
    v = v + __builtin_bit_cast(float, __builtin_amdgcn_update_dpp(0, __builtin_bit_cast(int, v), 0x4E, 0xf, 0xf, true));
    v = v + __builtin_bit_cast(float, __builtin_amdgcn_update_dpp(0, __builtin_bit_cast(int, v), 0x141, 0xf, 0xf, true));
    v = v + __builtin_bit_cast(float, __builtin_amdgcn_update_dpp(0, __builtin_bit_cast(int, v), 0x140, 0xf, 0xf, true));
    v = v + __builtin_bit_cast(float, __builtin_amdgcn_update_dpp(0, __builtin_bit_cast(int, v), 0x142, 0xa, 0xf, true));
    v = v + __builtin_bit_cast(float, __builtin_amdgcn_update_dpp(0, __builtin_bit_cast(int, v), 0x143, 0xc, 0xf, true));
    return __builtin_bit_cast(float, __builtin_amdgcn_readlane(__builtin_bit_cast(int, v), 63));
}

constexpr int XTAB_OFF = RING_BYTES + 2048, XTAB_BYTES = 1792;
__device__ __forceinline__ unsigned off_t64(unsigned row, unsigned ch) { return 128u * row + 16u * (ch ^ (row & 7u)); }
__device__ __forceinline__ bf16x8 pack8(const float (&v)[8]) { v4u w; w.x = cvtpk(v[0], v[1]); w.y = cvtpk(v[2], v[3]); w.z = cvtpk(v[4], v[5]); w.w = cvtpk(v[6], v[7]); return __builtin_bit_cast(bf16x8, w); }
__device__ __forceinline__ void unpack8(const v4u w, float (&v)[8]) {
#pragma unroll
    for (int c = 0; c < 4; ++c) { v[2 * c] = __builtin_bit_cast(float, w[c] << 16); v[2 * c + 1] = __builtin_bit_cast(float, w[c] & 0xffff0000u); }
}
__device__ __forceinline__ float conv_silu_rows(const bf16* src0, bool seq_start, const float* cw, LAS unsigned char* img, int lane) {
    float w[4][2];
#pragma unroll
    for (int j = 0; j < 4; ++j) { const f32x2_t t = *(const GAS f32x2_t*)(cw + j * 1536 + 2 * lane); w[j][0] = t[0]; w[j][1] = t[1]; }
    const GAS unsigned* gsrc = (const GAS unsigned*)(src0 + 2 * lane);
    unsigned raw[67];
#pragma unroll
    for (int r = 0; r < 3; ++r) raw[r] = seq_start ? 0u : gsrc[(long)(r - 3) * (NPROJ / 2)];
#pragma unroll
    for (int r = 0; r < 64; ++r) raw[3 + r] = gsrc[(size_t)r * (NPROJ / 2)];
    float myss = 0.f;
    const unsigned lbase = (unsigned)((lane & 3) * 4);
#pragma unroll
    for (int pz = 0; pz < 64; ++pz) {
        float y0 = 0.f, y1 = 0.f;
#pragma unroll
        for (int j = 0; j < 4; ++j) { const unsigned u = raw[pz + j]; y0 += w[j][0] * __builtin_bit_cast(float, u << 16); y1 += w[j][1] * __builtin_bit_cast(float, u & 0xffff0000u); }
        y0 = y0 * __builtin_amdgcn_rcpf(1.f + __builtin_amdgcn_exp2f(-1.4426950408889634f * y0));
        y1 = y1 * __builtin_amdgcn_rcpf(1.f + __builtin_amdgcn_exp2f(-1.4426950408889634f * y1));
        const float tot = wave_sum_dpp(y0 * y0 + y1 * y1);
        myss = (lane == pz) ? tot : myss;
        *(LAS unsigned*)(img + off_b((unsigned)pz, (unsigned)(lane >> 2)) + lbase) = cvtpk(y0, y1);
    }
    return myss;
}

template <int STOP>
__device__ __forceinline__ void dn_prep_chunk(LAS unsigned char* IMG  , LAS float* tab, const bf16* PROJ, const nv::P& p, unsigned char* DNA, unsigned char* DNU, int ci) {
    int lane = pg8::lane_id_fresh();
    const int bh = ci >> 6, n = ci & 63, b = bh >> 2, h = bh & 3;
    int l15 = lane & 15, g4 = lane >> 4, q = l15 >> 2, pp = lane & 3;
    LAS float* t_gc = tab; LAS float* t_be = tab + 64; LAS float* t_rk = tab + 128; LAS float* t_rq = tab + 192; LAS float* t_eq = tab + 256; LAS float* t_ekk = tab + 320; LAS float* t_bg = tab + 384;
    const size_t tok = (size_t)b * 4096 + n * 64 + lane;
    const bf16* prow = PROJ + tok * NPROJ;
    const bf16* prow0 = PROJ + ((size_t)b * 4096 + n * 64) * NPROJ;
    unsigned char* dna = DNA + (size_t)ci * DNA_CHUNK_BYTES + lane * 16;
    (void)q; (void)pp;
    float gc, beta, eg, gc63;
    {
        const float araw = bf2f(prow[PC_A + h]), braw = bf2f(prow[PC_B + h]);
        const float xx = araw + p.dt_bias[h];
        const float sp = xx > 20.f ? xx : log1pf(expf(xx));
        gc = -expf(p.a_log[h]) * sp;
        beta = 1.f / (1.f + expf(-braw));
#pragma unroll
        for (int o = 1; o < 64; o <<= 1) { const float t = __shfl_up(gc, o); if (lane >= o) gc += t; }
        gc63 = __shfl(gc, 63);
        eg = expf(gc);
        const unsigned gb = __builtin_bit_cast(unsigned, expf(gc63));
        *(GAS v4u*)(dna + 56 * 1024) = (v4u){gb, gb, gb, gb};
        const float ssq = conv_silu_rows(prow0 + PC_Q + h * 128, n == 0, p.conv_w + h * 128, IMG, lane);
        const float rq = 0.08838834764831845f / sqrtf(ssq + 1e-6f);
        t_gc[lane] = gc; t_be[lane] = beta; t_rq[lane] = rq; t_eq[lane] = eg * rq;
    }
    LDS_WAIT(); asm volatile("" ::: "memory");
    if constexpr (STOP == 1) return;
    bf16x8 qF[4][4];
#pragma unroll
    for (int mt = 0; mt < 4; ++mt)
#pragma unroll
        for (int ks = 0; ks < 4; ++ks) qF[mt][ks] = *(const LAS bf16x8*)(IMG + off_b((unsigned)(16 * mt + l15), (unsigned)(4 * ks + g4)));
#pragma unroll
    for (int mt = 0; mt < 4; ++mt) {
        const float egi = t_eq[16 * mt + l15];
#pragma unroll
        for (int ks = 0; ks < 4; ++ks) {
            const unsigned long long lo = *(const LAS unsigned long long*)(IMG + off_b((unsigned)(16 * mt + l15), (unsigned)(4 * ks + (g4 >> 1))) + (g4 & 1) * 8);
            const unsigned long long hi = *(const LAS unsigned long long*)(IMG + off_b((unsigned)(16 * mt + l15), (unsigned)(4 * ks + 2 + (g4 >> 1))) + (g4 & 1) * 8);
            float t8[8]; unpack8((v4u){(unsigned)lo, (unsigned)(lo >> 32), (unsigned)hi, (unsigned)(hi >> 32)}, t8);
#pragma unroll
            for (int e = 0; e < 8; ++e) t8[e] *= egi;
            *(GAS bf16x8*)(dna + (16 + mt * 4 + ks) * 1024) = pack8(t8);
        }
    }
    LDS_WAIT(); asm volatile("" ::: "memory");
    {
        const float ssk = conv_silu_rows(prow0 + PC_K + h * 128, n == 0, p.conv_w + 512 + h * 128, IMG, lane);
        const float rk = 1.f / sqrtf(ssk + 1e-6f);
        t_rk[lane] = rk; t_ekk[lane] = expf(gc63 - gc) * rk; t_bg[lane] = beta * eg * rk;
    }
    LDS_WAIT(); asm volatile("" ::: "memory");
    if constexpr (STOP == 2) return;
    f32x4 Am[4][4];
    {
        bf16x8 kF[4][4];
#pragma unroll
        for (int mt = 0; mt < 4; ++mt)
#pragma unroll
            for (int ks = 0; ks < 4; ++ks) kF[mt][ks] = *(const LAS bf16x8*)(IMG + off_b((unsigned)(16 * mt + l15), (unsigned)(4 * ks + g4)));
#pragma unroll
        for (int mi = 0; mi < 4; ++mi) {
            const f32x4 gci = *(const LAS f32x4*)(t_gc + 16 * mi + 4 * g4), bei = *(const LAS f32x4*)(t_be + 16 * mi + 4 * g4), rki = *(const LAS f32x4*)(t_rk + 16 * mi + 4 * g4);
#pragma unroll
            for (int nj = 0; nj <= mi; ++nj) {
                f32x4 acc = (f32x4){0.f, 0.f, 0.f, 0.f};
#pragma unroll
                for (int ks = 0; ks < 4; ++ks) acc = __builtin_amdgcn_mfma_f32_16x16x32_bf16(kF[mi][ks], kF[nj][ks], acc, 0, 0, 0);
                const float gcj = t_gc[16 * nj + l15], rkj = t_rk[16 * nj + l15]; const int j = 16 * nj + l15;
#pragma unroll
                for (int r = 0; r < 4; ++r) { const int i = 16 * mi + 4 * g4 + r; acc[r] = (j < i) ? bei[r] * rki[r] * rkj * acc[r] * expf(gci[r] - gcj) : 0.f; }
                Am[mi][nj] = acc;
            }
        }
#pragma unroll
        for (int it = 0; it < 4; ++it) {
            const float gci = t_gc[16 * it + l15], rqi = t_rq[16 * it + l15]; const int i = 16 * it + l15;
            f32x4 kq[4];
#pragma unroll
            for (int jt = 0; jt < 4; ++jt) {
                f32x4 acc = (f32x4){0.f, 0.f, 0.f, 0.f};
                if (jt <= it) {
#pragma unroll
                    for (int ks = 0; ks < 4; ++ks) acc = __builtin_amdgcn_mfma_f32_16x16x32_bf16(kF[jt][ks], qF[it][ks], acc, 0, 0, 0);
                    const f32x4 gcj = *(const LAS f32x4*)(t_gc + 16 * jt + 4 * g4), rkj = *(const LAS f32x4*)(t_rk + 16 * jt + 4 * g4);
#pragma unroll
                    for (int r = 0; r < 4; ++r) { const int j = 16 * jt + 4 * g4 + r; acc[r] = (j <= i) ? acc[r] * rqi * rkj[r] * expf(gci - gcj[r]) : 0.f; }
                }
                kq[jt] = acc;
            }
#pragma unroll
            for (int ks = 0; ks < 2; ++ks) { const float t8[8] = {kq[2 * ks][0], kq[2 * ks][1], kq[2 * ks][2], kq[2 * ks][3], kq[2 * ks + 1][0], kq[2 * ks + 1][1], kq[2 * ks + 1][2], kq[2 * ks + 1][3]};
                *(GAS bf16x8*)(dna + (48 + it * 2 + ks) * 1024) = pack8(t8); }
        }
    }
    if constexpr (STOP == 3) return;
    bf16x8 ktr[8][2];
    {
#pragma unroll
        for (int ks = 0; ks < 2; ++ks) {
            const f32x4 ek0 = *(const LAS f32x4*)(t_ekk + 32 * ks + 4 * g4), ek1 = *(const LAS f32x4*)(t_ekk + 32 * ks + 16 + 4 * g4);
#pragma unroll
            for (int mt = 0; mt < 8; ++mt) {
                const s16x4 lo = vtr(IMG + off_b((unsigned)(32 * ks + 4 * g4 + q), (unsigned)(2 * mt + (pp >> 1))) + 8 * (pp & 1));
                const s16x4 hi = vtr(IMG + off_b((unsigned)(32 * ks + 16 + 4 * g4 + q), (unsigned)(2 * mt + (pp >> 1))) + 8 * (pp & 1));
                const float t8[8] = {bf2f((unsigned short)lo[0]) * ek0.x, bf2f((unsigned short)lo[1]) * ek0.y, bf2f((unsigned short)lo[2]) * ek0.z, bf2f((unsigned short)lo[3]) * ek0.w,
                                     bf2f((unsigned short)hi[0]) * ek1.x, bf2f((unsigned short)hi[1]) * ek1.y, bf2f((unsigned short)hi[2]) * ek1.z, bf2f((unsigned short)hi[3]) * ek1.w};
                *(GAS bf16x8*)(dna + (32 + mt * 2 + ks) * 1024) = pack8(t8);
            }
        }
#pragma unroll
        for (int dt = 0; dt < 8; ++dt)
#pragma unroll
            for (int ks = 0; ks < 2; ++ks) {
                const s16x4 lo = vtr(IMG + off_b((unsigned)(32 * ks + 8 * g4 + q), (unsigned)(2 * dt + (pp >> 1))) + 8 * (pp & 1));
                const s16x4 hi = vtr(IMG + off_b((unsigned)(32 * ks + 8 * g4 + 4 + q), (unsigned)(2 * dt + (pp >> 1))) + 8 * (pp & 1));
                ktr[dt][ks] = (bf16x8){lo[0], lo[1], lo[2], lo[3], hi[0], hi[1], hi[2], hi[3]};
            }
    }
    LDS_WAIT(); asm volatile("" ::: "memory");
    {
        LAS float* AL = (LAS float*)IMG;
#pragma unroll
        for (int mi = 0; mi < 4; ++mi)
#pragma unroll
            for (int nj = 0; nj <= mi; ++nj)
#pragma unroll
                for (int r = 0; r < 4; ++r) AL[(16 * mi + 4 * g4 + r) * 64 + 16 * nj + l15] = Am[mi][nj][r];
    }
    LDS_WAIT(); asm volatile("" ::: "memory");
    float T[64];
    {
        const LAS float* AL = (const LAS float*)IMG;
#pragma clang loop unroll(full)
        for (int i = 0; i < 64; ++i) {
            float v4[4] = {(lane == i) ? 1.f : 0.f, 0.f, 0.f, 0.f};
#pragma clang loop unroll(full)
            for (int j4 = 0; j4 < (i + 3) / 4; ++j4) {
                const f32x4 a = *(const LAS f32x4*)(AL + i * 64 + 4 * j4);
#pragma clang loop unroll(full)
                for (int e = 0; e < 4; ++e) if (4 * j4 + e < i) v4[e] -= a[e] * T[4 * j4 + e];
            }
            T[i] = (v4[0] + v4[1]) + (v4[2] + v4[3]);
        }
    }
    LDS_WAIT(); asm volatile("" ::: "memory");
    if constexpr (STOP == 4) return;
    lane = pg8::lane_id_fresh(); l15 = lane & 15; g4 = lane >> 4; q = l15 >> 2; pp = lane & 3;
    dna = DNA + (size_t)ci * DNA_CHUNK_BYTES + lane * 16;
    {
        const float bc = t_be[lane], bgc = t_bg[lane];
        LAS unsigned char* TB = IMG; LAS unsigned char* TBE = IMG + 8192;
#pragma unroll
        for (int i = 0; i < 64; ++i) { const unsigned o = off_t64((unsigned)i, (unsigned)(lane >> 3)) + (lane & 7) * 2;
            *(LAS unsigned short*)(TB + o) = (unsigned short)f2bf(T[i] * bc); *(LAS unsigned short*)(TBE + o) = (unsigned short)f2bf(T[i] * bgc); }
    }
    LDS_WAIT(); asm volatile("" ::: "memory");
    bf16x8 tb[4][2];
    {
#pragma unroll
        for (int it = 0; it < 4; ++it) {
            bf16x8 tbe[2];
#pragma unroll
            for (int ks = 0; ks < 2; ++ks) tbe[ks] = *(const LAS bf16x8*)(IMG + 8192 + off_t64((unsigned)(16 * it + l15), (unsigned)(4 * ks + g4)));
            f32x4 acc[8];
#pragma unroll
            for (int dt = 0; dt < 8; ++dt) { acc[dt] = (f32x4){0.f, 0.f, 0.f, 0.f};
#pragma unroll
                for (int ks = 0; ks < 2; ++ks) acc[dt] = __builtin_amdgcn_mfma_f32_16x16x32_bf16(ktr[dt][ks], tbe[ks], acc[dt], 0, 0, 0); }
#pragma unroll
            for (int ks = 0; ks < 4; ++ks) { const float t8[8] = {-acc[2 * ks][0], -acc[2 * ks][1], -acc[2 * ks][2], -acc[2 * ks][3], -acc[2 * ks + 1][0], -acc[2 * ks + 1][1], -acc[2 * ks + 1][2], -acc[2 * ks + 1][3]};
                *(GAS bf16x8*)(dna + (it * 4 + ks) * 1024) = pack8(t8); }
        }
#pragma unroll
        for (int mt = 0; mt < 4; ++mt)
#pragma unroll
            for (int ks = 0; ks < 2; ++ks) tb[mt][ks] = *(const LAS bf16x8*)(IMG + off_t64((unsigned)(16 * mt + l15), (unsigned)(4 * ks + g4)));
    }
    LDS_WAIT(); asm volatile("" ::: "memory");
    if constexpr (STOP == 5) return;
    (void)conv_silu_rows(prow0 + PC_V + h * 128, n == 0, p.conv_w + 1024 + h * 128, IMG, lane);
    LDS_WAIT(); asm volatile("" ::: "memory");
    {
        unsigned char* dnu = DNU + (size_t)ci * DNU_CHUNK_BYTES + lane * 16;
#pragma unroll
        for (int dt = 0; dt < 8; ++dt) {
            bf16x8 vt[2];
#pragma unroll
            for (int ks = 0; ks < 2; ++ks) {
                const s16x4 lo = vtr(IMG + off_b((unsigned)(32 * ks + 8 * g4 + q), (unsigned)(2 * dt + (pp >> 1))) + 8 * (pp & 1));
                const s16x4 hi = vtr(IMG + off_b((unsigned)(32 * ks + 8 * g4 + 4 + q), (unsigned)(2 * dt + (pp >> 1))) + 8 * (pp & 1));
                vt[ks] = (bf16x8){lo[0], lo[1], lo[2], lo[3], hi[0], hi[1], hi[2], hi[3]};
            }
            f32x4 u[4];
#pragma unroll
            for (int mt = 0; mt < 4; ++mt) { u[mt] = (f32x4){0.f, 0.f, 0.f, 0.f};
#pragma unroll
                for (int ks = 0; ks < 2; ++ks) u[mt] = __builtin_amdgcn_mfma_f32_16x16x32_bf16(tb[mt][ks], vt[ks], u[mt], 0, 0, 0); }
#pragma unroll
            for (int pc = 0; pc < 2; ++pc) { const float t8[8] = {u[2 * pc][0], u[2 * pc][1], u[2 * pc][2], u[2 * pc][3], u[2 * pc + 1][0], u[2 * pc + 1][1], u[2 * pc + 1][2], u[2 * pc + 1][3]};
                *(GAS bf16x8*)(dnu + (dt * 2 + pc) * 1024) = pack8(t8); }
        }
    }
    LDS_WAIT(); asm volatile("" ::: "memory");
}

template <int STOP>
__device__ __forceinline__ void dn_prep_phase(LAS unsigned char* lds, const bf16* PROJ, const nv::P& p, unsigned char* DNA, unsigned char* DNU, int G, int vcu, int wave_s) {
    LAS unsigned char* img = lds + wave_s * 16384; LAS float* tab = (LAS float*)(lds + XTAB_OFF + wave_s * XTAB_BYTES);
    for (int ci = vcu * 8 + wave_s; ci < 2048; ci += G * 8) dn_prep_chunk<STOP>(img, tab, PROJ, p, DNA, DNU, ci);
}


struct RouterArgs { const float* z; const bf16* mix; float* zout; bf16* H1BF; int* EID; float* WGT; int* LIST; int* CNT; const float *ln_g, *ln_b, *w_rg, *b_rg, *w_re, *b_re; };
__device__ __forceinline__ void router_fill(LAS float* dst, const float* W, int ldw, int col0, int tid) {
#pragma unroll
    for (int it = 0; it < 4; ++it) { const int qd = tid + it * NTHREADS, k = qd >> 1, half = qd & 1;
        const f32x4 v = *(const GAS f32x4*)(W + (size_t)k * ldw + col0 + half * 4);
        *(LAS f32x4*)(dst + ((((k >> 8) * 4 + (k & 3)) * 64 + ((k >> 2) & 63)) * 8 + half * 4)) = v; }
}
__device__ __forceinline__ void router_phase(LAS unsigned char* lds, const RouterArgs& A, int gw, int NGW, int wave_s) {
    const int lane = pg8::lane_id_fresh(), tid = wave_s * 64 + lane;
    LAS float* WG = (LAS float*)lds; LAS int* HIST = (LAS int*)(lds + 32768); LAS int* BASE = HIST + 64; LAS int* RR = HIST + 128;
    router_fill(WG, A.w_rg, 8, 0, tid);
    if (tid < 64) HIST[tid] = 0;
    __syncthreads();
    int it_ = 0;
    f32x4 vn[4]; unsigned long long mn_[4];
    { const GAS f32x4* zr = (const GAS f32x4*)(A.z + (size_t)gw * DM) + lane; const GAS unsigned long long* mr = (const GAS unsigned long long*)(A.mix + (size_t)gw * DM) + lane;
#pragma unroll
      for (int j = 0; j < 4; ++j) { vn[j] = zr[64 * j]; mn_[j] = mr[64 * j]; } }
    for (int m = gw; m < NTOK; m += NGW) {
        f32x4 v[4];
#pragma unroll
        for (int j = 0; j < 4; ++j) { const unsigned long long mm = mn_[j];
            v[j].x = ALPHA_F * vn[j].x + bf2f((unsigned short)mm); v[j].y = ALPHA_F * vn[j].y + bf2f((unsigned short)(mm >> 16));
            v[j].z = ALPHA_F * vn[j].z + bf2f((unsigned short)(mm >> 32)); v[j].w = ALPHA_F * vn[j].w + bf2f((unsigned short)(mm >> 48)); }
        { const int mn = (m + NGW < NTOK) ? m + NGW : m; const GAS f32x4* zn = (const GAS f32x4*)(A.z + (size_t)mn * DM) + lane; const GAS unsigned long long* mr = (const GAS unsigned long long*)(A.mix + (size_t)mn * DM) + lane;
#pragma unroll
          for (int j = 0; j < 4; ++j) { vn[j] = zn[64 * j]; mn_[j] = mr[64 * j]; } }
        float s = 0.f;
#pragma unroll
        for (int j = 0; j < 4; ++j) s += (v[j].x + v[j].y) + (v[j].z + v[j].w);
        const float mean = wave_sum_dpp(s) * (1.f / DM); float s2 = 0.f;
#pragma unroll
        for (int j = 0; j < 4; ++j) { v[j] = v[j] - mean; s2 += (v[j].x * v[j].x + v[j].y * v[j].y) + (v[j].z * v[j].z + v[j].w * v[j].w); }
        const float rstd = 1.f / sqrtf(wave_sum_dpp(s2) * (1.f / DM) + 1e-5f);
        GAS unsigned long long* hb = (GAS unsigned long long*)(A.H1BF + (size_t)m * DM) + lane;
#pragma unroll
        for (int j = 0; j < 4; ++j) { const f32x4 g = *((const GAS f32x4*)A.ln_g + lane + 64 * j), bb = *((const GAS f32x4*)A.ln_b + lane + 64 * j); v[j] = v[j] * rstd * g + bb;
            hb[64 * j] = (unsigned long long)pk2(v[j].x, v[j].y) | ((unsigned long long)pk2(v[j].z, v[j].w) << 32); }
        float gl[8];
#pragma unroll
        for (int c = 0; c < 8; ++c) gl[c] = 0.f;
#pragma unroll
        for (int j = 0; j < 4; ++j)
#pragma unroll
            for (int c4 = 0; c4 < 4; ++c4) { const float hv = v[j][c4]; const LAS float* wp = WG + ((j * 4 + c4) * 64 + lane) * 8;
                const f32x4 w0 = *(const LAS f32x4*)wp, w1 = *(const LAS f32x4*)(wp + 4);
                gl[0] += hv * w0.x; gl[1] += hv * w0.y; gl[2] += hv * w0.z; gl[3] += hv * w0.w; gl[4] += hv * w1.x; gl[5] += hv * w1.y; gl[6] += hv * w1.z; gl[7] += hv * w1.w; }
        int gi = 0; float gm = -INFINITY;
#pragma unroll
        for (int c = 0; c < 8; ++c) { gl[c] = wave_sum_dpp(gl[c]) + A.b_rg[c]; if (gl[c] > gm) { gm = gl[c]; gi = c; } }
        float den = 0.f;
#pragma unroll
        for (int c = 0; c < 8; ++c) den += expf(gl[c] - gm);
        const float pg = 1.f / den;
        float el[8];
#pragma unroll
        for (int c = 0; c < 8; ++c) el[c] = 0.f;
        const float* wre = A.w_re + gi * 8192 + lane * 8;
#pragma unroll
        for (int j = 0; j < 4; ++j)
#pragma unroll
            for (int c4 = 0; c4 < 4; ++c4) { const float hv = v[j][c4];
                const f32x4 w0 = *(const GAS f32x4*)(wre + (j * 4 + c4) * 512), w1 = *(const GAS f32x4*)(wre + (j * 4 + c4) * 512 + 4);
                el[0] += hv * w0.x; el[1] += hv * w0.y; el[2] += hv * w0.z; el[3] += hv * w0.w; el[4] += hv * w1.x; el[5] += hv * w1.y; el[6] += hv * w1.z; el[7] += hv * w1.w; }
        int i0 = 0, i1 = 0; float v0 = -INFINITY, v1 = -INFINITY;
#pragma unroll
        for (int c = 0; c < 8; ++c) { el[c] = wave_sum_dpp(el[c]) + A.b_re[gi * 8 + c]; if (el[c] > v0) { v0 = el[c]; i0 = c; } }
#pragma unroll
        for (int c = 0; c < 8; ++c) { if (c != i0 && el[c] > v1) { v1 = el[c]; i1 = c; } }
        const float e1 = expf(v1 - v0), sm = 1.f / (1.f + e1);
        if (lane == 0) {
            const int ea = gi * 8 + i0, eb = gi * 8 + i1;
            LAS int* rr = RR + (wave_s * 16 + it_) * 6;
            rr[4] = (int)(f2bf(pg * sm) << 16); rr[5] = (int)(f2bf(pg * e1 * sm) << 16);
            rr[0] = ea; rr[1] = __hip_atomic_fetch_add(&HIST[ea], 1, __ATOMIC_RELAXED, __HIP_MEMORY_SCOPE_WORKGROUP); rr[2] = eb; rr[3] = __hip_atomic_fetch_add(&HIST[eb], 1, __ATOMIC_RELAXED, __HIP_MEMORY_SCOPE_WORKGROUP);
        }
        ++it_;
    }
    __syncthreads();
    if (tid < 64) BASE[tid] = __hip_atomic_fetch_add(&A.CNT[tid], HIST[tid], __ATOMIC_RELAXED, __HIP_MEMORY_SCOPE_AGENT);
    __syncthreads();
    if (lane < it_) {
        const LAS int* rr = RR + (wave_s * 16 + lane) * 6; const int m = gw + lane * NGW;
        A.LIST[(size_t)rr[0] * NTOK + BASE[rr[0]] + rr[1]] = (2 * m) | rr[4];
        A.LIST[(size_t)rr[2] * NTOK + BASE[rr[2]] + rr[3]] = (2 * m + 1) | rr[5];
    }
}

__device__ __forceinline__ void final_phase(float* OUT, const bf16* H1B, const bf16* YEXP, const float* ln_g, const float* ln_b, int gw, int NGW, int lane) {
    unsigned long long hn[4], an[4], bn[4];
#define FIN_LOAD(mm) do { const GAS unsigned long long* hq_ = (const GAS unsigned long long*)(H1B + (size_t)(mm) * DM) + lane; const GAS unsigned long long* y0_ = (const GAS unsigned long long*)(YEXP + (size_t)(2 * (mm)) * DM) + lane; \
        _Pragma("unroll") for (int j_ = 0; j_ < 4; ++j_) { hn[j_] = hq_[64 * j_]; an[j_] = y0_[64 * j_]; bn[j_] = y0_[DM / 4 + 64 * j_]; } } while (0)
    FIN_LOAD(gw < NTOK ? gw : 0);
    for (int m = gw; m < NTOK; m += NGW) {
        GAS f32x4* orow = (GAS f32x4*)(OUT + (size_t)m * DM) + lane;
        unsigned long long hc[4], ac[4], bc[4];
#pragma unroll
        for (int j = 0; j < 4; ++j) { hc[j] = hn[j]; ac[j] = an[j]; bc[j] = bn[j]; }
        { const int mn = (m + NGW < NTOK) ? m + NGW : m; FIN_LOAD(mn); }
        f32x4 v[4]; float s = 0.f;
#pragma unroll
        for (int j = 0; j < 4; ++j) { const unsigned long long hh = hc[j], a0 = ac[j], a1 = bc[j];
            v[j].x = ALPHA_F * bf2f((unsigned short)hh) + bf2f((unsigned short)a0) + bf2f((unsigned short)a1);
            v[j].y = ALPHA_F * bf2f((unsigned short)(hh >> 16)) + bf2f((unsigned short)(a0 >> 16)) + bf2f((unsigned short)(a1 >> 16));
            v[j].z = ALPHA_F * bf2f((unsigned short)(hh >> 32)) + bf2f((unsigned short)(a0 >> 32)) + bf2f((unsigned short)(a1 >> 32));
            v[j].w = ALPHA_F * bf2f((unsigned short)(hh >> 48)) + bf2f((unsigned short)(a0 >> 48)) + bf2f((unsigned short)(a1 >> 48));
            s += (v[j].x + v[j].y) + (v[j].z + v[j].w); }
        const float mean = wave_sum_dpp(s) * (1.f / DM); float s2 = 0.f;
#pragma unroll
        for (int j = 0; j < 4; ++j) { v[j] = v[j] - mean; s2 += (v[j].x * v[j].x + v[j].y * v[j].y) + (v[j].z * v[j].z + v[j].w * v[j].w); }
        const float rstd = 1.f / sqrtf(wave_sum_dpp(s2) * (1.f / DM) + 1e-5f);
#pragma unroll
        for (int j = 0; j < 4; ++j) { const f32x4 g = *((const GAS f32x4*)ln_g + lane + 64 * j), bb = *((const GAS f32x4*)ln_b + lane + 64 * j); orow[64 * j] = v[j] * rstd * g + bb; }
    }
}

#ifndef REPEAT_MASK
#define REPEAT_MASK 0
#endif
#define REPS(k) ((((REPEAT_MASK) >> (k)) & 1) + 1)
__global__ void __launch_bounds__(NTHREADS, 2) fwd_megakernel(MK a) {
    extern __shared__ __attribute__((aligned(16))) unsigned char lds_raw[];
    cg::grid_group grid = cg::this_grid();
    LAS unsigned char* lds = (LAS unsigned char*)lds_raw;
    volatile LAS unsigned* MISC = (volatile LAS unsigned*)(lds + MISC_OFF);
    LAS int* PREF = (LAS int*)(lds + PREF_OFF);
    const int tid = threadIdx.x; const int wave_s = __builtin_amdgcn_readfirstlane(tid >> 6);
    const int G = gridDim.x; const int bx = blockIdx.x; const int vcu = (G % 8 == 0) ? (bx % 8) * (G / 8) + bx / 8 : bx;
    unsigned char* ws = a.ws; const nv::P& p = a.p;
    gu32* ctl = (gu32*)(ws + WS_CTL);
    bf16* WIN = (bf16*)(ws + WS_WIN); bf16* WOUT = (bf16*)(ws + WS_WOUT); bf16* XBF = (bf16*)(ws + WS_A); bf16* PROJ = (bf16*)(ws + WS_B);
    bf16* WGU = (bf16*)(ws + WS_WGU); bf16* WD = (bf16*)(ws + WS_WD); bf16* HID = (bf16*)(ws + WS_A); bf16* H1BF = (bf16*)(ws + WS_H1BF); bf16* YEXP = (bf16*)(ws + WS_YEXP);
    int* LIST = (int*)(ws + WS_LIST); int* EID = (int*)(ws + WS_ROUTE); float* WGT = (float*)(ws + WS_ROUTE + 512 * 1024);
    int* CNT = (int*)(ws + WS_CTL) + CW_CNT;
    for (int u = tid; u < (LDS_BYTES - LDSCTL_OFF) / 4; u += NTHREADS) ((LAS unsigned*)(lds + LDSCTL_OFF))[u] = 0u;
    __syncthreads();
    XcdBarrier bar = xcd_barrier_post((unsigned*)(ctl + CW_BAR), MISC + 8);
    grid.sync();
#define FRESH() const int lane = pg8::lane_id_fresh(), wave = wave_s; const int tid_ = wave_s * 64 + lane; const int gtid = (int)blockIdx.x * NTHREADS + tid_, gsize = G * NTHREADS, gw = vcu * NWAVES + wave, NGW = G * NWAVES; (void)lane; (void)gtid; (void)gsize; (void)gw; (void)NGW;

    _Pragma("unroll 1") for (int rep_ = 0; rep_ < REPS(0); ++rep_) {
    {
        FRESH();
        LAS float* scr = (LAS float*)(lds + wave * 16384);
        constexpr int NB = 96, KB = DM / 64;
        for (int it = gw; it < NB * KB; it += NGW) { const int nb = it % NB, kb = it / NB; const int nsrc = nb < 64 ? nb * 32 : 2056 + (nb - 64) * 32, ndst = nb * 32;
            p0_transpose_item(p.w_in, nv::INC, DM, kb * 64, nsrc, WIN, ndst, scr, lane); }
        for (int i = gtid; i < 8 * DM; i += gsize) { const int j = (int)(i / DM), k = (int)(i % DM); WIN[(size_t)(PC_B + j) * DM + k] = (bf16)f2bf(p.w_in[(size_t)k * nv::INC + 2048 + j]); }
        for (int i = gtid; i < (long)(NPROJ - 3080) * DM / 8; i += gsize) *(GAS v4u*)(WIN + (size_t)3080 * DM + i * 8) = (v4u){0u, 0u, 0u, 0u};
        for (int i = gtid; i < (long)NTOK * DM / 8; i += gsize) { const f32x4 v0 = *(const GAS f32x4*)(p.x + i * 8), v1 = *(const GAS f32x4*)(p.x + i * 8 + 4);
            v4u o; o.x = pk2(v0.x, v0.y); o.y = pk2(v0.z, v0.w); o.z = pk2(v1.x, v1.y); o.w = pk2(v1.z, v1.w); *(GAS v4u*)(XBF + i * 8) = o; }
        for (int it = gw; it < 16 * 32; it += NGW) { const int nb = it & 31, kb = it >> 5; p0_transpose_item(p.w_out, DM, DM, kb * 64, nb * 32, WOUT, nb * 32, scr, lane); }
        for (int d = gtid; d < 8 * 8192; d += gsize) { const int g = d >> 13, r = d & 8191, c = r & 7, ll = (r >> 3) & 63, jc = r >> 9, k = 4 * (ll + 64 * (jc >> 2)) + (jc & 3);
            ((float*)(ws + WS_WREP))[d] = p.w_re[(size_t)k * 64 + g * 8 + c]; }
    }
    xcd_barrier(bar);
    }
    _Pragma("unroll 1") for (int rep_ = 0; rep_ < REPS(1); ++rep_) {
    {
        if (bx < GEMM_WGS) {
            pg8::DenseOrder S; S.init(XBF, DM, WIN, NTOK, NPROJ, DM, GEMM_WGS, bx);
            pg8::EpiBf16 E{PROJ, NPROJ};
            pg8::gemm_phase<pg8::EpiBf16, pg8::DenseOrder, true>(lds, S, E, nullptr, wave_s);
        } else {
            const int lane = pg8::lane_id_fresh();
            LAS float* scr = (LAS float*)(lds + wave_s * 16384);
            p0_experts(p.w_gate, p.w_up, p.w_down, WGU, WD, scr, (bx - GEMM_WGS) * NWAVES + wave_s, (G - GEMM_WGS) * NWAVES, lane);
        }
    }
    xcd_barrier(bar);
    }
    unsigned char* DNA = (unsigned char*)p.out; unsigned char* DNU = ws + WS_A + 32 * MiB; bf16* ODN = (bf16*)(ws + WS_A);
    _Pragma("unroll 1") for (int rep_ = 0; rep_ < REPS(2); ++rep_) {
    dn_prep_phase<0>(lds, PROJ, p, DNA, DNU, G, vcu, wave_s);
    xcd_barrier(bar);
    }
    _Pragma("unroll 1") for (int rep_ = 0; rep_ < REPS(3); ++rep_) {
    dn_scan_phase(lds, DNA, DNU, ODN, vcu, wave_s);
    xcd_barrier(bar);
    }
    _Pragma("unroll 1") for (int rep_ = 0; rep_ < REPS(5); ++rep_) {
    sgu_phase(lds, PROJ, p, G, vcu, wave_s);
    { FRESH(); dn_final_phase(ODN, PROJ, p.dn_norm_w, gw, NGW, lane); }
    xcd_barrier(bar);
    }
    _Pragma("unroll 1") for (int rep_ = 0; rep_ < REPS(6); ++rep_) {
    {
        pg8::DenseOrder S; S.init(PROJ, NPROJ, WOUT, NTOK, DM, DM, G, bx);
        pg8::EpiBf16 E{(bf16*)(ws + WS_A), DM};
        pg8::gemm_phase<pg8::EpiBf16, pg8::DenseOrder, true>(lds, S, E, nullptr, wave_s);
    }
    xcd_barrier(bar);
    }
    {
        RouterArgs RA{p.x, (const bf16*)(ws + WS_A), p.out, H1BF, EID, WGT, LIST, CNT, p.ln1_g, p.ln1_b, p.w_rg, p.b_rg, (const float*)(ws + WS_WREP), p.b_re};
        router_phase(lds, RA, vcu * NWAVES + wave_s, G * NWAVES, wave_s);
    }
    xcd_barrier(bar);
    if (threadIdx.x == 0) { int s = 0; for (int e = 0; e < NEXP; ++e) { PREF[e] = s; s += ((CNT[e] + 255) >> 8) * 4; } PREF[NEXP] = s; }
    __syncthreads();
    _Pragma("unroll 1") for (int rep_ = 0; rep_ < REPS(7); ++rep_) {
    {
        pg8::GroupedOrder S{H1BF, WGU, LIST, PREF, DM, DM, 1024, NTOK, 1, 4, G, bx, NEXP};
        pg8::EpiHid E{HID, LIST, CNT, NTOK};
        pg8::gemm_phase<pg8::EpiHid, pg8::GroupedOrder, true>(lds, S, E, CNT, wave_s);
    }
    xcd_barrier(bar);
    }
    _Pragma("unroll 1") for (int rep_ = 0; rep_ < REPS(8); ++rep_) {
    {
        pg8::GroupedOrder S{HID, WD, LIST, PREF, DEXP, DEXP, 1024, NTOK, 0, 4, G, bx, NEXP};
        pg8::EpiYexp E{YEXP, LIST, WGT, NTOK};
        pg8::gemm_phase<pg8::EpiYexp, pg8::GroupedOrder, true>(lds, S, E, CNT, wave_s);
    }
    xcd_barrier(bar);
    }
    { FRESH(); final_phase(p.out, H1BF, YEXP, p.ln2_g, p.ln2_b, gw, NGW, lane); }
#if defined(GHOSTPREP)
    xcd_barrier(bar);
    dn_prep_phase<GHOSTPREP>(lds, (const bf16*)(ws + WS_B), p, ws + WS_C, ws + WS_C + 120 * MiB, G, vcu, wave_s);
#endif
#if defined(GHOST6)
    xcd_barrier(bar);
    { RouterArgs RA{p.out, (const bf16*)(ws + WS_A), (float*)(ws + WS_B), (bf16*)(ws + WS_C), (int*)(ws + WS_A), (float*)(ws + WS_A + 1 * MiB), (int*)(ws + WS_A + 2 * MiB), (int*)(ws + WS_CTL) + CW_CNT + 1024, p.ln1_g, p.ln1_b, p.w_rg, p.b_rg, (const float*)(ws + WS_WREP), p.b_re};
      router_phase(lds, RA, vcu * NWAVES + wave_s, G * NWAVES, wave_s); }
#endif
#if defined(GHOST9)
    xcd_barrier(bar);
    { FRESH(); final_phase((float*)(ws + WS_A), H1BF, (const bf16*)(ws + WS_C), p.ln2_g, p.ln2_b, gw, NGW, lane); }
#endif
}

extern "C" void kernel_launch(void* const* d_in, const int* in_sizes, int n_in, void* d_out, int out_size, void* d_ws, size_t ws_size, hipStream_t stream) {
    if (ws_size < WS_END || n_in != 22) { fprintf(stderr, "kernel_launch: bad ws/n_in\n"); return; }
    static int grid_blocks = 0;
    if (!grid_blocks) {
        int dev = 0, cus = 0, per_cu = 0;
        (void)hipGetDevice(&dev);
        (void)hipDeviceGetAttribute(&cus, hipDeviceAttributeMultiprocessorCount, dev);
        (void)hipFuncSetAttribute((const void*)fwd_megakernel, hipFuncAttributeMaxDynamicSharedMemorySize, (int)LDS_BYTES);
        (void)hipOccupancyMaxActiveBlocksPerMultiprocessor(&per_cu, (const void*)fwd_megakernel, NTHREADS, LDS_BYTES);
        if (per_cu < 1) { fprintf(stderr, "kernel_launch: occupancy query says %d\n", per_cu); per_cu = 1; }
        grid_blocks = cus;
    }
    (void)hipMemsetAsync((char*)d_ws + WS_CTL, 0, CTL_ZERO_BYTES, stream);
    MK a{}; bind(a.p, d_in, (float*)d_out); a.ws = (unsigned char*)d_ws;
    void* args[] = {&a};
    hipError_t e = hipLaunchCooperativeKernel((const void*)fwd_megakernel, dim3(grid_blocks), dim3(NTHREADS), args, LDS_BYTES, stream);
    if (e != hipSuccess) fprintf(stderr, "cooperative launch failed: %s (grid %d)\n", hipGetErrorString(e), grid_blocks);
}
```

```cpp
#include <hip/hip_runtime.h>
#include <hip/hip_cooperative_groups.h>
#include <cstdio>
#include <cstdint>
namespace cg = cooperative_groups;

namespace nv {
constexpr int INC = 3080;
struct P {
    const float *x, *w_in, *conv_w, *a_log, *dt_bias, *dn_norm_w, *sgu_ln_g, *sgu_ln_b, *w_spatial, *b_spatial, *w_out, *ln1_g, *ln1_b,
        *w_rg, *b_rg, *w_re, *b_re, *w_gate, *w_up, *w_down, *ln2_g, *ln2_b;
    float* out;
};
static inline void bind(P& p, void* const* in, float* out) {
    const float** f = (const float**)&p.x; for (int i = 0; i < 22; ++i) f[i] = (const float*)in[i];
    p.out = out;
}
}
namespace pg8 {
#define PG8_LAS __attribute__((address_space(3)))
typedef unsigned short bf16_t;
typedef short bf16x8 __attribute__((ext_vector_type(8)));
typedef float f32x4 __attribute__((ext_vector_type(4)));
typedef unsigned u32x4 __attribute__((ext_vector_type(4)));
typedef unsigned u32x2 __attribute__((ext_vector_type(2)));
constexpr int BM = 256, BK = 64, HALF = 128, HTB = HALF * BK * 2  , STAGE_BYTES = 8 * HTB, NXCD = 8, WGM = 8;

__host__ __device__ __forceinline__ int lds_byte(int r, int c) { const int st = (r >> 4) * 2 + (c >> 5), rr = r & 15, cc = c & 31, ob = rr * 64 + cc * 2; return st * 1024 + (ob ^ (((ob >> 9) & 1) << 5)); }
__host__ __device__ __forceinline__ void stage_rc(int b, int& R, int& C) { const int st = b / 1024, sb = b % 1024, swz = sb ^ (((sb >> 9) & 1) << 5); R = (st >> 1) * 16 + swz / 64; C = (st & 1) * 32 + (swz % 64) / 2; }
__host__ __device__ __forceinline__ int perm32(int rho) { const int n = rho >> 4, i = rho & 15; return 8 * (i >> 2) + 4 * n + (i & 3); }

struct Unit { int pm, pn, e, rows; };

typedef float f32x2_t __attribute__((ext_vector_type(2))); typedef __bf16 bf16x2_t __attribute__((ext_vector_type(2)));
__device__ __forceinline__ unsigned cvt_pk_bf16(float lo, float hi) { const f32x2_t v = {lo, hi}; const bf16x2_t b = __builtin_convertvector(v, bf16x2_t); return __builtin_bit_cast(unsigned, b); }

__device__ __forceinline__ int lane_id_fresh() { int l; asm volatile("v_mbcnt_lo_u32_b32 %0, -1, 0\n\tv_mbcnt_hi_u32_b32 %0, -1, %0" : "=v"(l)); return l; }
__device__ __forceinline__ int xcd_remap(int L, int nwg) { const int q = nwg / NXCD, r = nwg % NXCD, xcd = L % NXCD, off = L / NXCD; return (xcd < r ? xcd * (q + 1) : r * (q + 1) + (xcd - r) * q) + off; }

struct DenseOrder {
    const bf16_t* A; const bf16_t* Bt; int lda, K; int nM, nN, nwg, G, c;
    static constexpr bool GATHER = false;
    __device__ void init(const bf16_t* A_, int lda_, const bf16_t* Bt_, int M, int N, int K_, int G_, int c_) { A = A_; Bt = Bt_; lda = lda_; K = K_; nM = M / BM; nN = N / BM; nwg = nM * nN; G = G_; c = c_; }
    __device__ bool next(int i, Unit& u) const {
        const long L = (long)i * G + c; if (L >= nwg) return false;
        const int wgid = xcd_remap((int)L, nwg);
        const int nig = WGM * nN, gid = wgid / nig, fm = gid * WGM, gsz = (nM - fm) < WGM ? (nM - fm) : WGM;
        u.pm = fm + ((wgid % nig) % gsz); u.pn = (wgid % nig) / gsz; u.e = 0; u.rows = BM; return true;
    }
    __device__ __forceinline__ const char* a_base(const Unit& u) const { return (const char*)A + (size_t)u.pm * BM * lda * 2; }
    __device__ __forceinline__ const char* b_base(const Unit& u) const { return (const char*)Bt + (size_t)u.pn * BM * K * 2; }
    __device__ __forceinline__ void a_off(const Unit&, const int (&R)[2], const int (&C)[2], unsigned (&v)[4]) const {
#pragma unroll
        for (int h = 0; h < 2; ++h)
#pragma unroll
            for (int i = 0; i < 2; ++i) v[h * 2 + i] = (unsigned)((h * HALF + R[i]) * lda + C[i]) * 2u;
    }
};

struct GroupedOrder {
    const bf16_t* A; const bf16_t* Bt; const int* list; const PG8_LAS int* pref;
    int lda, K, N, cap, ashift, nN, G, c, ne;
    static constexpr bool GATHER = true;
    __device__ bool next(int i, Unit& u) const {
        const int nwg = pref[ne]; const long L = (long)i * G + c; if (L >= nwg) return false;
        const int w = xcd_remap((int)L, nwg);
        int e = 0; while (pref[e + 1] <= w) ++e;
        const int j = w - pref[e], ntm = (pref[e + 1] - pref[e]) / nN;
        u.e = e; u.pm = j % ntm; u.pn = j / ntm; u.rows = 0; return true;
    }
    __device__ __forceinline__ const char* a_base(const Unit&) const { return (const char*)A; }
    __device__ __forceinline__ const char* b_base(const Unit& u) const { return (const char*)Bt + ((size_t)u.e * N + (size_t)u.pn * BM) * K * 2; }
    __device__ __forceinline__ void a_off(const Unit& u, const int (&R)[2], const int (&C)[2], unsigned (&v)[4], int cnt) const {
        const int* lp = list + (size_t)u.e * cap;
#pragma unroll
        for (int h = 0; h < 2; ++h)
#pragma unroll
            for (int i = 0; i < 2; ++i) { int r = u.pm * BM + h * HALF + R[i]; if (r >= cnt) r = 0; const int a = (lp[r] & 0xffff) >> ashift; v[h * 2 + i] = (unsigned)(a * lda + C[i]) * 2u; }
    }
};

template <class Epi, class Sched, bool ALIGN_EPI>
__device__ __forceinline__ void gemm_phase(PG8_LAS unsigned char* lds, const Sched& S, const Epi& E, const int* gcnt, const int wave_s) {
    const int tid_ = wave_s * 64 + lane_id_fresh();
    const int tid = tid_, wid = wave_s, lane = tid & 63, wr = wid >> 2, wc = wid & 3, fr = lane & 15, fq = lane >> 4;
    const int K = S.K, nt = K / BK;
    int Rr[2], Cc[2]; unsigned voffB[2];
#pragma unroll
    for (int i = 0; i < 2; ++i) { int R, C; stage_rc(tid * 16 + i * 8192, R, C); const int Rb = Epi::PERM ? ((R & ~31) + perm32(R & 31)) : R; Rr[i] = R; Cc[i] = C; voffB[i] = (unsigned)(Rb * K + C) * 2u; }
    const size_t kstep = (size_t)(BK * 2);
    const size_t hstep = (size_t)HALF * K * 2;
    const unsigned ldsw = (unsigned)wid * 1024u;
    const int aoff = lds_byte(wr * 64 + fr, fq * 8), boff = lds_byte(wc * 32 + fr, fq * 8);
#define PG8_SA(b, h) (((b) * 2 + (h)) * HTB)
#define PG8_SB(b, h) ((4 + (b) * 2 + (h)) * HTB)
#define PG8_STAGE(bufoff, gbase, v0, v1) do { \
        __builtin_amdgcn_global_load_lds((const unsigned*)((const char*)(gbase) + (v0)), (PG8_LAS unsigned*)(lds + (bufoff) + ldsw), 16, 0, 0); \
        __builtin_amdgcn_global_load_lds((const unsigned*)((const char*)(gbase) + (v1)), (PG8_LAS unsigned*)(lds + (bufoff) + ldsw + 8192), 16, 0, 0); } while (0)
#define PG8_STAGEB(bufoff, gbase) PG8_STAGE(bufoff, gbase, voffB[0], voffB[1])
#define PG8_LDA(dst, b, h) do { _Pragma("unroll") for (int m = 0; m < 4; ++m) _Pragma("unroll") for (int k = 0; k < 2; ++k) dst[m][k] = *(const PG8_LAS bf16x8*)(lds + PG8_SA(b, h) + aoff + m * 2048 + k * 1024); } while (0)
#define PG8_LDB(dst, b, h) do { _Pragma("unroll") for (int n = 0; n < 2; ++n) _Pragma("unroll") for (int k = 0; k < 2; ++k) dst[n][k] = *(const PG8_LAS bf16x8*)(lds + PG8_SB(b, h) + boff + n * 2048 + k * 1024); } while (0)
#define PG8_MMA(ai, bj, At, Bt) do { __builtin_amdgcn_s_setprio(1); _Pragma("unroll") for (int m = 0; m < 4; ++m) _Pragma("unroll") for (int n = 0; n < 2; ++n) _Pragma("unroll") for (int k = 0; k < 2; ++k) \
        acc[ai][bj][m][n] = __builtin_amdgcn_mfma_f32_16x16x32_bf16(Bt[n][k], At[m][k], acc[ai][bj][m][n], 0, 0, 0); __builtin_amdgcn_s_setprio(0); } while (0)
#define PG8_WAIT_V(n) asm volatile("s_waitcnt vmcnt(" #n ")" ::: "memory")
#define PG8_WAIT_L(n) asm volatile("s_waitcnt lgkmcnt(" #n ")" ::: "memory")
#define PG8_BAR __builtin_amdgcn_s_barrier()
#define PG8_SCHED __builtin_amdgcn_sched_barrier(0)
    Unit cur, nxt; int ui = 0;
    if (!S.next(0, cur)) return;
    int ccnt = BM * 1024, ncnt = BM * 1024;
    if constexpr (Sched::GATHER) { ccnt = gcnt[cur.e]; }
    cur.rows = ccnt - cur.pm * BM;
    f32x4 acc[2][2][4][2];
#pragma unroll
    for (int a = 0; a < 2; ++a)
#pragma unroll
        for (int b = 0; b < 2; ++b)
#pragma unroll
            for (int m = 0; m < 4; ++m)
#pragma unroll
                for (int n = 0; n < 2; ++n) acc[a][b][m][n] = (f32x4){0.f, 0.f, 0.f, 0.f};
    bf16x8 At[4][2], B0[2][2], B1[2][2];
    unsigned va[4], vn[4];
    if constexpr (Sched::GATHER) S.a_off(cur, Rr, Cc, va, ccnt); else S.a_off(cur, Rr, Cc, va);
    const char* cA = S.a_base(cur); const char* cB = S.b_base(cur);
    PG8_STAGEB(PG8_SB(0, 0), cB); PG8_STAGEB(PG8_SB(0, 1), cB + hstep); PG8_STAGE(PG8_SA(0, 0), cA, va[0], va[1]); PG8_STAGE(PG8_SA(0, 1), cA, va[2], va[3]);
    if (wr == 1) PG8_BAR;
    PG8_WAIT_V(2); PG8_BAR;
    PG8_STAGEB(PG8_SB(1, 0), cB + kstep); PG8_STAGE(PG8_SA(1, 0), cA + kstep, va[0], va[1]); PG8_STAGEB(PG8_SB(1, 1), cB + hstep + kstep);
    PG8_WAIT_V(6); PG8_BAR;
    for (;;) {
        const bool has_next = S.next(ui + 1, nxt);
        const char* nA = cA; const char* nB = cB;
#pragma unroll
        for (int j = 0; j < 4; ++j) vn[j] = va[j];
        if (has_next) {
            nA = S.a_base(nxt); nB = S.b_base(nxt);
            if constexpr (Sched::GATHER) { ncnt = gcnt[nxt.e]; S.a_off(nxt, Rr, Cc, vn, ncnt); } else S.a_off(nxt, Rr, Cc, vn);
            nxt.rows = ncnt - nxt.pm * BM;
        }
        for (int t = 0; t < nt; t += 2) {
            const bool last = (t == nt - 2);
            const char* a1 = cA + (size_t)(t + 1) * kstep;
            const char* a2 = last ? nA : cA + (size_t)(t + 2) * kstep; const char* b2 = last ? nB : cB + (size_t)(t + 2) * kstep;
            const char* a3 = a2 + kstep; const char* b3 = b2 + kstep;
            unsigned w0 = va[0], w1 = va[1], w2 = va[2], w3 = va[3];
            if (last) { w0 = vn[0]; w1 = vn[1]; w2 = vn[2]; w3 = vn[3]; }
            PG8_LDB(B0, 0, 0); PG8_LDB(B1, 0, 1); PG8_SCHED; PG8_LDA(At, 0, 0); PG8_STAGE(PG8_SA(1, 1), a1, va[2], va[3]);
            PG8_WAIT_V(8); PG8_WAIT_L(0); PG8_BAR; PG8_MMA(0, 0, At, B0); PG8_MMA(0, 1, At, B1); PG8_BAR; PG8_SCHED;
            PG8_LDA(At, 0, 1); PG8_STAGEB(PG8_SB(0, 0), b2); PG8_STAGEB(PG8_SB(0, 1), b2 + hstep); PG8_STAGE(PG8_SA(0, 0), a2, w0, w1);
            PG8_WAIT_V(8); PG8_WAIT_L(0); PG8_BAR; PG8_MMA(1, 0, At, B0); PG8_MMA(1, 1, At, B1); PG8_BAR; PG8_SCHED;
            PG8_LDB(B0, 1, 0); PG8_LDB(B1, 1, 1); PG8_SCHED; PG8_LDA(At, 1, 0); PG8_STAGE(PG8_SA(0, 1), a2, w2, w3);
            PG8_WAIT_V(8); PG8_WAIT_L(0); PG8_BAR; PG8_MMA(0, 0, At, B0); PG8_MMA(0, 1, At, B1); PG8_BAR; PG8_SCHED;
            PG8_LDA(At, 1, 1); PG8_STAGEB(PG8_SB(1, 0), b3); PG8_STAGEB(PG8_SB(1, 1), b3 + hstep); PG8_STAGE(PG8_SA(1, 0), a3, w0, w1);
            PG8_WAIT_V(8); PG8_WAIT_L(0); PG8_BAR; PG8_MMA(1, 0, At, B0); PG8_MMA(1, 1, At, B1); PG8_BAR; PG8_SCHED;
        }
        if constexpr (ALIGN_EPI) { if (wr == 0) PG8_BAR; }
        E(acc, cur, wr, wc, fr, fq);
        if (!has_next) break;
#pragma unroll
        for (int a = 0; a < 2; ++a)
#pragma unroll
            for (int b = 0; b < 2; ++b)
#pragma unroll
                for (int m = 0; m < 4; ++m)
#pragma unroll
                    for (int n = 0; n < 2; ++n) acc[a][b][m][n] = (f32x4){0.f, 0.f, 0.f, 0.f};
        cur = nxt; cA = nA; cB = nB; ++ui;
#pragma unroll
        for (int j = 0; j < 4; ++j) va[j] = vn[j];
        if constexpr (ALIGN_EPI) { if (wr == 1) PG8_BAR; }
    }
    PG8_WAIT_V(0);
    if constexpr (!ALIGN_EPI) { if (wr == 0) PG8_BAR; }
    PG8_BAR;
#undef PG8_SA
#undef PG8_SB
#undef PG8_STAGE
#undef PG8_STAGEB
#undef PG8_LDA
#undef PG8_LDB
#undef PG8_MMA
#undef PG8_WAIT_V
#undef PG8_WAIT_L
#undef PG8_BAR
#undef PG8_SCHED
}

struct EpiBf16 {
    static constexpr bool PERM = true;
    bf16_t* O; int ldc;
    __device__ __forceinline__ void operator()(const f32x4 (&acc)[2][2][4][2], const Unit& u, int wr, int wc, int fr, int fq) const {
        const int row0 = u.pm * BM + wr * 64 + fr, col0 = u.pn * BM + wc * 32 + 8 * fq;
#pragma unroll
        for (int ai = 0; ai < 2; ++ai)
#pragma unroll
            for (int m = 0; m < 4; ++m) { bf16_t* rowp = O + (size_t)(row0 + ai * HALF + m * 16) * ldc + col0;
#pragma unroll
                for (int bj = 0; bj < 2; ++bj) { const f32x4 v0 = acc[ai][bj][m][0], v1 = acc[ai][bj][m][1];
                    u32x4 w; w.x = cvt_pk_bf16(v0[0], v0[1]); w.y = cvt_pk_bf16(v0[2], v0[3]); w.z = cvt_pk_bf16(v1[0], v1[1]); w.w = cvt_pk_bf16(v1[2], v1[3]);
                    *(u32x4*)(rowp + bj * HALF) = w; } }
    }
};
}
#define GAS __attribute__((address_space(1)))
#define LAS __attribute__((address_space(3)))
typedef unsigned short bf16;
typedef unsigned v4u __attribute__((ext_vector_type(4)));
typedef float f32x4 __attribute__((ext_vector_type(4)));
typedef short bf16x8 __attribute__((ext_vector_type(8)));
typedef GAS unsigned gu32;
typedef GAS unsigned long long gu64;
#define RLX_AGENT __ATOMIC_RELAXED, __HIP_MEMORY_SCOPE_AGENT
#define LDS_WAIT() asm volatile("s_waitcnt lgkmcnt(0)" ::: "memory")
#define VM_WAIT() asm volatile("s_waitcnt vmcnt(0)" ::: "memory")
__device__ __forceinline__ unsigned long long rt() { return __builtin_amdgcn_s_memrealtime(); }
__device__ __forceinline__ unsigned f2bf(float f) { unsigned u = __builtin_bit_cast(unsigned, f); return (u + 0x7fffu + ((u >> 16) & 1u)) >> 16; }
__device__ __forceinline__ unsigned pk2(float lo, float hi) { return f2bf(lo) | (f2bf(hi) << 16); }

#define XB_TMO      128
#define XB_XCNT(j)  (256  + 64 * (j))
#define XB_XSUB(j)  (1280 + 64 * (j))
#define XB_XGEN(j)  (2304 + 64 * (j))
#define XB_TOP      3328
#define XB_TOPGEN   3392
#define XCD_BAR_WORDS 3456
#define XB_SPIN_CAP (1u << 18)

__device__ __forceinline__ unsigned xb_ld(unsigned* p)              { return __hip_atomic_load(p, __ATOMIC_RELAXED, __HIP_MEMORY_SCOPE_AGENT); }
__device__ __forceinline__ unsigned xb_add(unsigned* p, unsigned v) { return __hip_atomic_fetch_add(p, v, __ATOMIC_RELAXED, __HIP_MEMORY_SCOPE_AGENT); }
__device__ __forceinline__ unsigned xb_xcc_id() { return (unsigned)__builtin_amdgcn_s_getreg((3 << 11) | 20) & 0xFu; }
#define XB_SPIN(cond, bar) do { unsigned _sp = 0; while (cond) { __builtin_amdgcn_s_sleep(1); \
    if ((++_sp & 255u) == 0u) { if (xb_ld(&(bar)[XB_TMO])) break; if (_sp > XB_SPIN_CAP) { atomicAdd(&(bar)[XB_TMO], 1u); break; } } } } while (0)

struct XcdBarrier {
    unsigned* bar; unsigned x;
    volatile LAS unsigned* st;
};

__device__ __forceinline__ XcdBarrier xcd_barrier_post(unsigned* bar, volatile LAS unsigned* st) {
    XcdBarrier b; b.bar = bar; b.x = xb_xcc_id(); b.st = st;
    if (threadIdx.x == 0) (void)xb_add(&bar[XB_XCNT(b.x)], 1u);
    return b;
}
__device__ __forceinline__ void xcd_barrier_complete(unsigned* bar, unsigned x, unsigned& nloc, unsigned& nx) {
    const unsigned G = gridDim.x * gridDim.y * gridDim.z;
    unsigned sum, cnt, mine, sp = 0u;
    for (;;) {
        sum = 0u; cnt = 0u; mine = 0u;
#pragma unroll
        for (unsigned j = 0; j < 16; ++j) { const unsigned c = xb_ld(&bar[XB_XCNT(j)]); sum += c; cnt += (c > 0u) ? 1u : 0u; mine = (j == x) ? c : mine; }
        if (sum == G) break;
        __builtin_amdgcn_s_sleep(1);
        if ((++sp & 255u) == 0u) { if (xb_ld(&bar[XB_TMO])) break; if (sp > XB_SPIN_CAP) { atomicAdd(&bar[XB_TMO], 1u); break; } }
    }
    nloc = mine > 0u ? mine : 1u; nx = cnt > 0u ? cnt : 1u;
}

__device__ __forceinline__ void xcd_barrier(const XcdBarrier& b) {
    asm volatile("s_waitcnt vmcnt(0)" ::: "memory");
    __syncthreads();
    if (threadIdx.x == 0) {
        unsigned* bar = b.bar;
        __builtin_amdgcn_s_waitcnt(0);
        unsigned nloc = b.st[0], nx = b.st[1];
        if (nloc == 0u) { xcd_barrier_complete(bar, b.x, nloc, nx); b.st[0] = nloc; b.st[1] = nx; }
        const unsigned old = xb_add(&bar[XB_XSUB(b.x)], 1u);
        const unsigned gen = old / nloc;
        if (old + 1u == (gen + 1u) * nloc) {
            __builtin_amdgcn_fence(__ATOMIC_RELEASE, "agent");
            asm volatile("s_waitcnt vmcnt(0)" ::: "memory");
            const unsigned og = xb_add(&bar[XB_TOP], 1u);
            const unsigned tg = og / nx;
            if (og + 1u == (tg + 1u) * nx) xb_add(&bar[XB_TOPGEN], 1u);
            else XB_SPIN(xb_ld(&bar[XB_TOPGEN]) == tg, bar);
            __builtin_amdgcn_fence(__ATOMIC_ACQUIRE, "agent");
            xb_add(&bar[XB_XGEN(b.x)], 1u);
            asm volatile("s_waitcnt vmcnt(0)" ::: "memory");
        } else {
            XB_SPIN(xb_ld(&bar[XB_XGEN(b.x)]) == gen, bar);
            __builtin_amdgcn_fence(__ATOMIC_ACQUIRE, "agent");
            asm volatile("s_waitcnt vmcnt(0)" ::: "memory");
        }
    }
    __syncthreads();
}

constexpr int NTOK = 32768, DM = 1024, NPROJ = 3328;
constexpr int PC_Q = 0, PC_K = 512, PC_V = 1024, PC_Z = 1536, PC_U = 2048, PC_VS = 2560, PC_B = 3072, PC_A = 3076;
constexpr int NEXP = 64, DEXP = 512;
constexpr size_t MiB = 1u << 20;
constexpr size_t WS_CTL = 0, CTL_ZERO_BYTES = 1 * MiB;
constexpr size_t WS_WIN = 1 * MiB, WS_WOUT = 8 * MiB, WS_LIST = 10 * MiB, WS_ROUTE = 18 * MiB;
constexpr size_t WS_WREP = 19 * MiB;
constexpr size_t WS_C = 20 * MiB;
constexpr size_t WS_WGU = WS_C, WS_WD = WS_C + 128 * MiB;
constexpr size_t WS_A = 212 * MiB;
constexpr size_t WS_B = 276 * MiB;
constexpr size_t WS_H1BF = WS_B, WS_YEXP = WS_B + 64 * MiB;
constexpr size_t WS_END = 484 * MiB;
constexpr int CW_BAR = 4096;
constexpr int CW_CNT = 16384;
constexpr int RING_BYTES = 131072, LDSCTL_OFF = RING_BYTES, MISC_OFF = LDSCTL_OFF + 320, PREF_OFF = MISC_OFF + 128, LDS_BYTES = 147456;
constexpr int NTHREADS = 512, NWAVES = 8;
#ifndef GEMM_WGS_N
#define GEMM_WGS_N 184
#endif
constexpr int GEMM_WGS = GEMM_WGS_N;
constexpr float ALPHA_F = 1.189207115002721f;

__device__ __forceinline__ float bf2f(unsigned short v) { return __builtin_bit_cast(float, (unsigned)v << 16); }
__device__ __forceinline__ float wave_sum(float v) {
#pragma unroll
    for (int o = 1; o < 64; o <<= 1) v += __shfl_xor(v, o);
    return v;
}

__device__ __forceinline__ void p0_item_load(const float* W, int ldw, int k0, int n0src, int lane, float (&r)[32]) {
#pragma unroll
    for (int i = 0; i < 32; ++i) r[i] = W[(size_t)(k0 + 2 * i + (lane >> 5)) * ldw + n0src + (lane & 31)];
}
__device__ __forceinline__ void p0_item_store(const float (&r)[32], int K, int k0, bf16* WT, int dst_row0, LAS float* scr, int lane) {
#pragma unroll
    for (int i = 0; i < 32; ++i) scr[(2 * i + (lane >> 5)) * 33 + (lane & 31)] = r[i];
    LDS_WAIT(); asm volatile("" ::: "memory");
    const int c = lane & 7;
#pragma unroll
    for (int j = 0; j < 4; ++j) { const int n = (lane >> 3) + 8 * j; const LAS float* s = scr + (8 * c) * 33 + n;
        v4u o; o.x = pk2(s[0 * 33], s[1 * 33]); o.y = pk2(s[2 * 33], s[3 * 33]); o.z = pk2(s[4 * 33], s[5 * 33]); o.w = pk2(s[6 * 33], s[7 * 33]);
        *(GAS v4u*)(WT + (size_t)(dst_row0 + n) * K + k0 + 8 * c) = o; }
    LDS_WAIT(); asm volatile("" ::: "memory");
}
__device__ __forceinline__ void p0_transpose_item(const float* W, int ldw, int K, int k0, int n0src, bf16* WT, int dst_row0, LAS float* scr, int lane) {
    float r[32]; p0_item_load(W, ldw, k0, n0src, lane, r); p0_item_store(r, K, k0, WT, dst_row0, scr, lane);
}
struct P0Exp { const float* W; bf16* WT; int ldw, K, k0, n0, drow; };
__device__ __forceinline__ P0Exp p0_exp_item(int it, const float* wg, const float* wu, const float* wd, bf16* WGU, bf16* WD) {
    P0Exp x;
    if (it < 32768) { const int nb = it & 15, kb = (it >> 4) & 15, half = (it >> 8) & 1, e = it >> 9, n0 = nb * 32;
        x.W = (half ? wu : wg) + (size_t)e * DM * DEXP; x.WT = WGU + (size_t)e * 1024 * DM; x.ldw = DEXP; x.K = DM; x.k0 = kb * 64; x.n0 = n0; x.drow = (n0 >> 7) * 256 + half * 128 + (n0 & 127); }
    else { const int i2 = it - 32768, nb = i2 & 31, kb = (i2 >> 5) & 7, e = i2 >> 8;
        x.W = wd + (size_t)e * DEXP * DM; x.WT = WD + (size_t)e * DM * DEXP; x.ldw = DM; x.K = DEXP; x.k0 = kb * 64; x.n0 = nb * 32; x.drow = nb * 32; }
    return x;
}
__device__ __forceinline__ void p0_item_load4(const float* W, int ldw, int k0, int n0src, int lane, f32x4 (&r)[8]) {
#pragma unroll
    for (int i = 0; i < 8; ++i) r[i] = *(const GAS f32x4*)(W + (size_t)(k0 + (lane >> 3) + 8 * i) * ldw + n0src + 4 * (lane & 7));
}
__device__ __forceinline__ void p0_item_store4(const f32x4 (&r)[8], int K, int k0, bf16* WT, int dst_row0, LAS float* scr, int lane) {
#pragma unroll
    for (int i = 0; i < 8; ++i) { LAS float* d = scr + ((lane >> 3) + 8 * i) * 33 + 4 * (lane & 7); d[0] = r[i].x; d[1] = r[i].y; d[2] = r[i].z; d[3] = r[i].w; }
    LDS_WAIT(); asm volatile("" ::: "memory");
    const int c = lane & 7;
#pragma unroll
    for (int j = 0; j < 4; ++j) { const int n = (lane >> 3) + 8 * j; const LAS float* s = scr + (8 * c) * 33 + n;
        v4u o; o.x = pk2(s[0 * 33], s[1 * 33]); o.y = pk2(s[2 * 33], s[3 * 33]); o.z = pk2(s[4 * 33], s[5 * 33]); o.w = pk2(s[6 * 33], s[7 * 33]);
        *(GAS v4u*)(WT + (size_t)(dst_row0 + n) * K + k0 + 8 * c) = o; }
    LDS_WAIT(); asm volatile("" ::: "memory");
}
__device__ __forceinline__ void p0_experts(const float* wg, const float* wu, const float* wd, bf16* WGU, bf16* WD, LAS float* scr, int gw, int NGW, int lane) {
    constexpr int NIT = 32768 + 16384;
    f32x4 A[8], B[8], C[8], D[8];
#define P0_LOAD(buf, item) do { if ((item) < NIT) { const P0Exp x_ = p0_exp_item((item), wg, wu, wd, WGU, WD); p0_item_load4(x_.W, x_.ldw, x_.k0, x_.n0, lane, buf); } } while (0)
#define P0_STORE(buf, item) do { if ((item) < NIT) { const P0Exp x_ = p0_exp_item((item), wg, wu, wd, WGU, WD); p0_item_store4(buf, x_.K, x_.k0, x_.WT, x_.drow, scr, lane); } } while (0)
    int it = gw;
    P0_LOAD(A, it); P0_LOAD(B, it + NGW); P0_LOAD(C, it + 2 * NGW);
    for (; it < NIT; it += 4 * NGW) {
        P0_LOAD(D, it + 3 * NGW); P0_STORE(A, it);
        P0_LOAD(A, it + 4 * NGW); P0_STORE(B, it + NGW);
        P0_LOAD(B, it + 5 * NGW); P0_STORE(C, it + 2 * NGW);
        P0_LOAD(C, it + 6 * NGW); P0_STORE(D, it + 3 * NGW);
    }
#undef P0_LOAD
#undef P0_STORE
}

struct MK {
    nv::P p;
    unsigned char* ws;
};

namespace pg8 {
__device__ __forceinline__ float silu_f(float x) { return x * __builtin_amdgcn_rcpf(1.f + __builtin_amdgcn_exp2f(-1.4426950408889634f * x)); }
struct EpiHid {
    static constexpr bool PERM = true;
    bf16_t* HID; const int* list; const int* cnt; int cap;
    __device__ __forceinline__ void operator()(const f32x4 (&acc)[2][2][4][2], const Unit& u, int wr, int wc, int fr, int fq) const {
        const int* lp = list + (size_t)u.e * cap; const int col0 = u.pn * 128 + wc * 32 + 8 * fq;
#pragma unroll
        for (int ai = 0; ai < 2; ++ai)
#pragma unroll
            for (int m = 0; m < 4; ++m) { const int r = ai * HALF + wr * 64 + m * 16 + fr;
                if (r < u.rows) { const int a = lp[u.pm * BM + r] & 0xffff;
                    const f32x4 g0 = acc[ai][0][m][0], g1 = acc[ai][0][m][1], u0 = acc[ai][1][m][0], u1 = acc[ai][1][m][1];
                    u32x4 w; w.x = cvt_pk_bf16(silu_f(g0[0]) * u0[0], silu_f(g0[1]) * u0[1]); w.y = cvt_pk_bf16(silu_f(g0[2]) * u0[2], silu_f(g0[3]) * u0[3]);
                    w.z = cvt_pk_bf16(silu_f(g1[0]) * u1[0], silu_f(g1[1]) * u1[1]); w.w = cvt_pk_bf16(silu_f(g1[2]) * u1[2], silu_f(g1[3]) * u1[3]);
                    *(u32x4*)(HID + (size_t)a * 512 + col0) = w; } }
    }
};
struct EpiYexp {
    static constexpr bool PERM = true;
    bf16_t* Y; const int* list; const float* wgt; int cap;
    __device__ __forceinline__ void operator()(const f32x4 (&acc)[2][2][4][2], const Unit& u, int wr, int wc, int fr, int fq) const {
        const int* lp = list + (size_t)u.e * cap; const int col0 = u.pn * BM + wc * 32 + 8 * fq;
#pragma unroll
        for (int ai = 0; ai < 2; ++ai)
#pragma unroll
            for (int m = 0; m < 4; ++m) { const int r = ai * HALF + wr * 64 + m * 16 + fr;
                if (r < u.rows) { const unsigned ent = (unsigned)lp[u.pm * BM + r]; const int a = (int)(ent & 0xffffu); const float w8 = __builtin_bit_cast(float, ent & 0xffff0000u);
#pragma unroll
                    for (int bj = 0; bj < 2; ++bj) { const f32x4 v0 = acc[ai][bj][m][0] * w8, v1 = acc[ai][bj][m][1] * w8;
                        u32x4 w; w.x = cvt_pk_bf16(v0[0], v0[1]); w.y = cvt_pk_bf16(v0[2], v0[3]); w.z = cvt_pk_bf16(v1[0], v1[1]); w.w = cvt_pk_bf16(v1[2], v1[3]);
                        *(u32x4*)(Y + (size_t)a * 1024 + col0 + bj * HALF) = w; } } }
    }
};

struct EpiZ1 {
    static constexpr bool PERM = false;
    float* O; const float* X; float alpha;
    __device__ __forceinline__ void operator()(const f32x4 (&acc)[2][2][4][2], const Unit& u, int wr, int wc, int fr, int fq) const {
        const int row0 = u.pm * BM + wr * 64 + fr, col0 = u.pn * BM + wc * 32 + 4 * fq;
#pragma unroll
        for (int ai = 0; ai < 2; ++ai)
#pragma unroll
            for (int m = 0; m < 4; ++m) { const size_t off = (size_t)(row0 + ai * HALF + m * 16) * 1024 + col0;
#pragma unroll
                for (int bj = 0; bj < 2; ++bj)
#pragma unroll
                    for (int n = 0; n < 2; ++n) { const f32x4 xv = *(const f32x4*)(X + off + bj * HALF + n * 16); *(f32x4*)(O + off + bj * HALF + n * 16) = acc[ai][bj][m][n] + xv * alpha; } }
    }
};
}


typedef short s16x4 __attribute__((ext_vector_type(4)));
typedef short v4i16_t __attribute__((ext_vector_type(4)));
__device__ __forceinline__ unsigned off_b(unsigned row, unsigned ch) { return 256u * row + 16u * (ch ^ (((row & 3) << 2) | ((row >> 2) & 3))); }
__device__ __forceinline__ s16x4 vtr(LAS unsigned char* p) { return __builtin_bit_cast(s16x4, __builtin_amdgcn_ds_read_tr16_b64_v4i16((LAS v4i16_t*)p)); }
__device__ __forceinline__ float gelu_tanh(float x) { return x * __builtin_amdgcn_rcpf(1.f + __builtin_amdgcn_exp2f(-2.3022081986f * (x + 0.044715f * x * x * x))); }

__device__ __forceinline__ void sgu_phase(LAS unsigned char* lds, bf16* PROJ, const nv::P& p, int G, int vcu, int wave_s) {
    const int lane = pg8::lane_id_fresh(), tid = wave_s * 64 + lane;
    const int g4 = lane >> 4, q = (lane & 15) >> 2, pp = lane & 3, l15 = lane & 15;
    v4u rawn[4];
    { const int u0 = vcu < 1024 ? vcu : 0; const bf16* src = PROJ + ((size_t)(u0 >> 2) * 128 + (tid >> 2)) * NPROJ + PC_VS + (u0 & 3) * 128 + (tid & 3) * 32;
#pragma unroll
      for (int i = 0; i < 4; ++i) rawn[i] = *(const GAS v4u*)(src + 8 * i); }
    for (int u = vcu; u < 1024; u += G) {
        const int g = u & 3, bc = u >> 2; const size_t row0 = (size_t)bc * 128;
        {
            const int s = tid >> 2, qt = tid & 3;
            v4u raw[4];
#pragma unroll
            for (int i = 0; i < 4; ++i) raw[i] = rawn[i];
            { const int un = (u + G < 1024) ? u + G : u; const bf16* srcn = PROJ + ((size_t)(un >> 2) * 128 + s) * NPROJ + PC_VS + (un & 3) * 128 + qt * 32;
#pragma unroll
              for (int i = 0; i < 4; ++i) rawn[i] = *(const GAS v4u*)(srcn + 8 * i); }
            float x[32]; float s1 = 0.f;
#pragma unroll
            for (int i = 0; i < 4; ++i)
#pragma unroll
                for (int c = 0; c < 4; ++c) { const unsigned w = raw[i][c]; const float a = gelu_tanh(__builtin_bit_cast(float, w << 16)), b = gelu_tanh(__builtin_bit_cast(float, w & 0xffff0000u)); x[i * 8 + c * 2] = a; x[i * 8 + c * 2 + 1] = b; s1 += a + b; }
            s1 += __shfl_xor(s1, 1); s1 += __shfl_xor(s1, 2);
            const float mean = s1 * (1.f / 128.f); float s2 = 0.f;
#pragma unroll
            for (int i = 0; i < 32; ++i) { x[i] -= mean; s2 += x[i] * x[i]; }
            s2 += __shfl_xor(s2, 1); s2 += __shfl_xor(s2, 2);
            const float rstd = 1.f / sqrtf(s2 * (1.f / 128.f) + 1e-5f);
            const float* lg = p.sgu_ln_g + g * 128 + qt * 32; const float* lb = p.sgu_ln_b + g * 128 + qt * 32;
#pragma unroll
            for (int i = 0; i < 4; ++i) { const f32x4 g0 = *(const GAS f32x4*)(lg + 8 * i), g1 = *(const GAS f32x4*)(lg + 8 * i + 4), b0 = *(const GAS f32x4*)(lb + 8 * i), b1 = *(const GAS f32x4*)(lb + 8 * i + 4);
                v4u o; o.x = pk2(x[8 * i] * rstd * g0.x + b0.x, x[8 * i + 1] * rstd * g0.y + b0.y); o.y = pk2(x[8 * i + 2] * rstd * g0.z + b0.z, x[8 * i + 3] * rstd * g0.w + b0.w);
                o.z = pk2(x[8 * i + 4] * rstd * g1.x + b1.x, x[8 * i + 5] * rstd * g1.y + b1.y); o.w = pk2(x[8 * i + 6] * rstd * g1.z + b1.z, x[8 * i + 7] * rstd * g1.w + b1.w);
                *(LAS v4u*)(lds + off_b((unsigned)s, (unsigned)(qt * 4 + i))) = o; }
        }
        __syncthreads();
        {
            const int w = wave_s, t = 16 * w + l15, nks = (w >> 1) + 1;
            bf16* rowp = PROJ + (row0 + t) * NPROJ;
            unsigned long long uu8[8];
#pragma unroll
            for (int dt = 0; dt < 8; ++dt) uu8[dt] = *(const GAS unsigned long long*)(rowp + PC_U + g * 128 + 16 * dt + 4 * g4);
            const float bias = p.b_spatial[g * 128 + t];
            f32x4 acc[8];
#pragma unroll
            for (int dt = 0; dt < 8; ++dt) acc[dt] = (f32x4){0.f, 0.f, 0.f, 0.f};
            for (int ks = 0; ks < nks; ++ks) {
                const int sb = 32 * ks + 8 * g4;
                const float* wp = p.w_spatial + ((size_t)(g * 128 + t)) * 128 + sb;
                const f32x4 w0 = *(const GAS f32x4*)wp, w1 = *(const GAS f32x4*)(wp + 4);
                float wv[8] = {w0.x, w0.y, w0.z, w0.w, w1.x, w1.y, w1.z, w1.w};
#pragma unroll
                for (int j = 0; j < 8; ++j) if (sb + j > t) wv[j] = 0.f;
                v4u bw; bw.x = pk2(wv[0], wv[1]); bw.y = pk2(wv[2], wv[3]); bw.z = pk2(wv[4], wv[5]); bw.w = pk2(wv[6], wv[7]);
                const bf16x8 bfrag = __builtin_bit_cast(bf16x8, bw);
#pragma unroll
                for (int dt = 0; dt < 8; ++dt) {
                    const s16x4 lo = vtr(lds + off_b((unsigned)(sb + q), (unsigned)(2 * dt + (pp >> 1))) + 8 * (pp & 1));
                    const s16x4 hi = vtr(lds + off_b((unsigned)(sb + 4 + q), (unsigned)(2 * dt + (pp >> 1))) + 8 * (pp & 1));
                    const bf16x8 afrag = (bf16x8){lo[0], lo[1], lo[2], lo[3], hi[0], hi[1], hi[2], hi[3]};
                    acc[dt] = __builtin_amdgcn_mfma_f32_16x16x32_bf16(afrag, bfrag, acc[dt], 0, 0, 0);
                }
            }
#pragma unroll
            for (int dt = 0; dt < 8; ++dt) {
                const int d = g * 128 + 16 * dt + 4 * g4;
                const unsigned long long uu = uu8[dt];
                const float u0 = gelu_tanh(bf2f((unsigned short)uu)), u1 = gelu_tanh(bf2f((unsigned short)(uu >> 16))), u2 = gelu_tanh(bf2f((unsigned short)(uu >> 32))), u3 = gelu_tanh(bf2f((unsigned short)(uu >> 48)));
                const unsigned long long o = (unsigned long long)pk2(u0 * (acc[dt][0] + bias), u1 * (acc[dt][1] + bias)) | ((unsigned long long)pk2(u2 * (acc[dt][2] + bias), u3 * (acc[dt][3] + bias)) << 32);
                *(GAS unsigned long long*)(rowp + 512 + d) = o;
            }
        }
        __syncthreads();
    }
}

constexpr int DNA_PIECES = 57, DNU_PIECES = 2, DN_STEP_BYTES = (DNA_PIECES + DNU_PIECES) * 1024;
constexpr size_t DNA_CHUNK_BYTES = (size_t)DNA_PIECES * 1024, DNU_CHUNK_BYTES = 8 * DNU_PIECES * 1024;
__device__ __forceinline__ void glds16(const void* gsrc, LAS unsigned char* dst) { __builtin_amdgcn_global_load_lds((const unsigned*)gsrc, (LAS unsigned*)dst, 16, 0, 0); }
typedef float f32x2_t __attribute__((ext_vector_type(2))); typedef __bf16 bf16x2_t __attribute__((ext_vector_type(2)));
__device__ __forceinline__ unsigned cvtpk(float lo, float hi) { const f32x2_t v = {lo, hi}; const bf16x2_t b = __builtin_convertvector(v, bf16x2_t); return __builtin_bit_cast(unsigned, b); }

constexpr int DN_RING_PIECES = 42, DN_SLOT_BYTES = DN_RING_PIECES * 1024;
__device__ __forceinline__ void dn_scan_phase(LAS unsigned char* lds, const unsigned char* DNA, const unsigned char* DNU, bf16* ODN, int vcu, int wave_s) {
    if (vcu >= 256) return;
    const int lane = pg8::lane_id_fresh();
    const int bh = vcu >> 3, sl = vcu & 7, l15 = lane & 15, g4 = lane >> 4;
    const unsigned char* a_src = DNA + (size_t)bh * 64 * DNA_CHUNK_BYTES + lane * 16;
    const unsigned char* u_src = DNU + ((size_t)bh * 64 * 8 + sl) * (DNU_PIECES * 1024) + lane * 16;
#define DN_STAGE(step) do { if (wave_s >= 1 && wave_s <= 6) { const unsigned char* as_ = a_src + (size_t)(step) * DNA_CHUNK_BYTES; const unsigned char* us_ = u_src + (size_t)(step) * DNU_CHUNK_BYTES; \
        LAS unsigned char* sp_ = lds + ((step) % 3) * DN_SLOT_BYTES; \
        _Pragma("unroll") for (int i_ = 0; i_ < 7; ++i_) { const int p_ = (wave_s - 1) + 6 * i_; \
            const unsigned char* g_ = p_ < 16 ? as_ + p_ * 1024 : p_ < 32 ? as_ + (16 + p_) * 1024 : p_ < 40 ? as_ + (16 + p_) * 1024 : us_ + (p_ - 40) * 1024; \
            glds16(g_, sp_ + p_ * 1024); } } } while (0)
    DN_STAGE(0); DN_STAGE(1);
    if (wave_s != 0) {
        for (int n = 0; n < 64; ++n) {
            if (n < 63) asm volatile("s_waitcnt vmcnt(7)" ::: "memory"); else asm volatile("s_waitcnt vmcnt(0)" ::: "memory");
            __builtin_amdgcn_s_barrier();
            asm volatile("" ::: "memory");
            if (n + 2 < 64) DN_STAGE(n + 2);
        }
        asm volatile("s_waitcnt vmcnt(0)" ::: "memory");
        return;
    }
#undef DN_STAGE
    f32x4 S[8];
#pragma unroll
    for (int k = 0; k < 8; ++k) S[k] = (f32x4){0.f, 0.f, 0.f, 0.f};
    bf16x8 Qc[16], Qn[16]; float glc, gln;
#pragma unroll
    for (int i = 0; i < 16; ++i) Qc[i] = *(const GAS bf16x8*)(a_src + (16 + i) * 1024);
    glc = *(const GAS float*)(a_src + 56 * 1024);
    bf16* orow = ODN + (size_t)vcu * (64 * 64 * 16) + l15;
    for (int n = 0; n < 64; ++n) {
        asm volatile("s_waitcnt lgkmcnt(0)" ::: "memory");
        __builtin_amdgcn_s_barrier();
        asm volatile("" ::: "memory");
        { const unsigned char* nx = a_src + (size_t)(n + 1 < 64 ? n + 1 : n) * DNA_CHUNK_BYTES;
#pragma unroll
          for (int i = 0; i < 16; ++i) Qn[i] = *(const GAS bf16x8*)(nx + (16 + i) * 1024);
          gln = *(const GAS float*)(nx + 56 * 1024); }
        LAS unsigned char* lb = lds + (n % 3) * DN_SLOT_BYTES + lane * 16;
#define FRAG(piece) (*(const LAS bf16x8*)(lb + (piece) * 1024))
        bf16x8 Sb[4];
#pragma unroll
        for (int ks = 0; ks < 4; ++ks) { v4u w; w.x = cvtpk(S[2 * ks][0], S[2 * ks][1]); w.y = cvtpk(S[2 * ks][2], S[2 * ks][3]); w.z = cvtpk(S[2 * ks + 1][0], S[2 * ks + 1][1]); w.w = cvtpk(S[2 * ks + 1][2], S[2 * ks + 1][3]); Sb[ks] = __builtin_bit_cast(bf16x8, w); }
        f32x4 P[4];
        { const v4u u0 = *(const LAS v4u*)(lb + 40 * 1024), u1 = *(const LAS v4u*)(lb + 41 * 1024);
          P[0] = (f32x4){__builtin_bit_cast(float, u0.x << 16), __builtin_bit_cast(float, u0.x & 0xffff0000u), __builtin_bit_cast(float, u0.y << 16), __builtin_bit_cast(float, u0.y & 0xffff0000u)};
          P[1] = (f32x4){__builtin_bit_cast(float, u0.z << 16), __builtin_bit_cast(float, u0.z & 0xffff0000u), __builtin_bit_cast(float, u0.w << 16), __builtin_bit_cast(float, u0.w & 0xffff0000u)};
          P[2] = (f32x4){__builtin_bit_cast(float, u1.x << 16), __builtin_bit_cast(float, u1.x & 0xffff0000u), __builtin_bit_cast(float, u1.y << 16), __builtin_bit_cast(float, u1.y & 0xffff0000u)};
          P[3] = (f32x4){__builtin_bit_cast(float, u1.z << 16), __builtin_bit_cast(float, u1.z & 0xffff0000u), __builtin_bit_cast(float, u1.w << 16), __builtin_bit_cast(float, u1.w & 0xffff0000u)}; }
#pragma unroll
        for (int mt = 0; mt < 4; ++mt)
#pragma unroll
            for (int ks = 0; ks < 4; ++ks) P[mt] = __builtin_amdgcn_mfma_f32_16x16x32_bf16(FRAG(mt * 4 + ks), Sb[ks], P[mt], 0, 0, 0);
        bf16x8 Vb[2];
#pragma unroll
        for (int ks = 0; ks < 2; ++ks) { v4u w; w.x = cvtpk(P[2 * ks][0], P[2 * ks][1]); w.y = cvtpk(P[2 * ks][2], P[2 * ks][3]); w.z = cvtpk(P[2 * ks + 1][0], P[2 * ks + 1][1]); w.w = cvtpk(P[2 * ks + 1][2], P[2 * ks + 1][3]); Vb[ks] = __builtin_bit_cast(bf16x8, w); }
        f32x4 O[4];
#pragma unroll
        for (int mt = 0; mt < 4; ++mt) { O[mt] = (f32x4){0.f, 0.f, 0.f, 0.f};
#pragma unroll
            for (int ks = 0; ks < 4; ++ks) O[mt] = __builtin_amdgcn_mfma_f32_16x16x32_bf16(Qc[mt * 4 + ks], Sb[ks], O[mt], 0, 0, 0);
#pragma unroll
            for (int ks = 0; ks < 2; ++ks) O[mt] = __builtin_amdgcn_mfma_f32_16x16x32_bf16(FRAG(32 + mt * 2 + ks), Vb[ks], O[mt], 0, 0, 0); }
#pragma unroll
        for (int kt = 0; kt < 8; ++kt) { S[kt] = S[kt] * glc;
#pragma unroll
            for (int ks = 0; ks < 2; ++ks) S[kt] = __builtin_amdgcn_mfma_f32_16x16x32_bf16(FRAG(16 + kt * 2 + ks), Vb[ks], S[kt], 0, 0, 0); }
#undef FRAG
        bf16* ob = orow + (size_t)(n * 64 + 4 * g4) * 16;
#pragma unroll
        for (int mt = 0; mt < 4; ++mt)
#pragma unroll
            for (int r = 0; r < 4; ++r) ob[(16 * mt + r) * 16] = (bf16)f2bf(O[mt][r]);
#pragma unroll
        for (int i = 0; i < 16; ++i) Qc[i] = Qn[i];
        glc = gln;
    }
    asm volatile("s_waitcnt vmcnt(0)" ::: "memory");
}

__device__ __forceinline__ void dn_final_phase(const bf16* ODN, bf16* PROJ, const float* norm_w, int gw, int NGW, int lane) {
    const f32x4 nw0 = *(const GAS f32x4*)(norm_w + ((8 * lane) & 127)), nw1 = *(const GAS f32x4*)(norm_w + ((8 * lane) & 127) + 4);
#define DNF_LOAD(mm, OV, ZV) do { const int bb_ = (mm) >> 12, nn_ = ((mm) >> 6) & 63, ii_ = (mm) & 63; \
        OV = *(const GAS v4u*)(ODN + ((((size_t)((bb_ * 4 + (lane >> 4)) * 8 + ((lane >> 1) & 7)) * 64 + nn_) * 64 + ii_) * 16 + 8 * (lane & 1))); ZV = *(const GAS v4u*)(PROJ + (size_t)(mm) * NPROJ + PC_Z + 8 * lane); } while (0)
    v4u ovn, zvn; DNF_LOAD(gw < NTOK ? gw : 0, ovn, zvn);
    for (int m = gw; m < NTOK; m += NGW) {
        const v4u ov = ovn, zv = zvn;
        { const int mn = (m + NGW < NTOK) ? m + NGW : m; DNF_LOAD(mn, ovn, zvn); }
        float o[8], z[8];
#pragma unroll
        for (int c = 0; c < 4; ++c) { o[2 * c] = __builtin_bit_cast(float, ov[c] << 16); o[2 * c + 1] = __builtin_bit_cast(float, ov[c] & 0xffff0000u); z[2 * c] = __builtin_bit_cast(float, zv[c] << 16); z[2 * c + 1] = __builtin_bit_cast(float, zv[c] & 0xffff0000u); }
        float ss = 0.f;
#pragma unroll
        for (int c = 0; c < 8; ++c) ss += o[c] * o[c];
        ss += __shfl_xor(ss, 1); ss += __shfl_xor(ss, 2); ss += __shfl_xor(ss, 4); ss += __shfl_xor(ss, 8);
        const float rs = 1.f / sqrtf(ss * (1.f / 128.f) + 1e-6f);
        const float nw[8] = {nw0.x, nw0.y, nw0.z, nw0.w, nw1.x, nw1.y, nw1.z, nw1.w};
        float y[8];
#pragma unroll
        for (int c = 0; c < 8; ++c) y[c] = o[c] * rs * nw[c] * z[c] * __builtin_amdgcn_rcpf(1.f + __builtin_amdgcn_exp2f(-1.4426950408889634f * z[c]));
        v4u w; w.x = pk2(y[0], y[1]); w.y = pk2(y[2], y[3]); w.z = pk2(y[4], y[5]); w.w = pk2(y[6], y[7]);
        *(GAS v4u*)(PROJ + (size_t)m * NPROJ + 8 * lane) = w;
    }
}

__device__ __forceinline__ float wave_sum_dpp(float v) {
    v = v + __builtin_bit_cast(float, __builtin_amdgcn_update_dpp(0, __builtin_bit_cast(int, v), 0xB1, 0xf, 0xf, true));
    v = v + __builtin_bit_cast(float, __builtin_amdgcn_update_dpp(0, __builtin_bit_cast(int, v), 0x4E, 0xf, 0xf, true));
    v = v + __builtin_bit_cast(float, __builtin_amdgcn_update_dpp(0, __builtin_bit_cast(int, v), 0x141, 0xf, 0xf, true));
    v = v + __builtin_bit_cast(float, __builtin_amdgcn_update_dpp(0, __builtin_bit_cast(int, v), 0x140, 0xf, 0xf, true));
    v = v + __builtin_bit_cast(float, __builtin_amdgcn_update_dpp(0, __builtin_bit_cast(int, v), 0x142, 0xa, 0xf, true));
    v = v + __builtin_bit_cast(float, __builtin_amdgcn_update_dpp(0, __builtin_bit_cast(int, v), 0x143, 0xc, 0xf, true));
    return __builtin_bit_cast(float, __builtin_amdgcn_readlane(__builtin_bit_cast(int, v), 63));
}

constexpr int XTAB_OFF = RING_BYTES + 2048, XTAB_BYTES = 1792;
__device__ __forceinline__ unsigned off_t64(unsigned row, unsigned ch) { return 128u * row + 16u * (ch ^ (row & 7u)); }
__device__ __forceinline__ bf16x8 pack8(const float (&v)[8]) { v4u w; w.x = cvtpk(v[0], v[1]); w.y = cvtpk(v[2], v[3]); w.z = cvtpk(v[4], v[5]); w.w = cvtpk(v[6], v[7]); return __builtin_bit_cast(bf16x8, w); }
__device__ __forceinline__ void unpack8(const v4u w, float (&v)[8]) {
#pragma unroll
    for (int c = 0; c < 4; ++c) { v[2 * c] = __builtin_bit_cast(float, w[c] << 16); v[2 * c + 1] = __builtin_bit_cast(float, w[c] & 0xffff0000u); }
}
__device__ __forceinline__ float conv_silu_rows(const bf16* src0, bool seq_start, const float* cw, LAS unsigned char* img, int lane) {
    float w[4][2];
#pragma unroll
    for (int j = 0; j < 4; ++j) { const f32x2_t t = *(const GAS f32x2_t*)(cw + j * 1536 + 2 * lane); w[j][0] = t[0]; w[j][1] = t[1]; }
    const GAS unsigned* gsrc = (const GAS unsigned*)(src0 + 2 * lane);
    unsigned raw[67];
#pragma unroll
    for (int r = 0; r < 3; ++r) raw[r] = seq_start ? 0u : gsrc[(long)(r - 3) * (NPROJ / 2)];
#pragma unroll
    for (int r = 0; r < 64; ++r) raw[3 + r] = gsrc[(size_t)r * (NPROJ / 2)];
    float myss = 0.f;
    const unsigned lbase = (unsigned)((lane & 3) * 4);
#pragma unroll
    for (int pz = 0; pz < 64; ++pz) {
        float y0 = 0.f, y1 = 0.f;
#pragma unroll
        for (int j = 0; j < 4; ++j) { const unsigned u = raw[pz + j]; y0 += w[j][0] * __builtin_bit_cast(float, u << 16); y1 += w[j][1] * __builtin_bit_cast(float, u & 0xffff0000u); }
        y0 = y0 * __builtin_amdgcn_rcpf(1.f + __builtin_amdgcn_exp2f(-1.4426950408889634f * y0));
        y1 = y1 * __builtin_amdgcn_rcpf(1.f + __builtin_amdgcn_exp2f(-1.4426950408889634f * y1));
        const float tot = wave_sum_dpp(y0 * y0 + y1 * y1);
        myss = (lane == pz) ? tot : myss;
        *(LAS unsigned*)(img + off_b((unsigned)pz, (unsigned)(lane >> 2)) + lbase) = cvtpk(y0, y1);
    }
    return myss;
}

template <int STOP>
__device__ __forceinline__ void dn_prep_chunk(LAS unsigned char* IMG  , LAS float* tab, const bf16* PROJ, const nv::P& p, unsigned char* DNA, unsigned char* DNU, int ci) {
    int lane = pg8::lane_id_fresh();
    const int bh = ci >> 6, n = ci & 63, b = bh >> 2, h = bh & 3;
    int l15 = lane & 15, g4 = lane >> 4, q = l15 >> 2, pp = lane & 3;
    LAS float* t_gc = tab; LAS float* t_be = tab + 64; LAS float* t_rk = tab + 128; LAS float* t_rq = tab + 192; LAS float* t_eq = tab + 256; LAS float* t_ekk = tab + 320; LAS float* t_bg = tab + 384;
    const size_t tok = (size_t)b * 4096 + n * 64 + lane;
    const bf16* prow = PROJ + tok * NPROJ;
    const bf16* prow0 = PROJ + ((size_t)b * 4096 + n * 64) * NPROJ;
    unsigned char* dna = DNA + (size_t)ci * DNA_CHUNK_BYTES + lane * 16;
    (void)q; (void)pp;
    float gc, beta, eg, gc63;
    {
        const float araw = bf2f(prow[PC_A + h]), braw = bf2f(prow[PC_B + h]);
        const float xx = araw + p.dt_bias[h];
        const float sp = xx > 20.f ? xx : log1pf(expf(xx));
        gc = -expf(p.a_log[h]) * sp;
        beta = 1.f / (1.f + expf(-braw));
#pragma unroll
        for (int o = 1; o < 64; o <<= 1) { const float t = __shfl_up(gc, o); if (lane >= o) gc += t; }
        gc63 = __shfl(gc, 63);
        eg = expf(gc);
        const unsigned gb = __builtin_bit_cast(unsigned, expf(gc63));
        *(GAS v4u*)(dna + 56 * 1024) = (v4u){gb, gb, gb, gb};
        const float ssq = conv_silu_rows(prow0 + PC_Q + h * 128, n == 0, p.conv_w + h * 128, IMG, lane);
        const float rq = 0.08838834764831845f / sqrtf(ssq + 1e-6f);
        t_gc[lane] = gc; t_be[lane] = beta; t_rq[lane] = rq; t_eq[lane] = eg * rq;
    }
    LDS_WAIT(); asm volatile("" ::: "memory");
    if constexpr (STOP == 1) return;
    bf16x8 qF[4][4];
#pragma unroll
    for (int mt = 0; mt < 4; ++mt)
#pragma unroll
        for (int ks = 0; ks < 4; ++ks) qF[mt][ks] = *(const LAS bf16x8*)(IMG + off_b((unsigned)(16 * mt + l15), (unsigned)(4 * ks + g4)));
#pragma unroll
    for (int mt = 0; mt < 4; ++mt) {
        const float egi = t_eq[16 * mt + l15];
#pragma unroll
        for (int ks = 0; ks < 4; ++ks) {
            const unsigned long long lo = *(const LAS unsigned long long*)(IMG + off_b((unsigned)(16 * mt + l15), (unsigned)(4 * ks + (g4 >> 1))) + (g4 & 1) * 8);
            const unsigned long long hi = *(const LAS unsigned long long*)(IMG + off_b((unsigned)(16 * mt + l15), (unsigned)(4 * ks + 2 + (g4 >> 1))) + (g4 & 1) * 8);
            float t8[8]; unpack8((v4u){(unsigned)lo, (unsigned)(lo >> 32), (unsigned)hi, (unsigned)(hi >> 32)}, t8);
#pragma unroll
            for (int e = 0; e < 8; ++e) t8[e] *= egi;
            *(GAS bf16x8*)(dna + (16 + mt * 4 + ks) * 1024) = pack8(t8);
        }
    }
    LDS_WAIT(); asm volatile("" ::: "memory");
    {
        const float ssk = conv_silu_rows(prow0 + PC_K + h * 128, n == 0, p.conv_w + 512 + h * 128, IMG, lane);
        const float rk = 1.f / sqrtf(ssk + 1e-6f);
        t_rk[lane] = rk; t_ekk[lane] = expf(gc63 - gc) * rk; t_bg[lane] = beta * eg * rk;
    }
    LDS_WAIT(); asm volatile("" ::: "memory");
    if constexpr (STOP == 2) return;
    f32x4 Am[4][4];
    {
        bf16x8 kF[4][4];
#pragma unroll
        for (int mt = 0; mt < 4; ++mt)
#pragma unroll
            for (int ks = 0; ks < 4; ++ks) kF[mt][ks] = *(const LAS bf16x8*)(IMG + off_b((unsigned)(16 * mt + l15), (unsigned)(4 * ks + g4)));
#pragma unroll
        for (int mi = 0; mi < 4; ++mi) {
            const f32x4 gci = *(const LAS f32x4*)(t_gc + 16 * mi + 4 * g4), bei = *(const LAS f32x4*)(t_be + 16 * mi + 4 * g4), rki = *(const LAS f32x4*)(t_rk + 16 * mi + 4 * g4);
#pragma unroll
            for (int nj = 0; nj <= mi; ++nj) {
                f32x4 acc = (f32x4){0.f, 0.f, 0.f, 0.f};
#pragma unroll
                for (int ks = 0; ks < 4; ++ks) acc = __builtin_amdgcn_mfma_f32_16x16x32_bf16(kF[mi][ks], kF[nj][ks], acc, 0, 0, 0);
                const float gcj = t_gc[16 * nj + l15], rkj = t_rk[16 * nj + l15]; const int j = 16 * nj + l15;
#pragma unroll
                for (int r = 0; r < 4; ++r) { const int i = 16 * mi + 4 * g4 + r; acc[r] = (j < i) ? bei[r] * rki[r] * rkj * acc[r] * expf(gci[r] - gcj) : 0.f; }
                Am[mi][nj] = acc;
            }
        }
#pragma unroll
        for (int it = 0; it < 4; ++it) {
            const float gci = t_gc[16 * it + l15], rqi = t_rq[16 * it + l15]; const int i = 16 * it + l15;
            f32x4 kq[4];
#pragma unroll
            for (int jt = 0; jt < 4; ++jt) {
                f32x4 acc = (f32x4){0.f, 0.f, 0.f, 0.f};
                if (jt <= it) {
#pragma unroll
                    for (int ks = 0; ks < 4; ++ks) acc = __builtin_amdgcn_mfma_f32_16x16x32_bf16(kF[jt][ks], qF[it][ks], acc, 0, 0, 0);
                    const f32x4 gcj = *(const LAS f32x4*)(t_gc + 16 * jt + 4 * g4), rkj = *(const LAS f32x4*)(t_rk + 16 * jt + 4 * g4);
#pragma unroll
                    for (int r = 0; r < 4; ++r) { const int j = 16 * jt + 4 * g4 + r; acc[r] = (j <= i) ? acc[r] * rqi * rkj[r] * expf(gci - gcj[r]) : 0.f; }
                }
                kq[jt] = acc;
            }
#pragma unroll
            for (int ks = 0; ks < 2; ++ks) { const float t8[8] = {kq[2 * ks][0], kq[2 * ks][1], kq[2 * ks][2], kq[2 * ks][3], kq[2 * ks + 1][0], kq[2 * ks + 1][1], kq[2 * ks + 1][2], kq[2 * ks + 1][3]};
                *(GAS bf16x8*)(dna + (48 + it * 2 + ks) * 1024) = pack8(t8); }
        }
    }
    if constexpr (STOP == 3) return;
    bf16x8 ktr[8][2];
    {
#pragma unroll
        for (int ks = 0; ks < 2; ++ks) {
            const f32x4 ek0 = *(const LAS f32x4*)(t_ekk + 32 * ks + 4 * g4), ek1 = *(const LAS f32x4*)(t_ekk + 32 * ks + 16 + 4 * g4);
#pragma unroll
            for (int mt = 0; mt < 8; ++mt) {
                const s16x4 lo = vtr(IMG + off_b((unsigned)(32 * ks + 4 * g4 + q), (unsigned)(2 * mt + (pp >> 1))) + 8 * (pp & 1));
                const s16x4 hi = vtr(IMG + off_b((unsigned)(32 * ks + 16 + 4 * g4 + q), (unsigned)(2 * mt + (pp >> 1))) + 8 * (pp & 1));
                const float t8[8] = {bf2f((unsigned short)lo[0]) * ek0.x, bf2f((unsigned short)lo[1]) * ek0.y, bf2f((unsigned short)lo[2]) * ek0.z, bf2f((unsigned short)lo[3]) * ek0.w,
                                     bf2f((unsigned short)hi[0]) * ek1.x, bf2f((unsigned short)hi[1]) * ek1.y, bf2f((unsigned short)hi[2]) * ek1.z, bf2f((unsigned short)hi[3]) * ek1.w};
                *(GAS bf16x8*)(dna + (32 + mt * 2 + ks) * 1024) = pack8(t8);
            }
        }
#pragma unroll
        for (int dt = 0; dt < 8; ++dt)
#pragma unroll
            for (int ks = 0; ks < 2; ++ks) {
                const s16x4 lo = vtr(IMG + off_b((unsigned)(32 * ks + 8 * g4 + q), (unsigned)(2 * dt + (pp >> 1))) + 8 * (pp & 1));
                const s16x4 hi = vtr(IMG + off_b((unsigned)(32 * ks + 8 * g4 + 4 + q), (unsigned)(2 * dt + (pp >> 1))) + 8 * (pp & 1));
                ktr[dt][ks] = (bf16x8){lo[0], lo[1], lo[2], lo[3], hi[0], hi[1], hi[2], hi[3]};
            }
    }
    LDS_WAIT(); asm volatile("" ::: "memory");
    {
        LAS float* AL = (LAS float*)IMG;
#pragma unroll
        for (int mi = 0; mi < 4; ++mi)
#pragma unroll
            for (int nj = 0; nj <= mi; ++nj)
#pragma unroll
                for (int r = 0; r < 4; ++r) AL[(16 * mi + 4 * g4 + r) * 64 + 16 * nj + l15] = Am[mi][nj][r];
    }
    LDS_WAIT(); asm volatile("" ::: "memory");
    float T[64];
    {
        const LAS float* AL = (const LAS float*)IMG;
#pragma clang loop unroll(full)
        for (int i = 0; i < 64; ++i) {
            float v4[4] = {(lane == i) ? 1.f : 0.f, 0.f, 0.f, 0.f};
#pragma clang loop unroll(full)
            for (int j4 = 0; j4 < (i + 3) / 4; ++j4) {
                const f32x4 a = *(const LAS f32x4*)(AL + i * 64 + 4 * j4);
#pragma clang loop unroll(full)
                for (int e = 0; e < 4; ++e) if (4 * j4 + e < i) v4[e] -= a[e] * T[4 * j4 + e];
            }
            T[i] = (v4[0] + v4[1]) + (v4[2] + v4[3]);
        }
    }
    LDS_WAIT(); asm volatile("" ::: "memory");
    if constexpr (STOP == 4) return;
    lane = pg8::lane_id_fresh(); l15 = lane & 15; g4 = lane >> 4; q = l15 >> 2; pp = lane & 3;
    dna = DNA + (size_t)ci * DNA_CHUNK_BYTES + lane * 16;
    {
        const float bc = t_be[lane], bgc = t_bg[lane];
        LAS unsigned char* TB = IMG; LAS unsigned char* TBE = IMG + 8192;
#pragma unroll
        for (int i = 0; i < 64; ++i) { const unsigned o = off_t64((unsigned)i, (unsigned)(lane >> 3)) + (lane & 7) * 2;
            *(LAS unsigned short*)(TB + o) = (unsigned short)f2bf(T[i] * bc); *(LAS unsigned short*)(TBE + o) = (unsigned short)f2bf(T[i] * bgc); }
    }
    LDS_WAIT(); asm volatile("" ::: "memory");
    bf16x8 tb[4][2];
    {
#pragma unroll
        for (int it = 0; it < 4; ++it) {
            bf16x8 tbe[2];
#pragma unroll
            for (int ks = 0; ks < 2; ++ks) tbe[ks] = *(const LAS bf16x8*)(IMG + 8192 + off_t64((unsigned)(16 * it + l15), (unsigned)(4 * ks + g4)));
            f32x4 acc[8];
#pragma unroll
            for (int dt = 0; dt < 8; ++dt) { acc[dt] = (f32x4){0.f, 0.f, 0.f, 0.f};
#pragma unroll
                for (int ks = 0; ks < 2; ++ks) acc[dt] = __builtin_amdgcn_mfma_f32_16x16x32_bf16(ktr[dt][ks], tbe[ks], acc[dt], 0, 0, 0); }
#pragma unroll
            for (int ks = 0; ks < 4; ++ks) { const float t8[8] = {-acc[2 * ks][0], -acc[2 * ks][1], -acc[2 * ks][2], -acc[2 * ks][3], -acc[2 * ks + 1][0], -acc[2 * ks + 1][1], -acc[2 * ks + 1][2], -acc[2 * ks + 1][3]};
                *(GAS bf16x8*)(dna + (it * 4 + ks) * 1024) = pack8(t8); }
        }
#pragma unroll
        for (int mt = 0; mt < 4; ++mt)
#pragma unroll
            for (int ks = 0; ks < 2; ++ks) tb[mt][ks] = *(const LAS bf16x8*)(IMG + off_t64((unsigned)(16 * mt + l15), (unsigned)(4 * ks + g4)));
    }
    LDS_WAIT(); asm volatile("" ::: "memory");
    if constexpr (STOP == 5) return;
    (void)conv_silu_rows(prow0 + PC_V + h * 128, n == 0, p.conv_w + 1024 + h * 128, IMG, lane);
    LDS_WAIT(); asm volatile("" ::: "memory");
    {
        unsigned char* dnu = DNU + (size_t)ci * DNU_CHUNK_BYTES + lane * 16;
#pragma unroll
        for (int dt = 0; dt < 8; ++dt) {
            bf16x8 vt[2];
#pragma unroll
            for (int ks = 0; ks < 2; ++ks) {
                const s16x4 lo = vtr(IMG + off_b((unsigned)(32 * ks + 8 * g4 + q), (unsigned)(2 * dt + (pp >> 1))) + 8 * (pp & 1));
                const s16x4 hi = vtr(IMG + off_b((unsigned)(32 * ks + 8 * g4 + 4 + q), (unsigned)(2 * dt + (pp >> 1))) + 8 * (pp & 1));
                vt[ks] = (bf16x8){lo[0], lo[1], lo[2], lo[3], hi[0], hi[1], hi[2], hi[3]};
            }
            f32x4 u[4];
#pragma unroll
            for (int mt = 0; mt < 4; ++mt) { u[mt] = (f32x4){0.f, 0.f, 0.f, 0.f};
#pragma unroll
                for (int ks = 0; ks < 2; ++ks) u[mt] = __builtin_amdgcn_mfma_f32_16x16x32_bf16(tb[mt][ks], vt[ks], u[mt], 0, 0, 0); }
#pragma unroll
            for (int pc = 0; pc < 2; ++pc) { const float t8[8] = {u[2 * pc][0], u[2 * pc][1], u[2 * pc][2], u[2 * pc][3], u[2 * pc + 1][0], u[2 * pc + 1][1], u[2 * pc + 1][2], u[2 * pc + 1][3]};
                *(GAS bf16x8*)(dnu + (dt * 2 + pc) * 1024) = pack8(t8); }
        }
    }
    LDS_WAIT(); asm volatile("" ::: "memory");
}

template <int STOP>
__device__ __forceinline__ void dn_prep_phase(LAS unsigned char* lds, const bf16* PROJ, const nv::P& p, unsigned char* DNA, unsigned char* DNU, int G, int vcu, int wave_s) {
    LAS unsigned char* img = lds + wave_s * 16384; LAS float* tab = (LAS float*)(lds + XTAB_OFF + wave_s * XTAB_BYTES);
    for (int ci = vcu * 8 + wave_s; ci < 2048; ci += G * 8) dn_prep_chunk<STOP>(img, tab, PROJ, p, DNA, DNU, ci);
}


struct RouterArgs { const float* z; const bf16* mix; float* zout; bf16* H1BF; int* EID; float* WGT; int* LIST; int* CNT; const float *ln_g, *ln_b, *w_rg, *b_rg, *w_re, *b_re; };
__device__ __forceinline__ void router_fill(LAS float* dst, const float* W, int ldw, int col0, int tid) {
#pragma unroll
    for (int it = 0; it < 4; ++it) { const int qd = tid + it * NTHREADS, k = qd >> 1, half = qd & 1;
        const f32x4 v = *(const GAS f32x4*)(W + (size_t)k * ldw + col0 + half * 4);
        *(LAS f32x4*)(dst + ((((k >> 8) * 4 + (k & 3)) * 64 + ((k >> 2) & 63)) * 8 + half * 4)) = v; }
}
__device__ __forceinline__ void router_phase(LAS unsigned char* lds, const RouterArgs& A, int gw, int NGW, int wave_s) {
    const int lane = pg8::lane_id_fresh(), tid = wave_s * 64 + lane;
    LAS float* WG = (LAS float*)lds; LAS int* HIST = (LAS int*)(lds + 32768); LAS int* BASE = HIST + 64; LAS int* RR = HIST + 128;
    router_fill(WG, A.w_rg, 8, 0, tid);
    if (tid < 64) HIST[tid] = 0;
    __syncthreads();
    int it_ = 0;
    f32x4 vn[4]; unsigned long long mn_[4];
    { const GAS f32x4* zr = (const GAS f32x4*)(A.z + (size_t)gw * DM) + lane; const GAS unsigned long long* mr = (const GAS unsigned long long*)(A.mix + (size_t)gw * DM) + lane;
#pragma unroll
      for (int j = 0; j < 4; ++j) { vn[j] = zr[64 * j]; mn_[j] = mr[64 * j]; } }
    for (int m = gw; m < NTOK; m += NGW) {
        f32x4 v[4];
#pragma unroll
        for (int j = 0; j < 4; ++j) { const unsigned long long mm = mn_[j];
            v[j].x = ALPHA_F * vn[j].x + bf2f((unsigned short)mm); v[j].y = ALPHA_F * vn[j].y + bf2f((unsigned short)(mm >> 16));
            v[j].z = ALPHA_F * vn[j].z + bf2f((unsigned short)(mm >> 32)); v[j].w = ALPHA_F * vn[j].w + bf2f((unsigned short)(mm >> 48)); }
        { const int mn = (m + NGW < NTOK) ? m + NGW : m; const GAS f32x4* zn = (const GAS f32x4*)(A.z + (size_t)mn * DM) + lane; const GAS unsigned long long* mr = (const GAS unsigned long long*)(A.mix + (size_t)mn * DM) + lane;
#pragma unroll
          for (int j = 0; j < 4; ++j) { vn[j] = zn[64 * j]; mn_[j] = mr[64 * j]; } }
        float s = 0.f;
#pragma unroll
        for (int j = 0; j < 4; ++j) s += (v[j].x + v[j].y) + (v[j].z + v[j].w);
        const float mean = wave_sum_dpp(s) * (1.f / DM); float s2 = 0.f;
#pragma unroll
        for (int j = 0; j < 4; ++j) { v[j] = v[j] - mean; s2 += (v[j].x * v[j].x + v[j].y * v[j].y) + (v[j].z * v[j].z + v[j].w * v[j].w); }
        const float rstd = 1.f / sqrtf(wave_sum_dpp(s2) * (1.f / DM) + 1e-5f);
        GAS unsigned long long* hb = (GAS unsigned long long*)(A.H1BF + (size_t)m * DM) + lane;
#pragma unroll
        for (int j = 0; j < 4; ++j) { const f32x4 g = *((const GAS f32x4*)A.ln_g + lane + 64 * j), bb = *((const GAS f32x4*)A.ln_b + lane + 64 * j); v[j] = v[j] * rstd * g + bb;
            hb[64 * j] = (unsigned long long)pk2(v[j].x, v[j].y) | ((unsigned long long)pk2(v[j].z, v[j].w) << 32); }
        float gl[8];
#pragma unroll
        for (int c = 0; c < 8; ++c) gl[c] = 0.f;
#pragma unroll
        for (int j = 0; j < 4; ++j)
#pragma unroll
            for (int c4 = 0; c4 < 4; ++c4) { const float hv = v[j][c4]; const LAS float* wp = WG + ((j * 4 + c4) * 64 + lane) * 8;
                const f32x4 w0 = *(const LAS f32x4*)wp, w1 = *(const LAS f32x4*)(wp + 4);
                gl[0] += hv * w0.x; gl[1] += hv * w0.y; gl[2] += hv * w0.z; gl[3] += hv * w0.w; gl[4] += hv * w1.x; gl[5] += hv * w1.y; gl[6] += hv * w1.z; gl[7] += hv * w1.w; }
        int gi = 0; float gm = -INFINITY;
#pragma unroll
        for (int c = 0; c < 8; ++c) { gl[c] = wave_sum_dpp(gl[c]) + A.b_rg[c]; if (gl[c] > gm) { gm = gl[c]; gi = c; } }
        float den = 0.f;
#pragma unroll
        for (int c = 0; c < 8; ++c) den += expf(gl[c] - gm);
        const float pg = 1.f / den;
        float el[8];
#pragma unroll
        for (int c = 0; c < 8; ++c) el[c] = 0.f;
        const float* wre = A.w_re + gi * 8192 + lane * 8;
#pragma unroll
        for (int j = 0; j < 4; ++j)
#pragma unroll
            for (int c4 = 0; c4 < 4; ++c4) { const float hv = v[j][c4];
                const f32x4 w0 = *(const GAS f32x4*)(wre + (j * 4 + c4) * 512), w1 = *(const GAS f32x4*)(wre + (j * 4 + c4) * 512 + 4);
                el[0] += hv * w0.x; el[1] += hv * w0.y; el[2] += hv * w0.z; el[3] += hv * w0.w; el[4] += hv * w1.x; el[5] += hv * w1.y; el[6] += hv * w1.z; el[7] += hv * w1.w; }
        int i0 = 0, i1 = 0; float v0 = -INFINITY, v1 = -INFINITY;
#pragma unroll
        for (int c = 0; c < 8; ++c) { el[c] = wave_sum_dpp(el[c]) + A.b_re[gi * 8 + c]; if (el[c] > v0) { v0 = el[c]; i0 = c; } }
#pragma unroll
        for (int c = 0; c < 8; ++c) { if (c != i0 && el[c] > v1) { v1 = el[c]; i1 = c; } }
        const float e1 = expf(v1 - v0), sm = 1.f / (1.f + e1);
        if (lane == 0) {
            const int ea = gi * 8 + i0, eb = gi * 8 + i1;
            LAS int* rr = RR + (wave_s * 16 + it_) * 6;
            rr[4] = (int)(f2bf(pg * sm) << 16); rr[5] = (int)(f2bf(pg * e1 * sm) << 16);
            rr[0] = ea; rr[1] = __hip_atomic_fetch_add(&HIST[ea], 1, __ATOMIC_RELAXED, __HIP_MEMORY_SCOPE_WORKGROUP); rr[2] = eb; rr[3] = __hip_atomic_fetch_add(&HIST[eb], 1, __ATOMIC_RELAXED, __HIP_MEMORY_SCOPE_WORKGROUP);
        }
        ++it_;
    }
    __syncthreads();
    if (tid < 64) BASE[tid] = __hip_atomic_fetch_add(&A.CNT[tid], HIST[tid], __ATOMIC_RELAXED, __HIP_MEMORY_SCOPE_AGENT);
    __syncthreads();
    if (lane < it_) {
        const LAS int* rr = RR + (wave_s * 16 + lane) * 6; const int m = gw + lane * NGW;
        A.LIST[(size_t)rr[0] * NTOK + BASE[rr[0]] + rr[1]] = (2 * m) | rr[4];
        A.LIST[(size_t)rr[2] * NTOK + BASE[rr[2]] + rr[3]] = (2 * m + 1) | rr[5];
    }
}

__device__ __forceinline__ void final_phase(float* OUT, const bf16* H1B, const bf16* YEXP, const float* ln_g, const float* ln_b, int gw, int NGW, int lane) {
    unsigned long long hn[4], an[4], bn[4];
#define FIN_LOAD(mm) do { const GAS unsigned long long* hq_ = (const GAS unsigned long long*)(H1B + (size_t)(mm) * DM) + lane; const GAS unsigned long long* y0_ = (const GAS unsigned long long*)(YEXP + (size_t)(2 * (mm)) * DM) + lane; \
        _Pragma("unroll") for (int j_ = 0; j_ < 4; ++j_) { hn[j_] = hq_[64 * j_]; an[j_] = y0_[64 * j_]; bn[j_] = y0_[DM / 4 + 64 * j_]; } } while (0)
    FIN_LOAD(gw < NTOK ? gw : 0);
    for (int m = gw; m < NTOK; m += NGW) {
        GAS f32x4* orow = (GAS f32x4*)(OUT + (size_t)m * DM) + lane;
        unsigned long long hc[4], ac[4], bc[4];
#pragma unroll
        for (int j = 0; j < 4; ++j) { hc[j] = hn[j]; ac[j] = an[j]; bc[j] = bn[j]; }
        { const int mn = (m + NGW < NTOK) ? m + NGW : m; FIN_LOAD(mn); }
        f32x4 v[4]; float s = 0.f;
#pragma unroll
        for (int j = 0; j < 4; ++j) { const unsigned long long hh = hc[j], a0 = ac[j], a1 = bc[j];
            v[j].x = ALPHA_F * bf2f((unsigned short)hh) + bf2f((unsigned short)a0) + bf2f((unsigned short)a1);
            v[j].y = ALPHA_F * bf2f((unsigned short)(hh >> 16)) + bf2f((unsigned short)(a0 >> 16)) + bf2f((unsigned short)(a1 >> 16));
            v[j].z = ALPHA_F * bf2f((unsigned short)(hh >> 32)) + bf2f((unsigned short)(a0 >> 32)) + bf2f((unsigned short)(a1 >> 32));
            v[j].w = ALPHA_F * bf2f((unsigned short)(hh >> 48)) + bf2f((unsigned short)(a0 >> 48)) + bf2f((unsigned short)(a1 >> 48));
            s += (v[j].x + v[j].y) + (v[j].z + v[j].w); }
        const float mean = wave_sum_dpp(s) * (1.f / DM); float s2 = 0.f;
#pragma unroll
        for (int j = 0; j < 4; ++j) { v[j] = v[j] - mean; s2 += (v[j].x * v[j].x + v[j].y * v[j].y) + (v[j].z * v[j].z + v[j].w * v[j].w); }
        const float rstd = 1.f / sqrtf(wave_sum_dpp(s2) * (1.f / DM) + 1e-5f);
#pragma unroll
        for (int j = 0; j < 4; ++j) { const f32x4 g = *((const GAS f32x4*)ln_g + lane + 64 * j), bb = *((const GAS f32x4*)ln_b + lane + 64 * j); orow[64 * j] = v[j] * rstd * g + bb; }
    }
}

#ifndef REPEAT_MASK
#define REPEAT_MASK 0
#endif
#define REPS(k) ((((REPEAT_MASK) >> (k)) & 1) + 1)
__global__ void __launch_bounds__(NTHREADS, 2) fwd_megakernel(MK a) {
    extern __shared__ __attribute__((aligned(16))) unsigned char lds_raw[];
    cg::grid_group grid = cg::this_grid();
    LAS unsigned char* lds = (LAS unsigned char*)lds_raw;
    volatile LAS unsigned* MISC = (volatile LAS unsigned*)(lds + MISC_OFF);
    LAS int* PREF = (LAS int*)(lds + PREF_OFF);
    const int tid = threadIdx.x; const int wave_s = __builtin_amdgcn_readfirstlane(tid >> 6);
    const int G = gridDim.x; const int bx = blockIdx.x; const int vcu = (G % 8 == 0) ? (bx % 8) * (G / 8) + bx / 8 : bx;
    unsigned char* ws = a.ws; const nv::P& p = a.p;
    gu32* ctl = (gu32*)(ws + WS_CTL);
    bf16* WIN = (bf16*)(ws + WS_WIN); bf16* WOUT = (bf16*)(ws + WS_WOUT); bf16* XBF = (bf16*)(ws + WS_A); bf16* PROJ = (bf16*)(ws + WS_B);
    bf16* WGU = (bf16*)(ws + WS_WGU); bf16* WD = (bf16*)(ws + WS_WD); bf16* HID = (bf16*)(ws + WS_A); bf16* H1BF = (bf16*)(ws + WS_H1BF); bf16* YEXP = (bf16*)(ws + WS_YEXP);
    int* LIST = (int*)(ws + WS_LIST); int* EID = (int*)(ws + WS_ROUTE); float* WGT = (float*)(ws + WS_ROUTE + 512 * 1024);
    int* CNT = (int*)(ws + WS_CTL) + CW_CNT;
    for (int u = tid; u < (LDS_BYTES - LDSCTL_OFF) / 4; u += NTHREADS) ((LAS unsigned*)(lds + LDSCTL_OFF))[u] = 0u;
    __syncthreads();
    XcdBarrier bar = xcd_barrier_post((unsigned*)(ctl + CW_BAR), MISC + 8);
    grid.sync();
#define FRESH() const int lane = pg8::lane_id_fresh(), wave = wave_s; const int tid_ = wave_s * 64 + lane; const int gtid = (int)blockIdx.x * NTHREADS + tid_, gsize = G * NTHREADS, gw = vcu * NWAVES + wave, NGW = G * NWAVES; (void)lane; (void)gtid; (void)gsize; (void)gw; (void)NGW;

    _Pragma("unroll 1") for (int rep_ = 0; rep_ < REPS(0); ++rep_) {
    {
        FRESH();
        LAS float* scr = (LAS float*)(lds + wave * 16384);
        constexpr int NB = 96, KB = DM / 64;
        for (int it = gw; it < NB * KB; it += NGW) { const int nb = it % NB, kb = it / NB; const int nsrc = nb < 64 ? nb * 32 : 2056 + (nb - 64) * 32, ndst = nb * 32;
            p0_transpose_item(p.w_in, nv::INC, DM, kb * 64, nsrc, WIN, ndst, scr, lane); }
        for (int i = gtid; i < 8 * DM; i += gsize) { const int j = (int)(i / DM), k = (int)(i % DM); WIN[(size_t)(PC_B + j) * DM + k] = (bf16)f2bf(p.w_in[(size_t)k * nv::INC + 2048 + j]); }
        for (int i = gtid; i < (long)(NPROJ - 3080) * DM / 8; i += gsize) *(GAS v4u*)(WIN + (size_t)3080 * DM + i * 8) = (v4u){0u, 0u, 0u, 0u};
        for (int i = gtid; i < (long)NTOK * DM / 8; i += gsize) { const f32x4 v0 = *(const GAS f32x4*)(p.x + i * 8), v1 = *(const GAS f32x4*)(p.x + i * 8 + 4);
            v4u o; o.x = pk2(v0.x, v0.y); o.y = pk2(v0.z, v0.w); o.z = pk2(v1.x, v1.y); o.w = pk2(v1.z, v1.w); *(GAS v4u*)(XBF + i * 8) = o; }
        for (int it = gw; it < 16 * 32; it += NGW) { const int nb = it & 31, kb = it >> 5; p0_transpose_item(p.w_out, DM, DM, kb * 64, nb * 32, WOUT, nb * 32, scr, lane); }
        for (int d = gtid; d < 8 * 8192; d += gsize) { const int g = d >> 13, r = d & 8191, c = r & 7, ll = (r >> 3) & 63, jc = r >> 9, k = 4 * (ll + 64 * (jc >> 2)) + (jc & 3);
            ((float*)(ws + WS_WREP))[d] = p.w_re[(size_t)k * 64 + g * 8 + c]; }
    }
    xcd_barrier(bar);
    }
    _Pragma("unroll 1") for (int rep_ = 0; rep_ < REPS(1); ++rep_) {
    {
        if (bx < GEMM_WGS) {
            pg8::DenseOrder S; S.init(XBF, DM, WIN, NTOK, NPROJ, DM, GEMM_WGS, bx);
            pg8::EpiBf16 E{PROJ, NPROJ};
            pg8::gemm_phase<pg8::EpiBf16, pg8::DenseOrder, true>(lds, S, E, nullptr, wave_s);
        } else {
            const int lane = pg8::lane_id_fresh();
            LAS float* scr = (LAS float*)(lds + wave_s * 16384);
            p0_experts(p.w_gate, p.w_up, p.w_down, WGU, WD, scr, (bx - GEMM_WGS) * NWAVES + wave_s, (G - GEMM_WGS) * NWAVES, lane);
        }
    }
    xcd_barrier(bar);
    }
    unsigned char* DNA = (unsigned char*)p.out; unsigned char* DNU = ws + WS_A + 32 * MiB; bf16* ODN = (bf16*)(ws + WS_A);
    _Pragma("unroll 1") for (int rep_ = 0; rep_ < REPS(2); ++rep_) {
    dn_prep_phase<0>(lds, PROJ, p, DNA, DNU, G, vcu, wave_s);
    xcd_barrier(bar);
    }
    _Pragma("unroll 1") for (int rep_ = 0; rep_ < REPS(3); ++rep_) {
    dn_scan_phase(lds, DNA, DNU, ODN, vcu, wave_s);
    xcd_barrier(bar);
    }
    _Pragma("unroll 1") for (int rep_ = 0; rep_ < REPS(5); ++rep_) {
    sgu_phase(lds, PROJ, p, G, vcu, wave_s);
    { FRESH(); dn_final_phase(ODN, PROJ, p.dn_norm_w, gw, NGW, lane); }
    xcd_barrier(bar);
    }
    _Pragma("unroll 1") for (int rep_ = 0; rep_ < REPS(6); ++rep_) {
    {
        pg8::DenseOrder S; S.init(PROJ, NPROJ, WOUT, NTOK, DM, DM, G, bx);
        pg8::EpiBf16 E{(bf16*)(ws + WS_A), DM};
        pg8::gemm_phase<pg8::EpiBf16, pg8::DenseOrder, true>(lds, S, E, nullptr, wave_s);
    }
    xcd_barrier(bar);
    }
    {
        RouterArgs RA{p.x, (const bf16*)(ws + WS_A), p.out, H1BF, EID, WGT, LIST, CNT, p.ln1_g, p.ln1_b, p.w_rg, p.b_rg, (const float*)(ws + WS_WREP), p.b_re};
        router_phase(lds, RA, vcu * NWAVES + wave_s, G * NWAVES, wave_s);
    }
    xcd_barrier(bar);
    if (threadIdx.x == 0) { int s = 0; for (int e = 0; e < NEXP; ++e) { PREF[e] = s; s += ((CNT[e] + 255) >> 8) * 4; } PREF[NEXP] = s; }
    __syncthreads();
    _Pragma("unroll 1") for (int rep_ = 0; rep_ < REPS(7); ++rep_) {
    {
        pg8::GroupedOrder S{H1BF, WGU, LIST, PREF, DM, DM, 1024, NTOK, 1, 4, G, bx, NEXP};
        pg8::EpiHid E{HID, LIST, CNT, NTOK};
        pg8::gemm_phase<pg8::EpiHid, pg8::GroupedOrder, true>(lds, S, E, CNT, wave_s);
    }
    xcd_barrier(bar);
    }
    _Pragma("unroll 1") for (int rep_ = 0; rep_ < REPS(8); ++rep_) {
    {
        pg8::GroupedOrder S{HID, WD, LIST, PREF, DEXP, DEXP, 1024, NTOK, 0, 4, G, bx, NEXP};
        pg8::EpiYexp E{YEXP, LIST, WGT, NTOK};
        pg8::gemm_phase<pg8::EpiYexp, pg8::GroupedOrder, true>(lds, S, E, CNT, wave_s);
    }
    xcd_barrier(bar);
    }
    { FRESH(); final_phase(p.out, H1BF, YEXP, p.ln2_g, p.ln2_b, gw, NGW, lane); }
#if defined(GHOSTPREP)
    xcd_barrier(bar);
    dn_prep_phase<GHOSTPREP>(lds, (const bf16*)(ws + WS_B), p, ws + WS_C, ws + WS_C + 120 * MiB, G, vcu, wave_s);
#endif
#if defined(GHOST6)
    xcd_barrier(bar);
    { RouterArgs RA{p.out, (const bf16*)(ws + WS_A), (float*)(ws + WS_B), (bf16*)(ws + WS_C), (int*)(ws + WS_A), (float*)(ws + WS_A + 1 * MiB), (int*)(ws + WS_A + 2 * MiB), (int*)(ws + WS_CTL) + CW_CNT + 1024, p.ln1_g, p.ln1_b, p.w_rg, p.b_rg, (const float*)(ws + WS_WREP), p.b_re};
      router_phase(lds, RA, vcu * NWAVES + wave_s, G * NWAVES, wave_s); }
#endif
#if defined(GHOST9)
    xcd_barrier(bar);
    { FRESH(); final_phase((float*)(ws + WS_A), H1BF, (const bf16*)(ws + WS_C), p.ln2_g, p.ln2_b, gw, NGW, lane); }
#endif
}

extern "C" void kernel_launch(void* const* d_in, const int* in_sizes, int n_in, void* d_out, int out_size, void* d_ws, size_t ws_size, hipStream_t stream) {
    if (ws_size < WS_END || n_in != 22) { fprintf(stderr, "kernel_launch: bad ws/n_in\n"); return; }
    static int grid_blocks = 0;
    if (!grid_blocks) {
        int dev = 0, cus = 0, per_cu = 0;
        (void)hipGetDevice(&dev);
        (void)hipDeviceGetAttribute(&cus, hipDeviceAttributeMultiprocessorCount, dev);
        (void)hipFuncSetAttribute((const void*)fwd_megakernel, hipFuncAttributeMaxDynamicSharedMemorySize, (int)LDS_BYTES);
        (void)hipOccupancyMaxActiveBlocksPerMultiprocessor(&per_cu, (const void*)fwd_megakernel, NTHREADS, LDS_BYTES);
        if (per_cu < 1) { fprintf(stderr, "kernel_launch: occupancy query says %d\n", per_cu); per_cu = 1; }
        grid_blocks = cus;
    }
    (void)hipMemsetAsync((char*)d_ws + WS_CTL, 0, CTL_ZERO_BYTES, stream);
    MK a{}; bind(a.p, d_in, (float*)d_out); a.ws = (unsigned char*)d_ws;
    void* args[] = {&a};
    hipError_t e = hipLaunchCooperativeKernel((const void*)fwd_megakernel, dim3(grid_blocks), dim3(NTHREADS), args, LDS_BYTES, stream);
    if (e != hipSuccess) fprintf(stderr, "cooperative launch failed: %s (grid %d)\n", hipGetErrorString(e), grid_blocks);
}
```

```cpp
#include <hip/hip_runtime.h>
#include <hip/hip_cooperative_groups.h>
#include <cstdio>
#include <cstdint>
namespace cg = cooperative_groups;

namespace nv {
constexpr int INC = 3080;
struct P {
    const float *x, *w_in, *conv_w, *a_log, *dt_bias, *dn_norm_w, *sgu_ln_g, *sgu_ln_b, *w_spatial, *b_spatial, *w_out, *ln1_g, *ln1_b,
        *w_rg, *b_rg, *w_re, *b_re, *w_gate, *w_up, *w_down, *ln2_g, *ln2_b;
    float* out;
};
static inline void bind(P& p, void* const* in, float* out) {
    const float** f = (const float**)&p.x; for (int i = 0; i < 22; ++i) f[i] = (const float*)in[i];
    p.out = out;
}
}
namespace pg8 {
#define PG8_LAS __attribute__((address_space(3)))
typedef unsigned short bf16_t;
typedef short bf16x8 __attribute__((ext_vector_type(8)));
typedef float f32x4 __attribute__((ext_vector_type(4)));
typedef unsigned u32x4 __attribute__((ext_vector_type(4)));
typedef unsigned u32x2 __attribute__((ext_vector_type(2)));
constexpr int BM = 256, BK = 64, HALF = 128, HTB = HALF * BK * 2  , STAGE_BYTES = 8 * HTB, NXCD = 8, WGM = 8;

__host__ __device__ __forceinline__ int lds_byte(int r, int c) { const int st = (r >> 4) * 2 + (c >> 5), rr = r & 15, cc = c & 31, ob = rr * 64 + cc * 2; return st * 1024 + (ob ^ (((ob >> 9) & 1) << 5)); }
__host__ __device__ __forceinline__ void stage_rc(int b, int& R, int& C) { const int st = b / 1024, sb = b % 1024, swz = sb ^ (((sb >> 9) & 1) << 5); R = (st >> 1) * 16 + swz / 64; C = (st & 1) * 32 + (swz % 64) / 2; }
__host__ __device__ __forceinline__ int perm32(int rho) { const int n = rho >> 4, i = rho & 15; return 8 * (i >> 2) + 4 * n + (i & 3); }

struct Unit { int pm, pn, e, rows; };

typedef float f32x2_t __attribute__((ext_vector_type(2))); typedef __bf16 bf16x2_t __attribute__((ext_vector_type(2)));
__device__ __forceinline__ unsigned cvt_pk_bf16(float lo, float hi) { const f32x2_t v = {lo, hi}; const bf16x2_t b = __builtin_convertvector(v, bf16x2_t); return __builtin_bit_cast(unsigned, b); }

__device__ __forceinline__ int lane_id_fresh() { int l; asm volatile("v_mbcnt_lo_u32_b32 %0, -1, 0\n\tv_mbcnt_hi_u32_b32 %0, -1, %0" : "=v"(l)); return l; }
__device__ __forceinline__ int xcd_remap(int L, int nwg) { const int q = nwg / NXCD, r = nwg % NXCD, xcd = L % NXCD, off = L / NXCD; return (xcd < r ? xcd * (q + 1) : r * (q + 1) + (xcd - r) * q) + off; }

struct DenseOrder {
    const bf16_t* A; const bf16_t* Bt; int lda, K; int nM, nN, nwg, G, c;
    static constexpr bool GATHER = false;
    __device__ void init(const bf16_t* A_, int lda_, const bf16_t* Bt_, int M, int N, int K_, int G_, int c_) { A = A_; Bt = Bt_; lda = lda_; K = K_; nM = M / BM; nN = N / BM; nwg = nM * nN; G = G_; c = c_; }
    __device__ bool next(int i, Unit& u) const {
        const long L = (long)i * G + c; if (L >= nwg) return false;
        const int wgid = xcd_remap((int)L, nwg);
        const int nig = WGM * nN, gid = wgid / nig, fm = gid * WGM, gsz = (nM - fm) < WGM ? (nM - fm) : WGM;
        u.pm = fm + ((wgid % nig) % gsz); u.pn = (wgid % nig) / gsz; u.e = 0; u.rows = BM; return true;
    }
    __device__ __forceinline__ const char* a_base(const Unit& u) const { return (const char*)A + (size_t)u.pm * BM * lda * 2; }
    __device__ __forceinline__ const char* b_base(const Unit& u) const { return (const char*)Bt + (size_t)u.pn * BM * K * 2; }
    __device__ __forceinline__ void a_off(const Unit&, const int (&R)[2], const int (&C)[2], unsigned (&v)[4]) const {
#pragma unroll
        for (int h = 0; h < 2; ++h)
#pragma unroll
            for (int i = 0; i < 2; ++i) v[h * 2 + i] = (unsigned)((h * HALF + R[i]) * lda + C[i]) * 2u;
    }
};

struct GroupedOrder {
    const bf16_t* A; const bf16_t* Bt; const int* list; const PG8_LAS int* pref;
    int lda, K, N, cap, ashift, nN, G, c, ne;
    static constexpr bool GATHER = true;
    __device__ bool next(int i, Unit& u) const {
        const int nwg = pref[ne]; const long L = (long)i * G + c; if (L >= nwg) return false;
        const int w = xcd_remap((int)L, nwg);
        int e = 0; while (pref[e + 1] <= w) ++e;
        const int j = w - pref[e], ntm = (pref[e + 1] - pref[e]) / nN;
        u.e = e; u.pm = j % ntm; u.pn = j / ntm; u.rows = 0; return true;
    }
    __device__ __forceinline__ const char* a_base(const Unit&) const { return (const char*)A; }
    __device__ __forceinline__ const char* b_base(const Unit& u) const { return (const char*)Bt + ((size_t)u.e * N + (size_t)u.pn * BM) * K * 2; }
    __device__ __forceinline__ void a_off(const Unit& u, const int (&R)[2], const int (&C)[2], unsigned (&v)[4], int cnt) const {
        const int* lp = list + (size_t)u.e * cap;
#pragma unroll
        for (int h = 0; h < 2; ++h)
#pragma unroll
            for (int i = 0; i < 2; ++i) { int r = u.pm * BM + h * HALF + R[i]; if (r >= cnt) r = 0; const int a = (lp[r] & 0xffff) >> ashift; v[h * 2 + i] = (unsigned)(a * lda + C[i]) * 2u; }
    }
};

template <class Epi, class Sched, bool ALIGN_EPI>
__device__ __forceinline__ void gemm_phase(PG8_LAS unsigned char* lds, const Sched& S, const Epi& E, const int* gcnt, const int wave_s) {
    const int tid_ = wave_s * 64 + lane_id_fresh();
    const int tid = tid_, wid = wave_s, lane = tid & 63, wr = wid >> 2, wc = wid & 3, fr = lane & 15, fq = lane >> 4;
    const int K = S.K, nt = K / BK;
    int Rr[2], Cc[2]; unsigned voffB[2];
#pragma unroll
    for (int i = 0; i < 2; ++i) { int R, C; stage_rc(tid * 16 + i * 8192, R, C); const int Rb = Epi::PERM ? ((R & ~31) + perm32(R & 31)) : R; Rr[i] = R; Cc[i] = C; voffB[i] = (unsigned)(Rb * K + C) * 2u; }
    const size_t kstep = (size_t)(BK * 2);
    const size_t hstep = (size_t)HALF * K * 2;
    const unsigned ldsw = (unsigned)wid * 1024u;
    const int aoff = lds_byte(wr * 64 + fr, fq * 8), boff = lds_byte(wc * 32 + fr, fq * 8);
#define PG8_SA(b, h) (((b) * 2 + (h)) * HTB)
#define PG8_SB(b, h) ((4 + (b) * 2 + (h)) * HTB)
#define PG8_STAGE(bufoff, gbase, v0, v1) do { \
        __builtin_amdgcn_global_load_lds((const unsigned*)((const char*)(gbase) + (v0)), (PG8_LAS unsigned*)(lds + (bufoff) + ldsw), 16, 0, 0); \
        __builtin_amdgcn_global_load_lds((const unsigned*)((const char*)(gbase) + (v1)), (PG8_LAS unsigned*)(lds + (bufoff) + ldsw + 8192), 16, 0, 0); } while (0)
#define PG8_STAGEB(bufoff, gbase) PG8_STAGE(bufoff, gbase, voffB[0], voffB[1])
#define PG8_LDA(dst, b, h) do { _Pragma("unroll") for (int m = 0; m < 4; ++m) _Pragma("unroll") for (int k = 0; k < 2; ++k) dst[m][k] = *(const PG8_LAS bf16x8*)(lds + PG8_SA(b, h) + aoff + m * 2048 + k * 1024); } while (0)
#define PG8_LDB(dst, b, h) do { _Pragma("unroll") for (int n = 0; n < 2; ++n) _Pragma("unroll") for (int k = 0; k < 2; ++k) dst[n][k] = *(const PG8_LAS bf16x8*)(lds + PG8_SB(b, h) + boff + n * 2048 + k * 1024); } while (0)
#define PG8_MMA(ai, bj, At, Bt) do { __builtin_amdgcn_s_setprio(1); _Pragma("unroll") for (int m = 0; m < 4; ++m) _Pragma("unroll") for (int n = 0; n < 2; ++n) _Pragma("unroll") for (int k = 0; k < 2; ++k) \
        acc[ai][bj][m][n] = __builtin_amdgcn_mfma_f32_16x16x32_bf16(Bt[n][k], At[m][k], acc[ai][bj][m][n], 0, 0, 0); __builtin_amdgcn_s_setprio(0); } while (0)
#define PG8_WAIT_V(n) asm volatile("s_waitcnt vmcnt(" #n ")" ::: "memory")
#define PG8_WAIT_L(n) asm volatile("s_waitcnt lgkmcnt(" #n ")" ::: "memory")
#define PG8_BAR __builtin_amdgcn_s_barrier()
#define PG8_SCHED __builtin_amdgcn_sched_barrier(0)
    Unit cur, nxt; int ui = 0;
    if (!S.next(0, cur)) return;
    int ccnt = BM * 1024, ncnt = BM * 1024;
    if constexpr (Sched::GATHER) { ccnt = gcnt[cur.e]; }
    cur.rows = ccnt - cur.pm * BM;
    f32x4 acc[2][2][4][2];
#pragma unroll
    for (int a = 0; a < 2; ++a)
#pragma unroll
        for (int b = 0; b < 2; ++b)
#pragma unroll
            for (int m = 0; m < 4; ++m)
#pragma unroll
                for (int n = 0; n < 2; ++n) acc[a][b][m][n] = (f32x4){0.f, 0.f, 0.f, 0.f};
    bf16x8 At[4][2], B0[2][2], B1[2][2];
    unsigned va[4], vn[4];
    if constexpr (Sched::GATHER) S.a_off(cur, Rr, Cc, va, ccnt); else S.a_off(cur, Rr, Cc, va);
    const char* cA = S.a_base(cur); const char* cB = S.b_base(cur);
    PG8_STAGEB(PG8_SB(0, 0), cB); PG8_STAGEB(PG8_SB(0, 1), cB + hstep); PG8_STAGE(PG8_SA(0, 0), cA, va[0], va[1]); PG8_STAGE(PG8_SA(0, 1), cA, va[2], va[3]);
    if (wr == 1) PG8_BAR;
    PG8_WAIT_V(2); PG8_BAR;
    PG8_STAGEB(PG8_SB(1, 0), cB + kstep); PG8_STAGE(PG8_SA(1, 0), cA + kstep, va[0], va[1]); PG8_STAGEB(PG8_SB(1, 1), cB + hstep + kstep);
    PG8_WAIT_V(6); PG8_BAR;
    for (;;) {
        const bool has_next = S.next(ui + 1, nxt);
        const char* nA = cA; const char* nB = cB;
#pragma unroll
        for (int j = 0; j < 4; ++j) vn[j] = va[j];
        if (has_next) {
            nA = S.a_base(nxt); nB = S.b_base(nxt);
            if constexpr (Sched::GATHER) { ncnt = gcnt[nxt.e]; S.a_off(nxt, Rr, Cc, vn, ncnt); } else S.a_off(nxt, Rr, Cc, vn);
            nxt.rows = ncnt - nxt.pm * BM;
        }
        for (int t = 0; t < nt; t += 2) {
            const bool last = (t == nt - 2);
            const char* a1 = cA + (size_t)(t + 1) * kstep;
            const char* a2 = last ? nA : cA + (size_t)(t + 2) * kstep; const char* b2 = last ? nB : cB + (size_t)(t + 2) * kstep;
            const char* a3 = a2 + kstep; const char* b3 = b2 + kstep;
            unsigned w0 = va[0], w1 = va[1], w2 = va[2], w3 = va[3];
            if (last) { w0 = vn[0]; w1 = vn[1]; w2 = vn[2]; w3 = vn[3]; }
            PG8_LDB(B0, 0, 0); PG8_LDB(B1, 0, 1); PG8_SCHED; PG8_LDA(At, 0, 0); PG8_STAGE(PG8_SA(1, 1), a1, va[2], va[3]);
            PG8_WAIT_V(8); PG8_WAIT_L(0); PG8_BAR; PG8_MMA(0, 0, At, B0); PG8_MMA(0, 1, At, B1); PG8_BAR; PG8_SCHED;
            PG8_LDA(At, 0, 1); PG8_STAGEB(PG8_SB(0, 0), b2); PG8_STAGEB(PG8_SB(0, 1), b2 + hstep); PG8_STAGE(PG8_SA(0, 0), a2, w0, w1);
            PG8_WAIT_V(8); PG8_WAIT_L(0); PG8_BAR; PG8_MMA(1, 0, At, B0); PG8_MMA(1, 1, At, B1); PG8_BAR; PG8_SCHED;
            PG8_LDB(B0, 1, 0); PG8_LDB(B1, 1, 1); PG8_SCHED; PG8_LDA(At, 1, 0); PG8_STAGE(PG8_SA(0, 1), a2, w2, w3);
            PG8_WAIT_V(8); PG8_WAIT_L(0); PG8_BAR; PG8_MMA(0, 0, At, B0); PG8_MMA(0, 1, At, B1); PG8_BAR; PG8_SCHED;
            PG8_LDA(At, 1, 1); PG8_STAGEB(PG8_SB(1, 0), b3); PG8_STAGEB(PG8_SB(1, 1), b3 + hstep); PG8_STAGE(PG8_SA(1, 0), a3, w0, w1);
            PG8_WAIT_V(8); PG8_WAIT_L(0); PG8_BAR; PG8_MMA(1, 0, At, B0); PG8_MMA(1, 1, At, B1); PG8_BAR; PG8_SCHED;
        }
        if constexpr (ALIGN_EPI) { if (wr == 0) PG8_BAR; }
        E(acc, cur, wr, wc, fr, fq);
        if (!has_next) break;
#pragma unroll
        for (int a = 0; a < 2; ++a)
#pragma unroll
            for (int b = 0; b < 2; ++b)
#pragma unroll
                for (int m = 0; m < 4; ++m)
#pragma unroll
                    for (int n = 0; n < 2; ++n) acc[a][b][m][n] = (f32x4){0.f, 0.f, 0.f, 0.f};
        cur = nxt; cA = nA; cB = nB; ++ui;
#pragma unroll
        for (int j = 0; j < 4; ++j) va[j] = vn[j];
        if constexpr (ALIGN_EPI) { if (wr == 1) PG8_BAR; }
    }
    PG8_WAIT_V(0);
    if constexpr (!ALIGN_EPI) { if (wr == 0) PG8_BAR; }
    PG8_BAR;
#undef PG8_SA
#undef PG8_SB
#undef PG8_STAGE
#undef PG8_STAGEB
#undef PG8_LDA
#undef PG8_LDB
#undef PG8_MMA
#undef PG8_WAIT_V
#undef PG8_WAIT_L
#undef PG8_BAR
#undef PG8_SCHED
}

struct EpiBf16 {
    static constexpr bool PERM = true;
    bf16_t* O; int ldc;
    __device__ __forceinline__ void operator()(const f32x4 (&acc)[2][2][4][2], const Unit& u, int wr, int wc, int fr, int fq) const {
        const int row0 = u.pm * BM + wr * 64 + fr, col0 = u.pn * BM + wc * 32 + 8 * fq;
#pragma unroll
        for (int ai = 0; ai < 2; ++ai)
#pragma unroll
            for (int m = 0; m < 4; ++m) { bf16_t* rowp = O + (size_t)(row0 + ai * HALF + m * 16) * ldc + col0;
#pragma unroll
                for (int bj = 0; bj < 2; ++bj) { const f32x4 v0 = acc[ai][bj][m][0], v1 = acc[ai][bj][m][1];
                    u32x4 w; w.x = cvt_pk_bf16(v0[0], v0[1]); w.y = cvt_pk_bf16(v0[2], v0[3]); w.z = cvt_pk_bf16(v1[0], v1[1]); w.w = cvt_pk_bf16(v1[2], v1[3]);
                    *(u32x4*)(rowp + bj * HALF) = w; } }
    }
};
}
#define GAS __attribute__((address_space(1)))
#define LAS __attribute__((address_space(3)))
typedef unsigned short bf16;
typedef unsigned v4u __attribute__((ext_vector_type(4)));
typedef float f32x4 __attribute__((ext_vector_type(4)));
typedef short bf16x8 __attribute__((ext_vector_type(8)));
typedef GAS unsigned gu32;
typedef GAS unsigned long long gu64;
#define RLX_AGENT __ATOMIC_RELAXED, __HIP_MEMORY_SCOPE_AGENT
#define LDS_WAIT() asm volatile("s_waitcnt lgkmcnt(0)" ::: "memory")
#define VM_WAIT() asm volatile("s_waitcnt vmcnt(0)" ::: "memory")
__device__ __forceinline__ unsigned long long rt() { return __builtin_amdgcn_s_memrealtime(); }
__device__ __forceinline__ unsigned f2bf(float f) { unsigned u = __builtin_bit_cast(unsigned, f); return (u + 0x7fffu + ((u >> 16) & 1u)) >> 16; }
__device__ __forceinline__ unsigned pk2(float lo, float hi) { return f2bf(lo) | (f2bf(hi) << 16); }

#define XB_TMO      128
#define XB_XCNT(j)  (256  + 64 * (j))
#define XB_XSUB(j)  (1280 + 64 * (j))
#define XB_XGEN(j)  (2304 + 64 * (j))
#define XB_TOP      3328
#define XB_TOPGEN   3392
#define XCD_BAR_WORDS 3456
#define XB_SPIN_CAP (1u << 18)

__device__ __forceinline__ unsigned xb_ld(unsigned* p)              { return __hip_atomic_load(p, __ATOMIC_RELAXED, __HIP_MEMORY_SCOPE_AGENT); }
__device__ __forceinline__ unsigned xb_add(unsigned* p, unsigned v) { return __hip_atomic_fetch_add(p, v, __ATOMIC_RELAXED, __HIP_MEMORY_SCOPE_AGENT); }
__device__ __forceinline__ unsigned xb_xcc_id() { return (unsigned)__builtin_amdgcn_s_getreg((3 << 11) | 20) & 0xFu; }
#define XB_SPIN(cond, bar) do { unsigned _sp = 0; while (cond) { __builtin_amdgcn_s_sleep(1); \
    if ((++_sp & 255u) == 0u) { if (xb_ld(&(bar)[XB_TMO])) break; if (_sp > XB_SPIN_CAP) { atomicAdd(&(bar)[XB_TMO], 1u); break; } } } } while (0)

struct XcdBarrier {
    unsigned* bar; unsigned x;
    volatile LAS unsigned* st;
};

__device__ __forceinline__ XcdBarrier xcd_barrier_post(unsigned* bar, volatile LAS unsigned* st) {
    XcdBarrier b; b.bar = bar; b.x = xb_xcc_id(); b.st = st;
    if (threadIdx.x == 0) (void)xb_add(&bar[XB_XCNT(b.x)], 1u);
    return b;
}
__device__ __forceinline__ void xcd_barrier_complete(unsigned* bar, unsigned x, unsigned& nloc, unsigned& nx) {
    const unsigned G = gridDim.x * gridDim.y * gridDim.z;
    unsigned sum, cnt, mine, sp = 0u;
    for (;;) {
        sum = 0u; cnt = 0u; mine = 0u;
#pragma unroll
        for (unsigned j = 0; j < 16; ++j) { const unsigned c = xb_ld(&bar[XB_XCNT(j)]); sum += c; cnt += (c > 0u) ? 1u : 0u; mine = (j == x) ? c : mine; }
        if (sum == G) break;
        __builtin_amdgcn_s_sleep(1);
        if ((++sp & 255u) == 0u) { if (xb_ld(&bar[XB_TMO])) break; if (sp > XB_SPIN_CAP) { atomicAdd(&bar[XB_TMO], 1u); break; } }
    }
    nloc = mine > 0u ? mine : 1u; nx = cnt > 0u ? cnt : 1u;
}

__device__ __forceinline__ void xcd_barrier(const XcdBarrier& b) {
    asm volatile("s_waitcnt vmcnt(0)" ::: "memory");
    __syncthreads();
    if (threadIdx.x == 0) {
        unsigned* bar = b.bar;
        __builtin_amdgcn_s_waitcnt(0);
        unsigned nloc = b.st[0], nx = b.st[1];
        if (nloc == 0u) { xcd_barrier_complete(bar, b.x, nloc, nx); b.st[0] = nloc; b.st[1] = nx; }
        const unsigned old = xb_add(&bar[XB_XSUB(b.x)], 1u);
        const unsigned gen = old / nloc;
        if (old + 1u == (gen + 1u) * nloc) {
            __builtin_amdgcn_fence(__ATOMIC_RELEASE, "agent");
            asm volatile("s_waitcnt vmcnt(0)" ::: "memory");
            const unsigned og = xb_add(&bar[XB_TOP], 1u);
            const unsigned tg = og / nx;
            if (og + 1u == (tg + 1u) * nx) xb_add(&bar[XB_TOPGEN], 1u);
            else XB_SPIN(xb_ld(&bar[XB_TOPGEN]) == tg, bar);
            __builtin_amdgcn_fence(__ATOMIC_ACQUIRE, "agent");
            xb_add(&bar[XB_XGEN(b.x)], 1u);
            asm volatile("s_waitcnt vmcnt(0)" ::: "memory");
        } else {
            XB_SPIN(xb_ld(&bar[XB_XGEN(b.x)]) == gen, bar);
            __builtin_amdgcn_fence(__ATOMIC_ACQUIRE, "agent");
            asm volatile("s_waitcnt vmcnt(0)" ::: "memory");
        }
    }
    __syncthreads();
}

constexpr int NTOK = 32768, DM = 1024, NPROJ = 3328;
constexpr int PC_Q = 0, PC_K = 512, PC_V = 1024, PC_Z = 1536, PC_U = 2048, PC_VS = 2560, PC_B = 3072, PC_A = 3076;
constexpr int NEXP = 64, DEXP = 512;
constexpr size_t MiB = 1u << 20;
constexpr size_t WS_CTL = 0, CTL_ZERO_BYTES = 1 * MiB;
constexpr size_t WS_WIN = 1 * MiB, WS_WOUT = 8 * MiB, WS_LIST = 10 * MiB, WS_ROUTE = 18 * MiB;
constexpr size_t WS_WREP = 19 * MiB;
constexpr size_t WS_C = 20 * MiB;
constexpr size_t WS_WGU = WS_C, WS_WD = WS_C + 128 * MiB;
constexpr size_t WS_A = 212 * MiB;
constexpr size_t WS_B = 276 * MiB;
constexpr size_t WS_H1BF = WS_B, WS_YEXP = WS_B + 64 * MiB;
constexpr size_t WS_END = 484 * MiB;
constexpr int CW_BAR = 4096;
constexpr int CW_CNT = 16384;
constexpr int RING_BYTES = 131072, LDSCTL_OFF = RING_BYTES, MISC_OFF = LDSCTL_OFF + 320, PREF_OFF = MISC_OFF + 128, LDS_BYTES = 147456;
constexpr int NTHREADS = 512, NWAVES = 8;
#ifndef GEMM_WGS_N
#define GEMM_WGS_N 184
#endif
constexpr int GEMM_WGS = GEMM_WGS_N;
constexpr float ALPHA_F = 1.189207115002721f;

__device__ __forceinline__ float bf2f(unsigned short v) { return __builtin_bit_cast(float, (unsigned)v << 16); }
__device__ __forceinline__ float wave_sum(float v) {
#pragma unroll
    for (int o = 1; o < 64; o <<= 1) v += __shfl_xor(v, o);
    return v;
}

__device__ __forceinline__ void p0_item_load(const float* W, int ldw, int k0, int n0src, int lane, float (&r)[32]) {
#pragma unroll
    for (int i = 0; i < 32; ++i) r[i] = W[(size_t)(k0 + 2 * i + (lane >> 5)) * ldw + n0src + (lane & 31)];
}
__device__ __forceinline__ void p0_item_store(const float (&r)[32], int K, int k0, bf16* WT, int dst_row0, LAS float* scr, int lane) {
#pragma unroll
    for (int i = 0; i < 32; ++i) scr[(2 * i + (lane >> 5)) * 33 + (lane & 31)] = r[i];
    LDS_WAIT(); asm volatile("" ::: "memory");
    const int c = lane & 7;
#pragma unroll
    for (int j = 0; j < 4; ++j) { const int n = (lane >> 3) + 8 * j; const LAS float* s = scr + (8 * c) * 33 + n;
        v4u o; o.x = pk2(s[0 * 33], s[1 * 33]); o.y = pk2(s[2 * 33], s[3 * 33]); o.z = pk2(s[4 * 33], s[5 * 33]); o.w = pk2(s[6 * 33], s[7 * 33]);
        *(GAS v4u*)(WT + (size_t)(dst_row0 + n) * K + k0 + 8 * c) = o; }
    LDS_WAIT(); asm volatile("" ::: "memory");
}
__device__ __forceinline__ void p0_transpose_item(const float* W, int ldw, int K, int k0, int n0src, bf16* WT, int dst_row0, LAS float* scr, int lane) {
    float r[32]; p0_item_load(W, ldw, k0, n0src, lane, r); p0_item_store(r, K, k0, WT, dst_row0, scr, lane);
}
struct P0Exp { const float* W; bf16* WT; int ldw, K, k0, n0, drow; };
__device__ __forceinline__ P0Exp p0_exp_item(int it, const float* wg, const float* wu, const float* wd, bf16* WGU, bf16* WD) {
    P0Exp x;
    if (it < 32768) { const int nb = it & 15, kb = (it >> 4) & 15, half = (it >> 8) & 1, e = it >> 9, n0 = nb * 32;
        x.W = (half ? wu : wg) + (size_t)e * DM * DEXP; x.WT = WGU + (size_t)e * 1024 * DM; x.ldw = DEXP; x.K = DM; x.k0 = kb * 64; x.n0 = n0; x.drow = (n0 >> 7) * 256 + half * 128 + (n0 & 127); }
    else { const int i2 = it - 32768, nb = i2 & 31, kb = (i2 >> 5) & 7, e = i2 >> 8;
        x.W = wd + (size_t)e * DEXP * DM; x.WT = WD + (size_t)e * DM * DEXP; x.ldw = DM; x.K = DEXP; x.k0 = kb * 64; x.n0 = nb * 32; x.drow = nb * 32; }
    return x;
}
__device__ __forceinline__ void p0_item_load4(const float* W, int ldw, int k0, int n0src, int lane, f32x4 (&r)[8]) {
#pragma unroll
    for (int i = 0; i < 8; ++i) r[i] = *(const GAS f32x4*)(W + (size_t)(k0 + (lane >> 3) + 8 * i) * ldw + n0src + 4 * (lane & 7));
}
__device__ __forceinline__ void p0_item_store4(const f32x4 (&r)[8], int K, int k0, bf16* WT, int dst_row0, LAS float* scr, int lane) {
#pragma unroll
    for (int i = 0; i < 8; ++i) { LAS float* d = scr + ((lane >> 3) + 8 * i) * 33 + 4 * (lane & 7); d[0] = r[i].x; d[1] = r[i].y; d[2] = r[i].z; d[3] = r[i].w; }
    LDS_WAIT(); asm volatile("" ::: "memory");
    const int c = lane & 7;
#pragma unroll
    for (int j = 0; j < 4; ++j) { const int n = (lane >> 3) + 8 * j; const LAS float* s = scr + (8 * c) * 33 + n;
        v4u o; o.x = pk2(s[0 * 33], s[1 * 33]); o.y = pk2(s[2 * 33], s[3 * 33]); o.z = pk2(s[4 * 33], s[5 * 33]); o.w = pk2(s[6 * 33], s[7 * 33]);
        *(GAS v4u*)(WT + (size_t)(dst_row0 + n) * K + k0 + 8 * c) = o; }
    LDS_WAIT(); asm volatile("" ::: "memory");
}
__device__ __forceinline__ void p0_experts(const float* wg, const float* wu, const float* wd, bf16* WGU, bf16* WD, LAS float* scr, int gw, int NGW, int lane) {
    constexpr int NIT = 32768 + 16384;
    f32x4 A[8], B[8], C[8], D[8];
#define P0_LOAD(buf, item) do { if ((item) < NIT) { const P0Exp x_ = p0_exp_item((item), wg, wu, wd, WGU, WD); p0_item_load4(x_.W, x_.ldw, x_.k0, x_.n0, lane, buf); } } while (0)
#define P0_STORE(buf, item) do { if ((item) < NIT) { const P0Exp x_ = p0_exp_item((item), wg, wu, wd, WGU, WD); p0_item_store4(buf, x_.K, x_.k0, x_.WT, x_.drow, scr, lane); } } while (0)
    int it = gw;
    P0_LOAD(A, it); P0_LOAD(B, it + NGW); P0_LOAD(C, it + 2 * NGW);
    for (; it < NIT; it += 4 * NGW) {
        P0_LOAD(D, it + 3 * NGW); P0_STORE(A, it);
        P0_LOAD(A, it + 4 * NGW); P0_STORE(B, it + NGW);
        P0_LOAD(B, it + 5 * NGW); P0_STORE(C, it + 2 * NGW);
        P0_LOAD(C, it + 6 * NGW); P0_STORE(D, it + 3 * NGW);
    }
#undef P0_LOAD
#undef P0_STORE
}

struct MK {
    nv::P p;
    unsigned char* ws;
};

namespace pg8 {
__device__ __forceinline__ float silu_f(float x) { return x * __builtin_amdgcn_rcpf(1.f + __builtin_amdgcn_exp2f(-1.4426950408889634f * x)); }
struct EpiHid {
    static constexpr bool PERM = true;
    bf16_t* HID; const int* list; const int* cnt; int cap;
    __device__ __forceinline__ void operator()(const f32x4 (&acc)[2][2][4][2], const Unit& u, int wr, int wc, int fr, int fq) const {
        const int* lp = list + (size_t)u.e * cap; const int col0 = u.pn * 128 + wc * 32 + 8 * fq;
#pragma unroll
        for (int ai = 0; ai < 2; ++ai)
#pragma unroll
            for (int m = 0; m < 4; ++m) { const int r = ai * HALF + wr * 64 + m * 16 + fr;
                if (r < u.rows) { const int a = lp[u.pm * BM + r] & 0xffff;
                    const f32x4 g0 = acc[ai][0][m][0], g1 = acc[ai][0][m][1], u0 = acc[ai][1][m][0], u1 = acc[ai][1][m][1];
                    u32x4 w; w.x = cvt_pk_bf16(silu_f(g0[0]) * u0[0], silu_f(g0[1]) * u0[1]); w.y = cvt_pk_bf16(silu_f(g0[2]) * u0[2], silu_f(g0[3]) * u0[3]);
                    w.z = cvt_pk_bf16(silu_f(g1[0]) * u1[0], silu_f(g1[1]) * u1[1]); w.w = cvt_pk_bf16(silu_f(g1[2]) * u1[2], silu_f(g1[3]) * u1[3]);
                    *(u32x4*)(HID + (size_t)a * 512 + col0) = w; } }
    }
};
struct EpiYexp {
    static constexpr bool PERM = true;
    bf16_t* Y; const int* list; const float* wgt; int cap;
    __device__ __forceinline__ void operator()(const f32x4 (&acc)[2][2][4][2], const Unit& u, int wr, int wc, int fr, int fq) const {
        const int* lp = list + (size_t)u.e * cap; const int col0 = u.pn * BM + wc * 32 + 8 * fq;
#pragma unroll
        for (int ai = 0; ai < 2; ++ai)
#pragma unroll
            for (int m = 0; m < 4; ++m) { const int r = ai * HALF + wr * 64 + m * 16 + fr;
                if (r < u.rows) { const unsigned ent = (unsigned)lp[u.pm * BM + r]; const int a = (int)(ent & 0xffffu); const float w8 = __builtin_bit_cast(float, ent & 0xffff0000u);
#pragma unroll
                    for (int bj = 0; bj < 2; ++bj) { const f32x4 v0 = acc[ai][bj][m][0] * w8, v1 = acc[ai][bj][m][1] * w8;
                        u32x4 w; w.x = cvt_pk_bf16(v0[0], v0[1]); w.y = cvt_pk_bf16(v0[2], v0[3]); w.z = cvt_pk_bf16(v1[0], v1[1]); w.w = cvt_pk_bf16(v1[2], v1[3]);
                        *(u32x4*)(Y + (size_t)a * 1024 + col0 + bj * HALF) = w; } } }
    }
};

struct EpiZ1 {
    static constexpr bool PERM = false;
    float* O; const float* X; float alpha;
    __device__ __forceinline__ void operator()(const f32x4 (&acc)[2][2][4][2], const Unit& u, int wr, int wc, int fr, int fq) const {
        const int row0 = u.pm * BM + wr * 64 + fr, col0 = u.pn * BM + wc * 32 + 4 * fq;
#pragma unroll
        for (int ai = 0; ai < 2; ++ai)
#pragma unroll
            for (int m = 0; m < 4; ++m) { const size_t off = (size_t)(row0 + ai * HALF + m * 16) * 1024 + col0;
#pragma unroll
                for (int bj = 0; bj < 2; ++bj)
#pragma unroll
                    for (int n = 0; n < 2; ++n) { const f32x4 xv = *(const f32x4*)(X + off + bj * HALF + n * 16); *(f32x4*)(O + off + bj * HALF + n * 16) = acc[ai][bj][m][n] + xv * alpha; } }
    }
};
}


typedef short s16x4 __attribute__((ext_vector_type(4)));
typedef short v4i16_t __attribute__((ext_vector_type(4)));
__device__ __forceinline__ unsigned off_b(unsigned row, unsigned ch) { return 256u * row + 16u * (ch ^ (((row & 3) << 2) | ((row >> 2) & 3))); }
__device__ __forceinline__ s16x4 vtr(LAS unsigned char* p) { return __builtin_bit_cast(s16x4, __builtin_amdgcn_ds_read_tr16_b64_v4i16((LAS v4i16_t*)p)); }
__device__ __forceinline__ float gelu_tanh(float x) { return x * __builtin_amdgcn_rcpf(1.f + __builtin_amdgcn_exp2f(-2.3022081986f * (x + 0.044715f * x * x * x))); }

__device__ __forceinline__ void sgu_phase(LAS unsigned char* lds, bf16* PROJ, const nv::P& p, int G, int vcu, int wave_s) {
    const int lane = pg8::lane_id_fresh(), tid = wave_s * 64 + lane;
    const int g4 = lane >> 4, q = (lane & 15) >> 2, pp = lane & 3, l15 = lane & 15;
    v4u rawn[4];
    { const int u0 = vcu < 1024 ? vcu : 0; const bf16* src = PROJ + ((size_t)(u0 >> 2) * 128 + (tid >> 2)) * NPROJ + PC_VS + (u0 & 3) * 128 + (tid & 3) * 32;
#pragma unroll
      for (int i = 0; i < 4; ++i) rawn[i] = *(const GAS v4u*)(src + 8 * i); }
    for (int u = vcu; u < 1024; u += G) {
        const int g = u & 3, bc = u >> 2; const size_t row0 = (size_t)bc * 128;
        {
            const int s = tid >> 2, qt = tid & 3;
            v4u raw[4];
#pragma unroll
            for (int i = 0; i < 4; ++i) raw[i] = rawn[i];
            { const int un = (u + G < 1024) ? u + G : u; const bf16* srcn = PROJ + ((size_t)(un >> 2) * 128 + s) * NPROJ + PC_VS + (un & 3) * 128 + qt * 32;
#pragma unroll
              for (int i = 0; i < 4; ++i) rawn[i] = *(const GAS v4u*)(srcn + 8 * i); }
            float x[32]; float s1 = 0.f;
#pragma unroll
            for (int i = 0; i < 4; ++i)
#pragma unroll
                for (int c = 0; c < 4; ++c) { const unsigned w = raw[i][c]; const float a = gelu_tanh(__builtin_bit_cast(float, w << 16)), b = gelu_tanh(__builtin_bit_cast(float, w & 0xffff0000u)); x[i * 8 + c * 2] = a; x[i * 8 + c * 2 + 1] = b; s1 += a + b; }
            s1 += __shfl_xor(s1, 1); s1 += __shfl_xor(s1, 2);
            const float mean = s1 * (1.f / 128.f); float s2 = 0.f;
#pragma unroll
            for (int i = 0; i < 32; ++i) { x[i] -= mean; s2 += x[i] * x[i]; }
            s2 += __shfl_xor(s2, 1); s2 += __shfl_xor(s2, 2);
            const float rstd = 1.f / sqrtf(s2 * (1.f / 128.f) + 1e-5f);
            const float* lg = p.sgu_ln_g + g * 128 + qt * 32; const float* lb = p.sgu_ln_b + g * 128 + qt * 32;
#pragma unroll
            for (int i = 0; i < 4; ++i) { const f32x4 g0 = *(const GAS f32x4*)(lg + 8 * i), g1 = *(const GAS f32x4*)(lg + 8 * i + 4), b0 = *(const GAS f32x4*)(lb + 8 * i), b1 = *(const GAS f32x4*)(lb + 8 * i + 4);
                v4u o; o.x = pk2(x[8 * i] * rstd * g0.x + b0.x, x[8 * i + 1] * rstd * g0.y + b0.y); o.y = pk2(x[8 * i + 2] * rstd * g0.z + b0.z, x[8 * i + 3] * rstd * g0.w + b0.w);
                o.z = pk2(x[8 * i + 4] * rstd * g1.x + b1.x, x[8 * i + 5] * rstd * g1.y + b1.y); o.w = pk2(x[8 * i + 6] * rstd * g1.z + b1.z, x[8 * i + 7] * rstd * g1.w + b1.w);
                *(LAS v4u*)(lds + off_b((unsigned)s, (unsigned)(qt * 4 + i))) = o; }
        }
        __syncthreads();
        {
            const int w = wave_s, t = 16 * w + l15, nks = (w >> 1) + 1;
            bf16* rowp = PROJ + (row0 + t) * NPROJ;
            unsigned long long uu8[8];
#pragma unroll
            for (int dt = 0; dt < 8; ++dt) uu8[dt] = *(const GAS unsigned long long*)(rowp + PC_U + g * 128 + 16 * dt + 4 * g4);
            const float bias = p.b_spatial[g * 128 + t];
            f32x4 acc[8];
#pragma unroll
            for (int dt = 0; dt < 8; ++dt) acc[dt] = (f32x4){0.f, 0.f, 0.f, 0.f};
            for (int ks = 0; ks < nks; ++ks) {
                const int sb = 32 * ks + 8 * g4;
                const float* wp = p.w_spatial + ((size_t)(g * 128 + t)) * 128 + sb;
                const f32x4 w0 = *(const GAS f32x4*)wp, w1 = *(const GAS f32x4*)(wp + 4);
                float wv[8] = {w0.x, w0.y, w0.z, w0.w, w1.x, w1.y, w1.z, w1.w};
#pragma unroll
                for (int j = 0; j < 8; ++j) if (sb + j > t) wv[j] = 0.f;
                v4u bw; bw.x = pk2(wv[0], wv[1]); bw.y = pk2(wv[2], wv[3]); bw.z = pk2(wv[4], wv[5]); bw.w = pk2(wv[6], wv[7]);
                const bf16x8 bfrag = __builtin_bit_cast(bf16x8, bw);
#pragma unroll
                for (int dt = 0; dt < 8; ++dt) {
                    const s16x4 lo = vtr(lds + off_b((unsigned)(sb + q), (unsigned)(2 * dt + (pp >> 1))) + 8 * (pp & 1));
                    const s16x4 hi = vtr(lds + off_b((unsigned)(sb + 4 + q), (unsigned)(2 * dt + (pp >> 1))) + 8 * (pp & 1));
                    const bf16x8 afrag = (bf16x8){lo[0], lo[1], lo[2], lo[3], hi[0], hi[1], hi[2], hi[3]};
                    acc[dt] = __builtin_amdgcn_mfma_f32_16x16x32_bf16(afrag, bfrag, acc[dt], 0, 0, 0);
                }
            }
#pragma unroll
            for (int dt = 0; dt < 8; ++dt) {
                const int d = g * 128 + 16 * dt + 4 * g4;
                const unsigned long long uu = uu8[dt];
                const float u0 = gelu_tanh(bf2f((unsigned short)uu)), u1 = gelu_tanh(bf2f((unsigned short)(uu >> 16))), u2 = gelu_tanh(bf2f((unsigned short)(uu >> 32))), u3 = gelu_tanh(bf2f((unsigned short)(uu >> 48)));
                const unsigned long long o = (unsigned long long)pk2(u0 * (acc[dt][0] + bias), u1 * (acc[dt][1] + bias)) | ((unsigned long long)pk2(u2 * (acc[dt][2] + bias), u3 * (acc[dt][3] + bias)) << 32);
                *(GAS unsigned long long*)(rowp + 512 + d) = o;
            }
        }
        __syncthreads();
    }
}

constexpr int DNA_PIECES = 57, DNU_PIECES = 2, DN_STEP_BYTES = (DNA_PIECES + DNU_PIECES) * 1024;
constexpr size_t DNA_CHUNK_BYTES = (size_t)DNA_PIECES * 1024, DNU_CHUNK_BYTES = 8 * DNU_PIECES * 1024;
__device__ __forceinline__ void glds16(const void* gsrc, LAS unsigned char* dst) { __builtin_amdgcn_global_load_lds((const unsigned*)gsrc, (LAS unsigned*)dst, 16, 0, 0); }
typedef float f32x2_t __attribute__((ext_vector_type(2))); typedef __bf16 bf16x2_t __attribute__((ext_vector_type(2)));
__device__ __forceinline__ unsigned cvtpk(float lo, float hi) { const f32x2_t v = {lo, hi}; const bf16x2_t b = __builtin_convertvector(v, bf16x2_t); return __builtin_bit_cast(unsigned, b); }

struct DnSet { bf16x8 F[14]; unsigned long long U; float gl; };
__device__ __forceinline__ void dn_set_load(DnSet& X, const unsigned char* a_step, const unsigned char* u_step, int w) {
#pragma unroll
    for (int ks = 0; ks < 4; ++ks) X.F[ks] = *(const GAS bf16x8*)(a_step + (w * 4 + ks) * 1024);
#pragma unroll
    for (int ks = 0; ks < 4; ++ks) X.F[4 + ks] = *(const GAS bf16x8*)(a_step + (16 + w * 4 + ks) * 1024);
#pragma unroll
    for (int ks = 0; ks < 2; ++ks) X.F[8 + ks] = *(const GAS bf16x8*)(a_step + (48 + w * 2 + ks) * 1024);
#pragma unroll
    for (int t = 0; t < 2; ++t)
#pragma unroll
        for (int ks = 0; ks < 2; ++ks) X.F[10 + 2 * t + ks] = *(const GAS bf16x8*)(a_step + (32 + (2 * w + t) * 2 + ks) * 1024);
    X.U = *(const GAS unsigned long long*)(u_step + (w >> 1) * 1024 + (w & 1) * 8);
    X.gl = *(const GAS float*)(a_step + 56 * 1024);
}
__device__ __forceinline__ void dn_scan_phase(LAS unsigned char* lds, const unsigned char* DNA, const unsigned char* DNU, bf16* ODN, int vcu, int wave_s) {
    if (vcu >= 256) return;
#define DN_BAR() do { asm volatile("s_waitcnt lgkmcnt(0)" ::: "memory"); __builtin_amdgcn_s_barrier(); asm volatile("" ::: "memory"); } while (0)
    if (wave_s >= 4) {
        for (int n = 0; n < 64; ++n) { DN_BAR(); DN_BAR(); }
        return;
    }
    const int lane = pg8::lane_id_fresh(), w = wave_s;
    const int bh = vcu >> 3, sl = vcu & 7, l15 = lane & 15, g4 = lane >> 4;
    const unsigned char* a_src = DNA + (size_t)bh * 64 * DNA_CHUNK_BYTES + lane * 16;
    const unsigned char* u_src = DNU + ((size_t)bh * 64 * 8 + sl) * (DNU_PIECES * 1024) + lane * 16;
    LAS unsigned char* XS = lds + lane * 16;
    LAS unsigned char* XV = lds + 4096 + lane * 16;
    bf16* orow = ODN + (size_t)vcu * (64 * 64 * 16) + l15;
    f32x4 S0 = (f32x4){0.f, 0.f, 0.f, 0.f}, S1 = S0;
    DnSet A, B, C;
    dn_set_load(A, a_src, u_src, w);
    dn_set_load(B, a_src + DNA_CHUNK_BYTES, u_src + DNU_CHUNK_BYTES, w);
    dn_set_load(C, a_src + 2 * DNA_CHUNK_BYTES, u_src + 2 * DNU_CHUNK_BYTES, w);
#define DN_STEP(X, nn) do { const int n_ = (nn); if (n_ < 64) { \
        { v4u sw; sw.x = cvtpk(S0[0], S0[1]); sw.y = cvtpk(S0[2], S0[3]); sw.z = cvtpk(S1[0], S1[1]); sw.w = cvtpk(S1[2], S1[3]); *(LAS v4u*)(XS + w * 1024) = sw; } \
        DN_BAR(); \
        bf16x8 Sb[4]; _Pragma("unroll") for (int ks = 0; ks < 4; ++ks) Sb[ks] = *(const LAS bf16x8*)(XS + ks * 1024); \
        f32x4 P = (f32x4){__builtin_bit_cast(float, (unsigned)X.U << 16), __builtin_bit_cast(float, (unsigned)X.U & 0xffff0000u), __builtin_bit_cast(float, (unsigned)(X.U >> 32) << 16), __builtin_bit_cast(float, (unsigned)(X.U >> 32) & 0xffff0000u)}; \
        _Pragma("unroll") for (int ks = 0; ks < 4; ++ks) P = __builtin_amdgcn_mfma_f32_16x16x32_bf16(X.F[ks], Sb[ks], P, 0, 0, 0); \
        f32x4 O = (f32x4){0.f, 0.f, 0.f, 0.f}; \
        _Pragma("unroll") for (int ks = 0; ks < 4; ++ks) O = __builtin_amdgcn_mfma_f32_16x16x32_bf16(X.F[4 + ks], Sb[ks], O, 0, 0, 0); \
        { const unsigned long long hv = (unsigned long long)cvtpk(P[0], P[1]) | ((unsigned long long)cvtpk(P[2], P[3]) << 32); *(LAS unsigned long long*)(XV + (w >> 1) * 1024 + (w & 1) * 8) = hv; } \
        DN_BAR(); \
        bf16x8 Vb[2]; _Pragma("unroll") for (int ks = 0; ks < 2; ++ks) Vb[ks] = *(const LAS bf16x8*)(XV + ks * 1024); \
        _Pragma("unroll") for (int ks = 0; ks < 2; ++ks) O = __builtin_amdgcn_mfma_f32_16x16x32_bf16(X.F[8 + ks], Vb[ks], O, 0, 0, 0); \
        S0 = S0 * X.gl; S1 = S1 * X.gl; \
        _Pragma("unroll") for (int ks = 0; ks < 2; ++ks) { S0 = __builtin_amdgcn_mfma_f32_16x16x32_bf16(X.F[10 + ks], Vb[ks], S0, 0, 0, 0); S1 = __builtin_amdgcn_mfma_f32_16x16x32_bf16(X.F[12 + ks], Vb[ks], S1, 0, 0, 0); } \
        { bf16* ob = orow + (size_t)(n_ * 64 + 16 * w + 4 * g4) * 16; _Pragma("unroll") for (int r = 0; r < 4; ++r) ob[r * 16] = (bf16)f2bf(O[r]); } \
        if (n_ + 3 < 64) dn_set_load(X, a_src + (size_t)(n_ + 3) * DNA_CHUNK_BYTES, u_src + (size_t)(n_ + 3) * DNU_CHUNK_BYTES, w); } } while (0)
    for (int n = 0; n < 64; n += 3) { DN_STEP(A, n); DN_STEP(B, n + 1); DN_STEP(C, n + 2); }
#undef DN_STEP
#undef DN_BAR
    asm volatile("s_waitcnt vmcnt(0)" ::: "memory");
}

__device__ __forceinline__ void dn_final_phase(const bf16* ODN, bf16* PROJ, const float* norm_w, int gw, int NGW, int lane) {
    const f32x4 nw0 = *(const GAS f32x4*)(norm_w + ((8 * lane) & 127)), nw1 = *(const GAS f32x4*)(norm_w + ((8 * lane) & 127) + 4);
#define DNF_LOAD(mm, OV, ZV) do { const int bb_ = (mm) >> 12, nn_ = ((mm) >> 6) & 63, ii_ = (mm) & 63; \
        OV = *(const GAS v4u*)(ODN + ((((size_t)((bb_ * 4 + (lane >> 4)) * 8 + ((lane >> 1) & 7)) * 64 + nn_) * 64 + ii_) * 16 + 8 * (lane & 1))); ZV = *(const GAS v4u*)(PROJ + (size_t)(mm) * NPROJ + PC_Z + 8 * lane); } while (0)
    v4u ovn, zvn; DNF_LOAD(gw < NTOK ? gw : 0, ovn, zvn);
    for (int m = gw; m < NTOK; m += NGW) {
        const v4u ov = ovn, zv = zvn;
        { const int mn = (m + NGW < NTOK) ? m + NGW : m; DNF_LOAD(mn, ovn, zvn); }
        float o[8], z[8];
#pragma unroll
        for (int c = 0; c < 4; ++c) { o[2 * c] = __builtin_bit_cast(float, ov[c] << 16); o[2 * c + 1] = __builtin_bit_cast(float, ov[c] & 0xffff0000u); z[2 * c] = __builtin_bit_cast(float, zv[c] << 16); z[2 * c + 1] = __builtin_bit_cast(float, zv[c] & 0xffff0000u); }
        float ss = 0.f;
#pragma unroll
        for (int c = 0; c < 8; ++c) ss += o[c] * o[c];
        ss += __shfl_xor(ss, 1); ss += __shfl_xor(ss, 2); ss += __shfl_xor(ss, 4); ss += __shfl_xor(ss, 8);
        const float rs = 1.f / sqrtf(ss * (1.f / 128.f) + 1e-6f);
        const float nw[8] = {nw0.x, nw0.y, nw0.z, nw0.w, nw1.x, nw1.y, nw1.z, nw1.w};
        float y[8];
#pragma unroll
        for (int c = 0; c < 8; ++c) y[c] = o[c] * rs * nw[c] * z[c] * __builtin_amdgcn_rcpf(1.f + __builtin_amdgcn_exp2f(-1.4426950408889634f * z[c]));
        v4u w; w.x = pk2(y[0], y[1]); w.y = pk2(y[2], y[3]); w.z = pk2(y[4], y[5]); w.w = pk2(y[6], y[7]);
        *(GAS v4u*)(PROJ + (size_t)m * NPROJ + 8 * lane) = w;
    }
}

__device__ __forceinline__ float wave_sum_dpp(float v) {
    v = v + __builtin_bit_cast(float, __builtin_amdgcn_update_dpp(0, __builtin_bit_cast(int, v), 0xB1, 0xf, 0xf, true));
    v = v + __builtin_bit_cast(float, __builtin_amdgcn_update_dpp(0, __builtin_bit_cast(int, v), 0x4E, 0xf, 0xf, true));
    v = v + __builtin_bit_cast(float, __builtin_amdgcn_update_dpp(0, __builtin_bit_cast(int, v), 0x141, 0xf, 0xf, true));
    v = v + __builtin_bit_cast(float, __builtin_amdgcn_update_dpp(0, __builtin_bit_cast(int, v), 0x140, 0xf, 0xf, true));
    v = v + __builtin_bit_cast(float, __builtin_amdgcn_update_dpp(0, __builtin_bit_cast(int, v), 0x142, 0xa, 0xf, true));
    v = v + __builtin_bit_cast(float, __builtin_amdgcn_update_dpp(0, __builtin_bit_cast(int, v), 0x143, 0xc, 0xf, true));
    return __builtin_bit_cast(float, __builtin_amdgcn_readlane(__builtin_bit_cast(int, v), 63));
}

constexpr int XTAB_OFF = RING_BYTES + 2048, XTAB_BYTES = 1792;
__device__ __forceinline__ unsigned off_t64(unsigned row, unsigned ch) { return 128u * row + 16u * (ch ^ (row & 7u)); }
__device__ __forceinline__ bf16x8 pack8(const float (&v)[8]) { v4u w; w.x = cvtpk(v[0], v[1]); w.y = cvtpk(v[2], v[3]); w.z = cvtpk(v[4], v[5]); w.w = cvtpk(v[6], v[7]); return __builtin_bit_cast(bf16x8, w); }
__device__ __forceinline__ void unpack8(const v4u w, float (&v)[8]) {
#pragma unroll
    for (int c = 0; c < 4; ++c) { v[2 * c] = __builtin_bit_cast(float, w[c] << 16); v[2 * c + 1] = __builtin_bit_cast(float, w[c] & 0xffff0000u); }
}
__device__ __forceinline__ float conv_silu_rows(const bf16* src0, bool seq_start, const float* cw, LAS unsigned char* img, int lane) {
    float w[4][2];
#pragma unroll
    for (int j = 0; j < 4; ++j) { const f32x2_t t = *(const GAS f32x2_t*)(cw + j * 1536 + 2 * lane); w[j][0] = t[0]; w[j][1] = t[1]; }
    const GAS unsigned* gsrc = (const GAS unsigned*)(src0 + 2 * lane);
    unsigned raw[67];
#pragma unroll
    for (int r = 0; r < 3; ++r) raw[r] = seq_start ? 0u : gsrc[(long)(r - 3) * (NPROJ / 2)];
#pragma unroll
    for (int r = 0; r < 64; ++r) raw[3 + r] = gsrc[(size_t)r * (NPROJ / 2)];
    float myss = 0.f;
    const unsigned lbase = (unsigned)((lane & 3) * 4);
#pragma unroll
    for (int pz = 0; pz < 64; ++pz) {
        float y0 = 0.f, y1 = 0.f;
#pragma unroll
        for (int j = 0; j < 4; ++j) { const unsigned u = raw[pz + j]; y0 += w[j][0] * __builtin_bit_cast(float, u << 16); y1 += w[j][1] * __builtin_bit_cast(float, u & 0xffff0000u); }
        y0 = y0 * __builtin_amdgcn_rcpf(1.f + __builtin_amdgcn_exp2f(-1.4426950408889634f * y0));
        y1 = y1 * __builtin_amdgcn_rcpf(1.f + __builtin_amdgcn_exp2f(-1.4426950408889634f * y1));
        const float tot = wave_sum_dpp(y0 * y0 + y1 * y1);
        myss = (lane == pz) ? tot : myss;
        *(LAS unsigned*)(img + off_b((unsigned)pz, (unsigned)(lane >> 2)) + lbase) = cvtpk(y0, y1);
    }
    return myss;
}

template <int STOP>
__device__ __forceinline__ void dn_prep_chunk(LAS unsigned char* IMG  , LAS float* tab, const bf16* PROJ, const nv::P& p, unsigned char* DNA, unsigned char* DNU, int ci) {
    int lane = pg8::lane_id_fresh();
    const int bh = ci >> 6, n = ci & 63, b = bh >> 2, h = bh & 3;
    int l15 = lane & 15, g4 = lane >> 4, q = l15 >> 2, pp = lane & 3;
    LAS float* t_gc = tab; LAS float* t_be = tab + 64; LAS float* t_rk = tab + 128; LAS float* t_rq = tab + 192; LAS float* t_eq = tab + 256; LAS float* t_ekk = tab + 320; LAS float* t_bg = tab + 384;
    const size_t tok = (size_t)b * 4096 + n * 64 + lane;
    const bf16* prow = PROJ + tok * NPROJ;
    const bf16* prow0 = PROJ + ((size_t)b * 4096 + n * 64) * NPROJ;
    unsigned char* dna = DNA + (size_t)ci * DNA_CHUNK_BYTES + lane * 16;
    (void)q; (void)pp;
    float gc, beta, eg, gc63;
    {
        const float araw = bf2f(prow[PC_A + h]), braw = bf2f(prow[PC_B + h]);
        const float xx = araw + p.dt_bias[h];
        const float sp = xx > 20.f ? xx : log1pf(expf(xx));
        gc = -expf(p.a_log[h]) * sp;
        beta = 1.f / (1.f + expf(-braw));
#pragma unroll
        for (int o = 1; o < 64; o <<= 1) { const float t = __shfl_up(gc, o); if (lane >= o) gc += t; }
        gc63 = __shfl(gc, 63);
        eg = expf(gc);
        const unsigned gb = __builtin_bit_cast(unsigned, expf(gc63));
        *(GAS v4u*)(dna + 56 * 1024) = (v4u){gb, gb, gb, gb};
        const float ssq = conv_silu_rows(prow0 + PC_Q + h * 128, n == 0, p.conv_w + h * 128, IMG, lane);
        const float rq = 0.08838834764831845f / sqrtf(ssq + 1e-6f);
        t_gc[lane] = gc; t_be[lane] = beta; t_rq[lane] = rq; t_eq[lane] = eg * rq;
    }
    LDS_WAIT(); asm volatile("" ::: "memory");
    if constexpr (STOP == 1) return;
    bf16x8 qF[4][4];
#pragma unroll
    for (int mt = 0; mt < 4; ++mt)
#pragma unroll
        for (int ks = 0; ks < 4; ++ks) qF[mt][ks] = *(const LAS bf16x8*)(IMG + off_b((unsigned)(16 * mt + l15), (unsigned)(4 * ks + g4)));
#pragma unroll
    for (int mt = 0; mt < 4; ++mt) {
        const float egi = t_eq[16 * mt + l15];
#pragma unroll
        for (int ks = 0; ks < 4; ++ks) {
            const unsigned long long lo = *(const LAS unsigned long long*)(IMG + off_b((unsigned)(16 * mt + l15), (unsigned)(4 * ks + (g4 >> 1))) + (g4 & 1) * 8);
            const unsigned long long hi = *(const LAS unsigned long long*)(IMG + off_b((unsigned)(16 * mt + l15), (unsigned)(4 * ks + 2 + (g4 >> 1))) + (g4 & 1) * 8);
            float t8[8]; unpack8((v4u){(unsigned)lo, (unsigned)(lo >> 32), (unsigned)hi, (unsigned)(hi >> 32)}, t8);
#pragma unroll
            for (int e = 0; e < 8; ++e) t8[e] *= egi;
            *(GAS bf16x8*)(dna + (16 + mt * 4 + ks) * 1024) = pack8(t8);
        }
    }
    LDS_WAIT(); asm volatile("" ::: "memory");
    {
        const float ssk = conv_silu_rows(prow0 + PC_K + h * 128, n == 0, p.conv_w + 512 + h * 128, IMG, lane);
        const float rk = 1.f / sqrtf(ssk + 1e-6f);
        t_rk[lane] = rk; t_ekk[lane] = expf(gc63 - gc) * rk; t_bg[lane] = beta * eg * rk;
    }
    LDS_WAIT(); asm volatile("" ::: "memory");
    if constexpr (STOP == 2) return;
    f32x4 Am[4][4];
    {
        bf16x8 kF[4][4];
#pragma unroll
        for (int mt = 0; mt < 4; ++mt)
#pragma unroll
            for (int ks = 0; ks < 4; ++ks) kF[mt][ks] = *(const LAS bf16x8*)(IMG + off_b((unsigned)(16 * mt + l15), (unsigned)(4 * ks + g4)));
#pragma unroll
        for (int mi = 0; mi < 4; ++mi) {
            const f32x4 gci = *(const LAS f32x4*)(t_gc + 16 * mi + 4 * g4), bei = *(const LAS f32x4*)(t_be + 16 * mi + 4 * g4), rki = *(const LAS f32x4*)(t_rk + 16 * mi + 4 * g4);
#pragma unroll
            for (int nj = 0; nj <= mi; ++nj) {
                f32x4 acc = (f32x4){0.f, 0.f, 0.f, 0.f};
#pragma unroll
                for (int ks = 0; ks < 4; ++ks) acc = __builtin_amdgcn_mfma_f32_16x16x32_bf16(kF[mi][ks], kF[nj][ks], acc, 0, 0, 0);
                const float gcj = t_gc[16 * nj + l15], rkj = t_rk[16 * nj + l15]; const int j = 16 * nj + l15;
#pragma unroll
                for (int r = 0; r < 4; ++r) { const int i = 16 * mi + 4 * g4 + r; acc[r] = (j < i) ? bei[r] * rki[r] * rkj * acc[r] * expf(gci[r] - gcj) : 0.f; }
                Am[mi][nj] = acc;
            }
        }
#pragma unroll
        for (int it = 0; it < 4; ++it) {
            const float gci = t_gc[16 * it + l15], rqi = t_rq[16 * it + l15]; const int i = 16 * it + l15;
            f32x4 kq[4];
#pragma unroll
            for (int jt = 0; jt < 4; ++jt) {
                f32x4 acc = (f32x4){0.f, 0.f, 0.f, 0.f};
                if (jt <= it) {
#pragma unroll
                    for (int ks = 0; ks < 4; ++ks) acc = __builtin_amdgcn_mfma_f32_16x16x32_bf16(kF[jt][ks], qF[it][ks], acc, 0, 0, 0);
                    const f32x4 gcj = *(const LAS f32x4*)(t_gc + 16 * jt + 4 * g4), rkj = *(const LAS f32x4*)(t_rk + 16 * jt + 4 * g4);
#pragma unroll
                    for (int r = 0; r < 4; ++r) { const int j = 16 * jt + 4 * g4 + r; acc[r] = (j <= i) ? acc[r] * rqi * rkj[r] * expf(gci - gcj[r]) : 0.f; }
                }
                kq[jt] = acc;
            }
#pragma unroll
            for (int ks = 0; ks < 2; ++ks) { const float t8[8] = {kq[2 * ks][0], kq[2 * ks][1], kq[2 * ks][2], kq[2 * ks][3], kq[2 * ks + 1][0], kq[2 * ks + 1][1], kq[2 * ks + 1][2], kq[2 * ks + 1][3]};
                *(GAS bf16x8*)(dna + (48 + it * 2 + ks) * 1024) = pack8(t8); }
        }
    }
    if constexpr (STOP == 3) return;
    bf16x8 ktr[8][2];
    {
#pragma unroll
        for (int ks = 0; ks < 2; ++ks) {
            const f32x4 ek0 = *(const LAS f32x4*)(t_ekk + 32 * ks + 4 * g4), ek1 = *(const LAS f32x4*)(t_ekk + 32 * ks + 16 + 4 * g4);
#pragma unroll
            for (int mt = 0; mt < 8; ++mt) {
                const s16x4 lo = vtr(IMG + off_b((unsigned)(32 * ks + 4 * g4 + q), (unsigned)(2 * mt + (pp >> 1))) + 8 * (pp & 1));
                const s16x4 hi = vtr(IMG + off_b((unsigned)(32 * ks + 16 + 4 * g4 + q), (unsigned)(2 * mt + (pp >> 1))) + 8 * (pp & 1));
                const float t8[8] = {bf2f((unsigned short)lo[0]) * ek0.x, bf2f((unsigned short)lo[1]) * ek0.y, bf2f((unsigned short)lo[2]) * ek0.z, bf2f((unsigned short)lo[3]) * ek0.w,
                                     bf2f((unsigned short)hi[0]) * ek1.x, bf2f((unsigned short)hi[1]) * ek1.y, bf2f((unsigned short)hi[2]) * ek1.z, bf2f((unsigned short)hi[3]) * ek1.w};
                *(GAS bf16x8*)(dna + (32 + mt * 2 + ks) * 1024) = pack8(t8);
            }
        }
#pragma unroll
        for (int dt = 0; dt < 8; ++dt)
#pragma unroll
            for (int ks = 0; ks < 2; ++ks) {
                const s16x4 lo = vtr(IMG + off_b((unsigned)(32 * ks + 8 * g4 + q), (unsigned)(2 * dt + (pp >> 1))) + 8 * (pp & 1));
                const s16x4 hi = vtr(IMG + off_b((unsigned)(32 * ks + 8 * g4 + 4 + q), (unsigned)(2 * dt + (pp >> 1))) + 8 * (pp & 1));
                ktr[dt][ks] = (bf16x8){lo[0], lo[1], lo[2], lo[3], hi[0], hi[1], hi[2], hi[3]};
            }
    }
    LDS_WAIT(); asm volatile("" ::: "memory");
    {
        LAS float* AL = (LAS float*)IMG;
#pragma unroll
        for (int mi = 0; mi < 4; ++mi)
#pragma unroll
            for (int nj = 0; nj <= mi; ++nj)
#pragma unroll
                for (int r = 0; r < 4; ++r) AL[(16 * mi + 4 * g4 + r) * 64 + 16 * nj + l15] = Am[mi][nj][r];
    }
    LDS_WAIT(); asm volatile("" ::: "memory");
    float T[64];
    {
        const LAS float* AL = (const LAS float*)IMG;
#pragma clang loop unroll(full)
        for (int i = 0; i < 64; ++i) {
            float v4[4] = {(lane == i) ? 1.f : 0.f, 0.f, 0.f, 0.f};
#pragma clang loop unroll(full)
            for (int j4 = 0; j4 < (i + 3) / 4; ++j4) {
                const f32x4 a = *(const LAS f32x4*)(AL + i * 64 + 4 * j4);
#pragma clang loop unroll(full)
                for (int e = 0; e < 4; ++e) if (4 * j4 + e < i) v4[e] -= a[e] * T[4 * j4 + e];
            }
            T[i] = (v4[0] + v4[1]) + (v4[2] + v4[3]);
        }
    }
    LDS_WAIT(); asm volatile("" ::: "memory");
    if constexpr (STOP == 4) return;
    lane = pg8::lane_id_fresh(); l15 = lane & 15; g4 = lane >> 4; q = l15 >> 2; pp = lane & 3;
    dna = DNA + (size_t)ci * DNA_CHUNK_BYTES + lane * 16;
    {
        const float bc = t_be[lane], bgc = t_bg[lane];
        LAS unsigned char* TB = IMG; LAS unsigned char* TBE = IMG + 8192;
#pragma unroll
        for (int i = 0; i < 64; ++i) { const unsigned o = off_t64((unsigned)i, (unsigned)(lane >> 3)) + (lane & 7) * 2;
            *(LAS unsigned short*)(TB + o) = (unsigned short)f2bf(T[i] * bc); *(LAS unsigned short*)(TBE + o) = (unsigned short)f2bf(T[i] * bgc); }
    }
    LDS_WAIT(); asm volatile("" ::: "memory");
    bf16x8 tb[4][2];
    {
#pragma unroll
        for (int it = 0; it < 4; ++it) {
            bf16x8 tbe[2];
#pragma unroll
            for (int ks = 0; ks < 2; ++ks) tbe[ks] = *(const LAS bf16x8*)(IMG + 8192 + off_t64((unsigned)(16 * it + l15), (unsigned)(4 * ks + g4)));
            f32x4 acc[8];
#pragma unroll
            for (int dt = 0; dt < 8; ++dt) { acc[dt] = (f32x4){0.f, 0.f, 0.f, 0.f};
#pragma unroll
                for (int ks = 0; ks < 2; ++ks) acc[dt] = __builtin_amdgcn_mfma_f32_16x16x32_bf16(ktr[dt][ks], tbe[ks], acc[dt], 0, 0, 0); }
#pragma unroll
            for (int ks = 0; ks < 4; ++ks) { const float t8[8] = {-acc[2 * ks][0], -acc[2 * ks][1], -acc[2 * ks][2], -acc[2 * ks][3], -acc[2 * ks + 1][0], -acc[2 * ks + 1][1], -acc[2 * ks + 1][2], -acc[2 * ks + 1][3]};
                *(GAS bf16x8*)(dna + (it * 4 + ks) * 1024) = pack8(t8); }
        }
#pragma unroll
        for (int mt = 0; mt < 4; ++mt)
#pragma unroll
            for (int ks = 0; ks < 2; ++ks) tb[mt][ks] = *(const LAS bf16x8*)(IMG + off_t64((unsigned)(16 * mt + l15), (unsigned)(4 * ks + g4)));
    }
    LDS_WAIT(); asm volatile("" ::: "memory");
    if constexpr (STOP == 5) return;
    (void)conv_silu_rows(prow0 + PC_V + h * 128, n == 0, p.conv_w + 1024 + h * 128, IMG, lane);
    LDS_WAIT(); asm volatile("" ::: "memory");
    {
        unsigned char* dnu = DNU + (size_t)ci * DNU_CHUNK_BYTES + lane * 16;
#pragma unroll
        for (int dt = 0; dt < 8; ++dt) {
            bf16x8 vt[2];
#pragma unroll
            for (int ks = 0; ks < 2; ++ks) {
                const s16x4 lo = vtr(IMG + off_b((unsigned)(32 * ks + 8 * g4 + q), (unsigned)(2 * dt + (pp >> 1))) + 8 * (pp & 1));
                const s16x4 hi = vtr(IMG + off_b((unsigned)(32 * ks + 8 * g4 + 4 + q), (unsigned)(2 * dt + (pp >> 1))) + 8 * (pp & 1));
                vt[ks] = (bf16x8){lo[0], lo[1], lo[2], lo[3], hi[0], hi[1], hi[2], hi[3]};
            }
            f32x4 u[4];
#pragma unroll
            for (int mt = 0; mt < 4; ++mt) { u[mt] = (f32x4){0.f, 0.f, 0.f, 0.f};
#pragma unroll
                for (int ks = 0; ks < 2; ++ks) u[mt] = __builtin_amdgcn_mfma_f32_16x16x32_bf16(tb[mt][ks], vt[ks], u[mt], 0, 0, 0); }
#pragma unroll
            for (int pc = 0; pc < 2; ++pc) { const float t8[8] = {u[2 * pc][0], u[2 * pc][1], u[2 * pc][2], u[2 * pc][3], u[2 * pc + 1][0], u[2 * pc + 1][1], u[2 * pc + 1][2], u[2 * pc + 1][3]};
                *(GAS bf16x8*)(dnu + (dt * 2 + pc) * 1024) = pack8(t8); }
        }
    }
    LDS_WAIT(); asm volatile("" ::: "memory");
}

template <int STOP>
__device__ __forceinline__ void dn_prep_phase(LAS unsigned char* lds, const bf16* PROJ, const nv::P& p, unsigned char* DNA, unsigned char* DNU, int G, int vcu, int wave_s) {
    LAS unsigned char* img = lds + wave_s * 16384; LAS float* tab = (LAS float*)(lds + XTAB_OFF + wave_s * XTAB_BYTES);
    for (int ci = vcu * 8 + wave_s; ci < 2048; ci += G * 8) dn_prep_chunk<STOP>(img, tab, PROJ, p, DNA, DNU, ci);
}


struct RouterArgs { const float* z; const bf16* mix; float* zout; bf16* H1BF; int* EID; float* WGT; int* LIST; int* CNT; const float *ln_g, *ln_b, *w_rg, *b_rg, *w_re, *b_re; };
__device__ __forceinline__ void router_fill(LAS float* dst, const float* W, int ldw, int col0, int tid) {
#pragma unroll
    for (int it = 0; it < 4; ++it) { const int qd = tid + it * NTHREADS, k = qd >> 1, half = qd & 1;
        const f32x4 v = *(const GAS f32x4*)(W + (size_t)k * ldw + col0 + half * 4);
        *(LAS f32x4*)(dst + ((((k >> 8) * 4 + (k & 3)) * 64 + ((k >> 2) & 63)) * 8 + half * 4)) = v; }
}
__device__ __forceinline__ void router_phase(LAS unsigned char* lds, const RouterArgs& A, int gw, int NGW, int wave_s) {
    const int lane = pg8::lane_id_fresh(), tid = wave_s * 64 + lane;
    LAS float* WG = (LAS float*)lds; LAS int* HIST = (LAS int*)(lds + 32768); LAS int* BASE = HIST + 64; LAS int* RR = HIST + 128;
    router_fill(WG, A.w_rg, 8, 0, tid);
    if (tid < 64) HIST[tid] = 0;
    __syncthreads();
    int it_ = 0;
    f32x4 vn[4]; unsigned long long mn_[4];
    { const GAS f32x4* zr = (const GAS f32x4*)(A.z + (size_t)gw * DM) + lane; const GAS unsigned long long* mr = (const GAS unsigned long long*)(A.mix + (size_t)gw * DM) + lane;
#pragma unroll
      for (int j = 0; j < 4; ++j) { vn[j] = zr[64 * j]; mn_[j] = mr[64 * j]; } }
    for (int m = gw; m < NTOK; m += NGW) {
        f32x4 v[4];
#pragma unroll
        for (int j = 0; j < 4; ++j) { const unsigned long long mm = mn_[j];
            v[j].x = ALPHA_F * vn[j].x + bf2f((unsigned short)mm); v[j].y = ALPHA_F * vn[j].y + bf2f((unsigned short)(mm >> 16));
            v[j].z = ALPHA_F * vn[j].z + bf2f((unsigned short)(mm >> 32)); v[j].w = ALPHA_F * vn[j].w + bf2f((unsigned short)(mm >> 48)); }
        { const int mn = (m + NGW < NTOK) ? m + NGW : m; const GAS f32x4* zn = (const GAS f32x4*)(A.z + (size_t)mn * DM) + lane; const GAS unsigned long long* mr = (const GAS unsigned long long*)(A.mix + (size_t)mn * DM) + lane;
#pragma unroll
          for (int j = 0; j < 4; ++j) { vn[j] = zn[64 * j]; mn_[j] = mr[64 * j]; } }
        float s = 0.f;
#pragma unroll
        for (int j = 0; j < 4; ++j) s += (v[j].x + v[j].y) + (v[j].z + v[j].w);
        const float mean = wave_sum_dpp(s) * (1.f / DM); float s2 = 0.f;
#pragma unroll
        for (int j = 0; j < 4; ++j) { v[j] = v[j] - mean; s2 += (v[j].x * v[j].x + v[j].y * v[j].y) + (v[j].z * v[j].z + v[j].w * v[j].w); }
        const float rstd = 1.f / sqrtf(wave_sum_dpp(s2) * (1.f / DM) + 1e-5f);
        GAS unsigned long long* hb = (GAS unsigned long long*)(A.H1BF + (size_t)m * DM) + lane;
#pragma unroll
        for (int j = 0; j < 4; ++j) { const f32x4 g = *((const GAS f32x4*)A.ln_g + lane + 64 * j), bb = *((const GAS f32x4*)A.ln_b + lane + 64 * j); v[j] = v[j] * rstd * g + bb;
            hb[64 * j] = (unsigned long long)pk2(v[j].x, v[j].y) | ((unsigned long long)pk2(v[j].z, v[j].w) << 32); }
        float gl[8];
#pragma unroll
        for (int c = 0; c < 8; ++c) gl[c] = 0.f;
#pragma unroll
        for (int j = 0; j < 4; ++j)
#pragma unroll
            for (int c4 = 0; c4 < 4; ++c4) { const float hv = v[j][c4]; const LAS float* wp = WG + ((j * 4 + c4) * 64 + lane) * 8;
                const f32x4 w0 = *(const LAS f32x4*)wp, w1 = *(const LAS f32x4*)(wp + 4);
                gl[0] += hv * w0.x; gl[1] += hv * w0.y; gl[2] += hv * w0.z; gl[3] += hv * w0.w; gl[4] += hv * w1.x; gl[5] += hv * w1.y; gl[6] += hv * w1.z; gl[7] += hv * w1.w; }
        int gi = 0; float gm = -INFINITY;
#pragma unroll
        for (int c = 0; c < 8; ++c) { gl[c] = wave_sum_dpp(gl[c]) + A.b_rg[c]; if (gl[c] > gm) { gm = gl[c]; gi = c; } }
        float den = 0.f;
#pragma unroll
        for (int c = 0; c < 8; ++c) den += expf(gl[c] - gm);
        const float pg = 1.f / den;
        float el[8];
#pragma unroll
        for (int c = 0; c < 8; ++c) el[c] = 0.f;
        const float* wre = A.w_re + gi * 8192 + lane * 8;
#pragma unroll
        for (int j = 0; j < 4; ++j)
#pragma unroll
            for (int c4 = 0; c4 < 4; ++c4) { const float hv = v[j][c4];
                const f32x4 w0 = *(const GAS f32x4*)(wre + (j * 4 + c4) * 512), w1 = *(const GAS f32x4*)(wre + (j * 4 + c4) * 512 + 4);
                el[0] += hv * w0.x; el[1] += hv * w0.y; el[2] += hv * w0.z; el[3] += hv * w0.w; el[4] += hv * w1.x; el[5] += hv * w1.y; el[6] += hv * w1.z; el[7] += hv * w1.w; }
        int i0 = 0, i1 = 0; float v0 = -INFINITY, v1 = -INFINITY;
#pragma unroll
        for (int c = 0; c < 8; ++c) { el[c] = wave_sum_dpp(el[c]) + A.b_re[gi * 8 + c]; if (el[c] > v0) { v0 = el[c]; i0 = c; } }
#pragma unroll
        for (int c = 0; c < 8; ++c) { if (c != i0 && el[c] > v1) { v1 = el[c]; i1 = c; } }
        const float e1 = expf(v1 - v0), sm = 1.f / (1.f + e1);
        if (lane == 0) {
            const int ea = gi * 8 + i0, eb = gi * 8 + i1;
            LAS int* rr = RR + (wave_s * 16 + it_) * 6;
            rr[4] = (int)(f2bf(pg * sm) << 16); rr[5] = (int)(f2bf(pg * e1 * sm) << 16);
            rr[0] = ea; rr[1] = __hip_atomic_fetch_add(&HIST[ea], 1, __ATOMIC_RELAXED, __HIP_MEMORY_SCOPE_WORKGROUP); rr[2] = eb; rr[3] = __hip_atomic_fetch_add(&HIST[eb], 1, __ATOMIC_RELAXED, __HIP_MEMORY_SCOPE_WORKGROUP);
        }
        ++it_;
    }
    __syncthreads();
    if (tid < 64) BASE[tid] = __hip_atomic_fetch_add(&A.CNT[tid], HIST[tid], __ATOMIC_RELAXED, __HIP_MEMORY_SCOPE_AGENT);
    __syncthreads();
    if (lane < it_) {
        const LAS int* rr = RR + (wave_s * 16 + lane) * 6; const int m = gw + lane * NGW;
        A.LIST[(size_t)rr[0] * NTOK + BASE[rr[0]] + rr[1]] = (2 * m) | rr[4];
        A.LIST[(size_t)rr[2] * NTOK + BASE[rr[2]] + rr[3]] = (2 * m + 1) | rr[5];
    }
}

__device__ __forceinline__ void final_phase(float* OUT, const bf16* H1B, const bf16* YEXP, const float* ln_g, const float* ln_b, int gw, int NGW, int lane) {
    unsigned long long hn[4], an[4], bn[4];
#define FIN_LOAD(mm) do { const GAS unsigned long long* hq_ = (const GAS unsigned long long*)(H1B + (size_t)(mm) * DM) + lane; const GAS unsigned long long* y0_ = (const GAS unsigned long long*)(YEXP + (size_t)(2 * (mm)) * DM) + lane; \
        _Pragma("unroll") for (int j_ = 0; j_ < 4; ++j_) { hn[j_] = hq_[64 * j_]; an[j_] = y0_[64 * j_]; bn[j_] = y0_[DM / 4 + 64 * j_]; } } while (0)
    FIN_LOAD(gw < NTOK ? gw : 0);
    for (int m = gw; m < NTOK; m += NGW) {
        GAS f32x4* orow = (GAS f32x4*)(OUT + (size_t)m * DM) + lane;
        unsigned long long hc[4], ac[4], bc[4];
#pragma unroll
        for (int j = 0; j < 4; ++j) { hc[j] = hn[j]; ac[j] = an[j]; bc[j] = bn[j]; }
        { const int mn = (m + NGW < NTOK) ? m + NGW : m; FIN_LOAD(mn); }
        f32x4 v[4]; float s = 0.f;
#pragma unroll
        for (int j = 0; j < 4; ++j) { const unsigned long long hh = hc[j], a0 = ac[j], a1 = bc[j];
            v[j].x = ALPHA_F * bf2f((unsigned short)hh) + bf2f((unsigned short)a0) + bf2f((unsigned short)a1);
            v[j].y = ALPHA_F * bf2f((unsigned short)(hh >> 16)) + bf2f((unsigned short)(a0 >> 16)) + bf2f((unsigned short)(a1 >> 16));
            v[j].z = ALPHA_F * bf2f((unsigned short)(hh >> 32)) + bf2f((unsigned short)(a0 >> 32)) + bf2f((unsigned short)(a1 >> 32));
            v[j].w = ALPHA_F * bf2f((unsigned short)(hh >> 48)) + bf2f((unsigned short)(a0 >> 48)) + bf2f((unsigned short)(a1 >> 48));
            s += (v[j].x + v[j].y) + (v[j].z + v[j].w); }
        const float mean = wave_sum_dpp(s) * (1.f / DM); float s2 = 0.f;
#pragma unroll
        for (int j = 0; j < 4; ++j) { v[j] = v[j] - mean; s2 += (v[j].x * v[j].x + v[j].y * v[j].y) + (v[j].z * v[j].z + v[j].w * v[j].w); }
        const float rstd = 1.f / sqrtf(wave_sum_dpp(s2) * (1.f / DM) + 1e-5f);
#pragma unroll
        for (int j = 0; j < 4; ++j) { const f32x4 g = *((const GAS f32x4*)ln_g + lane + 64 * j), bb = *((const GAS f32x4*)ln_b + lane + 64 * j); orow[64 * j] = v[j] * rstd * g + bb; }
    }
}

#ifndef REPEAT_MASK
#define REPEAT_MASK 0
#endif
#define REPS(k) ((((REPEAT_MASK) >> (k)) & 1) + 1)
__global__ void __launch_bounds__(NTHREADS, 2) fwd_megakernel(MK a) {
    extern __shared__ __attribute__((aligned(16))) unsigned char lds_raw[];
    cg::grid_group grid = cg::this_grid();
    LAS unsigned char* lds = (LAS unsigned char*)lds_raw;
    volatile LAS unsigned* MISC = (volatile LAS unsigned*)(lds + MISC_OFF);
    LAS int* PREF = (LAS int*)(lds + PREF_OFF);
    const int tid = threadIdx.x; const int wave_s = __builtin_amdgcn_readfirstlane(tid >> 6);
    const int G = gridDim.x; const int bx = blockIdx.x; const int vcu = (G % 8 == 0) ? (bx % 8) * (G / 8) + bx / 8 : bx;
    unsigned char* ws = a.ws; const nv::P& p = a.p;
    gu32* ctl = (gu32*)(ws + WS_CTL);
    bf16* WIN = (bf16*)(ws + WS_WIN); bf16* WOUT = (bf16*)(ws + WS_WOUT); bf16* XBF = (bf16*)(ws + WS_A); bf16* PROJ = (bf16*)(ws + WS_B);
    bf16* WGU = (bf16*)(ws + WS_WGU); bf16* WD = (bf16*)(ws + WS_WD); bf16* HID = (bf16*)(ws + WS_A); bf16* H1BF = (bf16*)(ws + WS_H1BF); bf16* YEXP = (bf16*)(ws + WS_YEXP);
    int* LIST = (int*)(ws + WS_LIST); int* EID = (int*)(ws + WS_ROUTE); float* WGT = (float*)(ws + WS_ROUTE + 512 * 1024);
    int* CNT = (int*)(ws + WS_CTL) + CW_CNT;
    for (int u = tid; u < (LDS_BYTES - LDSCTL_OFF) / 4; u += NTHREADS) ((LAS unsigned*)(lds + LDSCTL_OFF))[u] = 0u;
    __syncthreads();
    XcdBarrier bar = xcd_barrier_post((unsigned*)(ctl + CW_BAR), MISC + 8);
    grid.sync();
#define FRESH() const int lane = pg8::lane_id_fresh(), wave = wave_s; const int tid_ = wave_s * 64 + lane; const int gtid = (int)blockIdx.x * NTHREADS + tid_, gsize = G * NTHREADS, gw = vcu * NWAVES + wave, NGW = G * NWAVES; (void)lane; (void)gtid; (void)gsize; (void)gw; (void)NGW;

    _Pragma("unroll 1") for (int rep_ = 0; rep_ < REPS(0); ++rep_) {
    {
        FRESH();
        LAS float* scr = (LAS float*)(lds + wave * 16384);
        constexpr int NB = 96, KB = DM / 64;
        for (int it = gw; it < NB * KB; it += NGW) { const int nb = it % NB, kb = it / NB; const int nsrc = nb < 64 ? nb * 32 : 2056 + (nb - 64) * 32, ndst = nb * 32;
            p0_transpose_item(p.w_in, nv::INC, DM, kb * 64, nsrc, WIN, ndst, scr, lane); }
        for (int i = gtid; i < 8 * DM; i += gsize) { const int j = (int)(i / DM), k = (int)(i % DM); WIN[(size_t)(PC_B + j) * DM + k] = (bf16)f2bf(p.w_in[(size_t)k * nv::INC + 2048 + j]); }
        for (int i = gtid; i < (long)(NPROJ - 3080) * DM / 8; i += gsize) *(GAS v4u*)(WIN + (size_t)3080 * DM + i * 8) = (v4u){0u, 0u, 0u, 0u};
        for (int i = gtid; i < (long)NTOK * DM / 8; i += gsize) { const f32x4 v0 = *(const GAS f32x4*)(p.x + i * 8), v1 = *(const GAS f32x4*)(p.x + i * 8 + 4);
            v4u o; o.x = pk2(v0.x, v0.y); o.y = pk2(v0.z, v0.w); o.z = pk2(v1.x, v1.y); o.w = pk2(v1.z, v1.w); *(GAS v4u*)(XBF + i * 8) = o; }
        for (int it = gw; it < 16 * 32; it += NGW) { const int nb = it & 31, kb = it >> 5; p0_transpose_item(p.w_out, DM, DM, kb * 64, nb * 32, WOUT, nb * 32, scr, lane); }
        for (int d = gtid; d < 8 * 8192; d += gsize) { const int g = d >> 13, r = d & 8191, c = r & 7, ll = (r >> 3) & 63, jc = r >> 9, k = 4 * (ll + 64 * (jc >> 2)) + (jc & 3);
            ((float*)(ws + WS_WREP))[d] = p.w_re[(size_t)k * 64 + g * 8 + c]; }
    }
    xcd_barrier(bar);
    }
    _Pragma("unroll 1") for (int rep_ = 0; rep_ < REPS(1); ++rep_) {
    {
        if (bx < GEMM_WGS) {
            pg8::DenseOrder S; S.init(XBF, DM, WIN, NTOK, NPROJ, DM, GEMM_WGS, bx);
            pg8::EpiBf16 E{PROJ, NPROJ};
            pg8::gemm_phase<pg8::EpiBf16, pg8::DenseOrder, true>(lds, S, E, nullptr, wave_s);
        } else {
            const int lane = pg8::lane_id_fresh();
            LAS float* scr = (LAS float*)(lds + wave_s * 16384);
            p0_experts(p.w_gate, p.w_up, p.w_down, WGU, WD, scr, (bx - GEMM_WGS) * NWAVES + wave_s, (G - GEMM_WGS) * NWAVES, lane);
        }
    }
    xcd_barrier(bar);
    }
    unsigned char* DNA = (unsigned char*)p.out; unsigned char* DNU = ws + WS_A + 32 * MiB; bf16* ODN = (bf16*)(ws + WS_A);
    _Pragma("unroll 1") for (int rep_ = 0; rep_ < REPS(2); ++rep_) {
    dn_prep_phase<0>(lds, PROJ, p, DNA, DNU, G, vcu, wave_s);
    xcd_barrier(bar);
    }
    _Pragma("unroll 1") for (int rep_ = 0; rep_ < REPS(3); ++rep_) {
    dn_scan_phase(lds, DNA, DNU, ODN, vcu, wave_s);
    xcd_barrier(bar);
    }
    _Pragma("unroll 1") for (int rep_ = 0; rep_ < REPS(5); ++rep_) {
    sgu_phase(lds, PROJ, p, G, vcu, wave_s);
    { FRESH(); dn_final_phase(ODN, PROJ, p.dn_norm_w, gw, NGW, lane); }
    xcd_barrier(bar);
    }
    _Pragma("unroll 1") for (int rep_ = 0; rep_ < REPS(6); ++rep_) {
    {
        pg8::DenseOrder S; S.init(PROJ, NPROJ, WOUT, NTOK, DM, DM, G, bx);
        pg8::EpiBf16 E{(bf16*)(ws + WS_A), DM};
        pg8::gemm_phase<pg8::EpiBf16, pg8::DenseOrder, true>(lds, S, E, nullptr, wave_s);
    }
    xcd_barrier(bar);
    }
    {
        RouterArgs RA{p.x, (const bf16*)(ws + WS_A), p.out, H1BF, EID, WGT, LIST, CNT, p.ln1_g, p.ln1_b, p.w_rg, p.b_rg, (const float*)(ws + WS_WREP), p.b_re};
        router_phase(lds, RA, vcu * NWAVES + wave_s, G * NWAVES, wave_s);
    }
    xcd_barrier(bar);
    if (threadIdx.x == 0) { int s = 0; for (int e = 0; e < NEXP; ++e) { PREF[e] = s; s += ((CNT[e] + 255) >> 8) * 4; } PREF[NEXP] = s; }
    __syncthreads();
    _Pragma("unroll 1") for (int rep_ = 0; rep_ < REPS(7); ++rep_) {
    {
        pg8::GroupedOrder S{H1BF, WGU, LIST, PREF, DM, DM, 1024, NTOK, 1, 4, G, bx, NEXP};
        pg8::EpiHid E{HID, LIST, CNT, NTOK};
        pg8::gemm_phase<pg8::EpiHid, pg8::GroupedOrder, true>(lds, S, E, CNT, wave_s);
    }
    xcd_barrier(bar);
    }
    _Pragma("unroll 1") for (int rep_ = 0; rep_ < REPS(8); ++rep_) {
    {
        pg8::GroupedOrder S{HID, WD, LIST, PREF, DEXP, DEXP, 1024, NTOK, 0, 4, G, bx, NEXP};
        pg8::EpiYexp E{YEXP, LIST, WGT, NTOK};
        pg8::gemm_phase<pg8::EpiYexp, pg8::GroupedOrder, true>(lds, S, E, CNT, wave_s);
    }
    xcd_barrier(bar);
    }
    { FRESH(); final_phase(p.out, H1BF, YEXP, p.ln2_g, p.ln2_b, gw, NGW, lane); }
#if defined(GHOSTPREP)
    xcd_barrier(bar);
    dn_prep_phase<GHOSTPREP>(lds, (const bf16*)(ws + WS_B), p, ws + WS_C, ws + WS_C + 120 * MiB, G, vcu, wave_s);
#endif
#if defined(GHOST6)
    xcd_barrier(bar);
    { RouterArgs RA{p.out, (const bf16*)(ws + WS_A), (float*)(ws + WS_B), (bf16*)(ws + WS_C), (int*)(ws + WS_A), (float*)(ws + WS_A + 1 * MiB), (int*)(ws + WS_A + 2 * MiB), (int*)(ws + WS_CTL) + CW_CNT + 1024, p.ln1_g, p.ln1_b, p.w_rg, p.b_rg, (const float*)(ws + WS_WREP), p.b_re};
      router_phase(lds, RA, vcu * NWAVES + wave_s, G * NWAVES, wave_s); }
#endif
#if defined(GHOST9)
    xcd_barrier(bar);
    { FRESH(); final_phase((float*)(ws + WS_A), H1BF, (const bf16*)(ws + WS_C), p.ln2_g, p.ln2_b, gw, NGW, lane); }
#endif
}

extern "C" void kernel_launch(void* const* d_in, const int* in_sizes, int n_in, void* d_out, int out_size, void* d_ws, size_t ws_size, hipStream_t stream) {
    if (ws_size < WS_END || n_in != 22) { fprintf(stderr, "kernel_launch: bad ws/n_in\n"); return; }
    static int grid_blocks = 0;
    if (!grid_blocks) {
        int dev = 0, cus = 0, per_cu = 0;
        (void)hipGetDevice(&dev);
        (void)hipDeviceGetAttribute(&cus, hipDeviceAttributeMultiprocessorCount, dev);
        (void)hipFuncSetAttribute((const void*)fwd_megakernel, hipFuncAttributeMaxDynamicSharedMemorySize, (int)LDS_BYTES);
        (void)hipOccupancyMaxActiveBlocksPerMultiprocessor(&per_cu, (const void*)fwd_megakernel, NTHREADS, LDS_BYTES);
        if (per_cu < 1) { fprintf(stderr, "kernel_launch: occupancy query says %d\n", per_cu); per_cu = 1; }
        grid_blocks = cus;
    }
    (void)hipMemsetAsync((char*)d_ws + WS_CTL, 0, CTL_ZERO_BYTES, stream);
    MK a{}; bind(a.p, d_in, (float*)d_out); a.ws = (unsigned char*)d_ws;
    void* args[] = {&a};
    hipError_t e = hipLaunchCooperativeKernel((const void*)fwd_megakernel, dim3(grid_blocks), dim3(NTHREADS), args, LDS_BYTES, stream);
    if (e != hipSuccess) fprintf(stderr, "cooperative launch failed: %s (grid %d)\n", hipGetErrorString(e), grid_blocks);
}
```

```cpp
#include <hip/hip_runtime.h>
#include <hip/hip_cooperative_groups.h>
#include <cstdio>
#include <cstdint>
namespace cg = cooperative_groups;

namespace nv {
constexpr int INC = 3080;
struct P {
    const float *x, *w_in, *conv_w, *a_log, *dt_bias, *dn_norm_w, *sgu_ln_g, *sgu_ln_b, *w_spatial, *b_spatial, *w_out, *ln1_g, *ln1_b,
        *w_rg, *b_rg, *w_re, *b_re, *w_gate, *w_up, *w_down, *ln2_g, *ln2_b;
    float* out;
};
static inline void bind(P& p, void* const* in, float* out) {
    const float** f = (const float**)&p.x; for (int i = 0; i < 22; ++i) f[i] = (const float*)in[i];
    p.out = out;
}
}
namespace pg8 {
#define PG8_LAS __attribute__((address_space(3)))
typedef unsigned short bf16_t;
typedef short bf16x8 __attribute__((ext_vector_type(8)));
typedef float f32x4 __attribute__((ext_vector_type(4)));
typedef unsigned u32x4 __attribute__((ext_vector_type(4)));
typedef unsigned u32x2 __attribute__((ext_vector_type(2)));
constexpr int BM = 256, BK = 64, HALF = 128, HTB = HALF * BK * 2  , STAGE_BYTES = 8 * HTB, NXCD = 8, WGM = 8;

__host__ __device__ __forceinline__ int lds_byte(int r, int c) { const int st = (r >> 4) * 2 + (c >> 5), rr = r & 15, cc = c & 31, ob = rr * 64 + cc * 2; return st * 1024 + (ob ^ (((ob >> 9) & 1) << 5)); }
__host__ __device__ __forceinline__ void stage_rc(int b, int& R, int& C) { const int st = b / 1024, sb = b % 1024, swz = sb ^ (((sb >> 9) & 1) << 5); R = (st >> 1) * 16 + swz / 64; C = (st & 1) * 32 + (swz % 64) / 2; }
__host__ __device__ __forceinline__ int perm32(int rho) { const int n = rho >> 4, i = rho & 15; return 8 * (i >> 2) + 4 * n + (i & 3); }

struct Unit { int pm, pn, e, rows; };

typedef float f32x2_t __attribute__((ext_vector_type(2))); typedef __bf16 bf16x2_t __attribute__((ext_vector_type(2)));
__device__ __forceinline__ unsigned cvt_pk_bf16(float lo, float hi) { const f32x2_t v = {lo, hi}; const bf16x2_t b = __builtin_convertvector(v, bf16x2_t); return __builtin_bit_cast(unsigned, b); }

__device__ __forceinline__ int lane_id_fresh() { int l; asm volatile("v_mbcnt_lo_u32_b32 %0, -1, 0\n\tv_mbcnt_hi_u32_b32 %0, -1, %0" : "=v"(l)); return l; }
__device__ __forceinline__ int xcd_remap(int L, int nwg) { const int q = nwg / NXCD, r = nwg % NXCD, xcd = L % NXCD, off = L / NXCD; return (xcd < r ? xcd * (q + 1) : r * (q + 1) + (xcd - r) * q) + off; }

struct DenseOrder {
    const bf16_t* A; const bf16_t* Bt; int lda, K; int nM, nN, nwg, G, c;
    static constexpr bool GATHER = false;
    __device__ void init(const bf16_t* A_, int lda_, const bf16_t* Bt_, int M, int N, int K_, int G_, int c_) { A = A_; Bt = Bt_; lda = lda_; K = K_; nM = M / BM; nN = N / BM; nwg = nM * nN; G = G_; c = c_; }
    __device__ bool next(int i, Unit& u) const {
        const long L = (long)i * G + c; if (L >= nwg) return false;
        const int wgid = xcd_remap((int)L, nwg);
        const int nig = WGM * nN, gid = wgid / nig, fm = gid * WGM, gsz = (nM - fm) < WGM ? (nM - fm) : WGM;
        u.pm = fm + ((wgid % nig) % gsz); u.pn = (wgid % nig) / gsz; u.e = 0; u.rows = BM; return true;
    }
    __device__ __forceinline__ const char* a_base(const Unit& u) const { return (const char*)A + (size_t)u.pm * BM * lda * 2; }
    __device__ __forceinline__ const char* b_base(const Unit& u) const { return (const char*)Bt + (size_t)u.pn * BM * K * 2; }
    __device__ __forceinline__ void a_off(const Unit&, const int (&R)[2], const int (&C)[2], unsigned (&v)[4]) const {
#pragma unroll
        for (int h = 0; h < 2; ++h)
#pragma unroll
            for (int i = 0; i < 2; ++i) v[h * 2 + i] = (unsigned)((h * HALF + R[i]) * lda + C[i]) * 2u;
    }
};

struct GroupedOrder {
    const bf16_t* A; const bf16_t* Bt; const int* list; const PG8_LAS int* pref;
    int lda, K, N, cap, ashift, nN, G, c, ne;
    static constexpr bool GATHER = true;
    __device__ bool next(int i, Unit& u) const {
        const int nwg = pref[ne]; const long L = (long)i * G + c; if (L >= nwg) return false;
        const int w = xcd_remap((int)L, nwg);
        int e = 0; while (pref[e + 1] <= w) ++e;
        const int j = w - pref[e], ntm = (pref[e + 1] - pref[e]) / nN;
        u.e = e; u.pm = j % ntm; u.pn = j / ntm; u.rows = 0; return true;
    }
    __device__ __forceinline__ const char* a_base(const Unit&) const { return (const char*)A; }
    __device__ __forceinline__ const char* b_base(const Unit& u) const { return (const char*)Bt + ((size_t)u.e * N + (size_t)u.pn * BM) * K * 2; }
    __device__ __forceinline__ void a_off(const Unit& u, const int (&R)[2], const int (&C)[2], unsigned (&v)[4], int cnt) const {
        const int* lp = list + (size_t)u.e * cap;
#pragma unroll
        for (int h = 0; h < 2; ++h)
#pragma unroll
            for (int i = 0; i < 2; ++i) { int r = u.pm * BM + h * HALF + R[i]; if (r >= cnt) r = 0; const int a = (lp[r] & 0xffff) >> ashift; v[h * 2 + i] = (unsigned)(a * lda + C[i]) * 2u; }
    }
};

template <class Epi, class Sched, bool ALIGN_EPI>
__device__ __forceinline__ void gemm_phase(PG8_LAS unsigned char* lds, const Sched& S, const Epi& E, const int* gcnt, const int wave_s) {
    const int tid_ = wave_s * 64 + lane_id_fresh();
    const int tid = tid_, wid = wave_s, lane = tid & 63, wr = wid >> 2, wc = wid & 3, fr = lane & 15, fq = lane >> 4;
    const int K = S.K, nt = K / BK;
    int Rr[2], Cc[2]; unsigned voffB[2];
#pragma unroll
    for (int i = 0; i < 2; ++i) { int R, C; stage_rc(tid * 16 + i * 8192, R, C); const int Rb = Epi::PERM ? ((R & ~31) + perm32(R & 31)) : R; Rr[i] = R; Cc[i] = C; voffB[i] = (unsigned)(Rb * K + C) * 2u; }
    const size_t kstep = (size_t)(BK * 2);
    const size_t hstep = (size_t)HALF * K * 2;
    const unsigned ldsw = (unsigned)wid * 1024u;
    const int aoff = lds_byte(wr * 64 + fr, fq * 8), boff = lds_byte(wc * 32 + fr, fq * 8);
#define PG8_SA(b, h) (((b) * 2 + (h)) * HTB)
#define PG8_SB(b, h) ((4 + (b) * 2 + (h)) * HTB)
#define PG8_STAGE(bufoff, gbase, v0, v1) do { \
        __builtin_amdgcn_global_load_lds((const unsigned*)((const char*)(gbase) + (v0)), (PG8_LAS unsigned*)(lds + (bufoff) + ldsw), 16, 0, 0); \
        __builtin_amdgcn_global_load_lds((const unsigned*)((const char*)(gbase) + (v1)), (PG8_LAS unsigned*)(lds + (bufoff) + ldsw + 8192), 16, 0, 0); } while (0)
#define PG8_STAGEB(bufoff, gbase) PG8_STAGE(bufoff, gbase, voffB[0], voffB[1])
#define PG8_LDA(dst, b, h) do { _Pragma("unroll") for (int m = 0; m < 4; ++m) _Pragma("unroll") for (int k = 0; k < 2; ++k) dst[m][k] = *(const PG8_LAS bf16x8*)(lds + PG8_SA(b, h) + aoff + m * 2048 + k * 1024); } while (0)
#define PG8_LDB(dst, b, h) do { _Pragma("unroll") for (int n = 0; n < 2; ++n) _Pragma("unroll") for (int k = 0; k < 2; ++k) dst[n][k] = *(const PG8_LAS bf16x8*)(lds + PG8_SB(b, h) + boff + n * 2048 + k * 1024); } while (0)
#define PG8_MMA(ai, bj, At, Bt) do { __builtin_amdgcn_s_setprio(1); _Pragma("unroll") for (int m = 0; m < 4; ++m) _Pragma("unroll") for (int n = 0; n < 2; ++n) _Pragma("unroll") for (int k = 0; k < 2; ++k) \
        acc[ai][bj][m][n] = __builtin_amdgcn_mfma_f32_16x16x32_bf16(Bt[n][k], At[m][k], acc[ai][bj][m][n], 0, 0, 0); __builtin_amdgcn_s_setprio(0); } while (0)
#define PG8_WAIT_V(n) asm volatile("s_waitcnt vmcnt(" #n ")" ::: "memory")
#define PG8_WAIT_L(n) asm volatile("s_waitcnt lgkmcnt(" #n ")" ::: "memory")
#define PG8_BAR __builtin_amdgcn_s_barrier()
#define PG8_SCHED __builtin_amdgcn_sched_barrier(0)
    Unit cur, nxt; int ui = 0;
    if (!S.next(0, cur)) return;
    int ccnt = BM * 1024, ncnt = BM * 1024;
    if constexpr (Sched::GATHER) { ccnt = gcnt[cur.e]; }
    cur.rows = ccnt - cur.pm * BM;
    f32x4 acc[2][2][4][2];
#pragma unroll
    for (int a = 0; a < 2; ++a)
#pragma unroll
        for (int b = 0; b < 2; ++b)
#pragma unroll
            for (int m = 0; m < 4; ++m)
#pragma unroll
                for (int n = 0; n < 2; ++n) acc[a][b][m][n] = (f32x4){0.f, 0.f, 0.f, 0.f};
    bf16x8 At[4][2], B0[2][2], B1[2][2];
    unsigned va[4], vn[4];
    if constexpr (Sched::GATHER) S.a_off(cur, Rr, Cc, va, ccnt); else S.a_off(cur, Rr, Cc, va);
    const char* cA = S.a_base(cur); const char* cB = S.b_base(cur);
    PG8_STAGEB(PG8_SB(0, 0), cB); PG8_STAGEB(PG8_SB(0, 1), cB + hstep); PG8_STAGE(PG8_SA(0, 0), cA, va[0], va[1]); PG8_STAGE(PG8_SA(0, 1), cA, va[2], va[3]);
    if (wr == 1) PG8_BAR;
    PG8_WAIT_V(2); PG8_BAR;
    PG8_STAGEB(PG8_SB(1, 0), cB + kstep); PG8_STAGE(PG8_SA(1, 0), cA + kstep, va[0], va[1]); PG8_STAGEB(PG8_SB(1, 1), cB + hstep + kstep);
    PG8_WAIT_V(6); PG8_BAR;
    for (;;) {
        const bool has_next = S.next(ui + 1, nxt);
        const char* nA = cA; const char* nB = cB;
#pragma unroll
        for (int j = 0; j < 4; ++j) vn[j] = va[j];
        if (has_next) {
            nA = S.a_base(nxt); nB = S.b_base(nxt);
            if constexpr (Sched::GATHER) { ncnt = gcnt[nxt.e]; S.a_off(nxt, Rr, Cc, vn, ncnt); } else S.a_off(nxt, Rr, Cc, vn);
            nxt.rows = ncnt - nxt.pm * BM;
        }
        for (int t = 0; t < nt; t += 2) {
            const bool last = (t == nt - 2);
            const char* a1 = cA + (size_t)(t + 1) * kstep;
            const char* a2 = last ? nA : cA + (size_t)(t + 2) * kstep; const char* b2 = last ? nB : cB + (size_t)(t + 2) * kstep;
            const char* a3 = a2 + kstep; const char* b3 = b2 + kstep;
            unsigned w0 = va[0], w1 = va[1], w2 = va[2], w3 = va[3];
            if (last) { w0 = vn[0]; w1 = vn[1]; w2 = vn[2]; w3 = vn[3]; }
            PG8_LDB(B0, 0, 0); PG8_LDB(B1, 0, 1); PG8_SCHED; PG8_LDA(At, 0, 0); PG8_STAGE(PG8_SA(1, 1), a1, va[2], va[3]);
            PG8_WAIT_V(8); PG8_WAIT_L(0); PG8_BAR; PG8_MMA(0, 0, At, B0); PG8_MMA(0, 1, At, B1); PG8_BAR; PG8_SCHED;
            PG8_LDA(At, 0, 1); PG8_STAGEB(PG8_SB(0, 0), b2); PG8_STAGEB(PG8_SB(0, 1), b2 + hstep); PG8_STAGE(PG8_SA(0, 0), a2, w0, w1);
            PG8_WAIT_V(8); PG8_WAIT_L(0); PG8_BAR; PG8_MMA(1, 0, At, B0); PG8_MMA(1, 1, At, B1); PG8_BAR; PG8_SCHED;
            PG8_LDB(B0, 1, 0); PG8_LDB(B1, 1, 1); PG8_SCHED; PG8_LDA(At, 1, 0); PG8_STAGE(PG8_SA(0, 1), a2, w2, w3);
            PG8_WAIT_V(8); PG8_WAIT_L(0); PG8_BAR; PG8_MMA(0, 0, At, B0); PG8_MMA(0, 1, At, B1); PG8_BAR; PG8_SCHED;
            PG8_LDA(At, 1, 1); PG8_STAGEB(PG8_SB(1, 0), b3); PG8_STAGEB(PG8_SB(1, 1), b3 + hstep); PG8_STAGE(PG8_SA(1, 0), a3, w0, w1);
            PG8_WAIT_V(8); PG8_WAIT_L(0); PG8_BAR; PG8_MMA(1, 0, At, B0); PG8_MMA(1, 1, At, B1); PG8_BAR; PG8_SCHED;
        }
        if constexpr (ALIGN_EPI) { if (wr == 0) PG8_BAR; }
        E(acc, cur, wr, wc, fr, fq);
        if (!has_next) break;
#pragma unroll
        for (int a = 0; a < 2; ++a)
#pragma unroll
            for (int b = 0; b < 2; ++b)
#pragma unroll
                for (int m = 0; m < 4; ++m)
#pragma unroll
                    for (int n = 0; n < 2; ++n) acc[a][b][m][n] = (f32x4){0.f, 0.f, 0.f, 0.f};
        cur = nxt; cA = nA; cB = nB; ++ui;
#pragma unroll
        for (int j = 0; j < 4; ++j) va[j] = vn[j];
        if constexpr (ALIGN_EPI) { if (wr == 1) PG8_BAR; }
    }
    PG8_WAIT_V(0);
    if constexpr (!ALIGN_EPI) { if (wr == 0) PG8_BAR; }
    PG8_BAR;
#undef PG8_SA
#undef PG8_SB
#undef PG8_STAGE
#undef PG8_STAGEB
#undef PG8_LDA
#undef PG8_LDB
#undef PG8_MMA
#undef PG8_WAIT_V
#undef PG8_WAIT_L
#undef PG8_BAR
#undef PG8_SCHED
}

struct EpiBf16 {
    static constexpr bool PERM = true;
    bf16_t* O; int ldc;
    __device__ __forceinline__ void operator()(const f32x4 (&acc)[2][2][4][2], const Unit& u, int wr, int wc, int fr, int fq) const {
        const int row0 = u.pm * BM + wr * 64 + fr, col0 = u.pn * BM + wc * 32 + 8 * fq;
#pragma unroll
        for (int ai = 0; ai < 2; ++ai)
#pragma unroll
            for (int m = 0; m < 4; ++m) { bf16_t* rowp = O + (size_t)(row0 + ai * HALF + m * 16) * ldc + col0;
#pragma unroll
                for (int bj = 0; bj < 2; ++bj) { const f32x4 v0 = acc[ai][bj][m][0], v1 = acc[ai][bj][m][1];
                    u32x4 w; w.x = cvt_pk_bf16(v0[0], v0[1]); w.y = cvt_pk_bf16(v0[2], v0[3]); w.z = cvt_pk_bf16(v1[0], v1[1]); w.w = cvt_pk_bf16(v1[2], v1[3]);
                    *(u32x4*)(rowp + bj * HALF) = w; } }
    }
};
}
#define GAS __attribute__((address_space(1)))
#define LAS __attribute__((address_space(3)))
typedef unsigned short bf16;
typedef unsigned v4u __attribute__((ext_vector_type(4)));
typedef float f32x4 __attribute__((ext_vector_type(4)));
typedef short bf16x8 __attribute__((ext_vector_type(8)));
typedef GAS unsigned gu32;
typedef GAS unsigned long long gu64;
#define RLX_AGENT __ATOMIC_RELAXED, __HIP_MEMORY_SCOPE_AGENT
#define LDS_WAIT() asm volatile("s_waitcnt lgkmcnt(0)" ::: "memory")
#define VM_WAIT() asm volatile("s_waitcnt vmcnt(0)" ::: "memory")
__device__ __forceinline__ unsigned long long rt() { return __builtin_amdgcn_s_memrealtime(); }
__device__ __forceinline__ unsigned f2bf(float f) { unsigned u = __builtin_bit_cast(unsigned, f); return (u + 0x7fffu + ((u >> 16) & 1u)) >> 16; }
__device__ __forceinline__ unsigned pk2(float lo, float hi) { return f2bf(lo) | (f2bf(hi) << 16); }

#define XB_TMO      128
#define XB_XCNT(j)  (256  + 64 * (j))
#define XB_XSUB(j)  (1280 + 64 * (j))
#define XB_XGEN(j)  (2304 + 64 * (j))
#define XB_TOP      3328
#define XB_TOPGEN   3392
#define XCD_BAR_WORDS 3456
#define XB_SPIN_CAP (1u << 18)

__device__ __forceinline__ unsigned xb_ld(unsigned* p)              { return __hip_atomic_load(p, __ATOMIC_RELAXED, __HIP_MEMORY_SCOPE_AGENT); }
__device__ __forceinline__ unsigned xb_add(unsigned* p, unsigned v) { return __hip_atomic_fetch_add(p, v, __ATOMIC_RELAXED, __HIP_MEMORY_SCOPE_AGENT); }
__device__ __forceinline__ unsigned xb_xcc_id() { return (unsigned)__builtin_amdgcn_s_getreg((3 << 11) | 20) & 0xFu; }
#define XB_SPIN(cond, bar) do { unsigned _sp = 0; while (cond) { __builtin_amdgcn_s_sleep(1); \
    if ((++_sp & 255u) == 0u) { if (xb_ld(&(bar)[XB_TMO])) break; if (_sp > XB_SPIN_CAP) { atomicAdd(&(bar)[XB_TMO], 1u); break; } } } } while (0)

struct XcdBarrier {
    unsigned* bar; unsigned x;
    volatile LAS unsigned* st;
};

__device__ __forceinline__ XcdBarrier xcd_barrier_post(unsigned* bar, volatile LAS unsigned* st) {
    XcdBarrier b; b.bar = bar; b.x = xb_xcc_id(); b.st = st;
    if (threadIdx.x == 0) (void)xb_add(&bar[XB_XCNT(b.x)], 1u);
    return b;
}
__device__ __forceinline__ void xcd_barrier_complete(unsigned* bar, unsigned x, unsigned& nloc, unsigned& nx) {
    const unsigned G = gridDim.x * gridDim.y * gridDim.z;
    unsigned sum, cnt, mine, sp = 0u;
    for (;;) {
        sum = 0u; cnt = 0u; mine = 0u;
#pragma unroll
        for (unsigned j = 0; j < 16; ++j) { const unsigned c = xb_ld(&bar[XB_XCNT(j)]); sum += c; cnt += (c > 0u) ? 1u : 0u; mine = (j == x) ? c : mine; }
        if (sum == G) break;
        __builtin_amdgcn_s_sleep(1);
        if ((++sp & 255u) == 0u) { if (xb_ld(&bar[XB_TMO])) break; if (sp > XB_SPIN_CAP) { atomicAdd(&bar[XB_TMO], 1u); break; } }
    }
    nloc = mine > 0u ? mine : 1u; nx = cnt > 0u ? cnt : 1u;
}

__device__ __forceinline__ void xcd_barrier(const XcdBarrier& b) {
    asm volatile("s_waitcnt vmcnt(0)" ::: "memory");
    __syncthreads();
    if (threadIdx.x == 0) {
        unsigned* bar = b.bar;
        __builtin_amdgcn_s_waitcnt(0);
        unsigned nloc = b.st[0], nx = b.st[1];
        if (nloc == 0u) { xcd_barrier_complete(bar, b.x, nloc, nx); b.st[0] = nloc; b.st[1] = nx; }
        const unsigned old = xb_add(&bar[XB_XSUB(b.x)], 1u);
        const unsigned gen = old / nloc;
        if (old + 1u == (gen + 1u) * nloc) {
            __builtin_amdgcn_fence(__ATOMIC_RELEASE, "agent");
            asm volatile("s_waitcnt vmcnt(0)" ::: "memory");
            const unsigned og = xb_add(&bar[XB_TOP], 1u);
            const unsigned tg = og / nx;
            if (og + 1u == (tg + 1u) * nx) xb_add(&bar[XB_TOPGEN], 1u);
            else XB_SPIN(xb_ld(&bar[XB_TOPGEN]) == tg, bar);
            __builtin_amdgcn_fence(__ATOMIC_ACQUIRE, "agent");
            xb_add(&bar[XB_XGEN(b.x)], 1u);
            asm volatile("s_waitcnt vmcnt(0)" ::: "memory");
        } else {
            XB_SPIN(xb_ld(&bar[XB_XGEN(b.x)]) == gen, bar);
            __builtin_amdgcn_fence(__ATOMIC_ACQUIRE, "agent");
            asm volatile("s_waitcnt vmcnt(0)" ::: "memory");
        }
    }
    __syncthreads();
}

constexpr int NTOK = 32768, DM = 1024, NPROJ = 3328;
constexpr int PC_Q = 0, PC_K = 512, PC_V = 1024, PC_Z = 1536, PC_U = 2048, PC_VS = 2560, PC_B = 3072, PC_A = 3076;
constexpr int NEXP = 64, DEXP = 512;
constexpr size_t MiB = 1u << 20;
constexpr size_t WS_CTL = 0, CTL_ZERO_BYTES = 1 * MiB;
constexpr size_t WS_WIN = 1 * MiB, WS_WOUT = 8 * MiB, WS_LIST = 10 * MiB, WS_ROUTE = 18 * MiB;
constexpr size_t WS_WREP = 19 * MiB;
constexpr size_t WS_C = 20 * MiB;
constexpr size_t WS_WGU = WS_C, WS_WD = WS_C + 128 * MiB;
constexpr size_t WS_A = 212 * MiB;
constexpr size_t WS_B = 276 * MiB;
constexpr size_t WS_H1BF = WS_B, WS_YEXP = WS_B + 64 * MiB;
constexpr size_t WS_END = 484 * MiB;
constexpr int CW_BAR = 4096;
constexpr int CW_CNT = 16384;
constexpr int RING_BYTES = 131072, LDSCTL_OFF = RING_BYTES, MISC_OFF = LDSCTL_OFF + 320, PREF_OFF = MISC_OFF + 128, LDS_BYTES = 147456;
constexpr int NTHREADS = 512, NWAVES = 8;
#ifndef GEMM_WGS_N
#define GEMM_WGS_N 184
#endif
constexpr int GEMM_WGS = GEMM_WGS_N;
constexpr float ALPHA_F = 1.189207115002721f;

__device__ __forceinline__ float bf2f(unsigned short v) { return __builtin_bit_cast(float, (unsigned)v << 16); }
__device__ __forceinline__ float wave_sum(float v) {
#pragma unroll
    for (int o = 1; o < 64; o <<= 1) v += __shfl_xor(v, o);
    return v;
}

__device__ __forceinline__ void p0_item_load(const float* W, int ldw, int k0, int n0src, int lane, float (&r)[32]) {
#pragma unroll
    for (int i = 0; i < 32; ++i) r[i] = W[(size_t)(k0 + 2 * i + (lane >> 5)) * ldw + n0src + (lane & 31)];
}
__device__ __forceinline__ void p0_item_store(const float (&r)[32], int K, int k0, bf16* WT, int dst_row0, LAS float* scr, int lane) {
#pragma unroll
    for (int i = 0; i < 32; ++i) scr[(2 * i + (lane >> 5)) * 33 + (lane & 31)] = r[i];
    LDS_WAIT(); asm volatile("" ::: "memory");
    const int c = lane & 7;
#pragma unroll
    for (int j = 0; j < 4; ++j) { const int n = (lane >> 3) + 8 * j; const LAS float* s = scr + (8 * c) * 33 + n;
        v4u o; o.x = pk2(s[0 * 33], s[1 * 33]); o.y = pk2(s[2 * 33], s[3 * 33]); o.z = pk2(s[4 * 33], s[5 * 33]); o.w = pk2(s[6 * 33], s[7 * 33]);
        *(GAS v4u*)(WT + (size_t)(dst_row0 + n) * K + k0 + 8 * c) = o; }
    LDS_WAIT(); asm volatile("" ::: "memory");
}
__device__ __forceinline__ void p0_transpose_item(const float* W, int ldw, int K, int k0, int n0src, bf16* WT, int dst_row0, LAS float* scr, int lane) {
    float r[32]; p0_item_load(W, ldw, k0, n0src, lane, r); p0_item_store(r, K, k0, WT, dst_row0, scr, lane);
}
struct P0Exp { const float* W; bf16* WT; int ldw, K, k0, n0, drow; };
__device__ __forceinline__ P0Exp p0_exp_item(int it, const float* wg, const float* wu, const float* wd, bf16* WGU, bf16* WD) {
    P0Exp x;
    if (it < 32768) { const int nb = it & 15, kb = (it >> 4) & 15, half = (it >> 8) & 1, e = it >> 9, n0 = nb * 32;
        x.W = (half ? wu : wg) + (size_t)e * DM * DEXP; x.WT = WGU + (size_t)e * 1024 * DM; x.ldw = DEXP; x.K = DM; x.k0 = kb * 64; x.n0 = n0; x.drow = (n0 >> 7) * 256 + half * 128 + (n0 & 127); }
    else { const int i2 = it - 32768, nb = i2 & 31, kb = (i2 >> 5) & 7, e = i2 >> 8;
        x.W = wd + (size_t)e * DEXP * DM; x.WT = WD + (size_t)e * DM * DEXP; x.ldw = DM; x.K = DEXP; x.k0 = kb * 64; x.n0 = nb * 32; x.drow = nb * 32; }
    return x;
}
__device__ __forceinline__ void p0_item_load4(const float* W, int ldw, int k0, int n0src, int lane, f32x4 (&r)[8]) {
#pragma unroll
    for (int i = 0; i < 8; ++i) r[i] = *(const GAS f32x4*)(W + (size_t)(k0 + (lane >> 3) + 8 * i) * ldw + n0src + 4 * (lane & 7));
}
__device__ __forceinline__ void p0_item_store4(const f32x4 (&r)[8], int K, int k0, bf16* WT, int dst_row0, LAS float* scr, int lane) {
#pragma unroll
    for (int i = 0; i < 8; ++i) { LAS float* d = scr + ((lane >> 3) + 8 * i) * 33 + 4 * (lane & 7); d[0] = r[i].x; d[1] = r[i].y; d[2] = r[i].z; d[3] = r[i].w; }
    LDS_WAIT(); asm volatile("" ::: "memory");
    const int c = lane & 7;
#pragma unroll
    for (int j = 0; j < 4; ++j) { const int n = (lane >> 3) + 8 * j; const LAS float* s = scr + (8 * c) * 33 + n;
        v4u o; o.x = pk2(s[0 * 33], s[1 * 33]); o.y = pk2(s[2 * 33], s[3 * 33]); o.z = pk2(s[4 * 33], s[5 * 33]); o.w = pk2(s[6 * 33], s[7 * 33]);
        *(GAS v4u*)(WT + (size_t)(dst_row0 + n) * K + k0 + 8 * c) = o; }
    LDS_WAIT(); asm volatile("" ::: "memory");
}
__device__ __forceinline__ void p0_experts(const float* wg, const float* wu, const float* wd, bf16* WGU, bf16* WD, LAS float* scr, int gw, int NGW, int lane) {
    constexpr int NIT = 32768 + 16384;
    f32x4 A[8], B[8], C[8], D[8];
#define P0_LOAD(buf, item) do { if ((item) < NIT) { const P0Exp x_ = p0_exp_item((item), wg, wu, wd, WGU, WD); p0_item_load4(x_.W, x_.ldw, x_.k0, x_.n0, lane, buf); } } while (0)
#define P0_STORE(buf, item) do { if ((item) < NIT) { const P0Exp x_ = p0_exp_item((item), wg, wu, wd, WGU, WD); p0_item_store4(buf, x_.K, x_.k0, x_.WT, x_.drow, scr, lane); } } while (0)
    int it = gw;
    P0_LOAD(A, it); P0_LOAD(B, it + NGW); P0_LOAD(C, it + 2 * NGW);
    for (; it < NIT; it += 4 * NGW) {
        P0_LOAD(D, it + 3 * NGW); P0_STORE(A, it);
        P0_LOAD(A, it + 4 * NGW); P0_STORE(B, it + NGW);
        P0_LOAD(B, it + 5 * NGW); P0_STORE(C, it + 2 * NGW);
        P0_LOAD(C, it + 6 * NGW); P0_STORE(D, it + 3 * NGW);
    }
#undef P0_LOAD
#undef P0_STORE
}

struct MK {
    nv::P p;
    unsigned char* ws;
};

namespace pg8 {
__device__ __forceinline__ float silu_f(float x) { return x * __builtin_amdgcn_rcpf(1.f + __builtin_amdgcn_exp2f(-1.4426950408889634f * x)); }
struct EpiHid {
    static constexpr bool PERM = true;
    bf16_t* HID; const int* list; const int* cnt; int cap;
    __device__ __forceinline__ void operator()(const f32x4 (&acc)[2][2][4][2], const Unit& u, int wr, int wc, int fr, int fq) const {
        const int* lp = list + (size_t)u.e * cap; const int col0 = u.pn * 128 + wc * 32 + 8 * fq;
#pragma unroll
        for (int ai = 0; ai < 2; ++ai)
#pragma unroll
            for (int m = 0; m < 4; ++m) { const int r = ai * HALF + wr * 64 + m * 16 + fr;
                if (r < u.rows) { const int a = lp[u.pm * BM + r] & 0xffff;
                    const f32x4 g0 = acc[ai][0][m][0], g1 = acc[ai][0][m][1], u0 = acc[ai][1][m][0], u1 = acc[ai][1][m][1];
                    u32x4 w; w.x = cvt_pk_bf16(silu_f(g0[0]) * u0[0], silu_f(g0[1]) * u0[1]); w.y = cvt_pk_bf16(silu_f(g0[2]) * u0[2], silu_f(g0[3]) * u0[3]);
                    w.z = cvt_pk_bf16(silu_f(g1[0]) * u1[0], silu_f(g1[1]) * u1[1]); w.w = cvt_pk_bf16(silu_f(g1[2]) * u1[2], silu_f(g1[3]) * u1[3]);
                    *(u32x4*)(HID + (size_t)a * 512 + col0) = w; } }
    }
};
struct EpiYexp {
    static constexpr bool PERM = true;
    bf16_t* Y; const int* list; const float* wgt; int cap;
    __device__ __forceinline__ void operator()(const f32x4 (&acc)[2][2][4][2], const Unit& u, int wr, int wc, int fr, int fq) const {
        const int* lp = list + (size_t)u.e * cap; const int col0 = u.pn * BM + wc * 32 + 8 * fq;
#pragma unroll
        for (int ai = 0; ai < 2; ++ai)
#pragma unroll
            for (int m = 0; m < 4; ++m) { const int r = ai * HALF + wr * 64 + m * 16 + fr;
                if (r < u.rows) { const unsigned ent = (unsigned)lp[u.pm * BM + r]; const int a = (int)(ent & 0xffffu); const float w8 = __builtin_bit_cast(float, ent & 0xffff0000u);
#pragma unroll
                    for (int bj = 0; bj < 2; ++bj) { const f32x4 v0 = acc[ai][bj][m][0] * w8, v1 = acc[ai][bj][m][1] * w8;
                        u32x4 w; w.x = cvt_pk_bf16(v0[0], v0[1]); w.y = cvt_pk_bf16(v0[2], v0[3]); w.z = cvt_pk_bf16(v1[0], v1[1]); w.w = cvt_pk_bf16(v1[2], v1[3]);
                        *(u32x4*)(Y + (size_t)a * 1024 + col0 + bj * HALF) = w; } } }
    }
};

struct EpiZ1 {
    static constexpr bool PERM = false;
    float* O; const float* X; float alpha;
    __device__ __forceinline__ void operator()(const f32x4 (&acc)[2][2][4][2], const Unit& u, int wr, int wc, int fr, int fq) const {
        const int row0 = u.pm * BM + wr * 64 + fr, col0 = u.pn * BM + wc * 32 + 4 * fq;
#pragma unroll
        for (int ai = 0; ai < 2; ++ai)
#pragma unroll
            for (int m = 0; m < 4; ++m) { const size_t off = (size_t)(row0 + ai * HALF + m * 16) * 1024 + col0;
#pragma unroll
                for (int bj = 0; bj < 2; ++bj)
#pragma unroll
                    for (int n = 0; n < 2; ++n) { const f32x4 xv = *(const f32x4*)(X + off + bj * HALF + n * 16); *(f32x4*)(O + off + bj * HALF + n * 16) = acc[ai][bj][m][n] + xv * alpha; } }
    }
};
}


typedef short s16x4 __attribute__((ext_vector_type(4)));
typedef short v4i16_t __attribute__((ext_vector_type(4)));
__device__ __forceinline__ unsigned off_b(unsigned row, unsigned ch) { return 256u * row + 16u * (ch ^ (((row & 3) << 2) | ((row >> 2) & 3))); }
__device__ __forceinline__ s16x4 vtr(LAS unsigned char* p) { return __builtin_bit_cast(s16x4, __builtin_amdgcn_ds_read_tr16_b64_v4i16((LAS v4i16_t*)p)); }
__device__ __forceinline__ float gelu_tanh(float x) { return x * __builtin_amdgcn_rcpf(1.f + __builtin_amdgcn_exp2f(-2.3022081986f * (x + 0.044715f * x * x * x))); }

__device__ __forceinline__ void sgu_phase(LAS unsigned char* lds, bf16* PROJ, const nv::P& p, int G, int vcu, int wave_s) {
    const int lane = pg8::lane_id_fresh(), tid = wave_s * 64 + lane;
    const int g4 = lane >> 4, q = (lane & 15) >> 2, pp = lane & 3, l15 = lane & 15;
    v4u rawn[4];
    { const int u0 = vcu < 1024 ? vcu : 0; const bf16* src = PROJ + ((size_t)(u0 >> 2) * 128 + (tid >> 2)) * NPROJ + PC_VS + (u0 & 3) * 128 + (tid & 3) * 32;
#pragma unroll
      for (int i = 0; i < 4; ++i) rawn[i] = *(const GAS v4u*)(src + 8 * i); }
    for (int u = vcu; u < 1024; u += G) {
        const int g = u & 3, bc = u >> 2; const size_t row0 = (size_t)bc * 128;
        {
            const int s = tid >> 2, qt = tid & 3;
            v4u raw[4];
#pragma unroll
            for (int i = 0; i < 4; ++i) raw[i] = rawn[i];
            { const int un = (u + G < 1024) ? u + G : u; const bf16* srcn = PROJ + ((size_t)(un >> 2) * 128 + s) * NPROJ + PC_VS + (un & 3) * 128 + qt * 32;
#pragma unroll
              for (int i = 0; i < 4; ++i) rawn[i] = *(const GAS v4u*)(srcn + 8 * i); }
            float x[32]; float s1 = 0.f;
#pragma unroll
            for (int i = 0; i < 4; ++i)
#pragma unroll
                for (int c = 0; c < 4; ++c) { const unsigned w = raw[i][c]; const float a = gelu_tanh(__builtin_bit_cast(float, w << 16)), b = gelu_tanh(__builtin_bit_cast(float, w & 0xffff0000u)); x[i * 8 + c * 2] = a; x[i * 8 + c * 2 + 1] = b; s1 += a + b; }
            s1 += __shfl_xor(s1, 1); s1 += __shfl_xor(s1, 2);
            const float mean = s1 * (1.f / 128.f); float s2 = 0.f;
#pragma unroll
            for (int i = 0; i < 32; ++i) { x[i] -= mean; s2 += x[i] * x[i]; }
            s2 += __shfl_xor(s2, 1); s2 += __shfl_xor(s2, 2);
            const float rstd = 1.f / sqrtf(s2 * (1.f / 128.f) + 1e-5f);
            const float* lg = p.sgu_ln_g + g * 128 + qt * 32; const float* lb = p.sgu_ln_b + g * 128 + qt * 32;
#pragma unroll
            for (int i = 0; i < 4; ++i) { const f32x4 g0 = *(const GAS f32x4*)(lg + 8 * i), g1 = *(const GAS f32x4*)(lg + 8 * i + 4), b0 = *(const GAS f32x4*)(lb + 8 * i), b1 = *(const GAS f32x4*)(lb + 8 * i + 4);
                v4u o; o.x = pk2(x[8 * i] * rstd * g0.x + b0.x, x[8 * i + 1] * rstd * g0.y + b0.y); o.y = pk2(x[8 * i + 2] * rstd * g0.z + b0.z, x[8 * i + 3] * rstd * g0.w + b0.w);
                o.z = pk2(x[8 * i + 4] * rstd * g1.x + b1.x, x[8 * i + 5] * rstd * g1.y + b1.y); o.w = pk2(x[8 * i + 6] * rstd * g1.z + b1.z, x[8 * i + 7] * rstd * g1.w + b1.w);
                *(LAS v4u*)(lds + off_b((unsigned)s, (unsigned)(qt * 4 + i))) = o; }
        }
        __syncthreads();
        {
            const int w = wave_s, t = 16 * w + l15, nks = (w >> 1) + 1;
            bf16* rowp = PROJ + (row0 + t) * NPROJ;
            unsigned long long uu8[8];
#pragma unroll
            for (int dt = 0; dt < 8; ++dt) uu8[dt] = *(const GAS unsigned long long*)(rowp + PC_U + g * 128 + 16 * dt + 4 * g4);
            const float bias = p.b_spatial[g * 128 + t];
            f32x4 acc[8];
#pragma unroll
            for (int dt = 0; dt < 8; ++dt) acc[dt] = (f32x4){0.f, 0.f, 0.f, 0.f};
            for (int ks = 0; ks < nks; ++ks) {
                const int sb = 32 * ks + 8 * g4;
                const float* wp = p.w_spatial + ((size_t)(g * 128 + t)) * 128 + sb;
                const f32x4 w0 = *(const GAS f32x4*)wp, w1 = *(const GAS f32x4*)(wp + 4);
                float wv[8] = {w0.x, w0.y, w0.z, w0.w, w1.x, w1.y, w1.z, w1.w};
#pragma unroll
                for (int j = 0; j < 8; ++j) if (sb + j > t) wv[j] = 0.f;
                v4u bw; bw.x = pk2(wv[0], wv[1]); bw.y = pk2(wv[2], wv[3]); bw.z = pk2(wv[4], wv[5]); bw.w = pk2(wv[6], wv[7]);
                const bf16x8 bfrag = __builtin_bit_cast(bf16x8, bw);
#pragma unroll
                for (int dt = 0; dt < 8; ++dt) {
                    const s16x4 lo = vtr(lds + off_b((unsigned)(sb + q), (unsigned)(2 * dt + (pp >> 1))) + 8 * (pp & 1));
                    const s16x4 hi = vtr(lds + off_b((unsigned)(sb + 4 + q), (unsigned)(2 * dt + (pp >> 1))) + 8 * (pp & 1));
                    const bf16x8 afrag = (bf16x8){lo[0], lo[1], lo[2], lo[3], hi[0], hi[1], hi[2], hi[3]};
                    acc[dt] = __builtin_amdgcn_mfma_f32_16x16x32_bf16(afrag, bfrag, acc[dt], 0, 0, 0);
                }
            }
#pragma unroll
            for (int dt = 0; dt < 8; ++dt) {
                const int d = g * 128 + 16 * dt + 4 * g4;
                const unsigned long long uu = uu8[dt];
                const float u0 = gelu_tanh(bf2f((unsigned short)uu)), u1 = gelu_tanh(bf2f((unsigned short)(uu >> 16))), u2 = gelu_tanh(bf2f((unsigned short)(uu >> 32))), u3 = gelu_tanh(bf2f((unsigned short)(uu >> 48)));
                const unsigned long long o = (unsigned long long)pk2(u0 * (acc[dt][0] + bias), u1 * (acc[dt][1] + bias)) | ((unsigned long long)pk2(u2 * (acc[dt][2] + bias), u3 * (acc[dt][3] + bias)) << 32);
                *(GAS unsigned long long*)(rowp + 512 + d) = o;
            }
        }
        __syncthreads();
    }
}

constexpr int DNA_PIECES = 57, DNU_PIECES = 2, DN_STEP_BYTES = (DNA_PIECES + DNU_PIECES) * 1024;
constexpr size_t DNA_CHUNK_BYTES = (size_t)DNA_PIECES * 1024, DNU_CHUNK_BYTES = 8 * DNU_PIECES * 1024;
__device__ __forceinline__ void glds16(const void* gsrc, LAS unsigned char* dst) { __builtin_amdgcn_global_load_lds((const unsigned*)gsrc, (LAS unsigned*)dst, 16, 0, 0); }
typedef float f32x2_t __attribute__((ext_vector_type(2))); typedef __bf16 bf16x2_t __attribute__((ext_vector_type(2)));
__device__ __forceinline__ unsigned cvtpk(float lo, float hi) { const f32x2_t v = {lo, hi}; const bf16x2_t b = __builtin_convertvector(v, bf16x2_t); return __builtin_bit_cast(unsigned, b); }

struct DnSet { bf16x8 F[14]; unsigned long long U; float gl; };
__device__ __forceinline__ void dn_set_load(DnSet& X, const unsigned char* a_step, const unsigned char* u_step, int w) {
#pragma unroll
    for (int ks = 0; ks < 4; ++ks) X.F[ks] = *(const GAS bf16x8*)(a_step + (w * 4 + ks) * 1024);
#pragma unroll
    for (int ks = 0; ks < 4; ++ks) X.F[4 + ks] = *(const GAS bf16x8*)(a_step + (16 + w * 4 + ks) * 1024);
#pragma unroll
    for (int ks = 0; ks < 2; ++ks) X.F[8 + ks] = *(const GAS bf16x8*)(a_step + (48 + w * 2 + ks) * 1024);
#pragma unroll
    for (int t = 0; t < 2; ++t)
#pragma unroll
        for (int ks = 0; ks < 2; ++ks) X.F[10 + 2 * t + ks] = *(const GAS bf16x8*)(a_step + (32 + (2 * w + t) * 2 + ks) * 1024);
    X.U = *(const GAS unsigned long long*)(u_step + (w >> 1) * 1024 + (w & 1) * 8);
    X.gl = *(const GAS float*)(a_step + 56 * 1024);
}
__device__ __forceinline__ void dn_scan_phase(LAS unsigned char* lds, const unsigned char* DNA, const unsigned char* DNU, bf16* ODN, int vcu, int wave_s) {
    if (vcu >= 256) return;
#define DN_BAR() do { asm volatile("s_waitcnt lgkmcnt(0)" ::: "memory"); __builtin_amdgcn_s_barrier(); asm volatile("" ::: "memory"); } while (0)
    if (wave_s >= 4) {
        for (int n = 0; n < 64; ++n) { DN_BAR(); DN_BAR(); }
        return;
    }
    const int lane = pg8::lane_id_fresh(), w = wave_s;
    const int bh = vcu >> 3, sl = vcu & 7, l15 = lane & 15, g4 = lane >> 4;
    const unsigned char* a_src = DNA + (size_t)bh * 64 * DNA_CHUNK_BYTES + lane * 16;
    const unsigned char* u_src = DNU + ((size_t)bh * 64 * 8 + sl) * (DNU_PIECES * 1024) + lane * 16;
    LAS unsigned char* XS = lds + lane * 16;
    LAS unsigned char* XV = lds + 4096 + lane * 16;
    bf16* orow = ODN + (size_t)vcu * (64 * 64 * 16) + l15;
    f32x4 S0 = (f32x4){0.f, 0.f, 0.f, 0.f}, S1 = S0;
    DnSet A, B, C;
    dn_set_load(A, a_src, u_src, w);
    dn_set_load(B, a_src + DNA_CHUNK_BYTES, u_src + DNU_CHUNK_BYTES, w);
    dn_set_load(C, a_src + 2 * DNA_CHUNK_BYTES, u_src + 2 * DNU_CHUNK_BYTES, w);
#define DN_STEP(X, nn) do { const int n_ = (nn); if (n_ < 64) { \
        { v4u sw; sw.x = cvtpk(S0[0], S0[1]); sw.y = cvtpk(S0[2], S0[3]); sw.z = cvtpk(S1[0], S1[1]); sw.w = cvtpk(S1[2], S1[3]); *(LAS v4u*)(XS + w * 1024) = sw; } \
        DN_BAR(); \
        bf16x8 Sb[4]; _Pragma("unroll") for (int ks = 0; ks < 4; ++ks) Sb[ks] = *(const LAS bf16x8*)(XS + ks * 1024); \
        f32x4 P = (f32x4){__builtin_bit_cast(float, (unsigned)X.U << 16), __builtin_bit_cast(float, (unsigned)X.U & 0xffff0000u), __builtin_bit_cast(float, (unsigned)(X.U >> 32) << 16), __builtin_bit_cast(float, (unsigned)(X.U >> 32) & 0xffff0000u)}; \
        _Pragma("unroll") for (int ks = 0; ks < 4; ++ks) P = __builtin_amdgcn_mfma_f32_16x16x32_bf16(X.F[ks], Sb[ks], P, 0, 0, 0); \
        f32x4 O = (f32x4){0.f, 0.f, 0.f, 0.f}; \
        _Pragma("unroll") for (int ks = 0; ks < 4; ++ks) O = __builtin_amdgcn_mfma_f32_16x16x32_bf16(X.F[4 + ks], Sb[ks], O, 0, 0, 0); \
        { const unsigned long long hv = (unsigned long long)cvtpk(P[0], P[1]) | ((unsigned long long)cvtpk(P[2], P[3]) << 32); *(LAS unsigned long long*)(XV + (w >> 1) * 1024 + (w & 1) * 8) = hv; } \
        DN_BAR(); \
        bf16x8 Vb[2]; _Pragma("unroll") for (int ks = 0; ks < 2; ++ks) Vb[ks] = *(const LAS bf16x8*)(XV + ks * 1024); \
        _Pragma("unroll") for (int ks = 0; ks < 2; ++ks) O = __builtin_amdgcn_mfma_f32_16x16x32_bf16(X.F[8 + ks], Vb[ks], O, 0, 0, 0); \
        S0 = S0 * X.gl; S1 = S1 * X.gl; \
        _Pragma("unroll") for (int ks = 0; ks < 2; ++ks) { S0 = __builtin_amdgcn_mfma_f32_16x16x32_bf16(X.F[10 + ks], Vb[ks], S0, 0, 0, 0); S1 = __builtin_amdgcn_mfma_f32_16x16x32_bf16(X.F[12 + ks], Vb[ks], S1, 0, 0, 0); } \
        { bf16* ob = orow + (size_t)(n_ * 64 + 16 * w + 4 * g4) * 16; _Pragma("unroll") for (int r = 0; r < 4; ++r) ob[r * 16] = (bf16)f2bf(O[r]); } \
        if (n_ + 3 < 64) dn_set_load(X, a_src + (size_t)(n_ + 3) * DNA_CHUNK_BYTES, u_src + (size_t)(n_ + 3) * DNU_CHUNK_BYTES, w); } } while (0)
    for (int n = 0; n < 64; n += 3) { DN_STEP(A, n); DN_STEP(B, n + 1); DN_STEP(C, n + 2); }
#undef DN_STEP
#undef DN_BAR
    asm volatile("s_waitcnt vmcnt(0)" ::: "memory");
}

__device__ __forceinline__ void dn_final_phase(const bf16* ODN, bf16* PROJ, const float* norm_w, int gw, int NGW, int lane) {
    const f32x4 nw0 = *(const GAS f32x4*)(norm_w + ((8 * lane) & 127)), nw1 = *(const GAS f32x4*)(norm_w + ((8 * lane) & 127) + 4);
#define DNF_LOAD(mm, OV, ZV) do { const int bb_ = (mm) >> 12, nn_ = ((mm) >> 6) & 63, ii_ = (mm) & 63; \
        OV = *(const GAS v4u*)(ODN + ((((size_t)((bb_ * 4 + (lane >> 4)) * 8 + ((lane >> 1) & 7)) * 64 + nn_) * 64 + ii_) * 16 + 8 * (lane & 1))); ZV = *(const GAS v4u*)(PROJ + (size_t)(mm) * NPROJ + PC_Z + 8 * lane); } while (0)
    v4u ovn, zvn; DNF_LOAD(gw < NTOK ? gw : 0, ovn, zvn);
    for (int m = gw; m < NTOK; m += NGW) {
        const v4u ov = ovn, zv = zvn;
        { const int mn = (m + NGW < NTOK) ? m + NGW : m; DNF_LOAD(mn, ovn, zvn); }
        float o[8], z[8];
#pragma unroll
        for (int c = 0; c < 4; ++c) { o[2 * c] = __builtin_bit_cast(float, ov[c] << 16); o[2 * c + 1] = __builtin_bit_cast(float, ov[c] & 0xffff0000u); z[2 * c] = __builtin_bit_cast(float, zv[c] << 16); z[2 * c + 1] = __builtin_bit_cast(float, zv[c] & 0xffff0000u); }
        float ss = 0.f;
#pragma unroll
        for (int c = 0; c < 8; ++c) ss += o[c] * o[c];
        ss += __shfl_xor(ss, 1); ss += __shfl_xor(ss, 2); ss += __shfl_xor(ss, 4); ss += __shfl_xor(ss, 8);
        const float rs = 1.f / sqrtf(ss * (1.f / 128.f) + 1e-6f);
        const float nw[8] = {nw0.x, nw0.y, nw0.z, nw0.w, nw1.x, nw1.y, nw1.z, nw1.w};
        float y[8];
#pragma unroll
        for (int c = 0; c < 8; ++c) y[c] = o[c] * rs * nw[c] * z[c] * __builtin_amdgcn_rcpf(1.f + __builtin_amdgcn_exp2f(-1.4426950408889634f * z[c]));
        v4u w; w.x = pk2(y[0], y[1]); w.y = pk2(y[2], y[3]); w.z = pk2(y[4], y[5]); w.w = pk2(y[6], y[7]);
        *(GAS v4u*)(PROJ + (size_t)m * NPROJ + 8 * lane) = w;
    }
}

__device__ __forceinline__ float wave_sum_dpp(float v) {
    v = v + __builtin_bit_cast(float, __builtin_amdgcn_update_dpp(0, __builtin_bit_cast(int, v), 0xB1, 0xf, 0xf, true));
    v = v + __builtin_bit_cast(float, __builtin_amdgcn_update_dpp(0, __builtin_bit_cast(int, v), 0x4E, 0xf, 0xf, true));
    v = v + __builtin_bit_cast(float, __builtin_amdgcn_update_dpp(0, __builtin_bit_cast(int, v), 0x141, 0xf, 0xf, true));
    v = v + __builtin_bit_cast(float, __builtin_amdgcn_update_dpp(0, __builtin_bit_cast(int, v), 0x140, 0xf, 0xf, true));
    v = v + __builtin_bit_cast(float, __builtin_amdgcn_update_dpp(0, __builtin_bit_cast(int, v), 0x142, 0xa, 0xf, true));
    v = v + __builtin_bit_cast(float, __builtin_amdgcn_update_dpp(0, __builtin_bit_cast(int, v), 0x143, 0xc, 0xf, true));
    return __builtin_bit_cast(float, __builtin_amdgcn_readlane(__builtin_bit_cast(int, v), 63));
}

constexpr int XTAB_OFF = RING_BYTES + 2048, XTAB_BYTES = 1792;
__device__ __forceinline__ unsigned off_t64(unsigned row, unsigned ch) { return 128u * row + 16u * (ch ^ (row & 7u)); }
__device__ __forceinline__ bf16x8 pack8(const float (&v)[8]) { v4u w; w.x = cvtpk(v[0], v[1]); w.y = cvtpk(v[2], v[3]); w.z = cvtpk(v[4], v[5]); w.w = cvtpk(v[6], v[7]); return __builtin_bit_cast(bf16x8, w); }
__device__ __forceinline__ void unpack8(const v4u w, float (&v)[8]) {
#pragma unroll
    for (int c = 0; c < 4; ++c) { v[2 * c] = __builtin_bit_cast(float, w[c] << 16); v[2 * c + 1] = __builtin_bit_cast(float, w[c] & 0xffff0000u); }
}
__device__ __forceinline__ float conv_silu_rows(const bf16* src0, bool seq_start, const float* cw, LAS unsigned char* img, int lane) {
    float w[4][2];
#pragma unroll
    for (int j = 0; j < 4; ++j) { const f32x2_t t = *(const GAS f32x2_t*)(cw + j * 1536 + 2 * lane); w[j][0] = t[0]; w[j][1] = t[1]; }
    const GAS unsigned* gsrc = (const GAS unsigned*)(src0 + 2 * lane);
    unsigned raw[67];
#pragma unroll
    for (int r = 0; r < 3; ++r) raw[r] = seq_start ? 0u : gsrc[(long)(r - 3) * (NPROJ / 2)];
#pragma unroll
    for (int r = 0; r < 64; ++r) raw[3 + r] = gsrc[(size_t)r * (NPROJ / 2)];
    float myss = 0.f;
    const unsigned lbase = (unsigned)((lane & 3) * 4);
#pragma unroll
    for (int pz = 0; pz < 64; ++pz) {
        float y0 = 0.f, y1 = 0.f;
#pragma unroll
        for (int j = 0; j < 4; ++j) { const unsigned u = raw[pz + j]; y0 += w[j][0] * __builtin_bit_cast(float, u << 16); y1 += w[j][1] * __builtin_bit_cast(float, u & 0xffff0000u); }
        y0 = y0 * __builtin_amdgcn_rcpf(1.f + __builtin_amdgcn_exp2f(-1.4426950408889634f * y0));
        y1 = y1 * __builtin_amdgcn_rcpf(1.f + __builtin_amdgcn_exp2f(-1.4426950408889634f * y1));
        const float tot = wave_sum_dpp(y0 * y0 + y1 * y1);
        myss = (lane == pz) ? tot : myss;
        *(LAS unsigned*)(img + off_b((unsigned)pz, (unsigned)(lane >> 2)) + lbase) = cvtpk(y0, y1);
    }
    return myss;
}

template <int STOP>
__device__ __forceinline__ void dn_prep_chunk(LAS unsigned char* IMG  , LAS float* tab, const bf16* PROJ, const nv::P& p, unsigned char* DNA, unsigned char* DNU, int ci) {
    int lane = pg8::lane_id_fresh();
    const int bh = ci >> 6, n = ci & 63, b = bh >> 2, h = bh & 3;
    int l15 = lane & 15, g4 = lane >> 4, q = l15 >> 2, pp = lane & 3;
    LAS float* t_gc = tab; LAS float* t_be = tab + 64; LAS float* t_rk = tab + 128; LAS float* t_rq = tab + 192; LAS float* t_eq = tab + 256; LAS float* t_ekk = tab + 320; LAS float* t_bg = tab + 384;
    const size_t tok = (size_t)b * 4096 + n * 64 + lane;
    const bf16* prow = PROJ + tok * NPROJ;
    const bf16* prow0 = PROJ + ((size_t)b * 4096 + n * 64) * NPROJ;
    unsigned char* dna = DNA + (size_t)ci * DNA_CHUNK_BYTES + lane * 16;
    (void)q; (void)pp;
    float gc, beta, eg, gc63;
    {
        const float araw = bf2f(prow[PC_A + h]), braw = bf2f(prow[PC_B + h]);
        const float xx = araw + p.dt_bias[h];
        const float sp = xx > 20.f ? xx : log1pf(expf(xx));
        gc = -expf(p.a_log[h]) * sp;
        beta = 1.f / (1.f + expf(-braw));
#pragma unroll
        for (int o = 1; o < 64; o <<= 1) { const float t = __shfl_up(gc, o); if (lane >= o) gc += t; }
        gc63 = __shfl(gc, 63);
        eg = expf(gc);
        const unsigned gb = __builtin_bit_cast(unsigned, expf(gc63));
        *(GAS v4u*)(dna + 56 * 1024) = (v4u){gb, gb, gb, gb};
        const float ssq = conv_silu_rows(prow0 + PC_Q + h * 128, n == 0, p.conv_w + h * 128, IMG, lane);
        const float rq = 0.08838834764831845f / sqrtf(ssq + 1e-6f);
        t_gc[lane] = gc; t_be[lane] = beta; t_rq[lane] = rq; t_eq[lane] = eg * rq;
    }
    LDS_WAIT(); asm volatile("" ::: "memory");
    if constexpr (STOP == 1) return;
    bf16x8 qF[4][4];
#pragma unroll
    for (int mt = 0; mt < 4; ++mt)
#pragma unroll
        for (int ks = 0; ks < 4; ++ks) qF[mt][ks] = *(const LAS bf16x8*)(IMG + off_b((unsigned)(16 * mt + l15), (unsigned)(4 * ks + g4)));
#pragma unroll
    for (int mt = 0; mt < 4; ++mt) {
        const float egi = t_eq[16 * mt + l15];
#pragma unroll
        for (int ks = 0; ks < 4; ++ks) {
            const unsigned long long lo = *(const LAS unsigned long long*)(IMG + off_b((unsigned)(16 * mt + l15), (unsigned)(4 * ks + (g4 >> 1))) + (g4 & 1) * 8);
            const unsigned long long hi = *(const LAS unsigned long long*)(IMG + off_b((unsigned)(16 * mt + l15), (unsigned)(4 * ks + 2 + (g4 >> 1))) + (g4 & 1) * 8);
            float t8[8]; unpack8((v4u){(unsigned)lo, (unsigned)(lo >> 32), (unsigned)hi, (unsigned)(hi >> 32)}, t8);
#pragma unroll
            for (int e = 0; e < 8; ++e) t8[e] *= egi;
            *(GAS bf16x8*)(dna + (16 + mt * 4 + ks) * 1024) = pack8(t8);
        }
    }
    LDS_WAIT(); asm volatile("" ::: "memory");
    {
        const float ssk = conv_silu_rows(prow0 + PC_K + h * 128, n == 0, p.conv_w + 512 + h * 128, IMG, lane);
        const float rk = 1.f / sqrtf(ssk + 1e-6f);
        t_rk[lane] = rk; t_ekk[lane] = expf(gc63 - gc) * rk; t_bg[lane] = beta * eg * rk;
    }
    LDS_WAIT(); asm volatile("" ::: "memory");
    if constexpr (STOP == 2) return;
    f32x4 Am[4][4];
    {
        bf16x8 kF[4][4];
#pragma unroll
        for (int mt = 0; mt < 4; ++mt)
#pragma unroll
            for (int ks = 0; ks < 4; ++ks) kF[mt][ks] = *(const LAS bf16x8*)(IMG + off_b((unsigned)(16 * mt + l15), (unsigned)(4 * ks + g4)));
#pragma unroll
        for (int mi = 0; mi < 4; ++mi) {
            const f32x4 gci = *(const LAS f32x4*)(t_gc + 16 * mi + 4 * g4), bei = *(const LAS f32x4*)(t_be + 16 * mi + 4 * g4), rki = *(const LAS f32x4*)(t_rk + 16 * mi + 4 * g4);
#pragma unroll
            for (int nj = 0; nj <= mi; ++nj) {
                f32x4 acc = (f32x4){0.f, 0.f, 0.f, 0.f};
#pragma unroll
                for (int ks = 0; ks < 4; ++ks) acc = __builtin_amdgcn_mfma_f32_16x16x32_bf16(kF[mi][ks], kF[nj][ks], acc, 0, 0, 0);
                const float gcj = t_gc[16 * nj + l15], rkj = t_rk[16 * nj + l15]; const int j = 16 * nj + l15;
#pragma unroll
                for (int r = 0; r < 4; ++r) { const int i = 16 * mi + 4 * g4 + r; acc[r] = (j < i) ? bei[r] * rki[r] * rkj * acc[r] * expf(gci[r] - gcj) : 0.f; }
                Am[mi][nj] = acc;
            }
        }
#pragma unroll
        for (int it = 0; it < 4; ++it) {
            const float gci = t_gc[16 * it + l15], rqi = t_rq[16 * it + l15]; const int i = 16 * it + l15;
            f32x4 kq[4];
#pragma unroll
            for (int jt = 0; jt < 4; ++jt) {
                f32x4 acc = (f32x4){0.f, 0.f, 0.f, 0.f};
                if (jt <= it) {
#pragma unroll
                    for (int ks = 0; ks < 4; ++ks) acc = __builtin_amdgcn_mfma_f32_16x16x32_bf16(kF[jt][ks], qF[it][ks], acc, 0, 0, 0);
                    const f32x4 gcj = *(const LAS f32x4*)(t_gc + 16 * jt + 4 * g4), rkj = *(const LAS f32x4*)(t_rk + 16 * jt + 4 * g4);
#pragma unroll
                    for (int r = 0; r < 4; ++r) { const int j = 16 * jt + 4 * g4 + r; acc[r] = (j <= i) ? acc[r] * rqi * rkj[r] * expf(gci - gcj[r]) : 0.f; }
                }
                kq[jt] = acc;
            }
#pragma unroll
            for (int ks = 0; ks < 2; ++ks) { const float t8[8] = {kq[2 * ks][0], kq[2 * ks][1], kq[2 * ks][2], kq[2 * ks][3], kq[2 * ks + 1][0], kq[2 * ks + 1][1], kq[2 * ks + 1][2], kq[2 * ks + 1][3]};
                *(GAS bf16x8*)(dna + (48 + it * 2 + ks) * 1024) = pack8(t8); }
        }
    }
    if constexpr (STOP == 3) return;
    bf16x8 ktr[8][2];
    {
#pragma unroll
        for (int ks = 0; ks < 2; ++ks) {
            const f32x4 ek0 = *(const LAS f32x4*)(t_ekk + 32 * ks + 4 * g4), ek1 = *(const LAS f32x4*)(t_ekk + 32 * ks + 16 + 4 * g4);
#pragma unroll
            for (int mt = 0; mt < 8; ++mt) {
                const s16x4 lo = vtr(IMG + off_b((unsigned)(32 * ks + 4 * g4 + q), (unsigned)(2 * mt + (pp >> 1))) + 8 * (pp & 1));
                const s16x4 hi = vtr(IMG + off_b((unsigned)(32 * ks + 16 + 4 * g4 + q), (unsigned)(2 * mt + (pp >> 1))) + 8 * (pp & 1));
                const float t8[8] = {bf2f((unsigned short)lo[0]) * ek0.x, bf2f((unsigned short)lo[1]) * ek0.y, bf2f((unsigned short)lo[2]) * ek0.z, bf2f((unsigned short)lo[3]) * ek0.w,
                                     bf2f((unsigned short)hi[0]) * ek1.x, bf2f((unsigned short)hi[1]) * ek1.y, bf2f((unsigned short)hi[2]) * ek1.z, bf2f((unsigned short)hi[3]) * ek1.w};
                *(GAS bf16x8*)(dna + (32 + mt * 2 + ks) * 1024) = pack8(t8);
            }
        }
#pragma unroll
        for (int dt = 0; dt < 8; ++dt)
#pragma unroll
            for (int ks = 0; ks < 2; ++ks) {
                const s16x4 lo = vtr(IMG + off_b((unsigned)(32 * ks + 8 * g4 + q), (unsigned)(2 * dt + (pp >> 1))) + 8 * (pp & 1));
                const s16x4 hi = vtr(IMG + off_b((unsigned)(32 * ks + 8 * g4 + 4 + q), (unsigned)(2 * dt + (pp >> 1))) + 8 * (pp & 1));
                ktr[dt][ks] = (bf16x8){lo[0], lo[1], lo[2], lo[3], hi[0], hi[1], hi[2], hi[3]};
            }
    }
    LDS_WAIT(); asm volatile("" ::: "memory");
    {
        LAS float* AL = (LAS float*)IMG;
#pragma unroll
        for (int mi = 0; mi < 4; ++mi)
#pragma unroll
            for (int nj = 0; nj <= mi; ++nj)
#pragma unroll
                for (int r = 0; r < 4; ++r) AL[(16 * mi + 4 * g4 + r) * 64 + 16 * nj + l15] = Am[mi][nj][r];
    }
    LDS_WAIT(); asm volatile("" ::: "memory");
    float T[64];
    {
        const LAS float* AL = (const LAS float*)IMG;
#pragma clang loop unroll(full)
        for (int i = 0; i < 64; ++i) {
            float v4[4] = {(lane == i) ? 1.f : 0.f, 0.f, 0.f, 0.f};
#pragma clang loop unroll(full)
            for (int j4 = 0; j4 < (i + 3) / 4; ++j4) {
                const f32x4 a = *(const LAS f32x4*)(AL + i * 64 + 4 * j4);
#pragma clang loop unroll(full)
                for (int e = 0; e < 4; ++e) if (4 * j4 + e < i) v4[e] -= a[e] * T[4 * j4 + e];
            }
            T[i] = (v4[0] + v4[1]) + (v4[2] + v4[3]);
        }
    }
    LDS_WAIT(); asm volatile("" ::: "memory");
    if constexpr (STOP == 4) return;
    lane = pg8::lane_id_fresh(); l15 = lane & 15; g4 = lane >> 4; q = l15 >> 2; pp = lane & 3;
    dna = DNA + (size_t)ci * DNA_CHUNK_BYTES + lane * 16;
    {
        const float bc = t_be[lane], bgc = t_bg[lane];
        LAS unsigned char* TB = IMG; LAS unsigned char* TBE = IMG + 8192;
#pragma unroll
        for (int i = 0; i < 64; ++i) { const unsigned o = off_t64((unsigned)i, (unsigned)(lane >> 3)) + (lane & 7) * 2;
            *(LAS unsigned short*)(TB + o) = (unsigned short)f2bf(T[i] * bc); *(LAS unsigned short*)(TBE + o) = (unsigned short)f2bf(T[i] * bgc); }
    }
    LDS_WAIT(); asm volatile("" ::: "memory");
    bf16x8 tb[4][2];
    {
#pragma unroll
        for (int it = 0; it < 4; ++it) {
            bf16x8 tbe[2];
#pragma unroll
            for (int ks = 0; ks < 2; ++ks) tbe[ks] = *(const LAS bf16x8*)(IMG + 8192 + off_t64((unsigned)(16 * it + l15), (unsigned)(4 * ks + g4)));
            f32x4 acc[8];
#pragma unroll
            for (int dt = 0; dt < 8; ++dt) { acc[dt] = (f32x4){0.f, 0.f, 0.f, 0.f};
#pragma unroll
                for (int ks = 0; ks < 2; ++ks) acc[dt] = __builtin_amdgcn_mfma_f32_16x16x32_bf16(ktr[dt][ks], tbe[ks], acc[dt], 0, 0, 0); }
#pragma unroll
            for (int ks = 0; ks < 4; ++ks) { const float t8[8] = {-acc[2 * ks][0], -acc[2 * ks][1], -acc[2 * ks][2], -acc[2 * ks][3], -acc[2 * ks + 1][0], -acc[2 * ks + 1][1], -acc[2 * ks + 1][2], -acc[2 * ks + 1][3]};
                *(GAS bf16x8*)(dna + (it * 4 + ks) * 1024) = pack8(t8); }
        }
#pragma unroll
        for (int mt = 0; mt < 4; ++mt)
#pragma unroll
            for (int ks = 0; ks < 2; ++ks) tb[mt][ks] = *(const LAS bf16x8*)(IMG + off_t64((unsigned)(16 * mt + l15), (unsigned)(4 * ks + g4)));
    }
    LDS_WAIT(); asm volatile("" ::: "memory");
    if constexpr (STOP == 5) return;
    (void)conv_silu_rows(prow0 + PC_V + h * 128, n == 0, p.conv_w + 1024 + h * 128, IMG, lane);
    LDS_WAIT(); asm volatile("" ::: "memory");
    {
        unsigned char* dnu = DNU + (size_t)ci * DNU_CHUNK_BYTES + lane * 16;
#pragma unroll
        for (int dt = 0; dt < 8; ++dt) {
            bf16x8 vt[2];
#pragma unroll
            for (int ks = 0; ks < 2; ++ks) {
                const s16x4 lo = vtr(IMG + off_b((unsigned)(32 * ks + 8 * g4 + q), (unsigned)(2 * dt + (pp >> 1))) + 8 * (pp & 1));
                const s16x4 hi = vtr(IMG + off_b((unsigned)(32 * ks + 8 * g4 + 4 + q), (unsigned)(2 * dt + (pp >> 1))) + 8 * (pp & 1));
                vt[ks] = (bf16x8){lo[0], lo[1], lo[2], lo[3], hi[0], hi[1], hi[2], hi[3]};
            }
            f32x4 u[4];
#pragma unroll
            for (int mt = 0; mt < 4; ++mt) { u[mt] = (f32x4){0.f, 0.f, 0.f, 0.f};
#pragma unroll
                for (int ks = 0; ks < 2; ++ks) u[mt] = __builtin_amdgcn_mfma_f32_16x16x32_bf16(tb[mt][ks], vt[ks], u[mt], 0, 0, 0); }
#pragma unroll
            for (int pc = 0; pc < 2; ++pc) { const float t8[8] = {u[2 * pc][0], u[2 * pc][1], u[2 * pc][2], u[2 * pc][3], u[2 * pc + 1][0], u[2 * pc + 1][1], u[2 * pc + 1][2], u[2 * pc + 1][3]};
                *(GAS bf16x8*)(dnu + (dt * 2 + pc) * 1024) = pack8(t8); }
        }
    }
    LDS_WAIT(); asm volatile("" ::: "memory");
}

template <int STOP>
__device__ __forceinline__ void dn_prep_phase(LAS unsigned char* lds, const bf16* PROJ, const nv::P& p, unsigned char* DNA, unsigned char* DNU, int G, int vcu, int wave_s) {
    LAS unsigned char* img = lds + wave_s * 16384; LAS float* tab = (LAS float*)(lds + XTAB_OFF + wave_s * XTAB_BYTES);
    for (int ci = vcu * 8 + wave_s; ci < 2048; ci += G * 8) dn_prep_chunk<STOP>(img, tab, PROJ, p, DNA, DNU, ci);
}


struct RouterArgs { const float* z; const bf16* mix; float* zout; bf16* H1BF; int* EID; float* WGT; int* LIST; int* CNT; const float *ln_g, *ln_b, *w_rg, *b_rg, *w_re, *b_re; };
__device__ __forceinline__ void router_fill(LAS float* dst, const float* W, int ldw, int col0, int tid) {
#pragma unroll
    for (int it = 0; it < 4; ++it) { const int qd = tid + it * NTHREADS, k = qd >> 1, half = qd & 1;
        const f32x4 v = *(const GAS f32x4*)(W + (size_t)k * ldw + col0 + half * 4);
        *(LAS f32x4*)(dst + ((((k >> 8) * 4 + (k & 3)) * 64 + ((k >> 2) & 63)) * 8 + half * 4)) = v; }
}
__device__ __forceinline__ void router_phase(LAS unsigned char* lds, const RouterArgs& A, int gw, int NGW, int wave_s) {
    const int lane = pg8::lane_id_fresh(), tid = wave_s * 64 + lane;
    LAS float* WG = (LAS float*)lds; LAS int* HIST = (LAS int*)(lds + 32768); LAS int* BASE = HIST + 64; LAS int* RR = HIST + 128;
    router_fill(WG, A.w_rg, 8, 0, tid);
    if (tid < 64) HIST[tid] = 0;
    __syncthreads();
    int it_ = 0;
    f32x4 vn[4]; unsigned long long mn_[4];
    { const GAS f32x4* zr = (const GAS f32x4*)(A.z + (size_t)gw * DM) + lane; const GAS unsigned long long* mr = (const GAS unsigned long long*)(A.mix + (size_t)gw * DM) + lane;
#pragma unroll
      for (int j = 0; j < 4; ++j) { vn[j] = zr[64 * j]; mn_[j] = mr[64 * j]; } }
    for (int m = gw; m < NTOK; m += NGW) {
        f32x4 v[4];
#pragma unroll
        for (int j = 0; j < 4; ++j) { const unsigned long long mm = mn_[j];
            v[j].x = ALPHA_F * vn[j].x + bf2f((unsigned short)mm); v[j].y = ALPHA_F * vn[j].y + bf2f((unsigned short)(mm >> 16));
            v[j].z = ALPHA_F * vn[j].z + bf2f((unsigned short)(mm >> 32)); v[j].w = ALPHA_F * vn[j].w + bf2f((unsigned short)(mm >> 48)); }
        { const int mn = (m + NGW < NTOK) ? m + NGW : m; const GAS f32x4* zn = (const GAS f32x4*)(A.z + (size_t)mn * DM) + lane; const GAS unsigned long long* mr = (const GAS unsigned long long*)(A.mix + (size_t)mn * DM) + lane;
#pragma unroll
          for (int j = 0; j < 4; ++j) { vn[j] = zn[64 * j]; mn_[j] = mr[64 * j]; } }
        float s = 0.f;
#pragma unroll
        for (int j = 0; j < 4; ++j) s += (v[j].x + v[j].y) + (v[j].z + v[j].w);
        const float mean = wave_sum_dpp(s) * (1.f / DM); float s2 = 0.f;
#pragma unroll
        for (int j = 0; j < 4; ++j) { v[j] = v[j] - mean; s2 += (v[j].x * v[j].x + v[j].y * v[j].y) + (v[j].z * v[j].z + v[j].w * v[j].w); }
        const float rstd = 1.f / sqrtf(wave_sum_dpp(s2) * (1.f / DM) + 1e-5f);
        GAS unsigned long long* hb = (GAS unsigned long long*)(A.H1BF + (size_t)m * DM) + lane;
#pragma unroll
        for (int j = 0; j < 4; ++j) { const f32x4 g = *((const GAS f32x4*)A.ln_g + lane + 64 * j), bb = *((const GAS f32x4*)A.ln_b + lane + 64 * j); v[j] = v[j] * rstd * g + bb;
            hb[64 * j] = (unsigned long long)pk2(v[j].x, v[j].y) | ((unsigned long long)pk2(v[j].z, v[j].w) << 32); }
        float gl[8];
#pragma unroll
        for (int c = 0; c < 8; ++c) gl[c] = 0.f;
#pragma unroll
        for (int j = 0; j < 4; ++j)
#pragma unroll
            for (int c4 = 0; c4 < 4; ++c4) { const float hv = v[j][c4]; const LAS float* wp = WG + ((j * 4 + c4) * 64 + lane) * 8;
                const f32x4 w0 = *(const LAS f32x4*)wp, w1 = *(const LAS f32x4*)(wp + 4);
                gl[0] += hv * w0.x; gl[1] += hv * w0.y; gl[2] += hv * w0.z; gl[3] += hv * w0.w; gl[4] += hv * w1.x; gl[5] += hv * w1.y; gl[6] += hv * w1.z; gl[7] += hv * w1.w; }
        int gi = 0; float gm = -INFINITY;
#pragma unroll
        for (int c = 0; c < 8; ++c) { gl[c] = wave_sum_dpp(gl[c]) + A.b_rg[c]; if (gl[c] > gm) { gm = gl[c]; gi = c; } }
        float den = 0.f;
#pragma unroll
        for (int c = 0; c < 8; ++c) den += expf(gl[c] - gm);
        const float pg = 1.f / den;
        float el[8];
#pragma unroll
        for (int c = 0; c < 8; ++c) el[c] = 0.f;
        const float* wre = A.w_re + gi * 8192 + lane * 8;
#pragma unroll
        for (int j = 0; j < 4; ++j)
#pragma unroll
            for (int c4 = 0; c4 < 4; ++c4) { const float hv = v[j][c4];
                const f32x4 w0 = *(const GAS f32x4*)(wre + (j * 4 + c4) * 512), w1 = *(const GAS f32x4*)(wre + (j * 4 + c4) * 512 + 4);
                el[0] += hv * w0.x; el[1] += hv * w0.y; el[2] += hv * w0.z; el[3] += hv * w0.w; el[4] += hv * w1.x; el[5] += hv * w1.y; el[6] += hv * w1.z; el[7] += hv * w1.w; }
        int i0 = 0, i1 = 0; float v0 = -INFINITY, v1 = -INFINITY;
#pragma unroll
        for (int c = 0; c < 8; ++c) { el[c] = wave_sum_dpp(el[c]) + A.b_re[gi * 8 + c]; if (el[c] > v0) { v0 = el[c]; i0 = c; } }
#pragma unroll
        for (int c = 0; c < 8; ++c) { if (c != i0 && el[c] > v1) { v1 = el[c]; i1 = c; } }
        const float e1 = expf(v1 - v0), sm = 1.f / (1.f + e1);
        if (lane == 0) {
            const int ea = gi * 8 + i0, eb = gi * 8 + i1;
            LAS int* rr = RR + (wave_s * 16 + it_) * 6;
            rr[4] = (int)(f2bf(pg * sm) << 16); rr[5] = (int)(f2bf(pg * e1 * sm) << 16);
            rr[0] = ea; rr[1] = __hip_atomic_fetch_add(&HIST[ea], 1, __ATOMIC_RELAXED, __HIP_MEMORY_SCOPE_WORKGROUP); rr[2] = eb; rr[3] = __hip_atomic_fetch_add(&HIST[eb], 1, __ATOMIC_RELAXED, __HIP_MEMORY_SCOPE_WORKGROUP);
        }
        ++it_;
    }
    __syncthreads();
    if (tid < 64) BASE[tid] = __hip_atomic_fetch_add(&A.CNT[tid], HIST[tid], __ATOMIC_RELAXED, __HIP_MEMORY_SCOPE_AGENT);
    __syncthreads();
    if (lane < it_) {
        const LAS int* rr = RR + (wave_s * 16 + lane) * 6; const int m = gw + lane * NGW;
        A.LIST[(size_t)rr[0] * NTOK + BASE[rr[0]] + rr[1]] = (2 * m) | rr[4];
        A.LIST[(size_t)rr[2] * NTOK + BASE[rr[2]] + rr[3]] = (2 * m + 1) | rr[5];
    }
}

__device__ __forceinline__ void final_phase(float* OUT, const bf16* H1B, const bf16* YEXP, const float* ln_g, const float* ln_b, int gw, int NGW, int lane) {
    unsigned long long hn[4], an[4], bn[4];
#define FIN_LOAD(mm) do { const GAS unsigned long long* hq_ = (const GAS unsigned long long*)(H1B + (size_t)(mm) * DM) + lane; const GAS unsigned long long* y0_ = (const GAS unsigned long long*)(YEXP + (size_t)(2 * (mm)) * DM) + lane; \
        _Pragma("unroll") for (int j_ = 0; j_ < 4; ++j_) { hn[j_] = hq_[64 * j_]; an[j_] = y0_[64 * j_]; bn[j_] = y0_[DM / 4 + 64 * j_]; } } while (0)
    FIN_LOAD(gw < NTOK ? gw : 0);
    for (int m = gw; m < NTOK; m += NGW) {
        GAS f32x4* orow = (GAS f32x4*)(OUT + (size_t)m * DM) + lane;
        unsigned long long hc[4], ac[4], bc[4];
#pragma unroll
        for (int j = 0; j < 4; ++j) { hc[j] = hn[j]; ac[j] = an[j]; bc[j] = bn[j]; }
        { const int mn = (m + NGW < NTOK) ? m + NGW : m; FIN_LOAD(mn); }
        f32x4 v[4]; float s = 0.f;
#pragma unroll
        for (int j = 0; j < 4; ++j) { const unsigned long long hh = hc[j], a0 = ac[j], a1 = bc[j];
            v[j].x = ALPHA_F * bf2f((unsigned short)hh) + bf2f((unsigned short)a0) + bf2f((unsigned short)a1);
            v[j].y = ALPHA_F * bf2f((unsigned short)(hh >> 16)) + bf2f((unsigned short)(a0 >> 16)) + bf2f((unsigned short)(a1 >> 16));
            v[j].z = ALPHA_F * bf2f((unsigned short)(hh >> 32)) + bf2f((unsigned short)(a0 >> 32)) + bf2f((unsigned short)(a1 >> 32));
            v[j].w = ALPHA_F * bf2f((unsigned short)(hh >> 48)) + bf2f((unsigned short)(a0 >> 48)) + bf2f((unsigned short)(a1 >> 48));
            s += (v[j].x + v[j].y) + (v[j].z + v[j].w); }
        const float mean = wave_sum_dpp(s) * (1.f / DM); float s2 = 0.f;
#pragma unroll
        for (int j = 0; j < 4; ++j) { v[j] = v[j] - mean; s2 += (v[j].x * v[j].x + v[j].y * v[j].y) + (v[j].z * v[j].z + v[j].w * v[j].w); }
        const float rstd = 1.f / sqrtf(wave_sum_dpp(s2) * (1.f / DM) + 1e-5f);
#pragma unroll
        for (int j = 0; j < 4; ++j) { const f32x4 g = *((const GAS f32x4*)ln_g + lane + 64 * j), bb = *((const GAS f32x4*)ln_b + lane + 64 * j); orow[64 * j] = v[j] * rstd * g + bb; }
    }
}

#ifndef REPEAT_MASK
#define REPEAT_MASK 0
#endif
#define REPS(k) ((((REPEAT_MASK) >> (k)) & 1) + 1)
__global__ void __launch_bounds__(NTHREADS, 2) fwd_megakernel(MK a) {
    extern __shared__ __attribute__((aligned(16))) unsigned char lds_raw[];
    cg::grid_group grid = cg::this_grid();
    LAS unsigned char* lds = (LAS unsigned char*)lds_raw;
    volatile LAS unsigned* MISC = (volatile LAS unsigned*)(lds + MISC_OFF);
    LAS int* PREF = (LAS int*)(lds + PREF_OFF);
    const int tid = threadIdx.x; const int wave_s = __builtin_amdgcn_readfirstlane(tid >> 6);
    const int G = gridDim.x; const int bx = blockIdx.x; const int vcu = (G % 8 == 0) ? (bx % 8) * (G / 8) + bx / 8 : bx;
    unsigned char* ws = a.ws; const nv::P& p = a.p;
    gu32* ctl = (gu32*)(ws + WS_CTL);
    bf16* WIN = (bf16*)(ws + WS_WIN); bf16* WOUT = (bf16*)(ws + WS_WOUT); bf16* XBF = (bf16*)(ws + WS_A); bf16* PROJ = (bf16*)(ws + WS_B);
    bf16* WGU = (bf16*)(ws + WS_WGU); bf16* WD = (bf16*)(ws + WS_WD); bf16* HID = (bf16*)(ws + WS_A); bf16* H1BF = (bf16*)(ws + WS_H1BF); bf16* YEXP = (bf16*)(ws + WS_YEXP);
    int* LIST = (int*)(ws + WS_LIST); int* EID = (int*)(ws + WS_ROUTE); float* WGT = (float*)(ws + WS_ROUTE + 512 * 1024);
    int* CNT = (int*)(ws + WS_CTL) + CW_CNT;
    for (int u = tid; u < (LDS_BYTES - LDSCTL_OFF) / 4; u += NTHREADS) ((LAS unsigned*)(lds + LDSCTL_OFF))[u] = 0u;
    __syncthreads();
    if (bx == 0) { for (int u = tid; u < XCD_BAR_WORDS + 64; u += NTHREADS) __hip_atomic_store((unsigned*)(ctl + CW_BAR) + u, 0u, RLX_AGENT);
                   for (int u = tid; u < 2048; u += NTHREADS) __hip_atomic_store((unsigned*)(ctl + CW_CNT) + u, 0u, RLX_AGENT); }
    grid.sync();
    XcdBarrier bar = xcd_barrier_post((unsigned*)(ctl + CW_BAR), MISC + 8);
#define FRESH() const int lane = pg8::lane_id_fresh(), wave = wave_s; const int tid_ = wave_s * 64 + lane; const int gtid = (int)blockIdx.x * NTHREADS + tid_, gsize = G * NTHREADS, gw = vcu * NWAVES + wave, NGW = G * NWAVES; (void)lane; (void)gtid; (void)gsize; (void)gw; (void)NGW;

    _Pragma("unroll 1") for (int rep_ = 0; rep_ < REPS(0); ++rep_) {
    {
        FRESH();
        LAS float* scr = (LAS float*)(lds + wave * 16384);
        constexpr int NB = 96, KB = DM / 64;
        for (int it = gw; it < NB * KB; it += NGW) { const int nb = it % NB, kb = it / NB; const int nsrc = nb < 64 ? nb * 32 : 2056 + (nb - 64) * 32, ndst = nb * 32;
            p0_transpose_item(p.w_in, nv::INC, DM, kb * 64, nsrc, WIN, ndst, scr, lane); }
        for (int i = gtid; i < 8 * DM; i += gsize) { const int j = (int)(i / DM), k = (int)(i % DM); WIN[(size_t)(PC_B + j) * DM + k] = (bf16)f2bf(p.w_in[(size_t)k * nv::INC + 2048 + j]); }
        for (int i = gtid; i < (long)(NPROJ - 3080) * DM / 8; i += gsize) *(GAS v4u*)(WIN + (size_t)3080 * DM + i * 8) = (v4u){0u, 0u, 0u, 0u};
        for (int i = gtid; i < (long)NTOK * DM / 8; i += gsize) { const f32x4 v0 = *(const GAS f32x4*)(p.x + i * 8), v1 = *(const GAS f32x4*)(p.x + i * 8 + 4);
            v4u o; o.x = pk2(v0.x, v0.y); o.y = pk2(v0.z, v0.w); o.z = pk2(v1.x, v1.y); o.w = pk2(v1.z, v1.w); *(GAS v4u*)(XBF + i * 8) = o; }
        for (int it = gw; it < 16 * 32; it += NGW) { const int nb = it & 31, kb = it >> 5; p0_transpose_item(p.w_out, DM, DM, kb * 64, nb * 32, WOUT, nb * 32, scr, lane); }
        for (int d = gtid; d < 8 * 8192; d += gsize) { const int g = d >> 13, r = d & 8191, c = r & 7, ll = (r >> 3) & 63, jc = r >> 9, k = 4 * (ll + 64 * (jc >> 2)) + (jc & 3);
            ((float*)(ws + WS_WREP))[d] = p.w_re[(size_t)k * 64 + g * 8 + c]; }
    }
    xcd_barrier(bar);
    }
    _Pragma("unroll 1") for (int rep_ = 0; rep_ < REPS(1); ++rep_) {
    {
        if (bx < GEMM_WGS) {
            pg8::DenseOrder S; S.init(XBF, DM, WIN, NTOK, NPROJ, DM, GEMM_WGS, bx);
            pg8::EpiBf16 E{PROJ, NPROJ};
            pg8::gemm_phase<pg8::EpiBf16, pg8::DenseOrder, true>(lds, S, E, nullptr, wave_s);
        } else {
            const int lane = pg8::lane_id_fresh();
            LAS float* scr = (LAS float*)(lds + wave_s * 16384);
            p0_experts(p.w_gate, p.w_up, p.w_down, WGU, WD, scr, (bx - GEMM_WGS) * NWAVES + wave_s, (G - GEMM_WGS) * NWAVES, lane);
        }
    }
    xcd_barrier(bar);
    }
    unsigned char* DNA = (unsigned char*)p.out; unsigned char* DNU = ws + WS_A + 32 * MiB; bf16* ODN = (bf16*)(ws + WS_A);
    _Pragma("unroll 1") for (int rep_ = 0; rep_ < REPS(2); ++rep_) {
    dn_prep_phase<0>(lds, PROJ, p, DNA, DNU, G, vcu, wave_s);
    xcd_barrier(bar);
    }
    _Pragma("unroll 1") for (int rep_ = 0; rep_ < REPS(3); ++rep_) {
    dn_scan_phase(lds, DNA, DNU, ODN, vcu, wave_s);
    xcd_barrier(bar);
    }
    _Pragma("unroll 1") for (int rep_ = 0; rep_ < REPS(5); ++rep_) {
    sgu_phase(lds, PROJ, p, G, vcu, wave_s);
    { FRESH(); dn_final_phase(ODN, PROJ, p.dn_norm_w, gw, NGW, lane); }
    xcd_barrier(bar);
    }
    _Pragma("unroll 1") for (int rep_ = 0; rep_ < REPS(6); ++rep_) {
    {
        pg8::DenseOrder S; S.init(PROJ, NPROJ, WOUT, NTOK, DM, DM, G, bx);
        pg8::EpiBf16 E{(bf16*)(ws + WS_A), DM};
        pg8::gemm_phase<pg8::EpiBf16, pg8::DenseOrder, true>(lds, S, E, nullptr, wave_s);
    }
    xcd_barrier(bar);
    }
    {
        RouterArgs RA{p.x, (const bf16*)(ws + WS_A), p.out, H1BF, EID, WGT, LIST, CNT, p.ln1_g, p.ln1_b, p.w_rg, p.b_rg, (const float*)(ws + WS_WREP), p.b_re};
        router_phase(lds, RA, vcu * NWAVES + wave_s, G * NWAVES, wave_s);
    }
    xcd_barrier(bar);
    if (threadIdx.x == 0) { int s = 0; for (int e = 0; e < NEXP; ++e) { PREF[e] = s; s += ((CNT[e] + 255) >> 8) * 4; } PREF[NEXP] = s; }
    __syncthreads();
    _Pragma("unroll 1") for (int rep_ = 0; rep_ < REPS(7); ++rep_) {
    {
        pg8::GroupedOrder S{H1BF, WGU, LIST, PREF, DM, DM, 1024, NTOK, 1, 4, G, bx, NEXP};
        pg8::EpiHid E{HID, LIST, CNT, NTOK};
        pg8::gemm_phase<pg8::EpiHid, pg8::GroupedOrder, true>(lds, S, E, CNT, wave_s);
    }
    xcd_barrier(bar);
    }
    _Pragma("unroll 1") for (int rep_ = 0; rep_ < REPS(8); ++rep_) {
    {
        pg8::GroupedOrder S{HID, WD, LIST, PREF, DEXP, DEXP, 1024, NTOK, 0, 4, G, bx, NEXP};
        pg8::EpiYexp E{YEXP, LIST, WGT, NTOK};
        pg8::gemm_phase<pg8::EpiYexp, pg8::GroupedOrder, true>(lds, S, E, CNT, wave_s);
    }
    xcd_barrier(bar);
    }
    { FRESH(); final_phase(p.out, H1BF, YEXP, p.ln2_g, p.ln2_b, gw, NGW, lane); }
#if defined(GHOSTPREP)
    xcd_barrier(bar);
    dn_prep_phase<GHOSTPREP>(lds, (const bf16*)(ws + WS_B), p, ws + WS_C, ws + WS_C + 120 * MiB, G, vcu, wave_s);
#endif
#if defined(GHOST6)
    xcd_barrier(bar);
    { RouterArgs RA{p.out, (const bf16*)(ws + WS_A), (float*)(ws + WS_B), (bf16*)(ws + WS_C), (int*)(ws + WS_A), (float*)(ws + WS_A + 1 * MiB), (int*)(ws + WS_A + 2 * MiB), (int*)(ws + WS_CTL) + CW_CNT + 1024, p.ln1_g, p.ln1_b, p.w_rg, p.b_rg, (const float*)(ws + WS_WREP), p.b_re};
      router_phase(lds, RA, vcu * NWAVES + wave_s, G * NWAVES, wave_s); }
#endif
#if defined(GHOST9)
    xcd_barrier(bar);
    { FRESH(); final_phase((float*)(ws + WS_A), H1BF, (const bf16*)(ws + WS_C), p.ln2_g, p.ln2_b, gw, NGW, lane); }
#endif
}

extern "C" void kernel_launch(void* const* d_in, const int* in_sizes, int n_in, void* d_out, int out_size, void* d_ws, size_t ws_size, hipStream_t stream) {
    if (ws_size < WS_END || n_in != 22) { fprintf(stderr, "kernel_launch: bad ws/n_in\n"); return; }
    static int grid_blocks = 0;
    if (!grid_blocks) {
        int dev = 0, cus = 0, per_cu = 0;
        (void)hipGetDevice(&dev);
        (void)hipDeviceGetAttribute(&cus, hipDeviceAttributeMultiprocessorCount, dev);
        (void)hipFuncSetAttribute((const void*)fwd_megakernel, hipFuncAttributeMaxDynamicSharedMemorySize, (int)LDS_BYTES);
        (void)hipOccupancyMaxActiveBlocksPerMultiprocessor(&per_cu, (const void*)fwd_megakernel, NTHREADS, LDS_BYTES);
        if (per_cu < 1) { fprintf(stderr, "kernel_launch: occupancy query says %d\n", per_cu); per_cu = 1; }
        grid_blocks = cus;
    }
    MK a{}; bind(a.p, d_in, (float*)d_out); a.ws = (unsigned char*)d_ws;
    void* args[] = {&a};
    hipError_t e = hipLaunchCooperativeKernel((const void*)fwd_megakernel, dim3(grid_blocks), dim3(NTHREADS), args, LDS_BYTES, stream);
    if (e != hipSuccess) fprintf(stderr, "cooperative launch failed: %s (grid %d)\n", hipGetErrorString(e), grid_blocks);
}
```

```cpp
#include <hip/hip_runtime.h>
#include <hip/hip_cooperative_groups.h>
#include <cstdio>
#include <cstdint>
namespace cg = cooperative_groups;

namespace nv {
constexpr int INC = 3080;
struct P {
    const float *x, *w_in, *conv_w, *a_log, *dt_bias, *dn_norm_w, *sgu_ln_g, *sgu_ln_b, *w_spatial, *b_spatial, *w_out, *ln1_g, *ln1_b,
        *w_rg, *b_rg, *w_re, *b_re, *w_gate, *w_up, *w_down, *ln2_g, *ln2_b;
    float* out;
};
static inline void bind(P& p, void* const* in, float* out) {
    const float** f = (const float**)&p.x; for (int i = 0; i < 22; ++i) f[i] = (const float*)in[i];
    p.out = out;
}
}
namespace pg8 {
#define PG8_LAS __attribute__((address_space(3)))
typedef unsigned short bf16_t;
typedef short bf16x8 __attribute__((ext_vector_type(8)));
typedef float f32x4 __attribute__((ext_vector_type(4)));
typedef unsigned u32x4 __attribute__((ext_vector_type(4)));
typedef unsigned u32x2 __attribute__((ext_vector_type(2)));
constexpr int BM = 256, BK = 64, HALF = 128, HTB = HALF * BK * 2  , STAGE_BYTES = 8 * HTB, NXCD = 8, WGM = 8;

__host__ __device__ __forceinline__ int lds_byte(int r, int c) { const int st = (r >> 4) * 2 + (c >> 5), rr = r & 15, cc = c & 31, ob = rr * 64 + cc * 2; return st * 1024 + (ob ^ (((ob >> 9) & 1) << 5)); }
__host__ __device__ __forceinline__ void stage_rc(int b, int& R, int& C) { const int st = b / 1024, sb = b % 1024, swz = sb ^ (((sb >> 9) & 1) << 5); R = (st >> 1) * 16 + swz / 64; C = (st & 1) * 32 + (swz % 64) / 2; }
__host__ __device__ __forceinline__ int perm32(int rho) { const int n = rho >> 4, i = rho & 15; return 8 * (i >> 2) + 4 * n + (i & 3); }

struct Unit { int pm, pn, e, rows; };

typedef float f32x2_t __attribute__((ext_vector_type(2))); typedef __bf16 bf16x2_t __attribute__((ext_vector_type(2)));
__device__ __forceinline__ unsigned cvt_pk_bf16(float lo, float hi) { const f32x2_t v = {lo, hi}; const bf16x2_t b = __builtin_convertvector(v, bf16x2_t); return __builtin_bit_cast(unsigned, b); }

__device__ __forceinline__ int lane_id_fresh() { int l; asm volatile("v_mbcnt_lo_u32_b32 %0, -1, 0\n\tv_mbcnt_hi_u32_b32 %0, -1, %0" : "=v"(l)); return l; }
__device__ __forceinline__ int xcd_remap(int L, int nwg) { const int q = nwg / NXCD, r = nwg % NXCD, xcd = L % NXCD, off = L / NXCD; return (xcd < r ? xcd * (q + 1) : r * (q + 1) + (xcd - r) * q) + off; }

struct DenseOrder {
    const bf16_t* A; const bf16_t* Bt; int lda, K; int nM, nN, nwg, G, c;
    static constexpr bool GATHER = false;
    __device__ void init(const bf16_t* A_, int lda_, const bf16_t* Bt_, int M, int N, int K_, int G_, int c_) { A = A_; Bt = Bt_; lda = lda_; K = K_; nM = M / BM; nN = N / BM; nwg = nM * nN; G = G_; c = c_; }
    __device__ bool next(int i, Unit& u) const {
        const long L = (long)i * G + c; if (L >= nwg) return false;
        const int wgid = xcd_remap((int)L, nwg);
        const int nig = WGM * nN, gid = wgid / nig, fm = gid * WGM, gsz = (nM - fm) < WGM ? (nM - fm) : WGM;
        u.pm = fm + ((wgid % nig) % gsz); u.pn = (wgid % nig) / gsz; u.e = 0; u.rows = BM; return true;
    }
    __device__ __forceinline__ const char* a_base(const Unit& u) const { return (const char*)A + (size_t)u.pm * BM * lda * 2; }
    __device__ __forceinline__ const char* b_base(const Unit& u) const { return (const char*)Bt + (size_t)u.pn * BM * K * 2; }
    __device__ __forceinline__ void a_off(const Unit&, const int (&R)[2], const int (&C)[2], unsigned (&v)[4]) const {
#pragma unroll
        for (int h = 0; h < 2; ++h)
#pragma unroll
            for (int i = 0; i < 2; ++i) v[h * 2 + i] = (unsigned)((h * HALF + R[i]) * lda + C[i]) * 2u;
    }
};

struct GroupedOrder {
    const bf16_t* A; const bf16_t* Bt; const int* list; const PG8_LAS int* pref;
    int lda, K, N, cap, ashift, nN, G, c, ne;
    static constexpr bool GATHER = true;
    __device__ bool next(int i, Unit& u) const {
        const int nwg = pref[ne]; const long L = (long)i * G + c; if (L >= nwg) return false;
        const int w = xcd_remap((int)L, nwg);
        int e = 0; while (pref[e + 1] <= w) ++e;
        const int j = w - pref[e], ntm = (pref[e + 1] - pref[e]) / nN;
        u.e = e; u.pm = j % ntm; u.pn = j / ntm; u.rows = 0; return true;
    }
    __device__ __forceinline__ const char* a_base(const Unit&) const { return (const char*)A; }
    __device__ __forceinline__ const char* b_base(const Unit& u) const { return (const char*)Bt + ((size_t)u.e * N + (size_t)u.pn * BM) * K * 2; }
    __device__ __forceinline__ void a_off(const Unit& u, const int (&R)[2], const int (&C)[2], unsigned (&v)[4], int cnt) const {
        const int* lp = list + (size_t)u.e * cap;
#pragma unroll
        for (int h = 0; h < 2; ++h)
#pragma unroll
            for (int i = 0; i < 2; ++i) { int r = u.pm * BM + h * HALF + R[i]; if (r >= cnt) r = 0; const int a = (lp[r] & 0xffff) >> ashift; v[h * 2 + i] = (unsigned)(a * lda + C[i]) * 2u; }
    }
};

template <class Epi, class Sched, bool ALIGN_EPI>
__device__ __forceinline__ void gemm_phase(PG8_LAS unsigned char* lds, const Sched& S, const Epi& E, const int* gcnt, const int wave_s) {
    const int tid_ = wave_s * 64 + lane_id_fresh();
    const int tid = tid_, wid = wave_s, lane = tid & 63, wr = wid >> 2, wc = wid & 3, fr = lane & 15, fq = lane >> 4;
    const int K = S.K, nt = K / BK;
    int Rr[2], Cc[2]; unsigned voffB[2];
#pragma unroll
    for (int i = 0; i < 2; ++i) { int R, C; stage_rc(tid * 16 + i * 8192, R, C); const int Rb = Epi::PERM ? ((R & ~31) + perm32(R & 31)) : R; Rr[i] = R; Cc[i] = C; voffB[i] = (unsigned)(Rb * K + C) * 2u; }
    const size_t kstep = (size_t)(BK * 2);
    const size_t hstep = (size_t)HALF * K * 2;
    const unsigned ldsw = (unsigned)wid * 1024u;
    const int aoff = lds_byte(wr * 64 + fr, fq * 8), boff = lds_byte(wc * 32 + fr, fq * 8);
#define PG8_SA(b, h) (((b) * 2 + (h)) * HTB)
#define PG8_SB(b, h) ((4 + (b) * 2 + (h)) * HTB)
#define PG8_STAGE(bufoff, gbase, v0, v1) do { \
        __builtin_amdgcn_global_load_lds((const unsigned*)((const char*)(gbase) + (v0)), (PG8_LAS unsigned*)(lds + (bufoff) + ldsw), 16, 0, 0); \
        __builtin_amdgcn_global_load_lds((const unsigned*)((const char*)(gbase) + (v1)), (PG8_LAS unsigned*)(lds + (bufoff) + ldsw + 8192), 16, 0, 0); } while (0)
#define PG8_STAGEB(bufoff, gbase) PG8_STAGE(bufoff, gbase, voffB[0], voffB[1])
#define PG8_LDA(dst, b, h) do { _Pragma("unroll") for (int m = 0; m < 4; ++m) _Pragma("unroll") for (int k = 0; k < 2; ++k) dst[m][k] = *(const PG8_LAS bf16x8*)(lds + PG8_SA(b, h) + aoff + m * 2048 + k * 1024); } while (0)
#define PG8_LDB(dst, b, h) do { _Pragma("unroll") for (int n = 0; n < 2; ++n) _Pragma("unroll") for (int k = 0; k < 2; ++k) dst[n][k] = *(const PG8_LAS bf16x8*)(lds + PG8_SB(b, h) + boff + n * 2048 + k * 1024); } while (0)
#define PG8_MMA(ai, bj, At, Bt) do { __builtin_amdgcn_s_setprio(1); _Pragma("unroll") for (int m = 0; m < 4; ++m) _Pragma("unroll") for (int n = 0; n < 2; ++n) _Pragma("unroll") for (int k = 0; k < 2; ++k) \
        acc[ai][bj][m][n] = __builtin_amdgcn_mfma_f32_16x16x32_bf16(Bt[n][k], At[m][k], acc[ai][bj][m][n], 0, 0, 0); __builtin_amdgcn_s_setprio(0); } while (0)
#define PG8_WAIT_V(n) asm volatile("s_waitcnt vmcnt(" #n ")" ::: "memory")
#define PG8_WAIT_L(n) asm volatile("s_waitcnt lgkmcnt(" #n ")" ::: "memory")
#define PG8_BAR __builtin_amdgcn_s_barrier()
#define PG8_SCHED __builtin_amdgcn_sched_barrier(0)
    Unit cur, nxt; int ui = 0;
    if (!S.next(0, cur)) return;
    int ccnt = BM * 1024, ncnt = BM * 1024;
    if constexpr (Sched::GATHER) { ccnt = gcnt[cur.e]; }
    cur.rows = ccnt - cur.pm * BM;
    f32x4 acc[2][2][4][2];
#pragma unroll
    for (int a = 0; a < 2; ++a)
#pragma unroll
        for (int b = 0; b < 2; ++b)
#pragma unroll
            for (int m = 0; m < 4; ++m)
#pragma unroll
                for (int n = 0; n < 2; ++n) acc[a][b][m][n] = (f32x4){0.f, 0.f, 0.f, 0.f};
    bf16x8 At[4][2], B0[2][2], B1[2][2];
    unsigned va[4], vn[4];
    if constexpr (Sched::GATHER) S.a_off(cur, Rr, Cc, va, ccnt); else S.a_off(cur, Rr, Cc, va);
    const char* cA = S.a_base(cur); const char* cB = S.b_base(cur);
    PG8_STAGEB(PG8_SB(0, 0), cB); PG8_STAGEB(PG8_SB(0, 1), cB + hstep); PG8_STAGE(PG8_SA(0, 0), cA, va[0], va[1]); PG8_STAGE(PG8_SA(0, 1), cA, va[2], va[3]);
    if (wr == 1) PG8_BAR;
    PG8_WAIT_V(2); PG8_BAR;
    PG8_STAGEB(PG8_SB(1, 0), cB + kstep); PG8_STAGE(PG8_SA(1, 0), cA + kstep, va[0], va[1]); PG8_STAGEB(PG8_SB(1, 1), cB + hstep + kstep);
    PG8_WAIT_V(6); PG8_BAR;
    for (;;) {
        const bool has_next = S.next(ui + 1, nxt);
        const char* nA = cA; const char* nB = cB;
#pragma unroll
        for (int j = 0; j < 4; ++j) vn[j] = va[j];
        if (has_next) {
            nA = S.a_base(nxt); nB = S.b_base(nxt);
            if constexpr (Sched::GATHER) { ncnt = gcnt[nxt.e]; S.a_off(nxt, Rr, Cc, vn, ncnt); } else S.a_off(nxt, Rr, Cc, vn);
            nxt.rows = ncnt - nxt.pm * BM;
        }
        for (int t = 0; t < nt; t += 2) {
            const bool last = (t == nt - 2);
            const char* a1 = cA + (size_t)(t + 1) * kstep;
            const char* a2 = last ? nA : cA + (size_t)(t + 2) * kstep; const char* b2 = last ? nB : cB + (size_t)(t + 2) * kstep;
            const char* a3 = a2 + kstep; const char* b3 = b2 + kstep;
            unsigned w0 = va[0], w1 = va[1], w2 = va[2], w3 = va[3];
            if (last) { w0 = vn[0]; w1 = vn[1]; w2 = vn[2]; w3 = vn[3]; }
            PG8_LDB(B0, 0, 0); PG8_LDB(B1, 0, 1); PG8_SCHED; PG8_LDA(At, 0, 0); PG8_STAGE(PG8_SA(1, 1), a1, va[2], va[3]);
            PG8_WAIT_V(8); PG8_WAIT_L(0); PG8_BAR; PG8_MMA(0, 0, At, B0); PG8_MMA(0, 1, At, B1); PG8_BAR; PG8_SCHED;
            PG8_LDA(At, 0, 1); PG8_STAGEB(PG8_SB(0, 0), b2); PG8_STAGEB(PG8_SB(0, 1), b2 + hstep); PG8_STAGE(PG8_SA(0, 0), a2, w0, w1);
            PG8_WAIT_V(8); PG8_WAIT_L(0); PG8_BAR; PG8_MMA(1, 0, At, B0); PG8_MMA(1, 1, At, B1); PG8_BAR; PG8_SCHED;
            PG8_LDB(B0, 1, 0); PG8_LDB(B1, 1, 1); PG8_SCHED; PG8_LDA(At, 1, 0); PG8_STAGE(PG8_SA(0, 1), a2, w2, w3);
            PG8_WAIT_V(8); PG8_WAIT_L(0); PG8_BAR; PG8_MMA(0, 0, At, B0); PG8_MMA(0, 1, At, B1); PG8_BAR; PG8_SCHED;
            PG8_LDA(At, 1, 1); PG8_STAGEB(PG8_SB(1, 0), b3); PG8_STAGEB(PG8_SB(1, 1), b3 + hstep); PG8_STAGE(PG8_SA(1, 0), a3, w0, w1);
            PG8_WAIT_V(8); PG8_WAIT_L(0); PG8_BAR; PG8_MMA(1, 0, At, B0); PG8_MMA(1, 1, At, B1); PG8_BAR; PG8_SCHED;
        }
        if constexpr (ALIGN_EPI) { if (wr == 0) PG8_BAR; }
        E(acc, cur, wr, wc, fr, fq);
        if (!has_next) break;
#pragma unroll
        for (int a = 0; a < 2; ++a)
#pragma unroll
            for (int b = 0; b < 2; ++b)
#pragma unroll
                for (int m = 0; m < 4; ++m)
#pragma unroll
                    for (int n = 0; n < 2; ++n) acc[a][b][m][n] = (f32x4){0.f, 0.f, 0.f, 0.f};
        cur = nxt; cA = nA; cB = nB; ++ui;
#pragma unroll
        for (int j = 0; j < 4; ++j) va[j] = vn[j];
        if constexpr (ALIGN_EPI) { if (wr == 1) PG8_BAR; }
    }
    PG8_WAIT_V(0);
    if constexpr (!ALIGN_EPI) { if (wr == 0) PG8_BAR; }
    PG8_BAR;
#undef PG8_SA
#undef PG8_SB
#undef PG8_STAGE
#undef PG8_STAGEB
#undef PG8_LDA
#undef PG8_LDB
#undef PG8_MMA
#undef PG8_WAIT_V
#undef PG8_WAIT_L
#undef PG8_BAR
#undef PG8_SCHED
}

struct EpiBf16 {
    static constexpr bool PERM = true;
    bf16_t* O; int ldc;
    __device__ __forceinline__ void operator()(const f32x4 (&acc)[2][2][4][2], const Unit& u, int wr, int wc, int fr, int fq) const {
        const int row0 = u.pm * BM + wr * 64 + fr, col0 = u.pn * BM + wc * 32 + 8 * fq;
#pragma unroll
        for (int ai = 0; ai < 2; ++ai)
#pragma unroll
            for (int m = 0; m < 4; ++m) { bf16_t* rowp = O + (size_t)(row0 + ai * HALF + m * 16) * ldc + col0;
#pragma unroll
                for (int bj = 0; bj < 2; ++bj) { const f32x4 v0 = acc[ai][bj][m][0], v1 = acc[ai][bj][m][1];
                    u32x4 w; w.x = cvt_pk_bf16(v0[0], v0[1]); w.y = cvt_pk_bf16(v0[2], v0[3]); w.z = cvt_pk_bf16(v1[0], v1[1]); w.w = cvt_pk_bf16(v1[2], v1[3]);
                    *(u32x4*)(rowp + bj * HALF) = w; } }
    }
};
}
#define GAS __attribute__((address_space(1)))
#define LAS __attribute__((address_space(3)))
typedef unsigned short bf16;
typedef unsigned v4u __attribute__((ext_vector_type(4)));
typedef float f32x4 __attribute__((ext_vector_type(4)));
typedef short bf16x8 __attribute__((ext_vector_type(8)));
typedef GAS unsigned gu32;
typedef GAS unsigned long long gu64;
#define RLX_AGENT __ATOMIC_RELAXED, __HIP_MEMORY_SCOPE_AGENT
#define LDS_WAIT() asm volatile("s_waitcnt lgkmcnt(0)" ::: "memory")
#define VM_WAIT() asm volatile("s_waitcnt vmcnt(0)" ::: "memory")
__device__ __forceinline__ unsigned long long rt() { return __builtin_amdgcn_s_memrealtime(); }
__device__ __forceinline__ unsigned f2bf(float f) { unsigned u = __builtin_bit_cast(unsigned, f); return (u + 0x7fffu + ((u >> 16) & 1u)) >> 16; }
__device__ __forceinline__ unsigned pk2(float lo, float hi) { return f2bf(lo) | (f2bf(hi) << 16); }

#define XB_TMO      128
#define XB_XCNT(j)  (256  + 64 * (j))
#define XB_XSUB(j)  (1280 + 64 * (j))
#define XB_XGEN(j)  (2304 + 64 * (j))
#define XB_TOP      3328
#define XB_TOPGEN   3392
#define XCD_BAR_WORDS 3456
#define XB_SPIN_CAP (1u << 18)

__device__ __forceinline__ unsigned xb_ld(unsigned* p)              { return __hip_atomic_load(p, __ATOMIC_RELAXED, __HIP_MEMORY_SCOPE_AGENT); }
__device__ __forceinline__ unsigned xb_add(unsigned* p, unsigned v) { return __hip_atomic_fetch_add(p, v, __ATOMIC_RELAXED, __HIP_MEMORY_SCOPE_AGENT); }
__device__ __forceinline__ unsigned xb_xcc_id() { return (unsigned)__builtin_amdgcn_s_getreg((3 << 11) | 20) & 0xFu; }
#define XB_SPIN(cond, bar) do { unsigned _sp = 0; while (cond) { __builtin_amdgcn_s_sleep(1); \
    if ((++_sp & 255u) == 0u) { if (xb_ld(&(bar)[XB_TMO])) break; if (_sp > XB_SPIN_CAP) { atomicAdd(&(bar)[XB_TMO], 1u); break; } } } } while (0)

struct XcdBarrier {
    unsigned* bar; unsigned x;
    volatile LAS unsigned* st;
};

__device__ __forceinline__ XcdBarrier xcd_barrier_post(unsigned* bar, volatile LAS unsigned* st) {
    XcdBarrier b; b.bar = bar; b.x = xb_xcc_id(); b.st = st;
    if (threadIdx.x == 0) (void)xb_add(&bar[XB_XCNT(b.x)], 1u);
    return b;
}
__device__ __forceinline__ void xcd_barrier_complete(unsigned* bar, unsigned x, unsigned& nloc, unsigned& nx) {
    const unsigned G = gridDim.x * gridDim.y * gridDim.z;
    unsigned sum, cnt, mine, sp = 0u;
    for (;;) {
        sum = 0u; cnt = 0u; mine = 0u;
#pragma unroll
        for (unsigned j = 0; j < 16; ++j) { const unsigned c = xb_ld(&bar[XB_XCNT(j)]); sum += c; cnt += (c > 0u) ? 1u : 0u; mine = (j == x) ? c : mine; }
        if (sum == G) break;
        __builtin_amdgcn_s_sleep(1);
        if ((++sp & 255u) == 0u) { if (xb_ld(&bar[XB_TMO])) break; if (sp > XB_SPIN_CAP) { atomicAdd(&bar[XB_TMO], 1u); break; } }
    }
    nloc = mine > 0u ? mine : 1u; nx = cnt > 0u ? cnt : 1u;
}

__device__ __forceinline__ void xcd_barrier(const XcdBarrier& b) {
    asm volatile("s_waitcnt vmcnt(0)" ::: "memory");
    __syncthreads();
    if (threadIdx.x == 0) {
        unsigned* bar = b.bar;
        __builtin_amdgcn_s_waitcnt(0);
        unsigned nloc = b.st[0], nx = b.st[1];
        if (nloc == 0u) { xcd_barrier_complete(bar, b.x, nloc, nx); b.st[0] = nloc; b.st[1] = nx; }
        const unsigned old = xb_add(&bar[XB_XSUB(b.x)], 1u);
        const unsigned gen = old / nloc;
        if (old + 1u == (gen + 1u) * nloc) {
            __builtin_amdgcn_fence(__ATOMIC_RELEASE, "agent");
            asm volatile("s_waitcnt vmcnt(0)" ::: "memory");
            const unsigned og = xb_add(&bar[XB_TOP], 1u);
            const unsigned tg = og / nx;
            if (og + 1u == (tg + 1u) * nx) xb_add(&bar[XB_TOPGEN], 1u);
            else XB_SPIN(xb_ld(&bar[XB_TOPGEN]) == tg, bar);
            __builtin_amdgcn_fence(__ATOMIC_ACQUIRE, "agent");
            xb_add(&bar[XB_XGEN(b.x)], 1u);
            asm volatile("s_waitcnt vmcnt(0)" ::: "memory");
        } else {
            XB_SPIN(xb_ld(&bar[XB_XGEN(b.x)]) == gen, bar);
            __builtin_amdgcn_fence(__ATOMIC_ACQUIRE, "agent");
            asm volatile("s_waitcnt vmcnt(0)" ::: "memory");
        }
    }
    __syncthreads();
}

constexpr int NTOK = 32768, DM = 1024, NPROJ = 3328;
constexpr int PC_Q = 0, PC_K = 512, PC_V = 1024, PC_Z = 1536, PC_U = 2048, PC_VS = 2560, PC_B = 3072, PC_A = 3076;
constexpr int NEXP = 64, DEXP = 512;
constexpr size_t MiB = 1u << 20;
constexpr size_t WS_CTL = 0, CTL_ZERO_BYTES = 1 * MiB;
constexpr size_t WS_WIN = 1 * MiB, WS_WOUT = 8 * MiB, WS_LIST = 10 * MiB, WS_ROUTE = 18 * MiB;
constexpr size_t WS_WREP = 19 * MiB;
constexpr size_t WS_C = 20 * MiB;
constexpr size_t WS_WGU = WS_C, WS_WD = WS_C + 128 * MiB;
constexpr size_t WS_A = 212 * MiB;
constexpr size_t WS_B = 276 * MiB;
constexpr size_t WS_H1BF = WS_B, WS_YEXP = WS_B + 64 * MiB;
constexpr size_t WS_END = 484 * MiB;
constexpr int CW_BAR = 4096;
constexpr int CW_CNT = 16384;
constexpr int RING_BYTES = 131072, LDSCTL_OFF = RING_BYTES, MISC_OFF = LDSCTL_OFF + 320, PREF_OFF = MISC_OFF + 128, LDS_BYTES = 147456;
constexpr int NTHREADS = 512, NWAVES = 8;
#ifndef GEMM_WGS_N
#define GEMM_WGS_N 184
#endif
constexpr int GEMM_WGS = GEMM_WGS_N;
constexpr float ALPHA_F = 1.189207115002721f;

__device__ __forceinline__ float bf2f(unsigned short v) { return __builtin_bit_cast(float, (unsigned)v << 16); }
__device__ __forceinline__ float wave_sum(float v) {
#pragma unroll
    for (int o = 1; o < 64; o <<= 1) v += __shfl_xor(v, o);
    return v;
}

__device__ __forceinline__ void p0_item_load(const float* W, int ldw, int k0, int n0src, int lane, float (&r)[32]) {
#pragma unroll
    for (int i = 0; i < 32; ++i) r[i] = W[(size_t)(k0 + 2 * i + (lane >> 5)) * ldw + n0src + (lane & 31)];
}
__device__ __forceinline__ void p0_item_store(const float (&r)[32], int K, int k0, bf16* WT, int dst_row0, LAS float* scr, int lane) {
#pragma unroll
    for (int i = 0; i < 32; ++i) scr[(2 * i + (lane >> 5)) * 33 + (lane & 31)] = r[i];
    LDS_WAIT(); asm volatile("" ::: "memory");
    const int c = lane & 7;
#pragma unroll
    for (int j = 0; j < 4; ++j) { const int n = (lane >> 3) + 8 * j; const LAS float* s = scr + (8 * c) * 33 + n;
        v4u o; o.x = pk2(s[0 * 33], s[1 * 33]); o.y = pk2(s[2 * 33], s[3 * 33]); o.z = pk2(s[4 * 33], s[5 * 33]); o.w = pk2(s[6 * 33], s[7 * 33]);
        *(GAS v4u*)(WT + (size_t)(dst_row0 + n) * K + k0 + 8 * c) = o; }
    LDS_WAIT(); asm volatile("" ::: "memory");
}
__device__ __forceinline__ void p0_transpose_item(const float* W, int ldw, int K, int k0, int n0src, bf16* WT, int dst_row0, LAS float* scr, int lane) {
    float r[32]; p0_item_load(W, ldw, k0, n0src, lane, r); p0_item_store(r, K, k0, WT, dst_row0, scr, lane);
}
struct P0Exp { const float* W; bf16* WT; int ldw, K, k0, n0, drow; };
__device__ __forceinline__ P0Exp p0_exp_item(int it, const float* wg, const float* wu, const float* wd, bf16* WGU, bf16* WD) {
    P0Exp x;
    if (it < 32768) { const int nb = it & 15, kb = (it >> 4) & 15, half = (it >> 8) & 1, e = it >> 9, n0 = nb * 32;
        x.W = (half ? wu : wg) + (size_t)e * DM * DEXP; x.WT = WGU + (size_t)e * 1024 * DM; x.ldw = DEXP; x.K = DM; x.k0 = kb * 64; x.n0 = n0; x.drow = (n0 >> 7) * 256 + half * 128 + (n0 & 127); }
    else { const int i2 = it - 32768, nb = i2 & 31, kb = (i2 >> 5) & 7, e = i2 >> 8;
        x.W = wd + (size_t)e * DEXP * DM; x.WT = WD + (size_t)e * DM * DEXP; x.ldw = DM; x.K = DEXP; x.k0 = kb * 64; x.n0 = nb * 32; x.drow = nb * 32; }
    return x;
}
__device__ __forceinline__ void p0_item_load4(const float* W, int ldw, int k0, int n0src, int lane, f32x4 (&r)[8]) {
#pragma unroll
    for (int i = 0; i < 8; ++i) r[i] = *(const GAS f32x4*)(W + (size_t)(k0 + (lane >> 3) + 8 * i) * ldw + n0src + 4 * (lane & 7));
}
__device__ __forceinline__ void p0_item_store4(const f32x4 (&r)[8], int K, int k0, bf16* WT, int dst_row0, LAS float* scr, int lane) {
#pragma unroll
    for (int i = 0; i < 8; ++i) { LAS float* d = scr + ((lane >> 3) + 8 * i) * 33 + 4 * (lane & 7); d[0] = r[i].x; d[1] = r[i].y; d[2] = r[i].z; d[3] = r[i].w; }
    LDS_WAIT(); asm volatile("" ::: "memory");
    const int c = lane & 7;
#pragma unroll
    for (int j = 0; j < 4; ++j) { const int n = (lane >> 3) + 8 * j; const LAS float* s = scr + (8 * c) * 33 + n;
        v4u o; o.x = pk2(s[0 * 33], s[1 * 33]); o.y = pk2(s[2 * 33], s[3 * 33]); o.z = pk2(s[4 * 33], s[5 * 33]); o.w = pk2(s[6 * 33], s[7 * 33]);
        *(GAS v4u*)(WT + (size_t)(dst_row0 + n) * K + k0 + 8 * c) = o; }
    LDS_WAIT(); asm volatile("" ::: "memory");
}
__device__ __forceinline__ void p0_experts(const float* wg, const float* wu, const float* wd, bf16* WGU, bf16* WD, LAS float* scr, int gw, int NGW, int lane) {
    constexpr int NIT = 32768 + 16384;
    f32x4 A[8], B[8], C[8], D[8];
#define P0_LOAD(buf, item) do { if ((item) < NIT) { const P0Exp x_ = p0_exp_item((item), wg, wu, wd, WGU, WD); p0_item_load4(x_.W, x_.ldw, x_.k0, x_.n0, lane, buf); } } while (0)
#define P0_STORE(buf, item) do { if ((item) < NIT) { const P0Exp x_ = p0_exp_item((item), wg, wu, wd, WGU, WD); p0_item_store4(buf, x_.K, x_.k0, x_.WT, x_.drow, scr, lane); } } while (0)
    int it = gw;
    P0_LOAD(A, it); P0_LOAD(B, it + NGW); P0_LOAD(C, it + 2 * NGW);
    for (; it < NIT; it += 4 * NGW) {
        P0_LOAD(D, it + 3 * NGW); P0_STORE(A, it);
        P0_LOAD(A, it + 4 * NGW); P0_STORE(B, it + NGW);
        P0_LOAD(B, it + 5 * NGW); P0_STORE(C, it + 2 * NGW);
        P0_LOAD(C, it + 6 * NGW); P0_STORE(D, it + 3 * NGW);
    }
#undef P0_LOAD
#undef P0_STORE
}

struct MK {
    nv::P p;
    unsigned char* ws;
};

namespace pg8 {
__device__ __forceinline__ float silu_f(float x) { return x * __builtin_amdgcn_rcpf(1.f + __builtin_amdgcn_exp2f(-1.4426950408889634f * x)); }
struct EpiHid {
    static constexpr bool PERM = true;
    bf16_t* HID; const int* list; const int* cnt; int cap;
    __device__ __forceinline__ void operator()(const f32x4 (&acc)[2][2][4][2], const Unit& u, int wr, int wc, int fr, int fq) const {
        const int* lp = list + (size_t)u.e * cap; const int col0 = u.pn * 128 + wc * 32 + 8 * fq;
#pragma unroll
        for (int ai = 0; ai < 2; ++ai)
#pragma unroll
            for (int m = 0; m < 4; ++m) { const int r = ai * HALF + wr * 64 + m * 16 + fr;
                if (r < u.rows) { const int a = lp[u.pm * BM + r] & 0xffff;
                    const f32x4 g0 = acc[ai][0][m][0], g1 = acc[ai][0][m][1], u0 = acc[ai][1][m][0], u1 = acc[ai][1][m][1];
                    u32x4 w; w.x = cvt_pk_bf16(silu_f(g0[0]) * u0[0], silu_f(g0[1]) * u0[1]); w.y = cvt_pk_bf16(silu_f(g0[2]) * u0[2], silu_f(g0[3]) * u0[3]);
                    w.z = cvt_pk_bf16(silu_f(g1[0]) * u1[0], silu_f(g1[1]) * u1[1]); w.w = cvt_pk_bf16(silu_f(g1[2]) * u1[2], silu_f(g1[3]) * u1[3]);
                    *(u32x4*)(HID + (size_t)a * 512 + col0) = w; } }
    }
};
struct EpiYexp {
    static constexpr bool PERM = true;
    bf16_t* Y; const int* list; const float* wgt; int cap;
    __device__ __forceinline__ void operator()(const f32x4 (&acc)[2][2][4][2], const Unit& u, int wr, int wc, int fr, int fq) const {
        const int* lp = list + (size_t)u.e * cap; const int col0 = u.pn * BM + wc * 32 + 8 * fq;
#pragma unroll
        for (int ai = 0; ai < 2; ++ai)
#pragma unroll
            for (int m = 0; m < 4; ++m) { const int r = ai * HALF + wr * 64 + m * 16 + fr;
                if (r < u.rows) { const unsigned ent = (unsigned)lp[u.pm * BM + r]; const int a = (int)(ent & 0xffffu); const float w8 = __builtin_bit_cast(float, ent & 0xffff0000u);
#pragma unroll
                    for (int bj = 0; bj < 2; ++bj) { const f32x4 v0 = acc[ai][bj][m][0] * w8, v1 = acc[ai][bj][m][1] * w8;
                        u32x4 w; w.x = cvt_pk_bf16(v0[0], v0[1]); w.y = cvt_pk_bf16(v0[2], v0[3]); w.z = cvt_pk_bf16(v1[0], v1[1]); w.w = cvt_pk_bf16(v1[2], v1[3]);
                        *(u32x4*)(Y + (size_t)a * 1024 + col0 + bj * HALF) = w; } } }
    }
};

struct EpiZ1 {
    static constexpr bool PERM = false;
    float* O; const float* X; float alpha;
    __device__ __forceinline__ void operator()(const f32x4 (&acc)[2][2][4][2], const Unit& u, int wr, int wc, int fr, int fq) const {
        const int row0 = u.pm * BM + wr * 64 + fr, col0 = u.pn * BM + wc * 32 + 4 * fq;
#pragma unroll
        for (int ai = 0; ai < 2; ++ai)
#pragma unroll
            for (int m = 0; m < 4; ++m) { const size_t off = (size_t)(row0 + ai * HALF + m * 16) * 1024 + col0;
#pragma unroll
                for (int bj = 0; bj < 2; ++bj)
#pragma unroll
                    for (int n = 0; n < 2; ++n) { const f32x4 xv = *(const f32x4*)(X + off + bj * HALF + n * 16); *(f32x4*)(O + off + bj * HALF + n * 16) = acc[ai][bj][m][n] + xv * alpha; } }
    }
};
}


typedef short s16x4 __attribute__((ext_vector_type(4)));
typedef short v4i16_t __attribute__((ext_vector_type(4)));
__device__ __forceinline__ unsigned off_b(unsigned row, unsigned ch) { return 256u * row + 16u * (ch ^ (((row & 3) << 2) | ((row >> 2) & 3))); }
__device__ __forceinline__ s16x4 vtr(LAS unsigned char* p) { return __builtin_bit_cast(s16x4, __builtin_amdgcn_ds_read_tr16_b64_v4i16((LAS v4i16_t*)p)); }
__device__ __forceinline__ float gelu_tanh(float x) { return x * __builtin_amdgcn_rcpf(1.f + __builtin_amdgcn_exp2f(-2.3022081986f * (x + 0.044715f * x * x * x))); }

__device__ __forceinline__ void sgu_phase(LAS unsigned char* lds, bf16* PROJ, const nv::P& p, int G, int vcu, int wave_s) {
    const int lane = pg8::lane_id_fresh(), tid = wave_s * 64 + lane;
    const int g4 = lane >> 4, q = (lane & 15) >> 2, pp = lane & 3, l15 = lane & 15;
    v4u rawn[4];
    { const int u0 = vcu < 1024 ? vcu : 0; const bf16* src = PROJ + ((size_t)(u0 >> 2) * 128 + (tid >> 2)) * NPROJ + PC_VS + (u0 & 3) * 128 + (tid & 3) * 32;
#pragma unroll
      for (int i = 0; i < 4; ++i) rawn[i] = *(const GAS v4u*)(src + 8 * i); }
    for (int u = vcu; u < 1024; u += G) {
        const int g = u & 3, bc = u >> 2; const size_t row0 = (size_t)bc * 128;
        {
            const int s = tid >> 2, qt = tid & 3;
            v4u raw[4];
#pragma unroll
            for (int i = 0; i < 4; ++i) raw[i] = rawn[i];
            { const int un = (u + G < 1024) ? u + G : u; const bf16* srcn = PROJ + ((size_t)(un >> 2) * 128 + s) * NPROJ + PC_VS + (un & 3) * 128 + qt * 32;
#pragma unroll
              for (int i = 0; i < 4; ++i) rawn[i] = *(const GAS v4u*)(srcn + 8 * i); }
            float x[32]; float s1 = 0.f;
#pragma unroll
            for (int i = 0; i < 4; ++i)
#pragma unroll
                for (int c = 0; c < 4; ++c) { const unsigned w = raw[i][c]; const float a = gelu_tanh(__builtin_bit_cast(float, w << 16)), b = gelu_tanh(__builtin_bit_cast(float, w & 0xffff0000u)); x[i * 8 + c * 2] = a; x[i * 8 + c * 2 + 1] = b; s1 += a + b; }
            s1 += __shfl_xor(s1, 1); s1 += __shfl_xor(s1, 2);
            const float mean = s1 * (1.f / 128.f); float s2 = 0.f;
#pragma unroll
            for (int i = 0; i < 32; ++i) { x[i] -= mean; s2 += x[i] * x[i]; }
            s2 += __shfl_xor(s2, 1); s2 += __shfl_xor(s2, 2);
            const float rstd = 1.f / sqrtf(s2 * (1.f / 128.f) + 1e-5f);
            const float* lg = p.sgu_ln_g + g * 128 + qt * 32; const float* lb = p.sgu_ln_b + g * 128 + qt * 32;
#pragma unroll
            for (int i = 0; i < 4; ++i) { const f32x4 g0 = *(const GAS f32x4*)(lg + 8 * i), g1 = *(const GAS f32x4*)(lg + 8 * i + 4), b0 = *(const GAS f32x4*)(lb + 8 * i), b1 = *(const GAS f32x4*)(lb + 8 * i + 4);
                v4u o; o.x = pk2(x[8 * i] * rstd * g0.x + b0.x, x[8 * i + 1] * rstd * g0.y + b0.y); o.y = pk2(x[8 * i + 2] * rstd * g0.z + b0.z, x[8 * i + 3] * rstd * g0.w + b0.w);
                o.z = pk2(x[8 * i + 4] * rstd * g1.x + b1.x, x[8 * i + 5] * rstd * g1.y + b1.y); o.w = pk2(x[8 * i + 6] * rstd * g1.z + b1.z, x[8 * i + 7] * rstd * g1.w + b1.w);
                *(LAS v4u*)(lds + off_b((unsigned)s, (unsigned)(qt * 4 + i))) = o; }
        }
        __syncthreads();
        {
            const int w = wave_s, t = 16 * w + l15, nks = (w >> 1) + 1;
            bf16* rowp = PROJ + (row0 + t) * NPROJ;
            unsigned long long uu8[8];
#pragma unroll
            for (int dt = 0; dt < 8; ++dt) uu8[dt] = *(const GAS unsigned long long*)(rowp + PC_U + g * 128 + 16 * dt + 4 * g4);
            const float bias = p.b_spatial[g * 128 + t];
            f32x4 acc[8];
#pragma unroll
            for (int dt = 0; dt < 8; ++dt) acc[dt] = (f32x4){0.f, 0.f, 0.f, 0.f};
            for (int ks = 0; ks < nks; ++ks) {
                const int sb = 32 * ks + 8 * g4;
                const float* wp = p.w_spatial + ((size_t)(g * 128 + t)) * 128 + sb;
                const f32x4 w0 = *(const GAS f32x4*)wp, w1 = *(const GAS f32x4*)(wp + 4);
                float wv[8] = {w0.x, w0.y, w0.z, w0.w, w1.x, w1.y, w1.z, w1.w};
#pragma unroll
                for (int j = 0; j < 8; ++j) if (sb + j > t) wv[j] = 0.f;
                v4u bw; bw.x = pk2(wv[0], wv[1]); bw.y = pk2(wv[2], wv[3]); bw.z = pk2(wv[4], wv[5]); bw.w = pk2(wv[6], wv[7]);
                const bf16x8 bfrag = __builtin_bit_cast(bf16x8, bw);
#pragma unroll
                for (int dt = 0; dt < 8; ++dt) {
                    const s16x4 lo = vtr(lds + off_b((unsigned)(sb + q), (unsigned)(2 * dt + (pp >> 1))) + 8 * (pp & 1));
                    const s16x4 hi = vtr(lds + off_b((unsigned)(sb + 4 + q), (unsigned)(2 * dt + (pp >> 1))) + 8 * (pp & 1));
                    const bf16x8 afrag = (bf16x8){lo[0], lo[1], lo[2], lo[3], hi[0], hi[1], hi[2], hi[3]};
                    acc[dt] = __builtin_amdgcn_mfma_f32_16x16x32_bf16(afrag, bfrag, acc[dt], 0, 0, 0);
                }
            }
#pragma unroll
            for (int dt = 0; dt < 8; ++dt) {
                const int d = g * 128 + 16 * dt + 4 * g4;
                const unsigned long long uu = uu8[dt];
                const float u0 = gelu_tanh(bf2f((unsigned short)uu)), u1 = gelu_tanh(bf2f((unsigned short)(uu >> 16))), u2 = gelu_tanh(bf2f((unsigned short)(uu >> 32))), u3 = gelu_tanh(bf2f((unsigned short)(uu >> 48)));
                const unsigned long long o = (unsigned long long)pk2(u0 * (acc[dt][0] + bias), u1 * (acc[dt][1] + bias)) | ((unsigned long long)pk2(u2 * (acc[dt][2] + bias), u3 * (acc[dt][3] + bias)) << 32);
                *(GAS unsigned long long*)(rowp + 512 + d) = o;
            }
        }
        __syncthreads();
    }
}

constexpr int DNA_PIECES = 57, DNU_PIECES = 2, DN_STEP_BYTES = (DNA_PIECES + DNU_PIECES) * 1024;
constexpr size_t DNA_CHUNK_BYTES = (size_t)DNA_PIECES * 1024, DNU_CHUNK_BYTES = 8 * DNU_PIECES * 1024;
__device__ __forceinline__ void glds16(const void* gsrc, LAS unsigned char* dst) { __builtin_amdgcn_global_load_lds((const unsigned*)gsrc, (LAS unsigned*)dst, 16, 0, 0); }
typedef float f32x2_t __attribute__((ext_vector_type(2))); typedef __bf16 bf16x2_t __attribute__((ext_vector_type(2)));
__device__ __forceinline__ unsigned cvtpk(float lo, float hi) { const f32x2_t v = {lo, hi}; const bf16x2_t b = __builtin_convertvector(v, bf16x2_t); return __builtin_bit_cast(unsigned, b); }

struct DnSet { bf16x8 F[14]; unsigned long long U; float gl; };
__device__ __forceinline__ void dn_set_load(DnSet& X, const unsigned char* a_step, const unsigned char* u_step, int w) {
#pragma unroll
    for (int ks = 0; ks < 4; ++ks) X.F[ks] = *(const GAS bf16x8*)(a_step + (w * 4 + ks) * 1024);
#pragma unroll
    for (int ks = 0; ks < 4; ++ks) X.F[4 + ks] = *(const GAS bf16x8*)(a_step + (16 + w * 4 + ks) * 1024);
#pragma unroll
    for (int ks = 0; ks < 2; ++ks) X.F[8 + ks] = *(const GAS bf16x8*)(a_step + (48 + w * 2 + ks) * 1024);
#pragma unroll
    for (int t = 0; t < 2; ++t)
#pragma unroll
        for (int ks = 0; ks < 2; ++ks) X.F[10 + 2 * t + ks] = *(const GAS bf16x8*)(a_step + (32 + (2 * w + t) * 2 + ks) * 1024);
    X.U = *(const GAS unsigned long long*)(u_step + (w >> 1) * 1024 + (w & 1) * 8);
    X.gl = *(const GAS float*)(a_step + 56 * 1024);
}
__device__ __forceinline__ void dn_scan_phase(LAS unsigned char* lds, const unsigned char* DNA, const unsigned char* DNU, bf16* ODN, int vcu, int wave_s) {
    if (vcu >= 256) return;
#define DN_BAR() do { asm volatile("s_waitcnt lgkmcnt(0)" ::: "memory"); __builtin_amdgcn_s_barrier(); asm volatile("" ::: "memory"); } while (0)
    if (wave_s >= 4) {
        for (int n = 0; n < 64; ++n) { DN_BAR(); DN_BAR(); }
        return;
    }
    const int lane = pg8::lane_id_fresh(), w = wave_s;
    const int bh = vcu >> 3, sl = vcu & 7, l15 = lane & 15, g4 = lane >> 4;
    const unsigned char* a_src = DNA + (size_t)bh * 64 * DNA_CHUNK_BYTES + lane * 16;
    const unsigned char* u_src = DNU + ((size_t)bh * 64 * 8 + sl) * (DNU_PIECES * 1024) + lane * 16;
    LAS unsigned char* XS = lds + lane * 16;
    LAS unsigned char* XV = lds + 4096 + lane * 16;
    bf16* orow = ODN + (size_t)vcu * (64 * 64 * 16) + l15;
    f32x4 S0 = (f32x4){0.f, 0.f, 0.f, 0.f}, S1 = S0;
    DnSet A, B, C;
    dn_set_load(A, a_src, u_src, w);
    dn_set_load(B, a_src + DNA_CHUNK_BYTES, u_src + DNU_CHUNK_BYTES, w);
    dn_set_load(C, a_src + 2 * DNA_CHUNK_BYTES, u_src + 2 * DNU_CHUNK_BYTES, w);
#define DN_STEP(X, nn) do { const int n_ = (nn); if (n_ < 64) { \
        { v4u sw; sw.x = cvtpk(S0[0], S0[1]); sw.y = cvtpk(S0[2], S0[3]); sw.z = cvtpk(S1[0], S1[1]); sw.w = cvtpk(S1[2], S1[3]); *(LAS v4u*)(XS + w * 1024) = sw; } \
        DN_BAR(); \
        bf16x8 Sb[4]; _Pragma("unroll") for (int ks = 0; ks < 4; ++ks) Sb[ks] = *(const LAS bf16x8*)(XS + ks * 1024); \
        f32x4 P = (f32x4){__builtin_bit_cast(float, (unsigned)X.U << 16), __builtin_bit_cast(float, (unsigned)X.U & 0xffff0000u), __builtin_bit_cast(float, (unsigned)(X.U >> 32) << 16), __builtin_bit_cast(float, (unsigned)(X.U >> 32) & 0xffff0000u)}; \
        _Pragma("unroll") for (int ks = 0; ks < 4; ++ks) P = __builtin_amdgcn_mfma_f32_16x16x32_bf16(X.F[ks], Sb[ks], P, 0, 0, 0); \
        f32x4 O = (f32x4){0.f, 0.f, 0.f, 0.f}; \
        _Pragma("unroll") for (int ks = 0; ks < 4; ++ks) O = __builtin_amdgcn_mfma_f32_16x16x32_bf16(X.F[4 + ks], Sb[ks], O, 0, 0, 0); \
        { const unsigned long long hv = (unsigned long long)cvtpk(P[0], P[1]) | ((unsigned long long)cvtpk(P[2], P[3]) << 32); *(LAS unsigned long long*)(XV + (w >> 1) * 1024 + (w & 1) * 8) = hv; } \
        DN_BAR(); \
        bf16x8 Vb[2]; _Pragma("unroll") for (int ks = 0; ks < 2; ++ks) Vb[ks] = *(const LAS bf16x8*)(XV + ks * 1024); \
        _Pragma("unroll") for (int ks = 0; ks < 2; ++ks) O = __builtin_amdgcn_mfma_f32_16x16x32_bf16(X.F[8 + ks], Vb[ks], O, 0, 0, 0); \
        S0 = S0 * X.gl; S1 = S1 * X.gl; \
        _Pragma("unroll") for (int ks = 0; ks < 2; ++ks) { S0 = __builtin_amdgcn_mfma_f32_16x16x32_bf16(X.F[10 + ks], Vb[ks], S0, 0, 0, 0); S1 = __builtin_amdgcn_mfma_f32_16x16x32_bf16(X.F[12 + ks], Vb[ks], S1, 0, 0, 0); } \
        { bf16* ob = orow + (size_t)(n_ * 64 + 16 * w + 4 * g4) * 16; _Pragma("unroll") for (int r = 0; r < 4; ++r) ob[r * 16] = (bf16)f2bf(O[r]); } \
        if (n_ + 3 < 64) dn_set_load(X, a_src + (size_t)(n_ + 3) * DNA_CHUNK_BYTES, u_src + (size_t)(n_ + 3) * DNU_CHUNK_BYTES, w); } } while (0)
    for (int n = 0; n < 64; n += 3) { DN_STEP(A, n); DN_STEP(B, n + 1); DN_STEP(C, n + 2); }
#undef DN_STEP
#undef DN_BAR
    asm volatile("s_waitcnt vmcnt(0)" ::: "memory");
}

__device__ __forceinline__ void dn_final_phase(const bf16* ODN, bf16* PROJ, const float* norm_w, int gw, int NGW, int lane) {
    const f32x4 nw0 = *(const GAS f32x4*)(norm_w + ((8 * lane) & 127)), nw1 = *(const GAS f32x4*)(norm_w + ((8 * lane) & 127) + 4);
#define DNF_LOAD(mm, OV, ZV) do { const int bb_ = (mm) >> 12, nn_ = ((mm) >> 6) & 63, ii_ = (mm) & 63; \
        OV = *(const GAS v4u*)(ODN + ((((size_t)((bb_ * 4 + (lane >> 4)) * 8 + ((lane >> 1) & 7)) * 64 + nn_) * 64 + ii_) * 16 + 8 * (lane & 1))); ZV = *(const GAS v4u*)(PROJ + (size_t)(mm) * NPROJ + PC_Z + 8 * lane); } while (0)
    v4u ovn, zvn; DNF_LOAD(gw < NTOK ? gw : 0, ovn, zvn);
    for (int m = gw; m < NTOK; m += NGW) {
        const v4u ov = ovn, zv = zvn;
        { const int mn = (m + NGW < NTOK) ? m + NGW : m; DNF_LOAD(mn, ovn, zvn); }
        float o[8], z[8];
#pragma unroll
        for (int c = 0; c < 4; ++c) { o[2 * c] = __builtin_bit_cast(float, ov[c] << 16); o[2 * c + 1] = __builtin_bit_cast(float, ov[c] & 0xffff0000u); z[2 * c] = __builtin_bit_cast(float, zv[c] << 16); z[2 * c + 1] = __builtin_bit_cast(float, zv[c] & 0xffff0000u); }
        float ss = 0.f;
#pragma unroll
        for (int c = 0; c < 8; ++c) ss += o[c] * o[c];
        ss += __shfl_xor(ss, 1); ss += __shfl_xor(ss, 2); ss += __shfl_xor(ss, 4); ss += __shfl_xor(ss, 8);
        const float rs = 1.f / sqrtf(ss * (1.f / 128.f) + 1e-6f);
        const float nw[8] = {nw0.x, nw0.y, nw0.z, nw0.w, nw1.x, nw1.y, nw1.z, nw1.w};
        float y[8];
#pragma unroll
        for (int c = 0; c < 8; ++c) y[c] = o[c] * rs * nw[c] * z[c] * __builtin_amdgcn_rcpf(1.f + __builtin_amdgcn_exp2f(-1.4426950408889634f * z[c]));
        v4u w; w.x = pk2(y[0], y[1]); w.y = pk2(y[2], y[3]); w.z = pk2(y[4], y[5]); w.w = pk2(y[6], y[7]);
        *(GAS v4u*)(PROJ + (size_t)m * NPROJ + 8 * lane) = w;
    }
}

__device__ __forceinline__ float wave_sum_dpp(float v) {
    v = v + __builtin_bit_cast(float, __builtin_amdgcn_update_dpp(0, __builtin_bit_cast(int, v), 0xB1, 0xf, 0xf, true));
    v = v + __builtin_bit_cast(float, __builtin_amdgcn_update_dpp(0, __builtin_bit_cast(int, v), 0x4E, 0xf, 0xf, true));
    v = v + __builtin_bit_cast(float, __builtin_amdgcn_update_dpp(0, __builtin_bit_cast(int, v), 0x141, 0xf, 0xf, true));
    v = v + __builtin_bit_cast(float, __builtin_amdgcn_update_dpp(0, __builtin_bit_cast(int, v), 0x140, 0xf, 0xf, true));
    v = v + __builtin_bit_cast(float, __builtin_amdgcn_update_dpp(0, __builtin_bit_cast(int, v), 0x142, 0xa, 0xf, true));
    v = v + __builtin_bit_cast(float, __builtin_amdgcn_update_dpp(0, __builtin_bit_cast(int, v), 0x143, 0xc, 0xf, true));
    return __builtin_bit_cast(float, __builtin_amdgcn_readlane(__builtin_bit_cast(int, v), 63));
}

constexpr int XTAB_OFF = RING_BYTES + 2048, XTAB_BYTES = 1792;
__device__ __forceinline__ unsigned off_t64(unsigned row, unsigned ch) { return 128u * row + 16u * (ch ^ (row & 7u)); }
__device__ __forceinline__ bf16x8 pack8(const float (&v)[8]) { v4u w; w.x = cvtpk(v[0], v[1]); w.y = cvtpk(v[2], v[3]); w.z = cvtpk(v[4], v[5]); w.w = cvtpk(v[6], v[7]); return __builtin_bit_cast(bf16x8, w); }
__device__ __forceinline__ void unpack8(const v4u w, float (&v)[8]) {
#pragma unroll
    for (int c = 0; c < 4; ++c) { v[2 * c] = __builtin_bit_cast(float, w[c] << 16); v[2 * c + 1] = __builtin_bit_cast(float, w[c] & 0xffff0000u); }
}
__device__ __forceinline__ float conv_silu_rows(const bf16* src0, bool seq_start, const float* cw, LAS unsigned char* img, int lane) {
    float w[4][2];
#pragma unroll
    for (int j = 0; j < 4; ++j) { const f32x2_t t = *(const GAS f32x2_t*)(cw + j * 1536 + 2 * lane); w[j][0] = t[0]; w[j][1] = t[1]; }
    const GAS unsigned* gsrc = (const GAS unsigned*)(src0 + 2 * lane);
    unsigned raw[67];
#pragma unroll
    for (int r = 0; r < 3; ++r) raw[r] = seq_start ? 0u : gsrc[(long)(r - 3) * (NPROJ / 2)];
#pragma unroll
    for (int r = 0; r < 64; ++r) raw[3 + r] = gsrc[(size_t)r * (NPROJ / 2)];
    float myss = 0.f;
    const unsigned lbase = (unsigned)((lane & 3) * 4);
#pragma unroll
    for (int pz = 0; pz < 64; ++pz) {
        float y0 = 0.f, y1 = 0.f;
#pragma unroll
        for (int j = 0; j < 4; ++j) { const unsigned u = raw[pz + j]; y0 += w[j][0] * __builtin_bit_cast(float, u << 16); y1 += w[j][1] * __builtin_bit_cast(float, u & 0xffff0000u); }
        y0 = y0 * __builtin_amdgcn_rcpf(1.f + __builtin_amdgcn_exp2f(-1.4426950408889634f * y0));
        y1 = y1 * __builtin_amdgcn_rcpf(1.f + __builtin_amdgcn_exp2f(-1.4426950408889634f * y1));
        const float tot = wave_sum_dpp(y0 * y0 + y1 * y1);
        myss = (lane == pz) ? tot : myss;
        *(LAS unsigned*)(img + off_b((unsigned)pz, (unsigned)(lane >> 2)) + lbase) = cvtpk(y0, y1);
    }
    return myss;
}

template <int STOP>
__device__ __forceinline__ void dn_prep_chunk(LAS unsigned char* IMG  , LAS float* tab, const bf16* PROJ, const nv::P& p, unsigned char* DNA, unsigned char* DNU, int ci) {
    int lane = pg8::lane_id_fresh();
    const int bh = ci >> 6, n = ci & 63, b = bh >> 2, h = bh & 3;
    int l15 = lane & 15, g4 = lane >> 4, q = l15 >> 2, pp = lane & 3;
    LAS float* t_gc = tab; LAS float* t_be = tab + 64; LAS float* t_rk = tab + 128; LAS float* t_rq = tab + 192; LAS float* t_eq = tab + 256; LAS float* t_ekk = tab + 320; LAS float* t_bg = tab + 384;
    const size_t tok = (size_t)b * 4096 + n * 64 + lane;
    const bf16* prow = PROJ + tok * NPROJ;
    const bf16* prow0 = PROJ + ((size_t)b * 4096 + n * 64) * NPROJ;
    unsigned char* dna = DNA + (size_t)ci * DNA_CHUNK_BYTES + lane * 16;
    (void)q; (void)pp;
    float gc, beta, eg, gc63;
    {
        const float araw = bf2f(prow[PC_A + h]), braw = bf2f(prow[PC_B + h]);
        const float xx = araw + p.dt_bias[h];
        const float sp = xx > 20.f ? xx : log1pf(expf(xx));
        gc = -expf(p.a_log[h]) * sp;
        beta = 1.f / (1.f + expf(-braw));
#pragma unroll
        for (int o = 1; o < 64; o <<= 1) { const float t = __shfl_up(gc, o); if (lane >= o) gc += t; }
        gc63 = __shfl(gc, 63);
        eg = expf(gc);
        const unsigned gb = __builtin_bit_cast(unsigned, expf(gc63));
        *(GAS v4u*)(dna + 56 * 1024) = (v4u){gb, gb, gb, gb};
        const float ssq = conv_silu_rows(prow0 + PC_Q + h * 128, n == 0, p.conv_w + h * 128, IMG, lane);
        const float rq = 0.08838834764831845f / sqrtf(ssq + 1e-6f);
        t_gc[lane] = gc; t_be[lane] = beta; t_rq[lane] = rq; t_eq[lane] = eg * rq;
    }
    LDS_WAIT(); asm volatile("" ::: "memory");
    if constexpr (STOP == 1) return;
    bf16x8 qF[4][4];
#pragma unroll
    for (int mt = 0; mt < 4; ++mt)
#pragma unroll
        for (int ks = 0; ks < 4; ++ks) qF[mt][ks] = *(const LAS bf16x8*)(IMG + off_b((unsigned)(16 * mt + l15), (unsigned)(4 * ks + g4)));
#pragma unroll
    for (int mt = 0; mt < 4; ++mt) {
        const float egi = t_eq[16 * mt + l15];
#pragma unroll
        for (int ks = 0; ks < 4; ++ks) {
            const unsigned long long lo = *(const LAS unsigned long long*)(IMG + off_b((unsigned)(16 * mt + l15), (unsigned)(4 * ks + (g4 >> 1))) + (g4 & 1) * 8);
            const unsigned long long hi = *(const LAS unsigned long long*)(IMG + off_b((unsigned)(16 * mt + l15), (unsigned)(4 * ks + 2 + (g4 >> 1))) + (g4 & 1) * 8);
            float t8[8]; unpack8((v4u){(unsigned)lo, (unsigned)(lo >> 32), (unsigned)hi, (unsigned)(hi >> 32)}, t8);
#pragma unroll
            for (int e = 0; e < 8; ++e) t8[e] *= egi;
            *(GAS bf16x8*)(dna + (16 + mt * 4 + ks) * 1024) = pack8(t8);
        }
    }
    LDS_WAIT(); asm volatile("" ::: "memory");
    {
        const float ssk = conv_silu_rows(prow0 + PC_K + h * 128, n == 0, p.conv_w + 512 + h * 128, IMG, lane);
        const float rk = 1.f / sqrtf(ssk + 1e-6f);
        t_rk[lane] = rk; t_ekk[lane] = expf(gc63 - gc) * rk; t_bg[lane] = beta * eg * rk;
    }
    LDS_WAIT(); asm volatile("" ::: "memory");
    if constexpr (STOP == 2) return;
    f32x4 Am[4][4];
    {
        bf16x8 kF[4][4];
#pragma unroll
        for (int mt = 0; mt < 4; ++mt)
#pragma unroll
            for (int ks = 0; ks < 4; ++ks) kF[mt][ks] = *(const LAS bf16x8*)(IMG + off_b((unsigned)(16 * mt + l15), (unsigned)(4 * ks + g4)));
#pragma unroll
        for (int mi = 0; mi < 4; ++mi) {
            const f32x4 gci = *(const LAS f32x4*)(t_gc + 16 * mi + 4 * g4), bei = *(const LAS f32x4*)(t_be + 16 * mi + 4 * g4), rki = *(const LAS f32x4*)(t_rk + 16 * mi + 4 * g4);
#pragma unroll
            for (int nj = 0; nj <= mi; ++nj) {
                f32x4 acc = (f32x4){0.f, 0.f, 0.f, 0.f};
#pragma unroll
                for (int ks = 0; ks < 4; ++ks) acc = __builtin_amdgcn_mfma_f32_16x16x32_bf16(kF[mi][ks], kF[nj][ks], acc, 0, 0, 0);
                const float gcj = t_gc[16 * nj + l15], rkj = t_rk[16 * nj + l15]; const int j = 16 * nj + l15;
#pragma unroll
                for (int r = 0; r < 4; ++r) { const int i = 16 * mi + 4 * g4 + r; acc[r] = (j < i) ? bei[r] * rki[r] * rkj * acc[r] * expf(gci[r] - gcj) : 0.f; }
                Am[mi][nj] = acc;
            }
        }
#pragma unroll
        for (int it = 0; it < 4; ++it) {
            const float gci = t_gc[16 * it + l15], rqi = t_rq[16 * it + l15]; const int i = 16 * it + l15;
            f32x4 kq[4];
#pragma unroll
            for (int jt = 0; jt < 4; ++jt) {
                f32x4 acc = (f32x4){0.f, 0.f, 0.f, 0.f};
                if (jt <= it) {
#pragma unroll
                    for (int ks = 0; ks < 4; ++ks) acc = __builtin_amdgcn_mfma_f32_16x16x32_bf16(kF[jt][ks], qF[it][ks], acc, 0, 0, 0);
                    const f32x4 gcj = *(const LAS f32x4*)(t_gc + 16 * jt + 4 * g4), rkj = *(const LAS f32x4*)(t_rk + 16 * jt + 4 * g4);
#pragma unroll
                    for (int r = 0; r < 4; ++r) { const int j = 16 * jt + 4 * g4 + r; acc[r] = (j <= i) ? acc[r] * rqi * rkj[r] * expf(gci - gcj[r]) : 0.f; }
                }
                kq[jt] = acc;
            }
#pragma unroll
            for (int ks = 0; ks < 2; ++ks) { const float t8[8] = {kq[2 * ks][0], kq[2 * ks][1], kq[2 * ks][2], kq[2 * ks][3], kq[2 * ks + 1][0], kq[2 * ks + 1][1], kq[2 * ks + 1][2], kq[2 * ks + 1][3]};
                *(GAS bf16x8*)(dna + (48 + it * 2 + ks) * 1024) = pack8(t8); }
        }
    }
    if constexpr (STOP == 3) return;
    bf16x8 ktr[8][2];
    {
#pragma unroll
        for (int ks = 0; ks < 2; ++ks) {
            const f32x4 ek0 = *(const LAS f32x4*)(t_ekk + 32 * ks + 4 * g4), ek1 = *(const LAS f32x4*)(t_ekk + 32 * ks + 16 + 4 * g4);
#pragma unroll
            for (int mt = 0; mt < 8; ++mt) {
                const s16x4 lo = vtr(IMG + off_b((unsigned)(32 * ks + 4 * g4 + q), (unsigned)(2 * mt + (pp >> 1))) + 8 * (pp & 1));
                const s16x4 hi = vtr(IMG + off_b((unsigned)(32 * ks + 16 + 4 * g4 + q), (unsigned)(2 * mt + (pp >> 1))) + 8 * (pp & 1));
                const float t8[8] = {bf2f((unsigned short)lo[0]) * ek0.x, bf2f((unsigned short)lo[1]) * ek0.y, bf2f((unsigned short)lo[2]) * ek0.z, bf2f((unsigned short)lo[3]) * ek0.w,
                                     bf2f((unsigned short)hi[0]) * ek1.x, bf2f((unsigned short)hi[1]) * ek1.y, bf2f((unsigned short)hi[2]) * ek1.z, bf2f((unsigned short)hi[3]) * ek1.w};
                *(GAS bf16x8*)(dna + (32 + mt * 2 + ks) * 1024) = pack8(t8);
            }
        }
#pragma unroll
        for (int dt = 0; dt < 8; ++dt)
#pragma unroll
            for (int ks = 0; ks < 2; ++ks) {
                const s16x4 lo = vtr(IMG + off_b((unsigned)(32 * ks + 8 * g4 + q), (unsigned)(2 * dt + (pp >> 1))) + 8 * (pp & 1));
                const s16x4 hi = vtr(IMG + off_b((unsigned)(32 * ks + 8 * g4 + 4 + q), (unsigned)(2 * dt + (pp >> 1))) + 8 * (pp & 1));
                ktr[dt][ks] = (bf16x8){lo[0], lo[1], lo[2], lo[3], hi[0], hi[1], hi[2], hi[3]};
            }
    }
    LDS_WAIT(); asm volatile("" ::: "memory");
    {
        LAS float* AL = (LAS float*)IMG;
#pragma unroll
        for (int mi = 0; mi < 4; ++mi)
#pragma unroll
            for (int nj = 0; nj <= mi; ++nj)
#pragma unroll
                for (int r = 0; r < 4; ++r) AL[(16 * mi + 4 * g4 + r) * 64 + 16 * nj + l15] = Am[mi][nj][r];
    }
    LDS_WAIT(); asm volatile("" ::: "memory");
    float T[64];
    {
        const LAS float* AL = (const LAS float*)IMG;
#pragma clang loop unroll(full)
        for (int i = 0; i < 64; ++i) {
            float v4[4] = {(lane == i) ? 1.f : 0.f, 0.f, 0.f, 0.f};
#pragma clang loop unroll(full)
            for (int j4 = 0; j4 < (i + 3) / 4; ++j4) {
                const f32x4 a = *(const LAS f32x4*)(AL + i * 64 + 4 * j4);
#pragma clang loop unroll(full)
                for (int e = 0; e < 4; ++e) if (4 * j4 + e < i) v4[e] -= a[e] * T[4 * j4 + e];
            }
            T[i] = (v4[0] + v4[1]) + (v4[2] + v4[3]);
        }
    }
    LDS_WAIT(); asm volatile("" ::: "memory");
    if constexpr (STOP == 4) return;
    lane = pg8::lane_id_fresh(); l15 = lane & 15; g4 = lane >> 4; q = l15 >> 2; pp = lane & 3;
    dna = DNA + (size_t)ci * DNA_CHUNK_BYTES + lane * 16;
    {
        const float bc = t_be[lane], bgc = t_bg[lane];
        LAS unsigned char* TB = IMG; LAS unsigned char* TBE = IMG + 8192;
#pragma unroll
        for (int i = 0; i < 64; ++i) { const unsigned o = off_t64((unsigned)i, (unsigned)(lane >> 3)) + (lane & 7) * 2;
            *(LAS unsigned short*)(TB + o) = (unsigned short)f2bf(T[i] * bc); *(LAS unsigned short*)(TBE + o) = (unsigned short)f2bf(T[i] * bgc); }
    }
    LDS_WAIT(); asm volatile("" ::: "memory");
    bf16x8 tb[4][2];
    {
#pragma unroll
        for (int it = 0; it < 4; ++it) {
            bf16x8 tbe[2];
#pragma unroll
            for (int ks = 0; ks < 2; ++ks) tbe[ks] = *(const LAS bf16x8*)(IMG + 8192 + off_t64((unsigned)(16 * it + l15), (unsigned)(4 * ks + g4)));
            f32x4 acc[8];
#pragma unroll
            for (int dt = 0; dt < 8; ++dt) { acc[dt] = (f32x4){0.f, 0.f, 0.f, 0.f};
#pragma unroll
                for (int ks = 0; ks < 2; ++ks) acc[dt] = __builtin_amdgcn_mfma_f32_16x16x32_bf16(ktr[dt][ks], tbe[ks], acc[dt], 0, 0, 0); }
#pragma unroll
            for (int ks = 0; ks < 4; ++ks) { const float t8[8] = {-acc[2 * ks][0], -acc[2 * ks][1], -acc[2 * ks][2], -acc[2 * ks][3], -acc[2 * ks + 1][0], -acc[2 * ks + 1][1], -acc[2 * ks + 1][2], -acc[2 * ks + 1][3]};
                *(GAS bf16x8*)(dna + (it * 4 + ks) * 1024) = pack8(t8); }
        }
#pragma unroll
        for (int mt = 0; mt < 4; ++mt)
#pragma unroll
            for (int ks = 0; ks < 2; ++ks) tb[mt][ks] = *(const LAS bf16x8*)(IMG + off_t64((unsigned)(16 * mt + l15), (unsigned)(4 * ks + g4)));
    }
    LDS_WAIT(); asm volatile("" ::: "memory");
    if constexpr (STOP == 5) return;
    (void)conv_silu_rows(prow0 + PC_V + h * 128, n == 0, p.conv_w + 1024 + h * 128, IMG, lane);
    LDS_WAIT(); asm volatile("" ::: "memory");
    {
        unsigned char* dnu = DNU + (size_t)ci * DNU_CHUNK_BYTES + lane * 16;
#pragma unroll
        for (int dt = 0; dt < 8; ++dt) {
            bf16x8 vt[2];
#pragma unroll
            for (int ks = 0; ks < 2; ++ks) {
                const s16x4 lo = vtr(IMG + off_b((unsigned)(32 * ks + 8 * g4 + q), (unsigned)(2 * dt + (pp >> 1))) + 8 * (pp & 1));
                const s16x4 hi = vtr(IMG + off_b((unsigned)(32 * ks + 8 * g4 + 4 + q), (unsigned)(2 * dt + (pp >> 1))) + 8 * (pp & 1));
                vt[ks] = (bf16x8){lo[0], lo[1], lo[2], lo[3], hi[0], hi[1], hi[2], hi[3]};
            }
            f32x4 u[4];
#pragma unroll
            for (int mt = 0; mt < 4; ++mt) { u[mt] = (f32x4){0.f, 0.f, 0.f, 0.f};
#pragma unroll
                for (int ks = 0; ks < 2; ++ks) u[mt] = __builtin_amdgcn_mfma_f32_16x16x32_bf16(tb[mt][ks], vt[ks], u[mt], 0, 0, 0); }
#pragma unroll
            for (int pc = 0; pc < 2; ++pc) { const float t8[8] = {u[2 * pc][0], u[2 * pc][1], u[2 * pc][2], u[2 * pc][3], u[2 * pc + 1][0], u[2 * pc + 1][1], u[2 * pc + 1][2], u[2 * pc + 1][3]};
                *(GAS bf16x8*)(dnu + (dt * 2 + pc) * 1024) = pack8(t8); }
        }
    }
    LDS_WAIT(); asm volatile("" ::: "memory");
}

template <int STOP>
__device__ __forceinline__ void dn_prep_phase(LAS unsigned char* lds, const bf16* PROJ, const nv::P& p, unsigned char* DNA, unsigned char* DNU, int G, int vcu, int wave_s) {
    LAS unsigned char* img = lds + wave_s * 16384; LAS float* tab = (LAS float*)(lds + XTAB_OFF + wave_s * XTAB_BYTES);
    for (int ci = vcu * 8 + wave_s; ci < 2048; ci += G * 8) dn_prep_chunk<STOP>(img, tab, PROJ, p, DNA, DNU, ci);
}


struct RouterArgs { const float* z; const bf16* mix; float* zout; bf16* H1BF; int* EID; float* WGT; int* LIST; int* CNT; const float *ln_g, *ln_b, *w_rg, *b_rg, *w_re, *b_re; };
__device__ __forceinline__ void router_fill(LAS float* dst, const float* W, int ldw, int col0, int tid) {
#pragma unroll
    for (int it = 0; it < 4; ++it) { const int qd = tid + it * NTHREADS, k = qd >> 1, half = qd & 1;
        const f32x4 v = *(const GAS f32x4*)(W + (size_t)k * ldw + col0 + half * 4);
        *(LAS f32x4*)(dst + half * 4096 + ((((k >> 7) * 4 + (k & 3)) * 32 + ((k >> 2) & 31)) * 4)) = v; }
}
__device__ __forceinline__ float half_sum_hi(float v) {
    v = v + __builtin_bit_cast(float, __builtin_amdgcn_update_dpp(0, __builtin_bit_cast(int, v), 0xB1, 0xf, 0xf, true));
    v = v + __builtin_bit_cast(float, __builtin_amdgcn_update_dpp(0, __builtin_bit_cast(int, v), 0x4E, 0xf, 0xf, true));
    v = v + __builtin_bit_cast(float, __builtin_amdgcn_update_dpp(0, __builtin_bit_cast(int, v), 0x141, 0xf, 0xf, true));
    v = v + __builtin_bit_cast(float, __builtin_amdgcn_update_dpp(0, __builtin_bit_cast(int, v), 0x140, 0xf, 0xf, true));
    v = v + __builtin_bit_cast(float, __builtin_amdgcn_update_dpp(0, __builtin_bit_cast(int, v), 0x142, 0xa, 0xf, true));
    return v;
}
__device__ __forceinline__ float half_sum_all(float v, bool hi) {
    v = half_sum_hi(v);
    const float a = __builtin_bit_cast(float, __builtin_amdgcn_readlane(__builtin_bit_cast(int, v), 31)), b = __builtin_bit_cast(float, __builtin_amdgcn_readlane(__builtin_bit_cast(int, v), 63));
    return hi ? b : a;
}
__device__ __forceinline__ void router_phase(LAS unsigned char* lds, const RouterArgs& A, int gw, int NGW, int wave_s) {
    const int lane = pg8::lane_id_fresh(), tid = wave_s * 64 + lane, hl = lane & 31; const bool hi = lane >= 32;
    LAS float* WG = (LAS float*)lds; LAS int* HIST = (LAS int*)(lds + 32768); LAS int* BASE = HIST + 64; LAS int* RR = HIST + 128;
    LAS f32x4* LNG = (LAS f32x4*)(lds + 36864); LAS f32x4* LNB = (LAS f32x4*)(lds + 40960); LAS float* BRE = (LAS float*)(lds + 45056);
    router_fill(WG, A.w_rg, 8, 0, tid);
    if (tid < 64) { HIST[tid] = 0; BRE[tid] = A.b_re[tid]; }
    if (tid < 256) LNG[tid] = *((const GAS f32x4*)A.ln_g + tid); else LNB[tid - 256] = *((const GAS f32x4*)A.ln_b + (tid - 256));
    __syncthreads();
    const int hoff = hi ? NGW : 0;
    f32x4 xa[8], xb[8]; unsigned long long ma[8], mb_[8];
#define RT_LOAD(xs, ms, mm) do { const int mm_ = (mm) < NTOK ? (mm) : 0; const GAS f32x4* zr_ = (const GAS f32x4*)(A.z + (size_t)mm_ * DM) + hl; const GAS unsigned long long* mr_ = (const GAS unsigned long long*)(A.mix + (size_t)mm_ * DM) + hl; \
        _Pragma("unroll") for (int j_ = 0; j_ < 8; ++j_) { xs[j_] = zr_[32 * j_]; ms[j_] = mr_[32 * j_]; } } while (0)
#define RT_WLOAD(buf, jj) do { _Pragma("unroll") for (int c4_ = 0; c4_ < 4; ++c4_) { wq[buf][2 * c4_] = *(const GAS f32x4*)(wre + ((jj) * 4 + c4_) * 128); wq[buf][2 * c4_ + 1] = *(const GAS f32x4*)(wre + ((jj) * 4 + c4_) * 128 + 4096); } } while (0)
    RT_LOAD(xa, ma, gw + hoff); RT_LOAD(xb, mb_, gw + 2 * NGW + hoff);
    auto body = [&](f32x4 (&xs)[8], unsigned long long (&ms)[8], const int mb, const int slot) __attribute__((always_inline)) {
        const int m = mb + hoff; const bool valid = m < NTOK;
        f32x4 v[8];
#pragma unroll
        for (int j = 0; j < 8; ++j) { const unsigned long long mm = ms[j];
            v[j].x = ALPHA_F * xs[j].x + bf2f((unsigned short)mm); v[j].y = ALPHA_F * xs[j].y + bf2f((unsigned short)(mm >> 16));
            v[j].z = ALPHA_F * xs[j].z + bf2f((unsigned short)(mm >> 32)); v[j].w = ALPHA_F * xs[j].w + bf2f((unsigned short)(mm >> 48)); }
        float s = 0.f;
#pragma unroll
        for (int j = 0; j < 8; ++j) s += (v[j].x + v[j].y) + (v[j].z + v[j].w);
        const float mean = half_sum_all(s, hi) * (1.f / DM); float s2 = 0.f;
#pragma unroll
        for (int j = 0; j < 8; ++j) { v[j] = v[j] - mean; s2 += (v[j].x * v[j].x + v[j].y * v[j].y) + (v[j].z * v[j].z + v[j].w * v[j].w); }
        const float rstd = 1.f / sqrtf(half_sum_all(s2, hi) * (1.f / DM) + 1e-5f);
        GAS unsigned long long* hb = (GAS unsigned long long*)(A.H1BF + (size_t)(valid ? m : 0) * DM) + hl;
#pragma unroll
        for (int j = 0; j < 8; ++j) { const f32x4 g = LNG[hl + 32 * j], bb = LNB[hl + 32 * j]; v[j] = v[j] * rstd * g + bb;
            if (valid) hb[32 * j] = (unsigned long long)pk2(v[j].x, v[j].y) | ((unsigned long long)pk2(v[j].z, v[j].w) << 32); }
        f32x2_t ga[4];
#pragma unroll
        for (int c = 0; c < 4; ++c) ga[c] = (f32x2_t){0.f, 0.f};
#pragma unroll
        for (int j = 0; j < 8; ++j)
#pragma unroll
            for (int c4 = 0; c4 < 4; ++c4) { const float hv = v[j][c4]; const f32x2_t h2 = {hv, hv}; const LAS float* wp = WG + ((j * 4 + c4) * 32 + hl) * 4;
                const f32x4 w0 = *(const LAS f32x4*)wp, w1 = *(const LAS f32x4*)(wp + 4096);
                ga[0] += h2 * w0.xy; ga[1] += h2 * w0.zw; ga[2] += h2 * w1.xy; ga[3] += h2 * w1.zw; }
        float gl[8]; int gi = 0; float gm = -INFINITY;
#pragma unroll
        for (int c = 0; c < 8; ++c) { gl[c] = half_sum_hi(ga[c >> 1][c & 1]) + A.b_rg[c]; if (gl[c] > gm) { gm = gl[c]; gi = c; } }
        float den = 0.f;
#pragma unroll
        for (int c = 0; c < 8; ++c) den += __builtin_amdgcn_exp2f((gl[c] - gm) * 1.4426950408889634f);
        const float pg = 1.f / den;
        const int gia = __builtin_amdgcn_readlane(gi, 31), gib = __builtin_amdgcn_readlane(gi, 63), gs = hi ? gib : gia;
        f32x2_t ea_[4];
#pragma unroll
        for (int c = 0; c < 4; ++c) ea_[c] = (f32x2_t){0.f, 0.f};
        const float* wre = A.w_re + gs * 8192 + hl * 4;
        f32x4 wq[2][8];
        RT_WLOAD(0, 0); RT_WLOAD(1, 1);
        asm volatile("" ::: "memory");
#pragma unroll
        for (int j = 0; j < 8; ++j) {
#pragma unroll
            for (int c4 = 0; c4 < 4; ++c4) { const float hv = v[j][c4]; const f32x2_t h2 = {hv, hv}; const f32x4 w0 = wq[j & 1][2 * c4], w1 = wq[j & 1][2 * c4 + 1];
                ea_[0] += h2 * w0.xy; ea_[1] += h2 * w0.zw; ea_[2] += h2 * w1.xy; ea_[3] += h2 * w1.zw; }
            if (j + 2 < 8) { RT_WLOAD(j & 1, j + 2); asm volatile("" ::: "memory"); }
            if (j == 5) { RT_LOAD(xs, ms, mb + 4 * NGW + hoff); asm volatile("" ::: "memory"); }
        }
        float el[8]; int i0 = 0, i1 = 0; float v0 = -INFINITY, v1 = -INFINITY;
#pragma unroll
        for (int c = 0; c < 8; ++c) { el[c] = half_sum_hi(ea_[c >> 1][c & 1]) + BRE[gs * 8 + c]; if (el[c] > v0) { v0 = el[c]; i0 = c; } }
#pragma unroll
        for (int c = 0; c < 8; ++c) { if (c != i0 && el[c] > v1) { v1 = el[c]; i1 = c; } }
        const float e1 = __builtin_amdgcn_exp2f((v1 - v0) * 1.4426950408889634f), sm = 1.f / (1.f + e1);
        if (hl == 31 && valid) {
            const int ea = gs * 8 + i0, eb = gs * 8 + i1;
            LAS int* rr = RR + (wave_s * 16 + slot + (hi ? 1 : 0)) * 6;
            rr[4] = (int)(f2bf(pg * sm) << 16); rr[5] = (int)(f2bf(pg * e1 * sm) << 16);
            rr[0] = ea; rr[1] = __hip_atomic_fetch_add(&HIST[ea], 1, __ATOMIC_RELAXED, __HIP_MEMORY_SCOPE_WORKGROUP); rr[2] = eb; rr[3] = __hip_atomic_fetch_add(&HIST[eb], 1, __ATOMIC_RELAXED, __HIP_MEMORY_SCOPE_WORKGROUP);
        }
    };
    int nrows = 0;
    for (int mb = gw; mb < NTOK; mb += 4 * NGW) {
        body(xa, ma, mb, nrows); nrows += 2;
        if (mb + 2 * NGW < NTOK) { body(xb, mb_, mb + 2 * NGW, nrows); nrows += 2; }
    }
#undef RT_LOAD
#undef RT_WLOAD
    __syncthreads();
    if (tid < 64) BASE[tid] = __hip_atomic_fetch_add(&A.CNT[tid], HIST[tid], __ATOMIC_RELAXED, __HIP_MEMORY_SCOPE_AGENT);
    __syncthreads();
    if (lane < nrows && gw + lane * NGW < NTOK) {
        const LAS int* rr = RR + (wave_s * 16 + lane) * 6; const int m = gw + lane * NGW;
        A.LIST[(size_t)rr[0] * NTOK + BASE[rr[0]] + rr[1]] = (2 * m) | rr[4];
        A.LIST[(size_t)rr[2] * NTOK + BASE[rr[2]] + rr[3]] = (2 * m + 1) | rr[5];
    }
}

__device__ __forceinline__ void final_phase(float* OUT, const bf16* H1B, const bf16* YEXP, const float* ln_g, const float* ln_b, int gw, int NGW, int lane) {
    unsigned long long hn[4], an[4], bn[4];
#define FIN_LOAD(mm) do { const GAS unsigned long long* hq_ = (const GAS unsigned long long*)(H1B + (size_t)(mm) * DM) + lane; const GAS unsigned long long* y0_ = (const GAS unsigned long long*)(YEXP + (size_t)(2 * (mm)) * DM) + lane; \
        _Pragma("unroll") for (int j_ = 0; j_ < 4; ++j_) { hn[j_] = hq_[64 * j_]; an[j_] = y0_[64 * j_]; bn[j_] = y0_[DM / 4 + 64 * j_]; } } while (0)
    FIN_LOAD(gw < NTOK ? gw : 0);
    for (int m = gw; m < NTOK; m += NGW) {
        GAS f32x4* orow = (GAS f32x4*)(OUT + (size_t)m * DM) + lane;
        unsigned long long hc[4], ac[4], bc[4];
#pragma unroll
        for (int j = 0; j < 4; ++j) { hc[j] = hn[j]; ac[j] = an[j]; bc[j] = bn[j]; }
        { const int mn = (m + NGW < NTOK) ? m + NGW : m; FIN_LOAD(mn); }
        f32x4 v[4]; float s = 0.f;
#pragma unroll
        for (int j = 0; j < 4; ++j) { const unsigned long long hh = hc[j], a0 = ac[j], a1 = bc[j];
            v[j].x = ALPHA_F * bf2f((unsigned short)hh) + bf2f((unsigned short)a0) + bf2f((unsigned short)a1);
            v[j].y = ALPHA_F * bf2f((unsigned short)(hh >> 16)) + bf2f((unsigned short)(a0 >> 16)) + bf2f((unsigned short)(a1 >> 16));
            v[j].z = ALPHA_F * bf2f((unsigned short)(hh >> 32)) + bf2f((unsigned short)(a0 >> 32)) + bf2f((unsigned short)(a1 >> 32));
            v[j].w = ALPHA_F * bf2f((unsigned short)(hh >> 48)) + bf2f((unsigned short)(a0 >> 48)) + bf2f((unsigned short)(a1 >> 48));
            s += (v[j].x + v[j].y) + (v[j].z + v[j].w); }
        const float mean = wave_sum_dpp(s) * (1.f / DM); float s2 = 0.f;
#pragma unroll
        for (int j = 0; j < 4; ++j) { v[j] = v[j] - mean; s2 += (v[j].x * v[j].x + v[j].y * v[j].y) + (v[j].z * v[j].z + v[j].w * v[j].w); }
        const float rstd = 1.f / sqrtf(wave_sum_dpp(s2) * (1.f / DM) + 1e-5f);
#pragma unroll
        for (int j = 0; j < 4; ++j) { const f32x4 g = *((const GAS f32x4*)ln_g + lane + 64 * j), bb = *((const GAS f32x4*)ln_b + lane + 64 * j); orow[64 * j] = v[j] * rstd * g + bb; }
    }
}

#ifndef REPEAT_MASK
#define REPEAT_MASK 0
#endif
#define REPS(k) ((((REPEAT_MASK) >> (k)) & 1) + 1)
__global__ void __launch_bounds__(NTHREADS, 2) fwd_megakernel(MK a) {
    extern __shared__ __attribute__((aligned(16))) unsigned char lds_raw[];
    cg::grid_group grid = cg::this_grid();
    LAS unsigned char* lds = (LAS unsigned char*)lds_raw;
    volatile LAS unsigned* MISC = (volatile LAS unsigned*)(lds + MISC_OFF);
    LAS int* PREF = (LAS int*)(lds + PREF_OFF);
    const int tid = threadIdx.x; const int wave_s = __builtin_amdgcn_readfirstlane(tid >> 6);
    const int G = gridDim.x; const int bx = blockIdx.x; const int vcu = (G % 8 == 0) ? (bx % 8) * (G / 8) + bx / 8 : bx;
    unsigned char* ws = a.ws; const nv::P& p = a.p;
    gu32* ctl = (gu32*)(ws + WS_CTL);
    bf16* WIN = (bf16*)(ws + WS_WIN); bf16* WOUT = (bf16*)(ws + WS_WOUT); bf16* XBF = (bf16*)(ws + WS_A); bf16* PROJ = (bf16*)(ws + WS_B);
    bf16* WGU = (bf16*)(ws + WS_WGU); bf16* WD = (bf16*)(ws + WS_WD); bf16* HID = (bf16*)(ws + WS_A); bf16* H1BF = (bf16*)(ws + WS_H1BF); bf16* YEXP = (bf16*)(ws + WS_YEXP);
    int* LIST = (int*)(ws + WS_LIST); int* EID = (int*)(ws + WS_ROUTE); float* WGT = (float*)(ws + WS_ROUTE + 512 * 1024);
    int* CNT = (int*)(ws + WS_CTL) + CW_CNT;
    for (int u = tid; u < (LDS_BYTES - LDSCTL_OFF) / 4; u += NTHREADS) ((LAS unsigned*)(lds + LDSCTL_OFF))[u] = 0u;
    __syncthreads();
    if (bx == 0) { for (int u = tid; u < XCD_BAR_WORDS + 64; u += NTHREADS) __hip_atomic_store((unsigned*)(ctl + CW_BAR) + u, 0u, RLX_AGENT);
                   for (int u = tid; u < 2048; u += NTHREADS) __hip_atomic_store((unsigned*)(ctl + CW_CNT) + u, 0u, RLX_AGENT); }
    grid.sync();
    XcdBarrier bar = xcd_barrier_post((unsigned*)(ctl + CW_BAR), MISC + 8);
#define FRESH() const int lane = pg8::lane_id_fresh(), wave = wave_s; const int tid_ = wave_s * 64 + lane; const int gtid = (int)blockIdx.x * NTHREADS + tid_, gsize = G * NTHREADS, gw = vcu * NWAVES + wave, NGW = G * NWAVES; (void)lane; (void)gtid; (void)gsize; (void)gw; (void)NGW;

    _Pragma("unroll 1") for (int rep_ = 0; rep_ < REPS(0); ++rep_) {
    {
        FRESH();
        LAS float* scr = (LAS float*)(lds + wave * 16384);
        constexpr int NB = 96, KB = DM / 64;
        for (int it = gw; it < NB * KB; it += NGW) { const int nb = it % NB, kb = it / NB; const int nsrc = nb < 64 ? nb * 32 : 2056 + (nb - 64) * 32, ndst = nb * 32;
            p0_transpose_item(p.w_in, nv::INC, DM, kb * 64, nsrc, WIN, ndst, scr, lane); }
        for (int i = gtid; i < 8 * DM; i += gsize) { const int j = (int)(i / DM), k = (int)(i % DM); WIN[(size_t)(PC_B + j) * DM + k] = (bf16)f2bf(p.w_in[(size_t)k * nv::INC + 2048 + j]); }
        for (int i = gtid; i < (long)(NPROJ - 3080) * DM / 8; i += gsize) *(GAS v4u*)(WIN + (size_t)3080 * DM + i * 8) = (v4u){0u, 0u, 0u, 0u};
        for (int i = gtid; i < (long)NTOK * DM / 8; i += gsize) { const f32x4 v0 = *(const GAS f32x4*)(p.x + i * 8), v1 = *(const GAS f32x4*)(p.x + i * 8 + 4);
            v4u o; o.x = pk2(v0.x, v0.y); o.y = pk2(v0.z, v0.w); o.z = pk2(v1.x, v1.y); o.w = pk2(v1.z, v1.w); *(GAS v4u*)(XBF + i * 8) = o; }
        for (int it = gw; it < 16 * 32; it += NGW) { const int nb = it & 31, kb = it >> 5; p0_transpose_item(p.w_out, DM, DM, kb * 64, nb * 32, WOUT, nb * 32, scr, lane); }
        for (int d = gtid; d < 8 * 8192; d += gsize) { const int g = d >> 13, r = d & 8191, hh = r >> 12, rr = r & 4095, c = rr & 3, ll = (rr >> 2) & 31, jc = rr >> 7, k = 128 * (jc >> 2) + 4 * ll + (jc & 3);
            ((float*)(ws + WS_WREP))[d] = p.w_re[(size_t)k * 64 + g * 8 + 4 * hh + c]; }
    }
    xcd_barrier(bar);
    }
    _Pragma("unroll 1") for (int rep_ = 0; rep_ < REPS(1); ++rep_) {
    {
        if (bx < GEMM_WGS) {
            pg8::DenseOrder S; S.init(XBF, DM, WIN, NTOK, NPROJ, DM, GEMM_WGS, bx);
            pg8::EpiBf16 E{PROJ, NPROJ};
            pg8::gemm_phase<pg8::EpiBf16, pg8::DenseOrder, true>(lds, S, E, nullptr, wave_s);
        } else {
            const int lane = pg8::lane_id_fresh();
            LAS float* scr = (LAS float*)(lds + wave_s * 16384);
            p0_experts(p.w_gate, p.w_up, p.w_down, WGU, WD, scr, (bx - GEMM_WGS) * NWAVES + wave_s, (G - GEMM_WGS) * NWAVES, lane);
        }
    }
    xcd_barrier(bar);
    }
    unsigned char* DNA = (unsigned char*)p.out; unsigned char* DNU = ws + WS_A + 32 * MiB; bf16* ODN = (bf16*)(ws + WS_A);
    _Pragma("unroll 1") for (int rep_ = 0; rep_ < REPS(2); ++rep_) {
    dn_prep_phase<0>(lds, PROJ, p, DNA, DNU, G, vcu, wave_s);
    xcd_barrier(bar);
    }
    _Pragma("unroll 1") for (int rep_ = 0; rep_ < REPS(3); ++rep_) {
    dn_scan_phase(lds, DNA, DNU, ODN, vcu, wave_s);
    xcd_barrier(bar);
    }
    _Pragma("unroll 1") for (int rep_ = 0; rep_ < REPS(5); ++rep_) {
    sgu_phase(lds, PROJ, p, G, vcu, wave_s);
    { FRESH(); dn_final_phase(ODN, PROJ, p.dn_norm_w, gw, NGW, lane); }
    xcd_barrier(bar);
    }
    _Pragma("unroll 1") for (int rep_ = 0; rep_ < REPS(6); ++rep_) {
    {
        pg8::DenseOrder S; S.init(PROJ, NPROJ, WOUT, NTOK, DM, DM, G, bx);
        pg8::EpiBf16 E{(bf16*)(ws + WS_A), DM};
        pg8::gemm_phase<pg8::EpiBf16, pg8::DenseOrder, true>(lds, S, E, nullptr, wave_s);
    }
    xcd_barrier(bar);
    }
    {
        RouterArgs RA{p.x, (const bf16*)(ws + WS_A), p.out, H1BF, EID, WGT, LIST, CNT, p.ln1_g, p.ln1_b, p.w_rg, p.b_rg, (const float*)(ws + WS_WREP), p.b_re};
        router_phase(lds, RA, vcu * NWAVES + wave_s, G * NWAVES, wave_s);
    }
    xcd_barrier(bar);
    if (threadIdx.x == 0) { int s = 0; for (int e = 0; e < NEXP; ++e) { PREF[e] = s; s += ((CNT[e] + 255) >> 8) * 4; } PREF[NEXP] = s; }
    __syncthreads();
    _Pragma("unroll 1") for (int rep_ = 0; rep_ < REPS(7); ++rep_) {
    {
        pg8::GroupedOrder S{H1BF, WGU, LIST, PREF, DM, DM, 1024, NTOK, 1, 4, G, bx, NEXP};
        pg8::EpiHid E{HID, LIST, CNT, NTOK};
        pg8::gemm_phase<pg8::EpiHid, pg8::GroupedOrder, true>(lds, S, E, CNT, wave_s);
    }
    xcd_barrier(bar);
    }
    _Pragma("unroll 1") for (int rep_ = 0; rep_ < REPS(8); ++rep_) {
    {
        pg8::GroupedOrder S{HID, WD, LIST, PREF, DEXP, DEXP, 1024, NTOK, 0, 4, G, bx, NEXP};
        pg8::EpiYexp E{YEXP, LIST, WGT, NTOK};
        pg8::gemm_phase<pg8::EpiYexp, pg8::GroupedOrder, true>(lds, S, E, CNT, wave_s);
    }
    xcd_barrier(bar);
    }
    { FRESH(); final_phase(p.out, H1BF, YEXP, p.ln2_g, p.ln2_b, gw, NGW, lane); }
#if defined(GHOSTPREP)
    xcd_barrier(bar);
    dn_prep_phase<GHOSTPREP>(lds, (const bf16*)(ws + WS_B), p, ws + WS_C, ws + WS_C + 120 * MiB, G, vcu, wave_s);
#endif
#if defined(GHOST6)
    xcd_barrier(bar);
    { RouterArgs RA{p.out, (const bf16*)(ws + WS_A), (float*)(ws + WS_B), (bf16*)(ws + WS_C), (int*)(ws + WS_A), (float*)(ws + WS_A + 1 * MiB), (int*)(ws + WS_A + 2 * MiB), (int*)(ws + WS_CTL) + CW_CNT + 1024, p.ln1_g, p.ln1_b, p.w_rg, p.b_rg, (const float*)(ws + WS_WREP), p.b_re};
      router_phase(lds, RA, vcu * NWAVES + wave_s, G * NWAVES, wave_s); }
#endif
#if defined(GHOST9)
    xcd_barrier(bar);
    { FRESH(); final_phase((float*)(ws + WS_A), H1BF, (const bf16*)(ws + WS_C), p.ln2_g, p.ln2_b, gw, NGW, lane); }
#endif
}

extern "C" void kernel_launch(void* const* d_in, const int* in_sizes, int n_in, void* d_out, int out_size, void* d_ws, size_t ws_size, hipStream_t stream) {
    if (ws_size < WS_END || n_in != 22) { fprintf(stderr, "kernel_launch: bad ws/n_in\n"); return; }
    static int grid_blocks = 0;
    if (!grid_blocks) {
        int dev = 0, cus = 0, per_cu = 0;
        (void)hipGetDevice(&dev);
        (void)hipDeviceGetAttribute(&cus, hipDeviceAttributeMultiprocessorCount, dev);
        (void)hipFuncSetAttribute((const void*)fwd_megakernel, hipFuncAttributeMaxDynamicSharedMemorySize, (int)LDS_BYTES);
        (void)hipOccupancyMaxActiveBlocksPerMultiprocessor(&per_cu, (const void*)fwd_megakernel, NTHREADS, LDS_BYTES);
        if (per_cu < 1) { fprintf(stderr, "kernel_launch: occupancy query says %d\n", per_cu); per_cu = 1; }
        grid_blocks = cus;
    }
    MK a{}; bind(a.p, d_in, (float*)d_out); a.ws = (unsigned char*)d_ws;
    void* args[] = {&a};
    hipError_t e = hipLaunchCooperativeKernel((const void*)fwd_megakernel, dim3(grid_blocks), dim3(NTHREADS), args, LDS_BYTES, stream);
    if (e != hipSuccess) fprintf(stderr, "cooperative launch failed: %s (grid %d)\n", hipGetErrorString(e), grid_blocks);
}
```

```cpp
#include <hip/hip_runtime.h>
#include <hip/hip_cooperative_groups.h>
#include <cstdio>
#include <cstdint>
namespace cg = cooperative_groups;

namespace nv {
constexpr int INC = 3080;
struct P {
    const float *x, *w_in, *conv_w, *a_log, *dt_bias, *dn_norm_w, *sgu_ln_g, *sgu_ln_b, *w_spatial, *b_spatial, *w_out, *ln1_g, *ln1_b,
        *w_rg, *b_rg, *w_re, *b_re, *w_gate, *w_up, *w_down, *ln2_g, *ln2_b;
    float* out;
};
static inline void bind(P& p, void* const* in, float* out) {
    const float** f = (const float**)&p.x; for (int i = 0; i < 22; ++i) f[i] = (const float*)in[i];
    p.out = out;
}
}
namespace pg8 {
#define PG8_LAS __attribute__((address_space(3)))
typedef unsigned short bf16_t;
typedef short bf16x8 __attribute__((ext_vector_type(8)));
typedef float f32x4 __attribute__((ext_vector_type(4)));
typedef unsigned u32x4 __attribute__((ext_vector_type(4)));
typedef unsigned u32x2 __attribute__((ext_vector_type(2)));
constexpr int BM = 256, BK = 64, HALF = 128, HTB = HALF * BK * 2  , STAGE_BYTES = 8 * HTB, NXCD = 8, WGM = 4;

__host__ __device__ __forceinline__ int lds_byte(int r, int c) { const int st = (r >> 4) * 2 + (c >> 5), rr = r & 15, cc = c & 31, ob = rr * 64 + cc * 2; return st * 1024 + (ob ^ (((ob >> 9) & 1) << 5)); }
__host__ __device__ __forceinline__ void stage_rc(int b, int& R, int& C) { const int st = b / 1024, sb = b % 1024, swz = sb ^ (((sb >> 9) & 1) << 5); R = (st >> 1) * 16 + swz / 64; C = (st & 1) * 32 + (swz % 64) / 2; }
__host__ __device__ __forceinline__ int perm32(int rho) { const int n = rho >> 4, i = rho & 15; return 8 * (i >> 2) + 4 * n + (i & 3); }

struct Unit { int pm, pn, e, rows; };

typedef float f32x2_t __attribute__((ext_vector_type(2))); typedef __bf16 bf16x2_t __attribute__((ext_vector_type(2)));
__device__ __forceinline__ unsigned cvt_pk_bf16(float lo, float hi) { const f32x2_t v = {lo, hi}; const bf16x2_t b = __builtin_convertvector(v, bf16x2_t); return __builtin_bit_cast(unsigned, b); }

__device__ __forceinline__ int lane_id_fresh() { int l; asm volatile("v_mbcnt_lo_u32_b32 %0, -1, 0\n\tv_mbcnt_hi_u32_b32 %0, -1, %0" : "=v"(l)); return l; }
__device__ __forceinline__ int xcd_remap(int L, int nwg) { const int q = nwg / NXCD, r = nwg % NXCD, xcd = L % NXCD, off = L / NXCD; return (xcd < r ? xcd * (q + 1) : r * (q + 1) + (xcd - r) * q) + off; }

struct DenseOrder {
    const bf16_t* A; const bf16_t* Bt; int lda, K; int nM, nN, nwg, G, c;
    static constexpr bool GATHER = false;
    __device__ void init(const bf16_t* A_, int lda_, const bf16_t* Bt_, int M, int N, int K_, int G_, int c_) { A = A_; Bt = Bt_; lda = lda_; K = K_; nM = M / BM; nN = N / BM; nwg = nM * nN; G = G_; c = c_; }
    __device__ bool next(int i, Unit& u) const {
        const long L = (long)i * G + c; if (L >= nwg) return false;
        const int wgid = xcd_remap((int)L, nwg);
        const int nig = WGM * nN, gid = wgid / nig, fm = gid * WGM, gsz = (nM - fm) < WGM ? (nM - fm) : WGM;
        u.pm = fm + ((wgid % nig) % gsz); u.pn = (wgid % nig) / gsz; u.e = 0; u.rows = BM; return true;
    }
    __device__ __forceinline__ const char* a_base(const Unit& u) const { return (const char*)A + (size_t)u.pm * BM * lda * 2; }
    __device__ __forceinline__ const char* b_base(const Unit& u) const { return (const char*)Bt + (size_t)u.pn * BM * K * 2; }
    __device__ __forceinline__ void a_off(const Unit&, const int (&R)[2], const int (&C)[2], unsigned (&v)[4]) const {
#pragma unroll
        for (int h = 0; h < 2; ++h)
#pragma unroll
            for (int i = 0; i < 2; ++i) v[h * 2 + i] = (unsigned)((h * HALF + R[i]) * lda + C[i]) * 2u;
    }
};

struct GroupedOrder {
    const bf16_t* A; const bf16_t* Bt; const int* list; const PG8_LAS int* pref;
    int lda, K, N, cap, ashift, nN, G, c, ne;
    static constexpr bool GATHER = true;
    __device__ bool next(int i, Unit& u) const {
        const int nwg = pref[ne]; const long L = (long)i * G + c; if (L >= nwg) return false;
        const int w = xcd_remap((int)L, nwg);
        int e = u.e; while (pref[e + 1] <= w) ++e;
        const int j = w - pref[e], ntm = (pref[e + 1] - pref[e]) / nN;
        u.e = e; u.pm = j % ntm; u.pn = j / ntm; u.rows = 0; return true;
    }
    __device__ __forceinline__ int count(int e) const { return __builtin_amdgcn_readfirstlane(pref[128 + e]); }
    __device__ __forceinline__ const char* a_base(const Unit&) const { return (const char*)A; }
    __device__ __forceinline__ const char* b_base(const Unit& u) const { return (const char*)Bt + ((size_t)u.e * N + (size_t)u.pn * BM) * K * 2; }
    __device__ __forceinline__ void a_off(const Unit& u, const int (&R)[2], const int (&C)[2], unsigned (&v)[4], int cnt) const {
        const int* lp = list + (size_t)u.e * cap;
#pragma unroll
        for (int h = 0; h < 2; ++h)
#pragma unroll
            for (int i = 0; i < 2; ++i) { int r = u.pm * BM + h * HALF + R[i]; if (r >= cnt) r = 0;
                const int a = ashift < 0 ? pref[192 + u.e] + r : ((lp[r] & 0xffff) >> ashift);
                v[h * 2 + i] = (unsigned)(a * lda + C[i]) * 2u; }
    }
};

template <class Epi, class Sched, bool ALIGN_EPI>
__device__ __forceinline__ void gemm_phase(PG8_LAS unsigned char* lds, const Sched& S, const Epi& E, const int* gcnt, const int wave_s) {
    const int tid_ = wave_s * 64 + lane_id_fresh();
    const int tid = tid_, wid = wave_s, lane = tid & 63, wr = wid >> 2, wc = wid & 3, fr = lane & 15, fq = lane >> 4;
    const int K = S.K, nt = K / BK;
    int Rr[2], Cc[2]; unsigned voffB[2];
#pragma unroll
    for (int i = 0; i < 2; ++i) { int R, C; stage_rc(tid * 16 + i * 8192, R, C); const int Rb = Epi::PERM ? ((R & ~31) + perm32(R & 31)) : R; Rr[i] = R; Cc[i] = C; voffB[i] = (unsigned)(Rb * K + C) * 2u; }
    const size_t kstep = (size_t)(BK * 2);
    const size_t hstep = (size_t)HALF * K * 2;
    const unsigned ldsw = (unsigned)wid * 1024u;
    const int aoff = lds_byte(wr * 64 + fr, fq * 8), boff = lds_byte(wc * 32 + fr, fq * 8);
#define PG8_SA(b, h) (((b) * 2 + (h)) * HTB)
#define PG8_SB(b, h) ((4 + (b) * 2 + (h)) * HTB)
#define PG8_STAGE(bufoff, gbase, v0, v1) do { \
        __builtin_amdgcn_global_load_lds((const unsigned*)((const char*)(gbase) + (v0)), (PG8_LAS unsigned*)(lds + (bufoff) + ldsw), 16, 0, 0); \
        __builtin_amdgcn_global_load_lds((const unsigned*)((const char*)(gbase) + (v1)), (PG8_LAS unsigned*)(lds + (bufoff) + ldsw + 8192), 16, 0, 0); } while (0)
#define PG8_STAGEB(bufoff, gbase) PG8_STAGE(bufoff, gbase, voffB[0], voffB[1])
#define PG8_LDA(dst, b, h) do { _Pragma("unroll") for (int m = 0; m < 4; ++m) _Pragma("unroll") for (int k = 0; k < 2; ++k) dst[m][k] = *(const PG8_LAS bf16x8*)(lds + PG8_SA(b, h) + aoff + m * 2048 + k * 1024); } while (0)
#define PG8_LDB(dst, b, h) do { _Pragma("unroll") for (int n = 0; n < 2; ++n) _Pragma("unroll") for (int k = 0; k < 2; ++k) dst[n][k] = *(const PG8_LAS bf16x8*)(lds + PG8_SB(b, h) + boff + n * 2048 + k * 1024); } while (0)
#define PG8_MMA(ai, bj, At, Bt) do { __builtin_amdgcn_s_setprio(1); _Pragma("unroll") for (int m = 0; m < 4; ++m) _Pragma("unroll") for (int n = 0; n < 2; ++n) _Pragma("unroll") for (int k = 0; k < 2; ++k) \
        acc[ai][bj][m][n] = __builtin_amdgcn_mfma_f32_16x16x32_bf16(Bt[n][k], At[m][k], acc[ai][bj][m][n], 0, 0, 0); __builtin_amdgcn_s_setprio(0); } while (0)
#define PG8_WAIT_V(n) asm volatile("s_waitcnt vmcnt(" #n ")" ::: "memory")
#define PG8_WAIT_L(n) asm volatile("s_waitcnt lgkmcnt(" #n ")" ::: "memory")
#define PG8_BAR __builtin_amdgcn_s_barrier()
#define PG8_SCHED __builtin_amdgcn_sched_barrier(0)
    Unit cur, nxt; int ui = 0;
    cur.e = 0;
    if (!S.next(0, cur)) return;
    int ccnt = BM * 1024, ncnt = BM * 1024;
    if constexpr (Sched::GATHER) { ccnt = S.count(cur.e); }
    cur.rows = ccnt - cur.pm * BM;
    f32x4 acc[2][2][4][2];
#pragma unroll
    for (int a = 0; a < 2; ++a)
#pragma unroll
        for (int b = 0; b < 2; ++b)
#pragma unroll
            for (int m = 0; m < 4; ++m)
#pragma unroll
                for (int n = 0; n < 2; ++n) acc[a][b][m][n] = (f32x4){0.f, 0.f, 0.f, 0.f};
    bf16x8 At[4][2], B0[2][2], B1[2][2];
    unsigned va[4], vn[4];
    if constexpr (Sched::GATHER) S.a_off(cur, Rr, Cc, va, ccnt); else S.a_off(cur, Rr, Cc, va);
    const char* cA = S.a_base(cur); const char* cB = S.b_base(cur);
    PG8_STAGEB(PG8_SB(0, 0), cB); PG8_STAGEB(PG8_SB(0, 1), cB + hstep); PG8_STAGE(PG8_SA(0, 0), cA, va[0], va[1]); PG8_STAGE(PG8_SA(0, 1), cA, va[2], va[3]);
    if (wr == 1) PG8_BAR;
    PG8_WAIT_V(2); PG8_BAR;
    PG8_STAGEB(PG8_SB(1, 0), cB + kstep); PG8_STAGE(PG8_SA(1, 0), cA + kstep, va[0], va[1]); PG8_STAGEB(PG8_SB(1, 1), cB + hstep + kstep);
    PG8_WAIT_V(6); PG8_BAR;
    for (;;) {
        nxt.e = cur.e;
        const bool has_next = S.next(ui + 1, nxt);
        const char* nA = cA; const char* nB = cB;
#pragma unroll
        for (int j = 0; j < 4; ++j) vn[j] = va[j];
        if (has_next) {
            nA = S.a_base(nxt); nB = S.b_base(nxt);
            if constexpr (Sched::GATHER) { ncnt = S.count(nxt.e); S.a_off(nxt, Rr, Cc, vn, ncnt); } else S.a_off(nxt, Rr, Cc, vn);
            nxt.rows = ncnt - nxt.pm * BM;
        }
        for (int t = 0; t < nt; t += 2) {
            const bool last = (t == nt - 2);
            const char* a1 = cA + (size_t)(t + 1) * kstep;
            const char* a2 = last ? nA : cA + (size_t)(t + 2) * kstep; const char* b2 = last ? nB : cB + (size_t)(t + 2) * kstep;
            const char* a3 = a2 + kstep; const char* b3 = b2 + kstep;
            unsigned w0 = va[0], w1 = va[1], w2 = va[2], w3 = va[3];
            if (last) { w0 = vn[0]; w1 = vn[1]; w2 = vn[2]; w3 = vn[3]; }
            PG8_LDB(B0, 0, 0); PG8_LDB(B1, 0, 1); PG8_SCHED; PG8_LDA(At, 0, 0); PG8_STAGE(PG8_SA(1, 1), a1, va[2], va[3]);
            PG8_WAIT_V(8); PG8_WAIT_L(0); PG8_BAR; PG8_MMA(0, 0, At, B0); PG8_MMA(0, 1, At, B1); PG8_BAR; PG8_SCHED;
            PG8_LDA(At, 0, 1); PG8_STAGEB(PG8_SB(0, 0), b2); PG8_STAGEB(PG8_SB(0, 1), b2 + hstep); PG8_STAGE(PG8_SA(0, 0), a2, w0, w1);
            PG8_WAIT_V(8); PG8_WAIT_L(0); PG8_BAR; PG8_MMA(1, 0, At, B0); PG8_MMA(1, 1, At, B1); PG8_BAR; PG8_SCHED;
            PG8_LDB(B0, 1, 0); PG8_LDB(B1, 1, 1); PG8_SCHED; PG8_LDA(At, 1, 0); PG8_STAGE(PG8_SA(0, 1), a2, w2, w3);
            PG8_WAIT_V(8); PG8_WAIT_L(0); PG8_BAR; PG8_MMA(0, 0, At, B0); PG8_MMA(0, 1, At, B1); PG8_BAR; PG8_SCHED;
            PG8_LDA(At, 1, 1); PG8_STAGEB(PG8_SB(1, 0), b3); PG8_STAGEB(PG8_SB(1, 1), b3 + hstep); PG8_STAGE(PG8_SA(1, 0), a3, w0, w1);
            PG8_WAIT_V(8); PG8_WAIT_L(0); PG8_BAR; PG8_MMA(1, 0, At, B0); PG8_MMA(1, 1, At, B1); PG8_BAR; PG8_SCHED;
        }
        if constexpr (ALIGN_EPI) { if (wr == 0) PG8_BAR; }
        E(acc, cur, wr, wc, fr, fq);
        if (!has_next) break;
#pragma unroll
        for (int a = 0; a < 2; ++a)
#pragma unroll
            for (int b = 0; b < 2; ++b)
#pragma unroll
                for (int m = 0; m < 4; ++m)
#pragma unroll
                    for (int n = 0; n < 2; ++n) acc[a][b][m][n] = (f32x4){0.f, 0.f, 0.f, 0.f};
        cur = nxt; cA = nA; cB = nB; ++ui;
#pragma unroll
        for (int j = 0; j < 4; ++j) va[j] = vn[j];
        if constexpr (ALIGN_EPI) { if (wr == 1) PG8_BAR; }
    }
    PG8_WAIT_V(0);
    if constexpr (!ALIGN_EPI) { if (wr == 0) PG8_BAR; }
    PG8_BAR;
#undef PG8_SA
#undef PG8_SB
#undef PG8_STAGE
#undef PG8_STAGEB
#undef PG8_LDA
#undef PG8_LDB
#undef PG8_MMA
#undef PG8_WAIT_V
#undef PG8_WAIT_L
#undef PG8_BAR
#undef PG8_SCHED
}

struct EpiBf16 {
    static constexpr bool PERM = true;
    bf16_t* O; int ldc;
    __device__ __forceinline__ void operator()(const f32x4 (&acc)[2][2][4][2], const Unit& u, int wr, int wc, int fr, int fq) const {
        const int row0 = u.pm * BM + wr * 64 + fr, col0 = u.pn * BM + wc * 32 + 8 * fq;
#pragma unroll
        for (int ai = 0; ai < 2; ++ai)
#pragma unroll
            for (int m = 0; m < 4; ++m) { bf16_t* rowp = O + (size_t)(row0 + ai * HALF + m * 16) * ldc + col0;
#pragma unroll
                for (int bj = 0; bj < 2; ++bj) { const f32x4 v0 = acc[ai][bj][m][0], v1 = acc[ai][bj][m][1];
                    u32x4 w; w.x = cvt_pk_bf16(v0[0], v0[1]); w.y = cvt_pk_bf16(v0[2], v0[3]); w.z = cvt_pk_bf16(v1[0], v1[1]); w.w = cvt_pk_bf16(v1[2], v1[3]);
                    *(u32x4*)(rowp + bj * HALF) = w; } }
    }
};
}
#define GAS __attribute__((address_space(1)))
#define LAS __attribute__((address_space(3)))
typedef unsigned short bf16;
typedef unsigned v4u __attribute__((ext_vector_type(4)));
typedef float f32x4 __attribute__((ext_vector_type(4)));
typedef short bf16x8 __attribute__((ext_vector_type(8)));
typedef GAS unsigned gu32;
typedef GAS unsigned long long gu64;
#define RLX_AGENT __ATOMIC_RELAXED, __HIP_MEMORY_SCOPE_AGENT
#define LDS_WAIT() asm volatile("s_waitcnt lgkmcnt(0)" ::: "memory")
#define VM_WAIT() asm volatile("s_waitcnt vmcnt(0)" ::: "memory")
__device__ __forceinline__ unsigned long long rt() { return __builtin_amdgcn_s_memrealtime(); }
__device__ __forceinline__ unsigned f2bf(float f) { unsigned u = __builtin_bit_cast(unsigned, f); return (u + 0x7fffu + ((u >> 16) & 1u)) >> 16; }
__device__ __forceinline__ unsigned pk2(float lo, float hi) { return f2bf(lo) | (f2bf(hi) << 16); }

#define XB_TMO      128
#define XB_XCNT(j)  (256  + 64 * (j))
#define XB_XSUB(j)  (1280 + 64 * (j))
#define XB_XGEN(j)  (2304 + 64 * (j))
#define XB_TOP      3328
#define XB_TOPGEN   3392
#define XCD_BAR_WORDS 3456
#define XB_SPIN_CAP (1u << 18)

__device__ __forceinline__ unsigned xb_ld(unsigned* p)              { return __hip_atomic_load(p, __ATOMIC_RELAXED, __HIP_MEMORY_SCOPE_AGENT); }
__device__ __forceinline__ unsigned xb_add(unsigned* p, unsigned v) { return __hip_atomic_fetch_add(p, v, __ATOMIC_RELAXED, __HIP_MEMORY_SCOPE_AGENT); }
__device__ __forceinline__ unsigned xb_xcc_id() { return (unsigned)__builtin_amdgcn_s_getreg((3 << 11) | 20) & 0xFu; }
#define XB_SPIN(cond, bar) do { unsigned _sp = 0; while (cond) { __builtin_amdgcn_s_sleep(1); \
    if ((++_sp & 255u) == 0u) { if (xb_ld(&(bar)[XB_TMO])) break; if (_sp > XB_SPIN_CAP) { atomicAdd(&(bar)[XB_TMO], 1u); break; } } } } while (0)

struct XcdBarrier {
    unsigned* bar; unsigned x;
    volatile LAS unsigned* st;
};

__device__ __forceinline__ XcdBarrier xcd_barrier_post(unsigned* bar, volatile LAS unsigned* st) {
    XcdBarrier b; b.bar = bar; b.x = xb_xcc_id(); b.st = st;
    if (threadIdx.x == 0) (void)xb_add(&bar[XB_XCNT(b.x)], 1u);
    return b;
}
__device__ __forceinline__ void xcd_barrier_complete(unsigned* bar, unsigned x, unsigned& nloc, unsigned& nx) {
    const unsigned G = gridDim.x * gridDim.y * gridDim.z;
    unsigned sum, cnt, mine, sp = 0u;
    for (;;) {
        sum = 0u; cnt = 0u; mine = 0u;
#pragma unroll
        for (unsigned j = 0; j < 16; ++j) { const unsigned c = xb_ld(&bar[XB_XCNT(j)]); sum += c; cnt += (c > 0u) ? 1u : 0u; mine = (j == x) ? c : mine; }
        if (sum == G) break;
        __builtin_amdgcn_s_sleep(1);
        if ((++sp & 255u) == 0u) { if (xb_ld(&bar[XB_TMO])) break; if (sp > XB_SPIN_CAP) { atomicAdd(&bar[XB_TMO], 1u); break; } }
    }
    nloc = mine > 0u ? mine : 1u; nx = cnt > 0u ? cnt : 1u;
}

__device__ __forceinline__ void xcd_barrier(const XcdBarrier& b) {
    asm volatile("s_waitcnt vmcnt(0)" ::: "memory");
    __syncthreads();
    if (threadIdx.x == 0) {
        unsigned* bar = b.bar;
        __builtin_amdgcn_s_waitcnt(0);
        unsigned nloc = b.st[0], nx = b.st[1];
        if (nloc == 0u) { xcd_barrier_complete(bar, b.x, nloc, nx); b.st[0] = nloc; b.st[1] = nx; }
        const unsigned old = xb_add(&bar[XB_XSUB(b.x)], 1u);
        const unsigned gen = old / nloc;
        if (old + 1u == (gen + 1u) * nloc) {
            __builtin_amdgcn_fence(__ATOMIC_RELEASE, "agent");
            asm volatile("s_waitcnt vmcnt(0)" ::: "memory");
            const unsigned og = xb_add(&bar[XB_TOP], 1u);
            const unsigned tg = og / nx;
            if (og + 1u == (tg + 1u) * nx) xb_add(&bar[XB_TOPGEN], 1u);
            else XB_SPIN(xb_ld(&bar[XB_TOPGEN]) == tg, bar);
            __builtin_amdgcn_fence(__ATOMIC_ACQUIRE, "agent");
            xb_add(&bar[XB_XGEN(b.x)], 1u);
            asm volatile("s_waitcnt vmcnt(0)" ::: "memory");
        } else {
            XB_SPIN(xb_ld(&bar[XB_XGEN(b.x)]) == gen, bar);
            __builtin_amdgcn_fence(__ATOMIC_ACQUIRE, "agent");
            asm volatile("s_waitcnt vmcnt(0)" ::: "memory");
        }
    }
    __syncthreads();
}

constexpr int NTOK = 32768, DM = 1024, NPROJ = 3328;
constexpr int PC_Q = 0, PC_K = 512, PC_V = 1024, PC_Z = 1536, PC_U = 2048, PC_VS = 2560, PC_B = 3072, PC_A = 3076;
constexpr int NEXP = 64, DEXP = 512;
constexpr size_t MiB = 1u << 20;
constexpr size_t WS_CTL = 0, CTL_ZERO_BYTES = 1 * MiB;
constexpr size_t WS_WIN = 1 * MiB, WS_WOUT = 8 * MiB, WS_LIST = 10 * MiB, WS_ROUTE = 18 * MiB;
constexpr size_t WS_WREP = 19 * MiB;
constexpr size_t WS_C = 20 * MiB;
constexpr size_t WS_WGU = WS_C, WS_WD = WS_C + 128 * MiB;
constexpr size_t WS_A = 212 * MiB;
constexpr size_t WS_B = 276 * MiB;
constexpr size_t WS_H1BF = WS_B, WS_YEXP = WS_B + 64 * MiB;
constexpr size_t WS_END = 484 * MiB;
constexpr int CW_BAR = 4096;
constexpr int CW_CNT = 16384;
constexpr int RING_BYTES = 131072, LDSCTL_OFF = RING_BYTES, MISC_OFF = LDSCTL_OFF + 320, PREF_OFF = MISC_OFF + 128, LDS_BYTES = 147456;
constexpr int NTHREADS = 512, NWAVES = 8;
#ifndef CONV_SG
#define CONV_SG 54
#endif
#ifndef GEMM_WGS_N
#define GEMM_WGS_N 192
#endif
constexpr int GEMM_WGS = GEMM_WGS_N;
constexpr float ALPHA_F = 1.189207115002721f;

__device__ __forceinline__ float bf2f(unsigned short v) { return __builtin_bit_cast(float, (unsigned)v << 16); }
__device__ __forceinline__ float wave_sum(float v) {
#pragma unroll
    for (int o = 1; o < 64; o <<= 1) v += __shfl_xor(v, o);
    return v;
}

__device__ __forceinline__ void p0_item_load(const float* W, int ldw, int k0, int n0src, int lane, float (&r)[32]) {
#pragma unroll
    for (int i = 0; i < 32; ++i) r[i] = W[(size_t)(k0 + 2 * i + (lane >> 5)) * ldw + n0src + (lane & 31)];
}
__device__ __forceinline__ void p0_item_store(const float (&r)[32], int K, int k0, bf16* WT, int dst_row0, LAS float* scr, int lane) {
#pragma unroll
    for (int i = 0; i < 32; ++i) scr[(2 * i + (lane >> 5)) * 33 + (lane & 31)] = r[i];
    LDS_WAIT(); asm volatile("" ::: "memory");
    const int c = lane & 7;
#pragma unroll
    for (int j = 0; j < 4; ++j) { const int n = (lane >> 3) + 8 * j; const LAS float* s = scr + (8 * c) * 33 + n;
        v4u o; o.x = pg8::cvt_pk_bf16(s[0 * 33], s[1 * 33]); o.y = pg8::cvt_pk_bf16(s[2 * 33], s[3 * 33]); o.z = pg8::cvt_pk_bf16(s[4 * 33], s[5 * 33]); o.w = pg8::cvt_pk_bf16(s[6 * 33], s[7 * 33]);
        *(GAS v4u*)(WT + (size_t)(dst_row0 + n) * K + k0 + 8 * c) = o; }
    LDS_WAIT(); asm volatile("" ::: "memory");
}
__device__ __forceinline__ void p0_transpose_item(const float* W, int ldw, int K, int k0, int n0src, bf16* WT, int dst_row0, LAS float* scr, int lane) {
    float r[32]; p0_item_load(W, ldw, k0, n0src, lane, r); p0_item_store(r, K, k0, WT, dst_row0, scr, lane);
}
struct P0Exp { const float* W; bf16* WT; int ldw, K, k0, n0, drow; };
__device__ __forceinline__ P0Exp p0_exp_item(int it, const float* wg, const float* wu, const float* wd, bf16* WGU, bf16* WD) {
    P0Exp x;
    if (it < 32768) { const int nb = it & 15, kb = (it >> 4) & 15, half = (it >> 8) & 1, e = it >> 9, n0 = nb * 32;
        x.W = (half ? wu : wg) + (size_t)e * DM * DEXP; x.WT = WGU + (size_t)e * 1024 * DM; x.ldw = DEXP; x.K = DM; x.k0 = kb * 64; x.n0 = n0; x.drow = (n0 >> 7) * 256 + half * 128 + (n0 & 127); }
    else { const int i2 = it - 32768, nb = i2 & 31, kb = (i2 >> 5) & 7, e = i2 >> 8;
        x.W = wd + (size_t)e * DEXP * DM; x.WT = WD + (size_t)e * DM * DEXP; x.ldw = DM; x.K = DEXP; x.k0 = kb * 64; x.n0 = nb * 32; x.drow = nb * 32; }
    return x;
}
__device__ __forceinline__ void p0_item_load4(const float* W, int ldw, int k0, int n0src, int lane, f32x4 (&r)[8]) {
#pragma unroll
    for (int i = 0; i < 8; ++i) r[i] = *(const GAS f32x4*)(W + (size_t)(k0 + (lane >> 3) + 8 * i) * ldw + n0src + 4 * (lane & 7));
}
__device__ __forceinline__ void p0_item_store4(const f32x4 (&r)[8], int K, int k0, bf16* WT, int dst_row0, LAS float* scr, int lane) {
#pragma unroll
    for (int i = 0; i < 8; ++i) { LAS float* d = scr + ((lane >> 3) + 8 * i) * 33 + 4 * (lane & 7); d[0] = r[i].x; d[1] = r[i].y; d[2] = r[i].z; d[3] = r[i].w; }
    LDS_WAIT(); asm volatile("" ::: "memory");
    const int c = lane & 7;
#pragma unroll
    for (int j = 0; j < 4; ++j) { const int n = (lane >> 3) + 8 * j; const LAS float* s = scr + (8 * c) * 33 + n;
        v4u o; o.x = pg8::cvt_pk_bf16(s[0 * 33], s[1 * 33]); o.y = pg8::cvt_pk_bf16(s[2 * 33], s[3 * 33]); o.z = pg8::cvt_pk_bf16(s[4 * 33], s[5 * 33]); o.w = pg8::cvt_pk_bf16(s[6 * 33], s[7 * 33]);
        __builtin_nontemporal_store(o, (GAS v4u*)(WT + (size_t)(dst_row0 + n) * K + k0 + 8 * c)); }
    LDS_WAIT(); asm volatile("" ::: "memory");
}
__device__ __forceinline__ void p0_experts(const float* wg, const float* wu, const float* wd, bf16* WGU, bf16* WD, LAS float* scr, int it0, int stride, int last, int lane) {
    f32x4 A[8], B[8], C[8], D[8];
#define P0_LOAD(buf, item) do { if ((item) < last) { const P0Exp x_ = p0_exp_item((item), wg, wu, wd, WGU, WD); p0_item_load4(x_.W, x_.ldw, x_.k0, x_.n0, lane, buf); } } while (0)
#define P0_STORE(buf, item) do { if ((item) < last) { const P0Exp x_ = p0_exp_item((item), wg, wu, wd, WGU, WD); p0_item_store4(buf, x_.K, x_.k0, x_.WT, x_.drow, scr, lane); } } while (0)
    int it = it0;
    P0_LOAD(A, it); P0_LOAD(B, it + stride); P0_LOAD(C, it + 2 * stride);
    for (; it < last; it += 4 * stride) {
        P0_LOAD(D, it + 3 * stride); P0_STORE(A, it);
        P0_LOAD(A, it + 4 * stride); P0_STORE(B, it + stride);
        P0_LOAD(B, it + 5 * stride); P0_STORE(C, it + 2 * stride);
        P0_LOAD(C, it + 6 * stride); P0_STORE(D, it + 3 * stride);
    }
#undef P0_LOAD
#undef P0_STORE
}

struct MK {
    nv::P p;
    unsigned char* ws;
};

namespace pg8 {
__device__ __forceinline__ float silu_f(float x) { return x * __builtin_amdgcn_rcpf(1.f + __builtin_amdgcn_exp2f(-1.4426950408889634f * x)); }
struct EpiHid {
    static constexpr bool PERM = true;
    bf16_t* HID; const int* list; const int* cnt; int cap; const PG8_LAS int* pref;
    __device__ __forceinline__ void operator()(const f32x4 (&acc)[2][2][4][2], const Unit& u, int wr, int wc, int fr, int fq) const {
        const int rbase = pref[192 + u.e]; const int col0 = u.pn * 128 + wc * 32 + 8 * fq;
#pragma unroll
        for (int ai = 0; ai < 2; ++ai)
#pragma unroll
            for (int m = 0; m < 4; ++m) { const int r = ai * HALF + wr * 64 + m * 16 + fr;
                if (r < u.rows) { const int a = rbase + u.pm * BM + r;
                    const f32x4 g0 = acc[ai][0][m][0], g1 = acc[ai][0][m][1], u0 = acc[ai][1][m][0], u1 = acc[ai][1][m][1];
                    u32x4 w; w.x = cvt_pk_bf16(silu_f(g0[0]) * u0[0], silu_f(g0[1]) * u0[1]); w.y = cvt_pk_bf16(silu_f(g0[2]) * u0[2], silu_f(g0[3]) * u0[3]);
                    w.z = cvt_pk_bf16(silu_f(g1[0]) * u1[0], silu_f(g1[1]) * u1[1]); w.w = cvt_pk_bf16(silu_f(g1[2]) * u1[2], silu_f(g1[3]) * u1[3]);
                    *(u32x4*)(HID + (size_t)a * 512 + col0) = w; } }
    }
};
struct EpiYexp {
    static constexpr bool PERM = true;
    bf16_t* Y; const int* list; const float* wgt; int cap;
    __device__ __forceinline__ void operator()(const f32x4 (&acc)[2][2][4][2], const Unit& u, int wr, int wc, int fr, int fq) const {
        const int* lp = list + (size_t)u.e * cap; const int col0 = u.pn * BM + wc * 32 + 8 * fq;
#pragma unroll
        for (int ai = 0; ai < 2; ++ai)
#pragma unroll
            for (int m = 0; m < 4; ++m) { const int r = ai * HALF + wr * 64 + m * 16 + fr;
                if (r < u.rows) { const unsigned ent = (unsigned)lp[u.pm * BM + r]; const int a = (int)(ent & 0xffffu); const float w8 = __builtin_bit_cast(float, ent & 0xffff0000u);
#pragma unroll
                    for (int bj = 0; bj < 2; ++bj) { const f32x4 v0 = acc[ai][bj][m][0] * w8, v1 = acc[ai][bj][m][1] * w8;
                        u32x4 w; w.x = cvt_pk_bf16(v0[0], v0[1]); w.y = cvt_pk_bf16(v0[2], v0[3]); w.z = cvt_pk_bf16(v1[0], v1[1]); w.w = cvt_pk_bf16(v1[2], v1[3]);
                        *(u32x4*)(Y + (size_t)a * 1024 + col0 + bj * HALF) = w; } } }
    }
};

struct EpiZ1 {
    static constexpr bool PERM = false;
    float* O; const float* X; float alpha;
    __device__ __forceinline__ void operator()(const f32x4 (&acc)[2][2][4][2], const Unit& u, int wr, int wc, int fr, int fq) const {
        const int row0 = u.pm * BM + wr * 64 + fr, col0 = u.pn * BM + wc * 32 + 4 * fq;
#pragma unroll
        for (int ai = 0; ai < 2; ++ai)
#pragma unroll
            for (int m = 0; m < 4; ++m) { const size_t off = (size_t)(row0 + ai * HALF + m * 16) * 1024 + col0;
#pragma unroll
                for (int bj = 0; bj < 2; ++bj)
#pragma unroll
                    for (int n = 0; n < 2; ++n) { const f32x4 xv = *(const f32x4*)(X + off + bj * HALF + n * 16); *(f32x4*)(O + off + bj * HALF + n * 16) = acc[ai][bj][m][n] + xv * alpha; } }
    }
};
}


typedef short s16x4 __attribute__((ext_vector_type(4)));
typedef short v4i16_t __attribute__((ext_vector_type(4)));
__device__ __forceinline__ unsigned off_b(unsigned row, unsigned ch) { return 256u * row + 16u * (ch ^ (((row & 3) << 2) | ((row >> 2) & 3))); }
__device__ __forceinline__ s16x4 vtr(LAS unsigned char* p) { return __builtin_bit_cast(s16x4, __builtin_amdgcn_ds_read_tr16_b64_v4i16((LAS v4i16_t*)p)); }
__device__ __forceinline__ float gelu_tanh(float x) { return x * __builtin_amdgcn_rcpf(1.f + __builtin_amdgcn_exp2f(-2.3022081986f * (x + 0.044715f * x * x * x))); }

__device__ __forceinline__ void sgu_phase(LAS unsigned char* lds, bf16* PROJ, const nv::P& p, int G, int vcu, int wave_s) {
    const int lane = pg8::lane_id_fresh(), tid = wave_s * 64 + lane;
    const int g4 = lane >> 4, q = (lane & 15) >> 2, pp = lane & 3, l15 = lane & 15;
    LAS float* LNP = (LAS float*)(lds + 40960);
    LNP[tid] = p.sgu_ln_g[tid]; LNP[512 + tid] = p.sgu_ln_b[tid];
    v4u rawn[4];
    { const int u0 = vcu < 1024 ? vcu : 0; const bf16* src = PROJ + ((size_t)(u0 >> 2) * 128 + (tid >> 2)) * NPROJ + PC_VS + (u0 & 3) * 128 + (tid & 3) * 32;
#pragma unroll
      for (int i = 0; i < 4; ++i) rawn[i] = *(const GAS v4u*)(src + 8 * i); }
    __syncthreads();
    for (int u = vcu; u < 1024; u += G) {
        const int g = u & 3, bc = u >> 2; const size_t row0 = (size_t)bc * 128;
        const int w = wave_s, t = 16 * w + l15, nks = (w >> 1) + 1;
        bf16* rowp = PROJ + (row0 + t) * NPROJ;
        unsigned long long uu8[8];
#pragma unroll
        for (int dt = 0; dt < 8; ++dt) uu8[dt] = *(const GAS unsigned long long*)(rowp + PC_U + g * 128 + 16 * dt + 4 * g4);
        f32x4 wq[4][2];
#pragma unroll
        for (int ks = 0; ks < 4; ++ks) { const float* wp = p.w_spatial + ((size_t)(g * 128 + t)) * 128 + 32 * ks + 8 * g4; wq[ks][0] = *(const GAS f32x4*)wp; wq[ks][1] = *(const GAS f32x4*)(wp + 4); }
        const float bias = p.b_spatial[g * 128 + t];
        asm volatile("" ::: "memory");
        {
            const int s = tid >> 2, qt = tid & 3;
            v4u raw[4];
#pragma unroll
            for (int i = 0; i < 4; ++i) raw[i] = rawn[i];
            { const int un = (u + G < 1024) ? u + G : u; const bf16* srcn = PROJ + ((size_t)(un >> 2) * 128 + s) * NPROJ + PC_VS + (un & 3) * 128 + qt * 32;
#pragma unroll
              for (int i = 0; i < 4; ++i) rawn[i] = *(const GAS v4u*)(srcn + 8 * i); }
            asm volatile("" ::: "memory");
            float x[32]; float s1 = 0.f;
#pragma unroll
            for (int i = 0; i < 4; ++i)
#pragma unroll
                for (int c = 0; c < 4; ++c) { const unsigned w_ = raw[i][c]; const float a_ = gelu_tanh(__builtin_bit_cast(float, w_ << 16)), b_ = gelu_tanh(__builtin_bit_cast(float, w_ & 0xffff0000u)); x[i * 8 + c * 2] = a_; x[i * 8 + c * 2 + 1] = b_; s1 += a_ + b_; }
            s1 += __shfl_xor(s1, 1); s1 += __shfl_xor(s1, 2);
            const float mean = s1 * (1.f / 128.f); float s2 = 0.f;
#pragma unroll
            for (int i = 0; i < 32; ++i) { x[i] -= mean; s2 += x[i] * x[i]; }
            s2 += __shfl_xor(s2, 1); s2 += __shfl_xor(s2, 2);
            const float rstd = 1.f / sqrtf(s2 * (1.f / 128.f) + 1e-5f);
            const LAS float* lg = LNP + g * 128 + qt * 32; const LAS float* lb = LNP + 512 + g * 128 + qt * 32;
#pragma unroll
            for (int i = 0; i < 4; ++i) { const f32x4 g0 = *(const LAS f32x4*)(lg + 8 * i), g1 = *(const LAS f32x4*)(lg + 8 * i + 4), b0 = *(const LAS f32x4*)(lb + 8 * i), b1 = *(const LAS f32x4*)(lb + 8 * i + 4);
                v4u o; o.x = pg8::cvt_pk_bf16(x[8 * i] * rstd * g0.x + b0.x, x[8 * i + 1] * rstd * g0.y + b0.y); o.y = pg8::cvt_pk_bf16(x[8 * i + 2] * rstd * g0.z + b0.z, x[8 * i + 3] * rstd * g0.w + b0.w);
                o.z = pg8::cvt_pk_bf16(x[8 * i + 4] * rstd * g1.x + b1.x, x[8 * i + 5] * rstd * g1.y + b1.y); o.w = pg8::cvt_pk_bf16(x[8 * i + 6] * rstd * g1.z + b1.z, x[8 * i + 7] * rstd * g1.w + b1.w);
                *(LAS v4u*)(lds + off_b((unsigned)s, (unsigned)(qt * 4 + i))) = o; }
        }
        __syncthreads();
        {
            f32x4 acc[8];
#pragma unroll
            for (int dt = 0; dt < 8; ++dt) acc[dt] = (f32x4){0.f, 0.f, 0.f, 0.f};
#pragma unroll
            for (int ks = 0; ks < 4; ++ks) if (ks < nks) {
                const int sb = 32 * ks + 8 * g4;
                const f32x4 w0 = wq[ks][0], w1 = wq[ks][1];
                float wv[8] = {w0.x, w0.y, w0.z, w0.w, w1.x, w1.y, w1.z, w1.w};
#pragma unroll
                for (int j = 0; j < 8; ++j) if (sb + j > t) wv[j] = 0.f;
                v4u bw; bw.x = pg8::cvt_pk_bf16(wv[0], wv[1]); bw.y = pg8::cvt_pk_bf16(wv[2], wv[3]); bw.z = pg8::cvt_pk_bf16(wv[4], wv[5]); bw.w = pg8::cvt_pk_bf16(wv[6], wv[7]);
                const bf16x8 bfrag = __builtin_bit_cast(bf16x8, bw);
#pragma unroll
                for (int dt = 0; dt < 8; ++dt) {
                    const s16x4 lo = vtr(lds + off_b((unsigned)(sb + q), (unsigned)(2 * dt + (pp >> 1))) + 8 * (pp & 1));
                    const s16x4 hi = vtr(lds + off_b((unsigned)(sb + 4 + q), (unsigned)(2 * dt + (pp >> 1))) + 8 * (pp & 1));
                    const bf16x8 afrag = (bf16x8){lo[0], lo[1], lo[2], lo[3], hi[0], hi[1], hi[2], hi[3]};
                    acc[dt] = __builtin_amdgcn_mfma_f32_16x16x32_bf16(afrag, bfrag, acc[dt], 0, 0, 0);
                }
            }
#pragma unroll
            for (int dt = 0; dt < 8; ++dt) {
                const int d = g * 128 + 16 * dt + 4 * g4;
                const unsigned long long uu = uu8[dt];
                const float u0 = gelu_tanh(bf2f((unsigned short)uu)), u1 = gelu_tanh(bf2f((unsigned short)(uu >> 16))), u2 = gelu_tanh(bf2f((unsigned short)(uu >> 32))), u3 = gelu_tanh(bf2f((unsigned short)(uu >> 48)));
                const unsigned long long o = (unsigned long long)pg8::cvt_pk_bf16(u0 * (acc[dt][0] + bias), u1 * (acc[dt][1] + bias)) | ((unsigned long long)pg8::cvt_pk_bf16(u2 * (acc[dt][2] + bias), u3 * (acc[dt][3] + bias)) << 32);
                *(GAS unsigned long long*)(rowp + 512 + d) = o;
            }
        }
        __syncthreads();
    }
}

constexpr int DNA_PIECES = 57, DNU_PIECES = 2, DN_STEP_BYTES = (DNA_PIECES + DNU_PIECES) * 1024;
constexpr size_t DNA_CHUNK_BYTES = (size_t)DNA_PIECES * 1024, DNU_CHUNK_BYTES = 8 * DNU_PIECES * 1024;
__device__ __forceinline__ void glds16(const void* gsrc, LAS unsigned char* dst) { __builtin_amdgcn_global_load_lds((const unsigned*)gsrc, (LAS unsigned*)dst, 16, 0, 0); }
typedef float f32x2_t __attribute__((ext_vector_type(2))); typedef __bf16 bf16x2_t __attribute__((ext_vector_type(2)));
__device__ __forceinline__ unsigned cvtpk(float lo, float hi) { const f32x2_t v = {lo, hi}; const bf16x2_t b = __builtin_convertvector(v, bf16x2_t); return __builtin_bit_cast(unsigned, b); }

struct DnSet { bf16x8 F[14]; unsigned long long U; float gl; };
__device__ __forceinline__ void dn_set_load(DnSet& X, const unsigned char* a_step, const unsigned char* u_step, int w) {
#pragma unroll
    for (int ks = 0; ks < 4; ++ks) X.F[ks] = *(const GAS bf16x8*)(a_step + (w * 4 + ks) * 1024);
#pragma unroll
    for (int ks = 0; ks < 4; ++ks) X.F[4 + ks] = *(const GAS bf16x8*)(a_step + (16 + w * 4 + ks) * 1024);
#pragma unroll
    for (int ks = 0; ks < 2; ++ks) X.F[8 + ks] = *(const GAS bf16x8*)(a_step + (48 + w * 2 + ks) * 1024);
#pragma unroll
    for (int t = 0; t < 2; ++t)
#pragma unroll
        for (int ks = 0; ks < 2; ++ks) X.F[10 + 2 * t + ks] = *(const GAS bf16x8*)(a_step + (32 + (2 * w + t) * 2 + ks) * 1024);
    X.U = *(const GAS unsigned long long*)(u_step + (w >> 1) * 1024 + (w & 1) * 8);
    X.gl = *(const GAS float*)(a_step + 56 * 1024);
}
__device__ __forceinline__ void dn_scan_phase(LAS unsigned char* lds, const unsigned char* DNA, const unsigned char* DNU, bf16* ODN, int vcu, int wave_s) {
    if (vcu >= 256) return;
#define DN_BAR() do { asm volatile("s_waitcnt lgkmcnt(0)" ::: "memory"); __builtin_amdgcn_s_barrier(); asm volatile("" ::: "memory"); } while (0)
    if (wave_s >= 4) {
        for (int n = 0; n < 64; ++n) { DN_BAR(); DN_BAR(); }
        return;
    }
    const int lane = pg8::lane_id_fresh(), w = wave_s;
    const int bh = vcu >> 3, sl = vcu & 7, l15 = lane & 15, g4 = lane >> 4;
    const unsigned char* a_src = DNA + (size_t)bh * 64 * DNA_CHUNK_BYTES + lane * 16;
    const unsigned char* u_src = DNU + ((size_t)bh * 64 * 8 + sl) * (DNU_PIECES * 1024) + lane * 16;
    LAS unsigned char* XS = lds + lane * 16;
    LAS unsigned char* XV = lds + 4096 + lane * 16;
    bf16* orow = ODN + (size_t)vcu * (64 * 64 * 16) + l15;
    f32x4 S0 = (f32x4){0.f, 0.f, 0.f, 0.f}, S1 = S0;
    DnSet A, B, C;
    dn_set_load(A, a_src, u_src, w);
    dn_set_load(B, a_src + DNA_CHUNK_BYTES, u_src + DNU_CHUNK_BYTES, w);
    dn_set_load(C, a_src + 2 * DNA_CHUNK_BYTES, u_src + 2 * DNU_CHUNK_BYTES, w);
#define DN_STEP(X, nn) do { const int n_ = (nn); { \
        { v4u sw; sw.x = cvtpk(S0[0], S0[1]); sw.y = cvtpk(S0[2], S0[3]); sw.z = cvtpk(S1[0], S1[1]); sw.w = cvtpk(S1[2], S1[3]); *(LAS v4u*)(XS + w * 1024) = sw; } \
        DN_BAR(); \
        bf16x8 Sb[4]; _Pragma("unroll") for (int ks = 0; ks < 4; ++ks) Sb[ks] = *(const LAS bf16x8*)(XS + ks * 1024); \
        f32x4 P = (f32x4){__builtin_bit_cast(float, (unsigned)X.U << 16), __builtin_bit_cast(float, (unsigned)X.U & 0xffff0000u), __builtin_bit_cast(float, (unsigned)(X.U >> 32) << 16), __builtin_bit_cast(float, (unsigned)(X.U >> 32) & 0xffff0000u)}; \
        _Pragma("unroll") for (int ks = 0; ks < 4; ++ks) P = __builtin_amdgcn_mfma_f32_16x16x32_bf16(X.F[ks], Sb[ks], P, 0, 0, 0); \
        f32x4 O = (f32x4){0.f, 0.f, 0.f, 0.f}; \
        _Pragma("unroll") for (int ks = 0; ks < 4; ++ks) O = __builtin_amdgcn_mfma_f32_16x16x32_bf16(X.F[4 + ks], Sb[ks], O, 0, 0, 0); \
        { const unsigned long long hv = (unsigned long long)cvtpk(P[0], P[1]) | ((unsigned long long)cvtpk(P[2], P[3]) << 32); *(LAS unsigned long long*)(XV + (w >> 1) * 1024 + (w & 1) * 8) = hv; } \
        DN_BAR(); \
        bf16x8 Vb[2]; _Pragma("unroll") for (int ks = 0; ks < 2; ++ks) Vb[ks] = *(const LAS bf16x8*)(XV + ks * 1024); \
        _Pragma("unroll") for (int ks = 0; ks < 2; ++ks) O = __builtin_amdgcn_mfma_f32_16x16x32_bf16(X.F[8 + ks], Vb[ks], O, 0, 0, 0); \
        S0 = S0 * X.gl; S1 = S1 * X.gl; \
        _Pragma("unroll") for (int ks = 0; ks < 2; ++ks) { S0 = __builtin_amdgcn_mfma_f32_16x16x32_bf16(X.F[10 + ks], Vb[ks], S0, 0, 0, 0); S1 = __builtin_amdgcn_mfma_f32_16x16x32_bf16(X.F[12 + ks], Vb[ks], S1, 0, 0, 0); } \
        { bf16* ob = orow + (size_t)(n_ * 64 + 16 * w + 4 * g4) * 16; const unsigned p01_ = cvtpk(O[0], O[1]), p23_ = cvtpk(O[2], O[3]); ob[0] = (bf16)p01_; ob[16] = (bf16)(p01_ >> 16); ob[32] = (bf16)p23_; ob[48] = (bf16)(p23_ >> 16); } \
        { const int ns_ = n_ + 3 < 64 ? n_ + 3 : 63; dn_set_load(X, a_src + (size_t)ns_ * DNA_CHUNK_BYTES, u_src + (size_t)ns_ * DNU_CHUNK_BYTES, w); } } } while (0)
    _Pragma("unroll 1") for (int n = 0; n < 63; n += 3) { DN_STEP(A, n); DN_STEP(B, n + 1); DN_STEP(C, n + 2); }
    DN_STEP(A, 63);
#undef DN_STEP
#undef DN_BAR
    asm volatile("s_waitcnt vmcnt(0)" ::: "memory");
}

__device__ __forceinline__ void dn_final_phase(const bf16* ODN, bf16* PROJ, const float* norm_w, int gw, int NGW, int lane) {
    const f32x4 nw0 = *(const GAS f32x4*)(norm_w + ((8 * lane) & 127)), nw1 = *(const GAS f32x4*)(norm_w + ((8 * lane) & 127) + 4);
#define DNF_LOAD(mm, OV, ZV) do { const int bb_ = (mm) >> 12, nn_ = ((mm) >> 6) & 63, ii_ = (mm) & 63; \
        OV = *(const GAS v4u*)(ODN + ((((size_t)((bb_ * 4 + (lane >> 4)) * 8 + ((lane >> 1) & 7)) * 64 + nn_) * 64 + ii_) * 16 + 8 * (lane & 1))); ZV = *(const GAS v4u*)(PROJ + (size_t)(mm) * NPROJ + PC_Z + 8 * lane); } while (0)
    v4u ovn, zvn; DNF_LOAD(gw < NTOK ? gw : 0, ovn, zvn);
    for (int m = gw; m < NTOK; m += NGW) {
        const v4u ov = ovn, zv = zvn;
        { const int mn = (m + NGW < NTOK) ? m + NGW : m; DNF_LOAD(mn, ovn, zvn); }
        float o[8], z[8];
#pragma unroll
        for (int c = 0; c < 4; ++c) { o[2 * c] = __builtin_bit_cast(float, ov[c] << 16); o[2 * c + 1] = __builtin_bit_cast(float, ov[c] & 0xffff0000u); z[2 * c] = __builtin_bit_cast(float, zv[c] << 16); z[2 * c + 1] = __builtin_bit_cast(float, zv[c] & 0xffff0000u); }
        float ss = 0.f;
#pragma unroll
        for (int c = 0; c < 8; ++c) ss += o[c] * o[c];
        ss = ss + __builtin_bit_cast(float, __builtin_amdgcn_update_dpp(0, __builtin_bit_cast(int, ss), 0xB1, 0xf, 0xf, true));
        ss = ss + __builtin_bit_cast(float, __builtin_amdgcn_update_dpp(0, __builtin_bit_cast(int, ss), 0x4E, 0xf, 0xf, true));
        ss = ss + __builtin_bit_cast(float, __builtin_amdgcn_update_dpp(0, __builtin_bit_cast(int, ss), 0x141, 0xf, 0xf, true));
        ss = ss + __builtin_bit_cast(float, __builtin_amdgcn_update_dpp(0, __builtin_bit_cast(int, ss), 0x140, 0xf, 0xf, true));
        const float rs = 1.f / sqrtf(ss * (1.f / 128.f) + 1e-6f);
        const float nw[8] = {nw0.x, nw0.y, nw0.z, nw0.w, nw1.x, nw1.y, nw1.z, nw1.w};
        float y[8];
#pragma unroll
        for (int c = 0; c < 8; ++c) y[c] = o[c] * rs * nw[c] * z[c] * __builtin_amdgcn_rcpf(1.f + __builtin_amdgcn_exp2f(-1.4426950408889634f * z[c]));
        v4u w; w.x = pg8::cvt_pk_bf16(y[0], y[1]); w.y = pg8::cvt_pk_bf16(y[2], y[3]); w.z = pg8::cvt_pk_bf16(y[4], y[5]); w.w = pg8::cvt_pk_bf16(y[6], y[7]);
        *(GAS v4u*)(PROJ + (size_t)m * NPROJ + 8 * lane) = w;
    }
}

__device__ __forceinline__ float wave_sum_dpp(float v) {
    v = v + __builtin_bit_cast(float, __builtin_amdgcn_update_dpp(0, __builtin_bit_cast(int, v), 0xB1, 0xf, 0xf, true));
    v = v + __builtin_bit_cast(float, __builtin_amdgcn_update_dpp(0, __builtin_bit_cast(int, v), 0x4E, 0xf, 0xf, true));
    v = v + __builtin_bit_cast(float, __builtin_amdgcn_update_dpp(0, __builtin_bit_cast(int, v), 0x141, 0xf, 0xf, true));
    v = v + __builtin_bit_cast(float, __builtin_amdgcn_update_dpp(0, __builtin_bit_cast(int, v), 0x140, 0xf, 0xf, true));
    v = v + __builtin_bit_cast(float, __builtin_amdgcn_update_dpp(0, __builtin_bit_cast(int, v), 0x142, 0xa, 0xf, true));
    v = v + __builtin_bit_cast(float, __builtin_amdgcn_update_dpp(0, __builtin_bit_cast(int, v), 0x143, 0xc, 0xf, true));
    return __builtin_bit_cast(float, __builtin_amdgcn_readlane(__builtin_bit_cast(int, v), 63));
}

constexpr int XTAB_OFF = RING_BYTES + 2048, XTAB_BYTES = 1792;
__device__ __forceinline__ unsigned off_t64(unsigned row, unsigned ch) { return 128u * row + 16u * (ch ^ (row & 7u)); }
__device__ __forceinline__ bf16x8 pack8(const float (&v)[8]) { v4u w; w.x = cvtpk(v[0], v[1]); w.y = cvtpk(v[2], v[3]); w.z = cvtpk(v[4], v[5]); w.w = cvtpk(v[6], v[7]); return __builtin_bit_cast(bf16x8, w); }
__device__ __forceinline__ void unpack8(const v4u w, float (&v)[8]) {
#pragma unroll
    for (int c = 0; c < 4; ++c) { v[2 * c] = __builtin_bit_cast(float, w[c] << 16); v[2 * c + 1] = __builtin_bit_cast(float, w[c] & 0xffff0000u); }
}
__device__ __forceinline__ float conv_silu_rows(const bf16* src0, bool seq_start, const float* cw, LAS unsigned char* img, int lane) {
    float w[4][2];
#pragma unroll
    for (int j = 0; j < 4; ++j) { const f32x2_t t = *(const GAS f32x2_t*)(cw + j * 1536 + 2 * lane); w[j][0] = t[0]; w[j][1] = t[1]; }
    const GAS unsigned* gsrc = (const GAS unsigned*)(src0 + 2 * lane);
    unsigned raw[67];
#pragma unroll
    for (int r = 0; r < 3; ++r) raw[r] = seq_start ? 0u : gsrc[(long)(r - 3) * (NPROJ / 2)];
#pragma unroll
    for (int r = 0; r < 64; ++r) raw[3 + r] = gsrc[(size_t)r * (NPROJ / 2)];
    float myss = 0.f;
    const unsigned lbase = (unsigned)((lane & 3) * 4);
    f32x2_t w2[4];
#pragma unroll
    for (int j = 0; j < 4; ++j) w2[j] = (f32x2_t){w[j][0], w[j][1]};
    f32x2_t xw[67];
#pragma unroll
    for (int r = 0; r < 3; ++r) xw[r] = (f32x2_t){__builtin_bit_cast(float, raw[r] << 16), __builtin_bit_cast(float, raw[r] & 0xffff0000u)};
#pragma unroll
    for (int pz = 0; pz < 64; ++pz) {
        xw[pz + 3] = (f32x2_t){__builtin_bit_cast(float, raw[pz + 3] << 16), __builtin_bit_cast(float, raw[pz + 3] & 0xffff0000u)};
        f32x2_t y = w2[0] * xw[pz];
        y += w2[1] * xw[pz + 1]; y += w2[2] * xw[pz + 2]; y += w2[3] * xw[pz + 3];
        float y0 = y[0], y1 = y[1];
        y0 = y0 * __builtin_amdgcn_rcpf(1.f + __builtin_amdgcn_exp2f(-1.4426950408889634f * y0));
        y1 = y1 * __builtin_amdgcn_rcpf(1.f + __builtin_amdgcn_exp2f(-1.4426950408889634f * y1));
        const float tot = wave_sum_dpp(y0 * y0 + y1 * y1);
        myss = (lane == pz) ? tot : myss;
        *(LAS unsigned*)(img + off_b((unsigned)pz, (unsigned)(lane >> 2)) + lbase) = cvtpk(y0, y1);
    }
    return myss;
}

template <int STOP>
__device__ __forceinline__ void dn_prep_chunk(LAS unsigned char* IMG  , LAS float* tab, const bf16* PROJ, const nv::P& p, unsigned char* DNA, unsigned char* DNU, int ci) {
    int lane = pg8::lane_id_fresh();
    const int bh = ci >> 6, n = ci & 63, b = bh >> 2, h = bh & 3;
    int l15 = lane & 15, g4 = lane >> 4, q = l15 >> 2, pp = lane & 3;
    LAS float* t_gc = tab; LAS float* t_be = tab + 64; LAS float* t_rk = tab + 128; LAS float* t_rq = tab + 192; LAS float* t_eq = tab + 256; LAS float* t_ekk = tab + 320; LAS float* t_bg = tab + 384;
    const size_t tok = (size_t)b * 4096 + n * 64 + lane;
    const bf16* prow = PROJ + tok * NPROJ;
    const bf16* prow0 = PROJ + ((size_t)b * 4096 + n * 64) * NPROJ;
    unsigned char* dna = DNA + (size_t)ci * DNA_CHUNK_BYTES + lane * 16;
    (void)q; (void)pp;
    float gc, beta, eg, gc63;
    {
        const float araw = bf2f(prow[PC_A + h]), braw = bf2f(prow[PC_B + h]);
        const float xx = araw + p.dt_bias[h];
        const float sp = xx > 20.f ? xx : log1pf(expf(xx));
        gc = -expf(p.a_log[h]) * sp;
        beta = 1.f / (1.f + expf(-braw));
#pragma unroll
        for (int o = 1; o < 64; o <<= 1) { const float t = __shfl_up(gc, o); if (lane >= o) gc += t; }
        gc63 = __shfl(gc, 63);
        eg = expf(gc);
        const unsigned gb = __builtin_bit_cast(unsigned, expf(gc63));
        *(GAS v4u*)(dna + 56 * 1024) = (v4u){gb, gb, gb, gb};
        const float ssq = conv_silu_rows(prow0 + PC_Q + h * 128, n == 0, p.conv_w + h * 128, IMG, lane);
        const float rq = 0.08838834764831845f / sqrtf(ssq + 1e-6f);
        t_gc[lane] = gc; t_be[lane] = beta; t_rq[lane] = rq; t_eq[lane] = eg * rq;
    }
    LDS_WAIT(); asm volatile("" ::: "memory");
    if constexpr (STOP == 1) return;
    bf16x8 qF[4][4];
#pragma unroll
    for (int mt = 0; mt < 4; ++mt)
#pragma unroll
        for (int ks = 0; ks < 4; ++ks) qF[mt][ks] = *(const LAS bf16x8*)(IMG + off_b((unsigned)(16 * mt + l15), (unsigned)(4 * ks + g4)));
#pragma unroll
    for (int mt = 0; mt < 4; ++mt) {
        const float egi = t_eq[16 * mt + l15];
#pragma unroll
        for (int ks = 0; ks < 4; ++ks) {
            const unsigned long long lo = *(const LAS unsigned long long*)(IMG + off_b((unsigned)(16 * mt + l15), (unsigned)(4 * ks + (g4 >> 1))) + (g4 & 1) * 8);
            const unsigned long long hi = *(const LAS unsigned long long*)(IMG + off_b((unsigned)(16 * mt + l15), (unsigned)(4 * ks + 2 + (g4 >> 1))) + (g4 & 1) * 8);
            float t8[8]; unpack8((v4u){(unsigned)lo, (unsigned)(lo >> 32), (unsigned)hi, (unsigned)(hi >> 32)}, t8);
#pragma unroll
            for (int e = 0; e < 8; ++e) t8[e] *= egi;
            *(GAS bf16x8*)(dna + (16 + mt * 4 + ks) * 1024) = pack8(t8);
        }
    }
    LDS_WAIT(); asm volatile("" ::: "memory");
    {
        const float ssk = conv_silu_rows(prow0 + PC_K + h * 128, n == 0, p.conv_w + 512 + h * 128, IMG, lane);
        const float rk = 1.f / sqrtf(ssk + 1e-6f);
        t_rk[lane] = rk; t_ekk[lane] = expf(gc63 - gc) * rk; t_bg[lane] = beta * eg * rk;
    }
    LDS_WAIT(); asm volatile("" ::: "memory");
    if constexpr (STOP == 2) return;
    f32x4 Am[4][4];
    {
        bf16x8 kF[4][4];
#pragma unroll
        for (int mt = 0; mt < 4; ++mt)
#pragma unroll
            for (int ks = 0; ks < 4; ++ks) kF[mt][ks] = *(const LAS bf16x8*)(IMG + off_b((unsigned)(16 * mt + l15), (unsigned)(4 * ks + g4)));
#pragma unroll
        for (int mi = 0; mi < 4; ++mi) {
            const f32x4 gci = *(const LAS f32x4*)(t_gc + 16 * mi + 4 * g4), bei = *(const LAS f32x4*)(t_be + 16 * mi + 4 * g4), rki = *(const LAS f32x4*)(t_rk + 16 * mi + 4 * g4);
#pragma unroll
            for (int nj = 0; nj <= mi; ++nj) {
                f32x4 acc = (f32x4){0.f, 0.f, 0.f, 0.f};
#pragma unroll
                for (int ks = 0; ks < 4; ++ks) acc = __builtin_amdgcn_mfma_f32_16x16x32_bf16(kF[mi][ks], kF[nj][ks], acc, 0, 0, 0);
                const float gcj = t_gc[16 * nj + l15], rkj = t_rk[16 * nj + l15]; const int j = 16 * nj + l15;
#pragma unroll
                for (int r = 0; r < 4; ++r) { const int i = 16 * mi + 4 * g4 + r; acc[r] = (j < i) ? bei[r] * rki[r] * rkj * acc[r] * expf(gci[r] - gcj) : 0.f; }
                Am[mi][nj] = acc;
            }
        }
#pragma unroll
        for (int it = 0; it < 4; ++it) {
            const float gci = t_gc[16 * it + l15], rqi = t_rq[16 * it + l15]; const int i = 16 * it + l15;
            f32x4 kq[4];
#pragma unroll
            for (int jt = 0; jt < 4; ++jt) {
                f32x4 acc = (f32x4){0.f, 0.f, 0.f, 0.f};
                if (jt <= it) {
#pragma unroll
                    for (int ks = 0; ks < 4; ++ks) acc = __builtin_amdgcn_mfma_f32_16x16x32_bf16(kF[jt][ks], qF[it][ks], acc, 0, 0, 0);
                    const f32x4 gcj = *(const LAS f32x4*)(t_gc + 16 * jt + 4 * g4), rkj = *(const LAS f32x4*)(t_rk + 16 * jt + 4 * g4);
#pragma unroll
                    for (int r = 0; r < 4; ++r) { const int j = 16 * jt + 4 * g4 + r; acc[r] = (j <= i) ? acc[r] * rqi * rkj[r] * expf(gci - gcj[r]) : 0.f; }
                }
                kq[jt] = acc;
            }
#pragma unroll
            for (int ks = 0; ks < 2; ++ks) { const float t8[8] = {kq[2 * ks][0], kq[2 * ks][1], kq[2 * ks][2], kq[2 * ks][3], kq[2 * ks + 1][0], kq[2 * ks + 1][1], kq[2 * ks + 1][2], kq[2 * ks + 1][3]};
                *(GAS bf16x8*)(dna + (48 + it * 2 + ks) * 1024) = pack8(t8); }
        }
    }
    if constexpr (STOP == 3) return;
    bf16x8 ktr[8][2];
    {
#pragma unroll
        for (int ks = 0; ks < 2; ++ks) {
            const f32x4 ek0 = *(const LAS f32x4*)(t_ekk + 32 * ks + 4 * g4), ek1 = *(const LAS f32x4*)(t_ekk + 32 * ks + 16 + 4 * g4);
#pragma unroll
            for (int mt = 0; mt < 8; ++mt) {
                const s16x4 lo = vtr(IMG + off_b((unsigned)(32 * ks + 4 * g4 + q), (unsigned)(2 * mt + (pp >> 1))) + 8 * (pp & 1));
                const s16x4 hi = vtr(IMG + off_b((unsigned)(32 * ks + 16 + 4 * g4 + q), (unsigned)(2 * mt + (pp >> 1))) + 8 * (pp & 1));
                const float t8[8] = {bf2f((unsigned short)lo[0]) * ek0.x, bf2f((unsigned short)lo[1]) * ek0.y, bf2f((unsigned short)lo[2]) * ek0.z, bf2f((unsigned short)lo[3]) * ek0.w,
                                     bf2f((unsigned short)hi[0]) * ek1.x, bf2f((unsigned short)hi[1]) * ek1.y, bf2f((unsigned short)hi[2]) * ek1.z, bf2f((unsigned short)hi[3]) * ek1.w};
                *(GAS bf16x8*)(dna + (32 + mt * 2 + ks) * 1024) = pack8(t8);
            }
        }
#pragma unroll
        for (int dt = 0; dt < 8; ++dt)
#pragma unroll
            for (int ks = 0; ks < 2; ++ks) {
                const s16x4 lo = vtr(IMG + off_b((unsigned)(32 * ks + 8 * g4 + q), (unsigned)(2 * dt + (pp >> 1))) + 8 * (pp & 1));
                const s16x4 hi = vtr(IMG + off_b((unsigned)(32 * ks + 8 * g4 + 4 + q), (unsigned)(2 * dt + (pp >> 1))) + 8 * (pp & 1));
                ktr[dt][ks] = (bf16x8){lo[0], lo[1], lo[2], lo[3], hi[0], hi[1], hi[2], hi[3]};
            }
    }
    LDS_WAIT(); asm volatile("" ::: "memory");
    {
        LAS float* AL = (LAS float*)IMG;
#pragma unroll
        for (int mi = 0; mi < 4; ++mi)
#pragma unroll
            for (int nj = 0; nj <= mi; ++nj)
#pragma unroll
                for (int r = 0; r < 4; ++r) AL[(16 * mi + 4 * g4 + r) * 64 + 16 * nj + l15] = Am[mi][nj][r];
    }
    LDS_WAIT(); asm volatile("" ::: "memory");
    float T[64];
    {
        const LAS float* AL = (const LAS float*)IMG;
#pragma clang loop unroll(full)
        for (int i = 0; i < 64; ++i) {
            float v4[4] = {(lane == i) ? 1.f : 0.f, 0.f, 0.f, 0.f};
#pragma clang loop unroll(full)
            for (int j4 = 0; j4 < (i + 3) / 4; ++j4) {
                const f32x4 a = *(const LAS f32x4*)(AL + i * 64 + 4 * j4);
#pragma clang loop unroll(full)
                for (int e = 0; e < 4; ++e) if (4 * j4 + e < i) v4[e] -= a[e] * T[4 * j4 + e];
            }
            T[i] = (v4[0] + v4[1]) + (v4[2] + v4[3]);
        }
    }
    LDS_WAIT(); asm volatile("" ::: "memory");
    if constexpr (STOP == 4) return;
    lane = pg8::lane_id_fresh(); l15 = lane & 15; g4 = lane >> 4; q = l15 >> 2; pp = lane & 3;
    dna = DNA + (size_t)ci * DNA_CHUNK_BYTES + lane * 16;
    {
        const float bc = t_be[lane], bgc = t_bg[lane];
        LAS unsigned char* TB = IMG; LAS unsigned char* TBE = IMG + 8192;
#pragma unroll
        for (int i = 0; i < 64; ++i) { const unsigned o = off_t64((unsigned)i, (unsigned)(lane >> 3)) + (lane & 7) * 2;
            *(LAS unsigned short*)(TB + o) = (unsigned short)f2bf(T[i] * bc); *(LAS unsigned short*)(TBE + o) = (unsigned short)f2bf(T[i] * bgc); }
    }
    LDS_WAIT(); asm volatile("" ::: "memory");
    bf16x8 tb[4][2];
    {
#pragma unroll
        for (int it = 0; it < 4; ++it) {
            bf16x8 tbe[2];
#pragma unroll
            for (int ks = 0; ks < 2; ++ks) tbe[ks] = *(const LAS bf16x8*)(IMG + 8192 + off_t64((unsigned)(16 * it + l15), (unsigned)(4 * ks + g4)));
            f32x4 acc[8];
#pragma unroll
            for (int dt = 0; dt < 8; ++dt) { acc[dt] = (f32x4){0.f, 0.f, 0.f, 0.f};
#pragma unroll
                for (int ks = 0; ks < 2; ++ks) acc[dt] = __builtin_amdgcn_mfma_f32_16x16x32_bf16(ktr[dt][ks], tbe[ks], acc[dt], 0, 0, 0); }
#pragma unroll
            for (int ks = 0; ks < 4; ++ks) { const float t8[8] = {-acc[2 * ks][0], -acc[2 * ks][1], -acc[2 * ks][2], -acc[2 * ks][3], -acc[2 * ks + 1][0], -acc[2 * ks + 1][1], -acc[2 * ks + 1][2], -acc[2 * ks + 1][3]};
                *(GAS bf16x8*)(dna + (it * 4 + ks) * 1024) = pack8(t8); }
        }
#pragma unroll
        for (int mt = 0; mt < 4; ++mt)
#pragma unroll
            for (int ks = 0; ks < 2; ++ks) tb[mt][ks] = *(const LAS bf16x8*)(IMG + off_t64((unsigned)(16 * mt + l15), (unsigned)(4 * ks + g4)));
    }
    LDS_WAIT(); asm volatile("" ::: "memory");
    if constexpr (STOP == 5) return;
    (void)conv_silu_rows(prow0 + PC_V + h * 128, n == 0, p.conv_w + 1024 + h * 128, IMG, lane);
    LDS_WAIT(); asm volatile("" ::: "memory");
    {
        unsigned char* dnu = DNU + (size_t)ci * DNU_CHUNK_BYTES + lane * 16;
#pragma unroll
        for (int dt = 0; dt < 8; ++dt) {
            bf16x8 vt[2];
#pragma unroll
            for (int ks = 0; ks < 2; ++ks) {
                const s16x4 lo = vtr(IMG + off_b((unsigned)(32 * ks + 8 * g4 + q), (unsigned)(2 * dt + (pp >> 1))) + 8 * (pp & 1));
                const s16x4 hi = vtr(IMG + off_b((unsigned)(32 * ks + 8 * g4 + 4 + q), (unsigned)(2 * dt + (pp >> 1))) + 8 * (pp & 1));
                vt[ks] = (bf16x8){lo[0], lo[1], lo[2], lo[3], hi[0], hi[1], hi[2], hi[3]};
            }
            f32x4 u[4];
#pragma unroll
            for (int mt = 0; mt < 4; ++mt) { u[mt] = (f32x4){0.f, 0.f, 0.f, 0.f};
#pragma unroll
                for (int ks = 0; ks < 2; ++ks) u[mt] = __builtin_amdgcn_mfma_f32_16x16x32_bf16(tb[mt][ks], vt[ks], u[mt], 0, 0, 0); }
#pragma unroll
            for (int pc = 0; pc < 2; ++pc) { const float t8[8] = {u[2 * pc][0], u[2 * pc][1], u[2 * pc][2], u[2 * pc][3], u[2 * pc + 1][0], u[2 * pc + 1][1], u[2 * pc + 1][2], u[2 * pc + 1][3]};
                *(GAS bf16x8*)(dnu + (dt * 2 + pc) * 1024) = pack8(t8); }
        }
    }
    LDS_WAIT(); asm volatile("" ::: "memory");
}

template <int STOP>
__device__ __forceinline__ void dn_prep_phase(LAS unsigned char* lds, const bf16* PROJ, const nv::P& p, unsigned char* DNA, unsigned char* DNU, int G, int vcu, int wave_s) {
    LAS unsigned char* img = lds + wave_s * 16384; LAS float* tab = (LAS float*)(lds + XTAB_OFF + wave_s * XTAB_BYTES);
    for (int ci = vcu * 8 + wave_s; ci < 2048; ci += G * 8) dn_prep_chunk<STOP>(img, tab, PROJ, p, DNA, DNU, ci);
}


struct RouterArgs { const float* z; const bf16* mix; float* zout; bf16* H1BF; int* EID; float* WGT; int* LIST; int* CNT; const float *ln_g, *ln_b, *w_rg, *b_rg, *w_re, *b_re; };
__device__ __forceinline__ void router_fill(LAS float* dst, const float* W, int ldw, int col0, int tid) {
#pragma unroll
    for (int it = 0; it < 4; ++it) { const int qd = tid + it * NTHREADS, k = qd >> 1, half = qd & 1;
        const f32x4 v = *(const GAS f32x4*)(W + (size_t)k * ldw + col0 + half * 4);
        *(LAS f32x4*)(dst + half * 4096 + ((((k >> 7) * 4 + (k & 3)) * 32 + ((k >> 2) & 31)) * 4)) = v; }
}
__device__ __forceinline__ float half_sum_hi(float v) {
    v = v + __builtin_bit_cast(float, __builtin_amdgcn_update_dpp(0, __builtin_bit_cast(int, v), 0xB1, 0xf, 0xf, true));
    v = v + __builtin_bit_cast(float, __builtin_amdgcn_update_dpp(0, __builtin_bit_cast(int, v), 0x4E, 0xf, 0xf, true));
    v = v + __builtin_bit_cast(float, __builtin_amdgcn_update_dpp(0, __builtin_bit_cast(int, v), 0x141, 0xf, 0xf, true));
    v = v + __builtin_bit_cast(float, __builtin_amdgcn_update_dpp(0, __builtin_bit_cast(int, v), 0x140, 0xf, 0xf, true));
    v = v + __builtin_bit_cast(float, __builtin_amdgcn_update_dpp(0, __builtin_bit_cast(int, v), 0x142, 0xa, 0xf, true));
    return v;
}
__device__ __forceinline__ float half_sum_all(float v, bool hi) {
    v = half_sum_hi(v);
    const float a = __builtin_bit_cast(float, __builtin_amdgcn_readlane(__builtin_bit_cast(int, v), 31)), b = __builtin_bit_cast(float, __builtin_amdgcn_readlane(__builtin_bit_cast(int, v), 63));
    return hi ? b : a;
}
__device__ __forceinline__ void router_phase(LAS unsigned char* lds, const RouterArgs& A, int gw, int NGW, int wave_s) {
    const int lane = pg8::lane_id_fresh(), tid = wave_s * 64 + lane, hl = lane & 31; const bool hi = lane >= 32;
    LAS float* WG = (LAS float*)lds; LAS int* HIST = (LAS int*)(lds + 32768); LAS int* BASE = HIST + 64; LAS int* RR = HIST + 128;
    LAS f32x4* LNG = (LAS f32x4*)(lds + 36864); LAS f32x4* LNB = (LAS f32x4*)(lds + 40960); LAS float* BRE = (LAS float*)(lds + 45056);
    router_fill(WG, A.w_rg, 8, 0, tid);
    LAS float* BRG = BRE + 64;
    if (tid < 64) { HIST[tid] = 0; BRE[tid] = A.b_re[tid]; }
    if (tid < 8) BRG[tid] = A.b_rg[tid];
    if (tid < 256) LNG[tid] = *((const GAS f32x4*)A.ln_g + tid); else LNB[tid - 256] = *((const GAS f32x4*)A.ln_b + (tid - 256));
    __syncthreads();
    const int hoff = hi ? NGW : 0;
    f32x4 xa[8], xb[8]; unsigned long long ma[8], mb_[8];
#define RT_LOAD(xs, ms, mm) do { const int mm_ = (mm) < NTOK ? (mm) : 0; const GAS f32x4* zr_ = (const GAS f32x4*)(A.z + (size_t)mm_ * DM) + hl; const GAS unsigned long long* mr_ = (const GAS unsigned long long*)(A.mix + (size_t)mm_ * DM) + hl; \
        _Pragma("unroll") for (int j_ = 0; j_ < 8; ++j_) { xs[j_] = zr_[32 * j_]; ms[j_] = mr_[32 * j_]; } } while (0)
#define RT_WLOAD(buf, jj) do { _Pragma("unroll") for (int c4_ = 0; c4_ < 4; ++c4_) { wq[buf][2 * c4_] = *(const GAS f32x4*)(wre + ((jj) * 4 + c4_) * 128); wq[buf][2 * c4_ + 1] = *(const GAS f32x4*)(wre + ((jj) * 4 + c4_) * 128 + 4096); } } while (0)
    RT_LOAD(xa, ma, gw + hoff); RT_LOAD(xb, mb_, gw + 2 * NGW + hoff);
    auto body = [&](f32x4 (&xs)[8], unsigned long long (&ms)[8], const int mb, const int slot) __attribute__((always_inline)) {
        const int m = mb + hoff; const bool valid = m < NTOK;
        f32x4 v[8];
#pragma unroll
        for (int j = 0; j < 8; ++j) { const unsigned long long mm = ms[j];
            v[j].x = ALPHA_F * xs[j].x + bf2f((unsigned short)mm); v[j].y = ALPHA_F * xs[j].y + bf2f((unsigned short)(mm >> 16));
            v[j].z = ALPHA_F * xs[j].z + bf2f((unsigned short)(mm >> 32)); v[j].w = ALPHA_F * xs[j].w + bf2f((unsigned short)(mm >> 48)); }
        float s = 0.f;
#pragma unroll
        for (int j = 0; j < 8; ++j) s += (v[j].x + v[j].y) + (v[j].z + v[j].w);
        const float mean = half_sum_all(s, hi) * (1.f / DM); float s2 = 0.f;
#pragma unroll
        for (int j = 0; j < 8; ++j) { v[j] = v[j] - mean; s2 += (v[j].x * v[j].x + v[j].y * v[j].y) + (v[j].z * v[j].z + v[j].w * v[j].w); }
        const float rstd = 1.f / sqrtf(half_sum_all(s2, hi) * (1.f / DM) + 1e-5f);
        GAS unsigned long long* hb = (GAS unsigned long long*)(A.H1BF + (size_t)(valid ? m : NTOK) * DM) + hl;
#pragma unroll
        for (int j = 0; j < 8; ++j) { const f32x4 g = LNG[hl + 32 * j], bb = LNB[hl + 32 * j]; v[j] = v[j] * rstd * g + bb;
            hb[32 * j] = (unsigned long long)pg8::cvt_pk_bf16(v[j].x, v[j].y) | ((unsigned long long)pg8::cvt_pk_bf16(v[j].z, v[j].w) << 32); }
        f32x2_t ga[4];
#pragma unroll
        for (int c = 0; c < 4; ++c) ga[c] = (f32x2_t){0.f, 0.f};
#pragma unroll
        for (int j = 0; j < 8; ++j)
#pragma unroll
            for (int c4 = 0; c4 < 4; ++c4) { const float hv = v[j][c4]; const f32x2_t h2 = {hv, hv}; const LAS float* wp = WG + ((j * 4 + c4) * 32 + hl) * 4;
                const f32x4 w0 = *(const LAS f32x4*)wp, w1 = *(const LAS f32x4*)(wp + 4096);
                ga[0] += h2 * w0.xy; ga[1] += h2 * w0.zw; ga[2] += h2 * w1.xy; ga[3] += h2 * w1.zw; }
        float gl[8]; int gi = 0; float gm = -INFINITY;
#pragma unroll
        for (int c = 0; c < 8; ++c) { gl[c] = half_sum_hi(ga[c >> 1][c & 1]) + BRG[c]; if (gl[c] > gm) { gm = gl[c]; gi = c; } }
        float den = 0.f;
#pragma unroll
        for (int c = 0; c < 8; ++c) den += __builtin_amdgcn_exp2f((gl[c] - gm) * 1.4426950408889634f);
        const float pg = 1.f / den;
        const int gia = __builtin_amdgcn_readlane(gi, 31), gib = __builtin_amdgcn_readlane(gi, 63), gs = hi ? gib : gia;
        f32x2_t ea_[4];
#pragma unroll
        for (int c = 0; c < 4; ++c) ea_[c] = (f32x2_t){0.f, 0.f};
        const float* wre = A.w_re + gs * 8192 + hl * 4;
        f32x4 wq[2][8];
        RT_WLOAD(0, 0); RT_WLOAD(1, 1);
        asm volatile("" : "+v"(ea_[0]), "+v"(ea_[1]), "+v"(ea_[2]), "+v"(ea_[3]) :: "memory");
#pragma unroll
        for (int j = 0; j < 8; ++j) {
#pragma unroll
            for (int c4 = 0; c4 < 4; ++c4) { const float hv = v[j][c4]; const f32x2_t h2 = {hv, hv}; const f32x4 w0 = wq[j & 1][2 * c4], w1 = wq[j & 1][2 * c4 + 1];
                ea_[0] += h2 * w0.xy; ea_[1] += h2 * w0.zw; ea_[2] += h2 * w1.xy; ea_[3] += h2 * w1.zw; }
            if (j + 2 < 8) { RT_WLOAD(j & 1, j + 2); asm volatile("" ::: "memory"); }
            if (j == 5) { RT_LOAD(xs, ms, mb + 4 * NGW + hoff); asm volatile("" ::: "memory"); }
        }
        float el[8]; int i0 = 0, i1 = 0; float v0 = -INFINITY, v1 = -INFINITY;
#pragma unroll
        for (int c = 0; c < 8; ++c) { el[c] = half_sum_hi(ea_[c >> 1][c & 1]) + BRE[gs * 8 + c]; if (el[c] > v0) { v0 = el[c]; i0 = c; } }
#pragma unroll
        for (int c = 0; c < 8; ++c) { if (c != i0 && el[c] > v1) { v1 = el[c]; i1 = c; } }
        const float e1 = __builtin_amdgcn_exp2f((v1 - v0) * 1.4426950408889634f), sm = 1.f / (1.f + e1);
        if (hl == 31 && valid) {
            const int ea = gs * 8 + i0, eb = gs * 8 + i1;
            LAS int* rr = RR + (wave_s * 16 + slot + (hi ? 1 : 0)) * 6;
            rr[4] = (int)(f2bf(pg * sm) << 16); rr[5] = (int)(f2bf(pg * e1 * sm) << 16);
            rr[0] = ea; rr[1] = __hip_atomic_fetch_add(&HIST[ea], 1, __ATOMIC_RELAXED, __HIP_MEMORY_SCOPE_WORKGROUP); rr[2] = eb; rr[3] = __hip_atomic_fetch_add(&HIST[eb], 1, __ATOMIC_RELAXED, __HIP_MEMORY_SCOPE_WORKGROUP);
        }
    };
    const int nquads = (NTOK - gw + 4 * NGW - 1) / (4 * NGW);
    int nrows = 0;
    _Pragma("unroll") for (int q_ = 0; q_ < 4; ++q_) { const int mb = gw + q_ * 4 * NGW;
        body(xa, ma, mb, 4 * q_); __builtin_amdgcn_sched_barrier(0);
        body(xb, mb_, mb + 2 * NGW, 4 * q_ + 2); __builtin_amdgcn_sched_barrier(0); }
    nrows = 16; (void)nquads;
    { const int ns_ = (NTOK - gw + NGW - 1) / NGW; nrows = ns_ < nrows ? ns_ : nrows; }
#undef RT_LOAD
#undef RT_WLOAD
    __syncthreads();
    if (tid < 64) BASE[tid] = __hip_atomic_fetch_add(&A.CNT[tid], HIST[tid], __ATOMIC_RELAXED, __HIP_MEMORY_SCOPE_AGENT);
    __syncthreads();
    if (lane < nrows && gw + lane * NGW < NTOK) {
        const LAS int* rr = RR + (wave_s * 16 + lane) * 6; const int m = gw + lane * NGW;
        A.LIST[(size_t)rr[0] * NTOK + BASE[rr[0]] + rr[1]] = (2 * m) | rr[4];
        A.LIST[(size_t)rr[2] * NTOK + BASE[rr[2]] + rr[3]] = (2 * m + 1) | rr[5];
    }
}

__device__ __forceinline__ void xbf_ba_phase(LAS unsigned char* lds, const float* X, const float* w_in, bf16* XBF, bf16* PROJ, int gw, int NGW, int wave_s) {
    const int lane = pg8::lane_id_fresh(), tid = wave_s * 64 + lane, hl = lane & 31; const bool hi = lane >= 32;
    LAS float* WG = (LAS float*)lds;
    router_fill(WG, w_in, nv::INC, 2048, tid);
    __syncthreads();
    const int hoff = hi ? NGW : 0;
    f32x4 xa[8], xb[8];
#define XB_LOAD(xs, mm) do { const int mm_ = (mm) < NTOK ? (mm) : 0; const GAS f32x4* zr_ = (const GAS f32x4*)(X + (size_t)mm_ * DM) + hl; \
        _Pragma("unroll") for (int j_ = 0; j_ < 8; ++j_) xs[j_] = zr_[32 * j_]; } while (0)
    XB_LOAD(xa, gw + hoff); XB_LOAD(xb, gw + 2 * NGW + hoff);
    auto body = [&](f32x4 (&xs)[8], const int mb) __attribute__((always_inline)) {
        const int m = mb + hoff; const bool valid = m < NTOK;
        f32x4 v[8];
#pragma unroll
        for (int j = 0; j < 8; ++j) v[j] = xs[j];
        XB_LOAD(xs, mb + 4 * NGW + hoff);
        GAS unsigned long long* hb = (GAS unsigned long long*)(XBF + (size_t)(valid ? m : NTOK) * DM) + hl;
#pragma unroll
        for (int j = 0; j < 8; ++j) hb[32 * j] = (unsigned long long)pg8::cvt_pk_bf16(v[j].x, v[j].y) | ((unsigned long long)pg8::cvt_pk_bf16(v[j].z, v[j].w) << 32);
        f32x2_t ga[4];
#pragma unroll
        for (int c = 0; c < 4; ++c) ga[c] = (f32x2_t){0.f, 0.f};
#pragma unroll
        for (int j = 0; j < 8; ++j) {
#pragma unroll
            for (int c4 = 0; c4 < 4; ++c4) { const float hv = v[j][c4]; const f32x2_t h2 = {hv, hv}; const LAS float* wp = WG + ((j * 4 + c4) * 32 + hl) * 4;
                const f32x4 w0 = *(const LAS f32x4*)wp, w1 = *(const LAS f32x4*)(wp + 4096);
                ga[0] += h2 * w0.xy; ga[1] += h2 * w0.zw; ga[2] += h2 * w1.xy; ga[3] += h2 * w1.zw; }
            asm volatile("" ::: "memory");
        }
        float gl[8];
#pragma unroll
        for (int c = 0; c < 8; ++c) gl[c] = half_sum_hi(ga[c >> 1][c & 1]);
        if (hl == 31 && valid) { v4u o; o.x = pg8::cvt_pk_bf16(gl[0], gl[1]); o.y = pg8::cvt_pk_bf16(gl[2], gl[3]); o.z = pg8::cvt_pk_bf16(gl[4], gl[5]); o.w = pg8::cvt_pk_bf16(gl[6], gl[7]);
            *(GAS v4u*)(PROJ + (size_t)m * NPROJ + PC_B) = o; }
    };
    const int nquads = (NTOK - gw + 4 * NGW - 1) / (4 * NGW);
    _Pragma("unroll 1") for (int q_ = 0; q_ < nquads; ++q_) { const int mb = gw + q_ * 4 * NGW; body(xa, mb); body(xb, mb + 2 * NGW); }
#undef XB_LOAD
    __syncthreads();
}

__device__ __forceinline__ void final_phase(float* OUT, const bf16* H1B, const bf16* YEXP, const float* ln_g, const float* ln_b, int gw, int NGW, int lane) {
    f32x4 lg[4], lb[4];
#pragma unroll
    for (int j = 0; j < 4; ++j) { lg[j] = *((const GAS f32x4*)ln_g + lane + 64 * j); lb[j] = *((const GAS f32x4*)ln_b + lane + 64 * j); }
    unsigned long long h0[4], a0[4], b0[4], h1[4], a1[4], b1[4];
#define FIN_LOAD(hn, an, bn, mm) do { const int mm_ = (mm) < NTOK ? (mm) : gw; const GAS unsigned long long* hq_ = (const GAS unsigned long long*)(H1B + (size_t)mm_ * DM) + lane; const GAS unsigned long long* y0_ = (const GAS unsigned long long*)(YEXP + (size_t)(2 * mm_) * DM) + lane; \
        _Pragma("unroll") for (int j_ = 0; j_ < 4; ++j_) { hn[j_] = hq_[64 * j_]; an[j_] = y0_[64 * j_]; bn[j_] = y0_[DM / 4 + 64 * j_]; } } while (0)
#define FIN_ROW(hc, ac, bc, mrow) do { const int m_ = (mrow); \
        f32x4 v[4]; float s = 0.f; \
        _Pragma("unroll") for (int j = 0; j < 4; ++j) { const unsigned long long hh = hc[j], y0 = ac[j], y1 = bc[j]; \
            v[j].x = ALPHA_F * bf2f((unsigned short)hh) + bf2f((unsigned short)y0) + bf2f((unsigned short)y1); \
            v[j].y = ALPHA_F * bf2f((unsigned short)(hh >> 16)) + bf2f((unsigned short)(y0 >> 16)) + bf2f((unsigned short)(y1 >> 16)); \
            v[j].z = ALPHA_F * bf2f((unsigned short)(hh >> 32)) + bf2f((unsigned short)(y0 >> 32)) + bf2f((unsigned short)(y1 >> 32)); \
            v[j].w = ALPHA_F * bf2f((unsigned short)(hh >> 48)) + bf2f((unsigned short)(y0 >> 48)) + bf2f((unsigned short)(y1 >> 48)); \
            s += (v[j].x + v[j].y) + (v[j].z + v[j].w); } \
        asm volatile("" ::: "memory"); FIN_LOAD(hc, ac, bc, m_ + 2 * NGW); asm volatile("" ::: "memory");     \
        const float mean = wave_sum_dpp(s) * (1.f / DM); float s2 = 0.f; \
        _Pragma("unroll") for (int j = 0; j < 4; ++j) { v[j] = v[j] - mean; s2 += (v[j].x * v[j].x + v[j].y * v[j].y) + (v[j].z * v[j].z + v[j].w * v[j].w); } \
        const float rstd = 1.f / sqrtf(wave_sum_dpp(s2) * (1.f / DM) + 1e-5f); \
        GAS f32x4* orow = (GAS f32x4*)(OUT + (size_t)m_ * DM) + lane; \
        _Pragma("unroll") for (int j = 0; j < 4; ++j) orow[64 * j] = v[j] * rstd * lg[j] + lb[j]; } while (0)
    FIN_LOAD(h0, a0, b0, gw); FIN_LOAD(h1, a1, b1, gw + NGW);
    _Pragma("unroll 1") for (int q_ = 0; q_ < 8; ++q_) { const int m = gw + 2 * q_ * NGW;
        FIN_ROW(h0, a0, b0, m); __builtin_amdgcn_sched_barrier(0);
        FIN_ROW(h1, a1, b1, m + NGW); __builtin_amdgcn_sched_barrier(0); }
#undef FIN_ROW
#undef FIN_LOAD
}

__device__ __forceinline__ void stagger_wait(unsigned ticks) { const unsigned long long t0_ = rt(); while (rt() - t0_ < (unsigned long long)ticks) __builtin_amdgcn_s_sleep(8); }
#ifndef STAG1
#define STAG1 0
#endif
#ifndef STAG1_L
#define STAG1_L 2
#endif
#ifndef STAG5
#define STAG5 0
#endif
#ifndef STAG7
#define STAG7 0
#endif
#ifndef STAG8
#define STAG8 0
#endif
#ifndef REPEAT_MASK
#define REPEAT_MASK 0
#endif
#define REPS(k) ((((REPEAT_MASK) >> (k)) & 1) + 1)
__global__ void __launch_bounds__(NTHREADS, 2) fwd_megakernel(MK a) {
    extern __shared__ __attribute__((aligned(16))) unsigned char lds_raw[];
    cg::grid_group grid = cg::this_grid();
    LAS unsigned char* lds = (LAS unsigned char*)lds_raw;
    volatile LAS unsigned* MISC = (volatile LAS unsigned*)(lds + MISC_OFF);
    LAS int* PREF = (LAS int*)(lds + PREF_OFF);
    const int tid = threadIdx.x; const int wave_s = __builtin_amdgcn_readfirstlane(tid >> 6);
    const int G = gridDim.x; const int bx = blockIdx.x; const int vcu = (G % 8 == 0) ? (bx % 8) * (G / 8) + bx / 8 : bx;
    unsigned char* ws = a.ws; const nv::P& p = a.p;
    gu32* ctl = (gu32*)(ws + WS_CTL);
    bf16* WIN = (bf16*)(ws + WS_WIN); bf16* WOUT = (bf16*)(ws + WS_WOUT); bf16* XBF = (bf16*)(ws + WS_A); bf16* PROJ = (bf16*)(ws + WS_B);
    bf16* WGU = (bf16*)(ws + WS_WGU); bf16* WD = (bf16*)(ws + WS_WD); bf16* HID = (bf16*)(ws + WS_A); bf16* H1BF = (bf16*)(ws + WS_H1BF); bf16* YEXP = (bf16*)(ws + WS_YEXP);
    int* LIST = (int*)(ws + WS_LIST); int* EID = (int*)(ws + WS_ROUTE); float* WGT = (float*)(ws + WS_ROUTE + 512 * 1024);
    int* CNT = (int*)(ws + WS_CTL) + CW_CNT;
    for (int u = tid; u < (LDS_BYTES - LDSCTL_OFF) / 4; u += NTHREADS) ((LAS unsigned*)(lds + LDSCTL_OFF))[u] = 0u;
    __syncthreads();
    if (bx == 0) { for (int u = tid; u < XCD_BAR_WORDS + 64; u += NTHREADS) __hip_atomic_store((unsigned*)(ctl + CW_BAR) + u, 0u, RLX_AGENT);
                   for (int u = tid; u < 2048; u += NTHREADS) __hip_atomic_store((unsigned*)(ctl + CW_CNT) + u, 0u, RLX_AGENT); }
    grid.sync();
    XcdBarrier bar = xcd_barrier_post((unsigned*)(ctl + CW_BAR), MISC + 8);
#define FRESH() const int lane = pg8::lane_id_fresh(), wave = wave_s; const int tid_ = wave_s * 64 + lane; const int gtid = (int)blockIdx.x * NTHREADS + tid_, gsize = G * NTHREADS, gw = vcu * NWAVES + wave, NGW = G * NWAVES; (void)lane; (void)gtid; (void)gsize; (void)gw; (void)NGW;

    _Pragma("unroll 1") for (int rep_ = 0; rep_ < REPS(0); ++rep_) {
    {
        FRESH();
        LAS float* scr = (LAS float*)(lds + wave * 16384);
        constexpr int NB = 96, KB = DM / 64;
        for (int it = gw; it < NB * KB; it += NGW) { const int nb = it % NB, kb = it / NB; const int nsrc = nb < 64 ? nb * 32 : 2056 + (nb - 64) * 32, ndst = nb * 32;
            p0_transpose_item(p.w_in, nv::INC, DM, kb * 64, nsrc, WIN, ndst, scr, lane); }
        for (int i = gtid; i < 8 * DM; i += gsize) { const int j = (int)(i / DM), k = (int)(i % DM); WIN[(size_t)(PC_B + j) * DM + k] = (bf16)f2bf(p.w_in[(size_t)k * nv::INC + 2048 + j]); }
        for (int i = gtid; i < (long)(NPROJ - 3080) * DM / 8; i += gsize) *(GAS v4u*)(WIN + (size_t)3080 * DM + i * 8) = (v4u){0u, 0u, 0u, 0u};
        for (int it = gw; it < 16 * 32; it += NGW) { const int nb = it & 31, kb = it >> 5; p0_transpose_item(p.w_out, DM, DM, kb * 64, nb * 32, WOUT, nb * 32, scr, lane); }
        for (int d = gtid; d < 8 * 8192; d += gsize) { const int g = d >> 13, r = d & 8191, hh = r >> 12, rr = r & 4095, c = rr & 3, ll = (rr >> 2) & 31, jc = rr >> 7, k = 128 * (jc >> 2) + 4 * ll + (jc & 3);
            ((float*)(ws + WS_WREP))[d] = p.w_re[(size_t)k * 64 + g * 8 + 4 * hh + c]; }
    }
    __syncthreads();
    xbf_ba_phase(lds, p.x, p.w_in, XBF, PROJ, vcu * NWAVES + wave_s, G * NWAVES, wave_s);
    xcd_barrier(bar);
    }
    _Pragma("unroll 1") for (int rep_ = 0; rep_ < REPS(1); ++rep_) {
    {
        constexpr int NIT = 32768 + 16384, NITC = NIT - GEMM_WGS * CONV_SG;
        if (bx < GEMM_WGS) {
            if (STAG1 && ((bx >> 3) % STAG1_L)) stagger_wait(STAG1 * ((bx >> 3) % STAG1_L));
            pg8::DenseOrder S; S.init(XBF, DM, WIN, NTOK, 3072, DM, GEMM_WGS, bx);
            pg8::EpiBf16 E{PROJ, NPROJ};
            pg8::gemm_phase<pg8::EpiBf16, pg8::DenseOrder, true>(lds, S, E, nullptr, wave_s);
            const int lane = pg8::lane_id_fresh();
            LAS float* scr = (LAS float*)(lds + wave_s * 16384);
            p0_experts(p.w_gate, p.w_up, p.w_down, WGU, WD, scr, NITC + bx * CONV_SG + wave_s, NWAVES, NITC + (bx + 1) * CONV_SG, lane);
        } else {
            const int lane = pg8::lane_id_fresh();
            LAS float* scr = (LAS float*)(lds + wave_s * 16384);
            p0_experts(p.w_gate, p.w_up, p.w_down, WGU, WD, scr, (bx - GEMM_WGS) * NWAVES + wave_s, (G - GEMM_WGS) * NWAVES, NITC, lane);
        }
    }
    xcd_barrier(bar);
    }
    unsigned char* DNA = (unsigned char*)p.out; unsigned char* DNU = ws + WS_A + 32 * MiB; bf16* ODN = (bf16*)(ws + WS_A);
    _Pragma("unroll 1") for (int rep_ = 0; rep_ < REPS(2); ++rep_) {
    dn_prep_phase<0>(lds, PROJ, p, DNA, DNU, G, vcu, wave_s);
    xcd_barrier(bar);
    }
    _Pragma("unroll 1") for (int rep_ = 0; rep_ < REPS(3); ++rep_) {
    dn_scan_phase(lds, DNA, DNU, ODN, vcu, wave_s);
    xcd_barrier(bar);
    }
    _Pragma("unroll 1") for (int rep_ = 0; rep_ < REPS(5); ++rep_) {
    sgu_phase(lds, PROJ, p, G, vcu, wave_s);
    { FRESH(); dn_final_phase(ODN, PROJ, p.dn_norm_w, gw, NGW, lane); }
    xcd_barrier(bar);
    }
    _Pragma("unroll 1") for (int rep_ = 0; rep_ < REPS(6); ++rep_) {
    {
        if (STAG5 && ((bx >> 3) & 1)) stagger_wait(STAG5);
        pg8::DenseOrder S; S.init(PROJ, NPROJ, WOUT, NTOK, DM, DM, G, bx);
        pg8::EpiBf16 E{(bf16*)(ws + WS_A), DM};
        pg8::gemm_phase<pg8::EpiBf16, pg8::DenseOrder, true>(lds, S, E, nullptr, wave_s);
    }
    xcd_barrier(bar);
    }
    {
        RouterArgs RA{p.x, (const bf16*)(ws + WS_A), p.out, H1BF, EID, WGT, LIST, CNT, p.ln1_g, p.ln1_b, p.w_rg, p.b_rg, (const float*)(ws + WS_WREP), p.b_re};
        router_phase(lds, RA, vcu * NWAVES + wave_s, G * NWAVES, wave_s);
    }
    xcd_barrier(bar);
    if (threadIdx.x == 0) { int s = 0, rs = 0; for (int e = 0; e < NEXP; ++e) { const int c_ = CNT[e]; PREF[e] = s; s += ((c_ + 255) >> 8) * 4; PREF[192 + e] = rs; rs += c_; } PREF[NEXP] = s; }
    if (wave_s == 1) { const int l_ = pg8::lane_id_fresh(); PREF[128 + l_] = CNT[l_]; }
    __syncthreads();
    _Pragma("unroll 1") for (int rep_ = 0; rep_ < REPS(7); ++rep_) {
    {
        if (STAG7 && ((bx >> 3) & 1)) stagger_wait(STAG7);
        pg8::GroupedOrder S{H1BF, WGU, LIST, PREF, DM, DM, 1024, NTOK, 1, 4, G, bx, NEXP};
        pg8::EpiHid E{HID, LIST, CNT, NTOK, PREF};
        pg8::gemm_phase<pg8::EpiHid, pg8::GroupedOrder, true>(lds, S, E, CNT, wave_s);
    }
    xcd_barrier(bar);
    }
    _Pragma("unroll 1") for (int rep_ = 0; rep_ < REPS(8); ++rep_) {
    {
        if (STAG8 && ((bx >> 3) & 1)) stagger_wait(STAG8);
        pg8::GroupedOrder S{HID, WD, LIST, PREF, DEXP, DEXP, 1024, NTOK, -1, 4, G, bx, NEXP};
        pg8::EpiYexp E{YEXP, LIST, WGT, NTOK};
        pg8::gemm_phase<pg8::EpiYexp, pg8::GroupedOrder, true>(lds, S, E, CNT, wave_s);
    }
    xcd_barrier(bar);
    }
    { FRESH(); final_phase(p.out, H1BF, YEXP, p.ln2_g, p.ln2_b, gw, NGW, lane); }
#if defined(GHOSTPREP)
    xcd_barrier(bar);
    dn_prep_phase<GHOSTPREP>(lds, (const bf16*)(ws + WS_B), p, ws + WS_C, ws + WS_C + 120 * MiB, G, vcu, wave_s);
#endif
#if defined(GHOST6)
    xcd_barrier(bar);
    { RouterArgs RA{p.out, (const bf16*)(ws + WS_A), (float*)(ws + WS_B), (bf16*)(ws + WS_C), (int*)(ws + WS_A), (float*)(ws + WS_A + 1 * MiB), (int*)(ws + WS_A + 2 * MiB), (int*)(ws + WS_CTL) + CW_CNT + 1024, p.ln1_g, p.ln1_b, p.w_rg, p.b_rg, (const float*)(ws + WS_WREP), p.b_re};
      router_phase(lds, RA, vcu * NWAVES + wave_s, G * NWAVES, wave_s); }
#endif
#if defined(GHOST9)
    xcd_barrier(bar);
    { FRESH(); final_phase((float*)(ws + WS_A), H1BF, (const bf16*)(ws + WS_C), p.ln2_g, p.ln2_b, gw, NGW, lane); }
#endif
}

extern "C" void kernel_launch(void* const* d_in, const int* in_sizes, int n_in, void* d_out, int out_size, void* d_ws, size_t ws_size, hipStream_t stream) {
    if (ws_size < WS_END || n_in != 22) { fprintf(stderr, "kernel_launch: bad ws/n_in\n"); return; }
    static int grid_blocks = 0;
    if (!grid_blocks) {
        int dev = 0, cus = 0, per_cu = 0;
        (void)hipGetDevice(&dev);
        (void)hipDeviceGetAttribute(&cus, hipDeviceAttributeMultiprocessorCount, dev);
        (void)hipFuncSetAttribute((const void*)fwd_megakernel, hipFuncAttributeMaxDynamicSharedMemorySize, (int)LDS_BYTES);
        (void)hipOccupancyMaxActiveBlocksPerMultiprocessor(&per_cu, (const void*)fwd_megakernel, NTHREADS, LDS_BYTES);
        if (per_cu < 1) { fprintf(stderr, "kernel_launch: occupancy query says %d\n", per_cu); per_cu = 1; }
        grid_blocks = cus;
        if (grid_blocks != 256) { fprintf(stderr, "kernel_launch: this build is laid out for 256 CUs (found %d)\n", cus); grid_blocks = 0; return; }
    }
    MK a{}; bind(a.p, d_in, (float*)d_out); a.ws = (unsigned char*)d_ws;
    void* args[] = {&a};
    hipError_t e = hipLaunchCooperativeKernel((const void*)fwd_megakernel, dim3(grid_blocks), dim3(NTHREADS), args, LDS_BYTES, stream);
    if (e != hipSuccess) fprintf(stderr, "cooperative launch failed: %s (grid %d)\n", hipGetErrorString(e), grid_blocks);
}
```
